# Optimizing an MI355X kernel written in HIP

```python
import math
import jax
import jax.numpy as jnp
from jax import lax
import numpy as np

D_MODEL = 1024
BATCH = 32
SEQ = 2048
DEPTH = 2
DEC_BATCH = 16
DEC_SEQ = 64
PAST_LEN = 1024

CHUNK = 64
N_MIXERS = 2
N_ATTN_LAYERS = (DEPTH + 1) // 2
N_SSM_LAYERS = DEPTH // 2
N_HEADS = 16
N_KV_HEADS = 4
HEAD_DIM = D_MODEL // N_HEADS
Q_PER_KV = N_HEADS // N_KV_HEADS
QKV_DIM = (N_HEADS + 2 * N_KV_HEADS) * HEAD_DIM
ROT_DIM = HEAD_DIM // 4
ROPE_THETA = 500000.0
WINDOW = 128
BAND_CHUNKS = WINDOW // CHUNK
GROUP_SIZE = 16
N_GROUPS = D_MODEL // GROUP_SIZE
STATE_DIM = 64
D_FF = 2816
CONV_WIDTH = 3
NORM_EPS = 1e-6
NEG_INF = -1e30

kernel_name = 'swa_sink_s5_convffn_stream_step'


def rms_norm(x, g):
    x32 = x.astype(jnp.float32)
    y = x32 * lax.rsqrt(jnp.mean(x32 * x32, axis=-1, keepdims=True) + NORM_EPS) * g.astype(jnp.float32)
    return y.astype(x.dtype)


def partial_rope(x, pos):
    half = ROT_DIM // 2
    inv_freq = jnp.power(jnp.float32(ROPE_THETA), -jnp.arange(half, dtype=jnp.float32) * (2.0 / ROT_DIM))
    ang = pos.astype(jnp.float32)[:, None] * inv_freq[None, :]
    cos = jnp.cos(ang)[None, :, None, :]
    sin = jnp.sin(ang)[None, :, None, :]
    xf = x.astype(jnp.float32)
    x1 = xf[..., :half]
    x2 = xf[..., half:ROT_DIM]
    out = jnp.concatenate([x1 * cos - x2 * sin, x2 * cos + x1 * sin, xf[..., ROT_DIM:]], axis=-1)
    return out.astype(x.dtype)


def qkv_project(h, w_qkv, b_qkv, pos):
    b, t, _ = h.shape
    qkv = h @ w_qkv + b_qkv
    nq = N_HEADS * HEAD_DIM
    nk = N_KV_HEADS * HEAD_DIM
    q = qkv[..., :nq].reshape(b, t, N_HEADS, HEAD_DIM)
    k = qkv[..., nq:nq + nk].reshape(b, t, N_KV_HEADS, HEAD_DIM)
    v = qkv[..., nq + nk:].reshape(b, t, N_KV_HEADS, HEAD_DIM)
    return partial_rope(q, pos), partial_rope(k, pos), v


def sink_softmax(s, sink, mask=None):
    if mask is not None:
        s = jnp.where(mask, s, NEG_INF)
    m = jnp.maximum(jnp.max(s, axis=-1, keepdims=True), sink)
    p = jnp.exp(s - m)
    return p / (jnp.sum(p, axis=-1, keepdims=True) + jnp.exp(sink - m))


def attn_prompt(h, w_qkv, b_qkv, sinks, w_o, b_o):
    b, s_len, _ = h.shape
    n_c = s_len // CHUNK
    q, k, v = qkv_project(h, w_qkv, b_qkv, jnp.arange(s_len))
    qb = q.reshape(b, n_c, CHUNK, N_KV_HEADS, Q_PER_KV, HEAD_DIM)
    pad = ((0, 0), (BAND_CHUNKS * CHUNK, 0), (0, 0), (0, 0))
    kp = jnp.pad(k, pad).reshape(b, n_c + BAND_CHUNKS, CHUNK, N_KV_HEADS, HEAD_DIM)
    vp = jnp.pad(v, pad).reshape(b, n_c + BAND_CHUNKS, CHUNK, N_KV_HEADS, HEAD_DIM)
    kb = jnp.concatenate([kp[:, j:j + n_c] for j in range(BAND_CHUNKS + 1)], axis=2)
    vb = jnp.concatenate([vp[:, j:j + n_c] for j in range(BAND_CHUNKS + 1)], axis=2)
    sc = jnp.einsum('bnqhgd,bnkhd->bnhgqk', qb, kb).astype(jnp.float32) * (HEAD_DIM ** -0.5)
    key_pos = (jnp.arange(n_c)[:, None] - BAND_CHUNKS) * CHUNK + jnp.arange((BAND_CHUNKS + 1) * CHUNK)[None, :]
    mask = (key_pos >= 0)[None, :, None, None, None, :]
    sink = sinks.astype(jnp.float32).reshape(N_KV_HEADS, Q_PER_KV)[None, None, :, :, None, None]
    p = sink_softmax(sc, sink, mask)
    o = jnp.einsum('bnhgqk,bnkhd->bnqhgd', p.astype(vb.dtype), vb).reshape(b, s_len, D_MODEL)
    return o @ w_o + b_o, k[:, -WINDOW:], v[:, -WINDOW:]


def attn_sample(h, ck, cv, w_qkv, b_qkv, sinks, w_o, b_o):
    b, t, _ = h.shape
    q, k, v = qkv_project(h, w_qkv, b_qkv, PAST_LEN + jnp.arange(t))
    kk = jnp.concatenate([ck.astype(k.dtype), k], axis=1)
    vv = jnp.concatenate([cv.astype(v.dtype), v], axis=1)
    qg = q.reshape(b, t, N_KV_HEADS, Q_PER_KV, HEAD_DIM)
    sc = jnp.einsum('bqhgd,bkhd->bhgqk', qg, kk).astype(jnp.float32) * (HEAD_DIM ** -0.5)
    sink = sinks.astype(jnp.float32).reshape(N_KV_HEADS, Q_PER_KV)[None, :, :, None, None]
    p = sink_softmax(sc, sink)
    o = jnp.einsum('bhgqk,bkhd->bqhgd', p.astype(vv.dtype), vv).reshape(b, t, D_MODEL)
    w_rows = ck.shape[1]
    return o @ w_o + b_o, kk[:, -w_rows:], vv[:, -w_rows:]


def _affine_combine(e1, e2):
    ar1, ai1, br1, bi1 = e1
    ar2, ai2, br2, bi2 = e2
    return (ar2 * ar1 - ai2 * ai1,
            ar2 * ai1 + ai2 * ar1,
            ar2 * br1 - ai2 * bi1 + br2,
            ar2 * bi1 + ai2 * br1 + bi2)


def s5_discretize(lam_re, lam_im, log_dt, b_re, b_im):
    lr = lam_re.astype(jnp.float32)
    li = lam_im.astype(jnp.float32)
    dt = jnp.exp(log_dt.astype(jnp.float32))[:, None]
    mag = jnp.exp(lr * dt)
    lbar_re = mag * jnp.cos(li * dt)
    lbar_im = mag * jnp.sin(li * dt)
    nr = lbar_re - 1.0
    ni = lbar_im
    den = lr * lr + li * li
    cr = (nr * lr + ni * li) / den
    ci = (ni * lr - nr * li) / den
    br = b_re.astype(jnp.float32)
    bi = b_im.astype(jnp.float32)
    bbar_re = cr[..., None] * br - ci[..., None] * bi
    bbar_im = cr[..., None] * bi + ci[..., None] * br
    return lbar_re, lbar_im, bbar_re, bbar_im


def s5_mixer(h, h0_re, h0_im, lam_re, lam_im, log_dt, b_re, b_im, c_re, c_im, d_skip, w_glu, b_glu):
    b, t, _ = h.shape
    blk = min(t, CHUNK)
    n_blk = t // blk
    u = h.astype(jnp.float32).reshape(b, n_blk, blk, N_GROUPS, GROUP_SIZE).transpose(1, 0, 2, 3, 4)
    lr, li, bbr, bbi = s5_discretize(lam_re, lam_im, log_dt, b_re, b_im)
    cr = c_re.astype(jnp.float32)
    ci = c_im.astype(jnp.float32)

    def block(carry, u_blk):
        hr, hi = carry
        xr = jnp.einsum('blgi,gpi->blgp', u_blk, bbr)
        xi = jnp.einsum('blgi,gpi->blgp', u_blk, bbi)
        xr = xr.at[:, 0].add(lr * hr - li * hi)
        xi = xi.at[:, 0].add(lr * hi + li * hr)
        ar = jnp.broadcast_to(lr, xr.shape)
        ai = jnp.broadcast_to(li, xi.shape)
        _, _, sr, si = lax.associative_scan(_affine_combine, (ar, ai, xr, xi), axis=1)
        y = jnp.einsum('blgp,gip->blgi', sr, cr) - jnp.einsum('blgp,gip->blgi', si, ci)
        return (sr[:, -1], si[:, -1]), y

    (hr, hi), ys = lax.scan(block, (h0_re.astype(jnp.float32), h0_im.astype(jnp.float32)), u)
    y = ys.transpose(1, 0, 2, 3, 4).reshape(b, t, D_MODEL) + d_skip.astype(jnp.float32) * h.astype(jnp.float32)
    z = jax.nn.gelu(y).astype(h.dtype)
    ag = z @ w_glu + b_glu
    out = ag[..., :D_MODEL] * jax.nn.sigmoid(ag[..., D_MODEL:])
    return out, hr, hi


def conv_ffn(h, prev, w_up, conv_w, conv_b, w_down):
    t = h.shape[1]
    up = h @ w_up
    full = jnp.concatenate([prev.astype(up.dtype), up], axis=1)
    c = conv_b
    for j in range(CONV_WIDTH):
        c = c + conv_w[j] * full[:, j:j + t]
    y = (jax.nn.gelu(c[..., :D_FF]) * c[..., D_FF:]) @ w_down
    return y, full[:, -(CONV_WIDTH - 1):]


def setup_inputs(seed: int = 0) -> dict:
    key = jax.random.key(seed)
    ks = iter(jax.random.split(key, 40))
    f32 = jnp.float32

    def nrm(shape, scale=1.0):
        return jax.random.normal(next(ks), shape, f32) * scale

    na, ns = N_ATTN_LAYERS, N_SSM_LAYERS
    win_rows = min(WINDOW, PAST_LEN)
    lam_im = jnp.pi * jnp.arange(STATE_DIM, dtype=f32)[None, None, :] + nrm((ns, N_GROUPS, STATE_DIM), 0.01)
    return {
        'x_prompt': nrm((BATCH, SEQ, D_MODEL)),
        'x_sample': nrm((DEC_BATCH, DEC_SEQ, D_MODEL)),
        'cache_k': nrm((na, DEC_BATCH, win_rows, N_KV_HEADS, HEAD_DIM)),
        'cache_v': nrm((na, DEC_BATCH, win_rows, N_KV_HEADS, HEAD_DIM)),
        'state_ssm_re': nrm((ns, DEC_BATCH, N_GROUPS, STATE_DIM), 0.5),
        'state_ssm_im': nrm((ns, DEC_BATCH, N_GROUPS, STATE_DIM), 0.5),
        'cache_conv': nrm((DEPTH, DEC_BATCH, CONV_WIDTH - 1, 2 * D_FF)),
        'g_pre_mix': 1.0 + nrm((DEPTH, D_MODEL), 0.05),
        'g_post_mix': 1.0 + nrm((DEPTH, D_MODEL), 0.05),
        'g_pre_ffn': 1.0 + nrm((DEPTH, D_MODEL), 0.05),
        'g_post_ffn': 1.0 + nrm((DEPTH, D_MODEL), 0.05),
        'w_qkv': nrm((na, D_MODEL, QKV_DIM), D_MODEL ** -0.5),
        'b_qkv': nrm((na, QKV_DIM), 0.02),
        'attn_sinks': nrm((na, N_HEADS), 0.5),
        'w_o': nrm((na, D_MODEL, D_MODEL), D_MODEL ** -0.5),
        'b_o': nrm((na, D_MODEL), 0.02),
        'ssm_lam_re': -0.5 + nrm((ns, N_GROUPS, STATE_DIM), 0.01),
        'ssm_lam_im': lam_im,
        'ssm_log_dt': jax.random.uniform(next(ks), (ns, N_GROUPS), f32, math.log(1e-3), math.log(1e-1)),
        'ssm_b_re': nrm((ns, N_GROUPS, STATE_DIM, GROUP_SIZE), (2 * GROUP_SIZE) ** -0.5),
        'ssm_b_im': nrm((ns, N_GROUPS, STATE_DIM, GROUP_SIZE), (2 * GROUP_SIZE) ** -0.5),
        'ssm_c_re': nrm((ns, N_GROUPS, GROUP_SIZE, STATE_DIM), (2 * STATE_DIM) ** -0.5),
        'ssm_c_im': nrm((ns, N_GROUPS, GROUP_SIZE, STATE_DIM), (2 * STATE_DIM) ** -0.5),
        'ssm_d': nrm((ns, D_MODEL)),
        'w_glu': nrm((ns, D_MODEL, 2 * D_MODEL), D_MODEL ** -0.5),
        'b_glu': nrm((ns, 2 * D_MODEL), 0.02),
        'w_up': nrm((DEPTH, D_MODEL, 2 * D_FF), D_MODEL ** -0.5),
        'conv_w': nrm((DEPTH, CONV_WIDTH, 2 * D_FF), CONV_WIDTH ** -0.5),
        'conv_b': nrm((DEPTH, 2 * D_FF), 0.02),
        'w_down': nrm((DEPTH, D_FF, D_MODEL), D_FF ** -0.5),
    }


def reference(x_prompt, x_sample, cache_k, cache_v, state_ssm_re, state_ssm_im, cache_conv,
              g_pre_mix, g_post_mix, g_pre_ffn, g_post_ffn,
              w_qkv, b_qkv, attn_sinks, w_o, b_o,
              ssm_lam_re, ssm_lam_im, ssm_log_dt, ssm_b_re, ssm_b_im, ssm_c_re, ssm_c_im, ssm_d, w_glu, b_glu,
              w_up, conv_w, conv_b, w_down):
    xp, xs = x_prompt, x_sample
    bp = xp.shape[0]
    k_p, v_p, k_s, v_s = [], [], [], []
    re_p, im_p, re_s, im_s = [], [], [], []
    conv_p, conv_s = [], []
    for i in range(DEPTH):
        j = i // N_MIXERS
        hp = rms_norm(xp, g_pre_mix[i])
        hs = rms_norm(xs, g_pre_mix[i])
        if i % N_MIXERS == 0:
            mp, kpi, vpi = attn_prompt(hp, w_qkv[j], b_qkv[j], attn_sinks[j], w_o[j], b_o[j])
            ms, ksi, vsi = attn_sample(hs, cache_k[j], cache_v[j], w_qkv[j], b_qkv[j], attn_sinks[j], w_o[j], b_o[j])
            k_p.append(kpi)
            v_p.append(vpi)
            k_s.append(ksi)
            v_s.append(vsi)
        else:
            ssm_params = (ssm_lam_re[j], ssm_lam_im[j], ssm_log_dt[j], ssm_b_re[j], ssm_b_im[j],
                          ssm_c_re[j], ssm_c_im[j], ssm_d[j], w_glu[j], b_glu[j])
            h0 = jnp.zeros((bp, N_GROUPS, STATE_DIM), jnp.float32)
            mp, hrp, hip = s5_mixer(hp, h0, h0, *ssm_params)
            ms, hrs, his = s5_mixer(hs, state_ssm_re[j], state_ssm_im[j], *ssm_params)
            re_p.append(hrp)
            im_p.append(hip)
            re_s.append(hrs)
            im_s.append(his)
        xp = xp + rms_norm(mp, g_post_mix[i])
        xs = xs + rms_norm(ms, g_post_mix[i])
        hp = rms_norm(xp, g_pre_ffn[i])
        hs = rms_norm(xs, g_pre_ffn[i])
        fp, cpi = conv_ffn(hp, jnp.zeros((bp, CONV_WIDTH - 1, 2 * D_FF), hp.dtype), w_up[i], conv_w[i], conv_b[i], w_down[i])
        fs, csi = conv_ffn(hs, cache_conv[i], w_up[i], conv_w[i], conv_b[i], w_down[i])
        conv_p.append(cpi)
        conv_s.append(csi)
        xp = xp + rms_norm(fp, g_post_ffn[i])
        xs = xs + rms_norm(fs, g_post_ffn[i])
    return (xp, xs,
            jnp.stack(k_p), jnp.stack(v_p), jnp.stack(k_s), jnp.stack(v_s),
            jnp.stack(re_p), jnp.stack(im_p), jnp.stack(re_s), jnp.stack(im_s),
            jnp.stack(conv_p), jnp.stack(conv_s))
```

```cpp
#include <hip/hip_runtime.h>
#include <hip/hip_cooperative_groups.h>
#include <cstdio>
#include <cstdint>
namespace cg = cooperative_groups;

#define LAS __attribute__((address_space(3)))
typedef unsigned short bf16_t;
typedef short bf16x8 __attribute__((ext_vector_type(8)));
typedef short s16x4 __attribute__((ext_vector_type(4)));
typedef float f32x4 __attribute__((ext_vector_type(4)));
typedef float f32x16 __attribute__((ext_vector_type(16)));
typedef unsigned u32x4 __attribute__((ext_vector_type(4)));
typedef unsigned u32x2 __attribute__((ext_vector_type(2)));

constexpr int DM = 1024, NB = 32, SEQ = 2048, MP = NB * SEQ, DB = 16, DS = 64, MS = DB * DS, MT = MP + MS;
constexpr int QKVD = 1536, FF = 2816, FF2 = 5632, NSEG = MT / 64;
constexpr int KVROWS = MP + DB * 192;
constexpr float EPS = 1e-6f, LOG2E = 1.4426950408889634f, QSCALE = 0.125f * 1.4426950408889634f;
constexpr size_t O_Y = 0, O_KP = (size_t)MT * DM, O_VP = O_KP + (size_t)NB * 128 * 256, O_KS = O_VP + (size_t)NB * 128 * 256, O_VS = O_KS + (size_t)DB * 128 * 256,
                 O_REP = O_VS + (size_t)DB * 128 * 256, O_IMP = O_REP + NB * 4096, O_RES = O_IMP + NB * 4096, O_IMS = O_RES + DB * 4096,
                 O_CP = O_IMS + DB * 4096, O_CS = O_CP + (size_t)2 * NB * 2 * FF2, O_END = O_CS + (size_t)2 * DB * 2 * FF2;
constexpr size_t MiB = 1u << 20;
constexpr size_t WS_WQKV = 1 * MiB, WS_WO = 4 * MiB, WS_WGLU = 6 * MiB, WS_WUP = 10 * MiB, WS_WDN = 32 * MiB, WS_ROPE = 43 * MiB, WS_SS = 44 * MiB,
                 WS_A = 54 * MiB, WS_MB = 185 * MiB, WS_E = 316 * MiB, WS_G = 406 * MiB, WS_Q = WS_G, WS_K = WS_G + 132 * MiB, WS_V = WS_K + 34 * MiB, WS_END = WS_G + 358 * MiB;
static_assert(WS_WUP + (size_t)2 * FF2 * DM * 2 <= WS_WDN && WS_WDN + (size_t)2 * DM * FF * 2 <= WS_ROPE && WS_SS + (size_t)MT * 32 * 4 <= WS_A, "ws map 1");
static_assert(WS_A + (size_t)MT * DM * 2 <= WS_MB && WS_MB + (size_t)MT * DM * 2 <= WS_E && WS_E + (size_t)NSEG * 4 * FF2 * 4 <= WS_G, "ws map 2");
static_assert(WS_Q + (size_t)MT * DM * 2 <= WS_K && WS_K + (size_t)KVROWS * 256 * 2 <= WS_V && WS_V + (size_t)KVROWS * 256 * 2 <= WS_END && WS_G + (size_t)MT * FF * 2 <= WS_END, "ws map 3");

__device__ __forceinline__ unsigned cvt_pk_bf16(float lo, float hi) { unsigned r; asm volatile("v_cvt_pk_bf16_f32 %0, %1, %2" : "=v"(r) : "v"(lo), "v"(hi)); return r; }
__device__ __forceinline__ float bf2f(unsigned short b) { return __uint_as_float((unsigned)b << 16); }
__device__ __forceinline__ float gelu_tanh(float x) {
    const float x2 = x * x, u = x * (0.7978845608f + 0.0356774081f * x2);
    const float e = __builtin_amdgcn_exp2f(-2.885390082f * u);
    return x * __builtin_amdgcn_rcpf(1.0f + e);
}
__device__ __forceinline__ float sigmoid_f(float v) { return __builtin_amdgcn_rcpf(1.0f + __builtin_amdgcn_exp2f(-LOG2E * v)); }
__device__ __forceinline__ float wave_sum(float v) {
#pragma unroll
    for (int o = 1; o < 64; o <<= 1) v += __shfl_xor(v, o);
    return v;
}
template <int CTRL> __device__ __forceinline__ float dpp_f(float x) { return __builtin_bit_cast(float, __builtin_amdgcn_update_dpp(0, __builtin_bit_cast(int, x), CTRL, 0xf, 0xf, false)); }

namespace pg8 {
constexpr int BM = 256, BK = 64, HALF = 128, HTB = HALF * BK * 2, STAGE_BYTES = 8 * HTB, NXCD = 8, WGM = 8;
__host__ __device__ __forceinline__ int lds_byte(int r, int c) { const int st = (r >> 4) * 2 + (c >> 5), rr = r & 15, cc = c & 31, ob = rr * 64 + cc * 2; return st * 1024 + (ob ^ (((ob >> 9) & 1) << 5)); }
__host__ __device__ __forceinline__ void stage_rc(int b, int& R, int& C) { const int st = b / 1024, sb = b % 1024, swz = sb ^ (((sb >> 9) & 1) << 5); R = (st >> 1) * 16 + swz / 64; C = (st & 1) * 32 + (swz % 64) / 2; }
__host__ __device__ __forceinline__ int perm32(int rho) { const int n = rho >> 4, i = rho & 15; return 8 * (i >> 2) + 4 * n + (i & 3); }
struct Unit { int pm, pn; };
struct Gemm { const bf16_t* A; const bf16_t* Bt; int M, N, K; };
struct StaticOrder {
    int nM, nN, nwg, G, c;
    __device__ void init(int M, int N, int G_, int c_) { nM = M / BM; nN = N / BM; nwg = nM * nN; G = G_; c = c_; }
    __device__ bool next(int i, Unit& u) const {
        const long L = (long)i * G + c; if (L >= nwg) return false;
        int wgid = (int)L; { const int q = nwg / NXCD, r = nwg % NXCD, xcd = wgid % NXCD, off = wgid / NXCD; wgid = (xcd < r ? xcd * (q + 1) : r * (q + 1) + (xcd - r) * q) + off; }
        const int nig = WGM * nN, gid = wgid / nig, fm = gid * WGM, gsz = (nM - fm) < WGM ? (nM - fm) : WGM;
        u.pm = fm + ((wgid % nig) % gsz); u.pn = (wgid % nig) / gsz; return true;
    }
};
template <class Epi, bool ALIGN_EPI, bool SP2>
__device__ __forceinline__ void gemm_phase(LAS unsigned char* lds, const Gemm g, const StaticOrder& S, const Epi& E) {
    const int tid = threadIdx.x, wid = __builtin_amdgcn_readfirstlane(tid >> 6), lane = tid & 63, wr = wid >> 2, wc = wid & 3, fr = lane & 15, fq = lane >> 4;
    const int K = g.K, nt = K / BK;
    unsigned voffA[2], voffB[2];
#pragma unroll
    for (int i = 0; i < 2; ++i) { int R, C; stage_rc(tid * 16 + i * 8192, R, C); const int Rb = Epi::PERM ? ((R & ~31) + perm32(R & 31)) : R;
        voffA[i] = (unsigned)(R * K + C) * 2u; voffB[i] = (unsigned)(Rb * K + C) * 2u; }
    const size_t kstep = (size_t)(BK * 2);
    const size_t hstep = (size_t)HALF * K * 2;
    const size_t tstep = 2 * hstep;
    const unsigned ldsw = (unsigned)wid * 1024u;
    const int aoff = lds_byte(wr * 64 + fr, fq * 8), boff = lds_byte(wc * 32 + fr, fq * 8);
#define PG8_SA(b, h) (((b) * 2 + (h)) * HTB)
#define PG8_SB(b, h) ((4 + (b) * 2 + (h)) * HTB)
#define PG8_STAGE(bufoff, gbase, voff) do { _Pragma("unroll") for (int _i = 0; _i < 2; ++_i) \
        __builtin_amdgcn_global_load_lds((const unsigned*)((const char*)(gbase) + (voff)[_i]), (LAS unsigned*)(lds + (bufoff) + ldsw + _i * 8192), 16, 0, 0); } while (0)
#define PG8_LDA(dst, b, h) do { _Pragma("unroll") for (int m = 0; m < 4; ++m) _Pragma("unroll") for (int k = 0; k < 2; ++k) dst[m][k] = *(const LAS bf16x8*)(lds + PG8_SA(b, h) + aoff + m * 2048 + k * 1024); } while (0)
#define PG8_LDB(dst, b, h) do { _Pragma("unroll") for (int n = 0; n < 2; ++n) _Pragma("unroll") for (int k = 0; k < 2; ++k) dst[n][k] = *(const LAS bf16x8*)(lds + PG8_SB(b, h) + boff + n * 2048 + k * 1024); } while (0)
#define PG8_MMA(ai, bj, At, Bt) do { __builtin_amdgcn_s_setprio(1); _Pragma("unroll") for (int m = 0; m < 4; ++m) _Pragma("unroll") for (int n = 0; n < 2; ++n) _Pragma("unroll") for (int k = 0; k < 2; ++k) \
        acc[ai][bj][m][n] = __builtin_amdgcn_mfma_f32_16x16x32_bf16(Bt[n][k], At[m][k], acc[ai][bj][m][n], 0, 0, 0); __builtin_amdgcn_s_setprio(0); } while (0)
#define PG8_WAIT_V(n) asm volatile("s_waitcnt vmcnt(" #n ")" ::: "memory")
#define PG8_WAIT_L(n) asm volatile("s_waitcnt lgkmcnt(" #n ")" ::: "memory")
#define PG8_BAR __builtin_amdgcn_s_barrier()
#define PG8_SCHED __builtin_amdgcn_sched_barrier(0)
    Unit cur, nxt; int ui = 0;
    if (!S.next(0, cur)) return;
    f32x4 acc[2][2][4][2];
#pragma unroll
    for (int a = 0; a < 2; ++a)
#pragma unroll
        for (int b = 0; b < 2; ++b)
#pragma unroll
            for (int m = 0; m < 4; ++m)
#pragma unroll
                for (int n = 0; n < 2; ++n) acc[a][b][m][n] = (f32x4){0.f, 0.f, 0.f, 0.f};
    bf16x8 At[4][2], B0[2][2], B1[2][2];
    const char* cA = (const char*)g.A + (size_t)cur.pm * tstep; const char* cB = (const char*)g.Bt + (size_t)cur.pn * tstep;
    if constexpr (SP2) {
        PG8_STAGE(PG8_SB(0, 0), cB, voffB); PG8_STAGE(PG8_SB(0, 1), cB + hstep, voffB); PG8_STAGE(PG8_SA(0, 0), cA, voffA); PG8_STAGE(PG8_SA(0, 1), cA + hstep, voffA);
        if (wr == 1) PG8_BAR;
        PG8_WAIT_V(2); PG8_BAR;
        PG8_STAGE(PG8_SB(1, 0), cB + kstep, voffB); PG8_STAGE(PG8_SA(1, 0), cA + kstep, voffA); PG8_STAGE(PG8_SB(1, 1), cB + hstep + kstep, voffB);
        PG8_WAIT_V(6); PG8_BAR;
    } else {
        PG8_STAGE(PG8_SB(0, 0), cB, voffB); PG8_STAGE(PG8_SA(0, 0), cA, voffA); PG8_STAGE(PG8_SB(0, 1), cB + hstep, voffB); PG8_STAGE(PG8_SA(0, 1), cA + hstep, voffA);
        if (wr == 1) PG8_BAR;
        PG8_WAIT_V(4); PG8_BAR;
        PG8_STAGE(PG8_SB(1, 0), cB + kstep, voffB); PG8_STAGE(PG8_SA(1, 0), cA + kstep, voffA); PG8_STAGE(PG8_SB(1, 1), cB + hstep + kstep, voffB);
        PG8_WAIT_V(6); PG8_BAR;
    }
    for (;;) {
        const bool has_next = S.next(ui + 1, nxt);
        const char* nA = has_next ? (const char*)g.A + (size_t)nxt.pm * tstep : cA; const char* nB = has_next ? (const char*)g.Bt + (size_t)nxt.pn * tstep : cB;
        for (int t = 0; t < nt; t += 2) {
            const bool last = (t == nt - 2);
            const char* a1 = cA + (size_t)(t + 1) * kstep;
            const char* a2 = last ? nA : cA + (size_t)(t + 2) * kstep; const char* b2 = last ? nB : cB + (size_t)(t + 2) * kstep;
            const char* a3 = a2 + kstep; const char* b3 = b2 + kstep;
            if constexpr (SP2) {
            PG8_LDB(B0, 0, 0); PG8_LDB(B1, 0, 1); PG8_SCHED; PG8_LDA(At, 0, 0); PG8_STAGE(PG8_SA(1, 1), a1 + hstep, voffA);
            PG8_WAIT_V(8); PG8_WAIT_L(0); PG8_BAR; PG8_MMA(0, 0, At, B0); PG8_MMA(0, 1, At, B1); PG8_BAR; PG8_SCHED;
            PG8_LDA(At, 0, 1); PG8_STAGE(PG8_SB(0, 0), b2, voffB); PG8_STAGE(PG8_SB(0, 1), b2 + hstep, voffB); PG8_STAGE(PG8_SA(0, 0), a2, voffA);
            PG8_WAIT_V(8); PG8_WAIT_L(0); PG8_BAR; PG8_MMA(1, 0, At, B0); PG8_MMA(1, 1, At, B1); PG8_BAR; PG8_SCHED;
            PG8_LDB(B0, 1, 0); PG8_LDB(B1, 1, 1); PG8_SCHED; PG8_LDA(At, 1, 0); PG8_STAGE(PG8_SA(0, 1), a2 + hstep, voffA);
            PG8_WAIT_V(8); PG8_WAIT_L(0); PG8_BAR; PG8_MMA(0, 0, At, B0); PG8_MMA(0, 1, At, B1); PG8_BAR; PG8_SCHED;
            PG8_LDA(At, 1, 1); PG8_STAGE(PG8_SB(1, 0), b3, voffB); PG8_STAGE(PG8_SB(1, 1), b3 + hstep, voffB); PG8_STAGE(PG8_SA(1, 0), a3, voffA);
            PG8_WAIT_V(8); PG8_WAIT_L(0); PG8_BAR; PG8_MMA(1, 0, At, B0); PG8_MMA(1, 1, At, B1); PG8_BAR; PG8_SCHED;
            } else {
            PG8_LDB(B0, 0, 0); PG8_SCHED; PG8_LDA(At, 0, 0); PG8_STAGE(PG8_SA(1, 1), a1 + hstep, voffA);
            PG8_WAIT_L(8); PG8_BAR; PG8_WAIT_L(0); PG8_MMA(0, 0, At, B0); PG8_BAR; PG8_SCHED;
            PG8_LDB(B1, 0, 1); PG8_STAGE(PG8_SB(0, 0), b2, voffB);
            PG8_BAR; PG8_WAIT_L(0); PG8_MMA(0, 1, At, B1); PG8_BAR;
            PG8_LDA(At, 0, 1); PG8_STAGE(PG8_SA(0, 0), a2, voffA);
            PG8_BAR; PG8_WAIT_L(0); PG8_MMA(1, 0, At, B0); PG8_BAR; PG8_SCHED;
            PG8_STAGE(PG8_SB(0, 1), b2 + hstep, voffB);
            PG8_WAIT_V(6); PG8_BAR; PG8_MMA(1, 1, At, B1); PG8_BAR;
            PG8_LDB(B0, 1, 0); PG8_SCHED; PG8_LDA(At, 1, 0); PG8_STAGE(PG8_SA(0, 1), a2 + hstep, voffA);
            PG8_WAIT_L(8); PG8_BAR; PG8_WAIT_L(0); PG8_MMA(0, 0, At, B0); PG8_BAR; PG8_SCHED;
            PG8_LDB(B1, 1, 1); PG8_STAGE(PG8_SB(1, 0), b3, voffB);
            PG8_BAR; PG8_WAIT_L(0); PG8_MMA(0, 1, At, B1); PG8_BAR;
            PG8_LDA(At, 1, 1); PG8_STAGE(PG8_SA(1, 0), a3, voffA);
            PG8_BAR; PG8_WAIT_L(0); PG8_MMA(1, 0, At, B0); PG8_BAR; PG8_SCHED;
            PG8_STAGE(PG8_SB(1, 1), b3 + hstep, voffB);
            PG8_WAIT_V(6); PG8_BAR; PG8_MMA(1, 1, At, B1); PG8_BAR;
            }
        }
        if constexpr (ALIGN_EPI) { if (wr == 0) PG8_BAR; }
        E(acc, cur, wr, wc, fr, fq);
        if (!has_next) break;
#pragma unroll
        for (int a = 0; a < 2; ++a)
#pragma unroll
            for (int b = 0; b < 2; ++b)
#pragma unroll
                for (int m = 0; m < 4; ++m)
#pragma unroll
                    for (int n = 0; n < 2; ++n) acc[a][b][m][n] = (f32x4){0.f, 0.f, 0.f, 0.f};
        cur = nxt; cA = nA; cB = nB; ++ui;
        if constexpr (ALIGN_EPI) { if (wr == 1) PG8_BAR; }
    }
    PG8_WAIT_V(0);
    if constexpr (!ALIGN_EPI) { if (wr == 0) PG8_BAR; }
    PG8_BAR;
#undef PG8_SA
#undef PG8_SB
#undef PG8_STAGE
#undef PG8_LDA
#undef PG8_LDB
#undef PG8_MMA
#undef PG8_WAIT_V
#undef PG8_WAIT_L
#undef PG8_BAR
#undef PG8_SCHED
}

struct EpiQKV {
    static constexpr bool PERM = true;
    bf16_t* Q; bf16_t* Kb; bf16_t* Vb; const float* bias; const float* rope; float* kp; float* vp; float* ks; float* vs;
    __device__ __forceinline__ void operator()(const f32x4 (&acc)[2][2][4][2], const Unit& u, int wr, int wc, int fr, int fq) const {
        const int kind = u.pn < 4 ? 0 : u.pn - 3;
        const int lc0 = wc * 32 + 8 * fq;
        f32x4 bv[2][2];
#pragma unroll
        for (int bj = 0; bj < 2; ++bj)
#pragma unroll
            for (int n = 0; n < 2; ++n) bv[bj][n] = *(const f32x4*)(bias + u.pn * 256 + bj * 128 + lc0 + 4 * n);
        const bool dorope = (kind < 2) && ((wc & 1) == 0);
        const float sgn = (fq == 0) ? -1.f : 1.f;
#pragma unroll
        for (int ai = 0; ai < 2; ++ai)
#pragma unroll
            for (int m = 0; m < 4; ++m) {
                const int r = u.pm * 256 + ai * 128 + wr * 64 + m * 16 + fr;
                const bool prompt = r < MP;
                const int t = prompt ? (r & 2047) : ((r - MP) & 63), b = prompt ? (r >> 11) : ((r - MP) >> 6);
                const int pos = prompt ? t : 1024 + t;
                f32x4 cs[2], sn[2];
                if (dorope) { cs[0] = *(const f32x4*)(rope + pos * 16); cs[1] = *(const f32x4*)(rope + pos * 16 + 4); sn[0] = *(const f32x4*)(rope + pos * 16 + 8); sn[1] = *(const f32x4*)(rope + pos * 16 + 12); }
#pragma unroll
                for (int bj = 0; bj < 2; ++bj) {
                    f32x4 v[2];
#pragma unroll
                    for (int n = 0; n < 2; ++n) {
                        v[n] = acc[ai][bj][m][n] + bv[bj][n];
                        if (dorope) {
#pragma unroll
                            for (int j = 0; j < 4; ++j) { const float p = __shfl_xor(v[n][j], 16); const float rv = v[n][j] * cs[n][j] + sgn * p * sn[n][j]; v[n][j] = (fq < 2) ? rv : v[n][j]; }
                        }
                    }
                    if (kind == 0) {
                        u32x4 w; w.x = cvt_pk_bf16(v[0][0] * QSCALE, v[0][1] * QSCALE); w.y = cvt_pk_bf16(v[0][2] * QSCALE, v[0][3] * QSCALE); w.z = cvt_pk_bf16(v[1][0] * QSCALE, v[1][1] * QSCALE); w.w = cvt_pk_bf16(v[1][2] * QSCALE, v[1][3] * QSCALE);
                        *(u32x4*)(Q + (size_t)r * DM + u.pn * 256 + bj * 128 + lc0) = w;
                    } else {
                        const int col = bj * 128 + lc0;
                        const size_t krow = prompt ? (size_t)r : (size_t)MP + b * 192 + 128 + t;
                        u32x4 w; w.x = cvt_pk_bf16(v[0][0], v[0][1]); w.y = cvt_pk_bf16(v[0][2], v[0][3]); w.z = cvt_pk_bf16(v[1][0], v[1][1]); w.w = cvt_pk_bf16(v[1][2], v[1][3]);
                        *(u32x4*)((kind == 1 ? Kb : Vb) + krow * 256 + col) = w;
                        float* o = nullptr;
                        if (prompt) { if (t >= SEQ - 128) o = (kind == 1 ? kp : vp) + ((size_t)(b * 128 + t - (SEQ - 128)) * 256 + col); }
                        else o = (kind == 1 ? ks : vs) + ((size_t)(b * 128 + 64 + t) * 256 + col);
                        if (o) { *(f32x4*)o = v[0]; *(f32x4*)(o + 4) = v[1]; }
                    }
                }
            }
    }
};
struct EpiPlainSS {
    static constexpr bool PERM = true;
    bf16_t* O; const float* bias; float* ss;
    __device__ __forceinline__ void operator()(const f32x4 (&acc)[2][2][4][2], const Unit& u, int wr, int wc, int fr, int fq) const {
        const int col0 = u.pn * 256 + wc * 32 + 8 * fq;
        f32x4 bv[2][2];
#pragma unroll
        for (int bj = 0; bj < 2; ++bj)
#pragma unroll
            for (int n = 0; n < 2; ++n) bv[bj][n] = bias ? *(const f32x4*)(bias + col0 + bj * 128 + 4 * n) : (f32x4){0.f, 0.f, 0.f, 0.f};
#pragma unroll
        for (int ai = 0; ai < 2; ++ai)
#pragma unroll
            for (int m = 0; m < 4; ++m) {
                const int r = u.pm * 256 + ai * 128 + wr * 64 + m * 16 + fr; float s = 0.f;
#pragma unroll
                for (int bj = 0; bj < 2; ++bj) {
                    const f32x4 v0 = acc[ai][bj][m][0] + bv[bj][0], v1 = acc[ai][bj][m][1] + bv[bj][1];
                    s += (v0[0] * v0[0] + v0[1] * v0[1]) + (v0[2] * v0[2] + v0[3] * v0[3]) + (v1[0] * v1[0] + v1[1] * v1[1]) + (v1[2] * v1[2] + v1[3] * v1[3]);
                    u32x4 w; w.x = cvt_pk_bf16(v0[0], v0[1]); w.y = cvt_pk_bf16(v0[2], v0[3]); w.z = cvt_pk_bf16(v1[0], v1[1]); w.w = cvt_pk_bf16(v1[2], v1[3]);
                    *(u32x4*)(O + (size_t)r * DM + col0 + bj * 128) = w;
                }
                s += __shfl_xor(s, 16); s += __shfl_xor(s, 32);
                if (fq == 0) ss[(size_t)r * 32 + u.pn * 4 + wc] = s;
            }
    }
};
struct EpiGlu {
    static constexpr bool PERM = true;
    bf16_t* O; const float* bias; float* ss;
    __device__ __forceinline__ void operator()(const f32x4 (&acc)[2][2][4][2], const Unit& u, int wr, int wc, int fr, int fq) const {
        const int oc0 = u.pn * 128 + wc * 32 + 8 * fq;
        f32x4 ba[2], bg[2];
#pragma unroll
        for (int n = 0; n < 2; ++n) { ba[n] = *(const f32x4*)(bias + oc0 + 4 * n); bg[n] = *(const f32x4*)(bias + DM + oc0 + 4 * n); }
#pragma unroll
        for (int ai = 0; ai < 2; ++ai)
#pragma unroll
            for (int m = 0; m < 4; ++m) {
                const int r = u.pm * 256 + ai * 128 + wr * 64 + m * 16 + fr; float s = 0.f; f32x4 o[2];
#pragma unroll
                for (int n = 0; n < 2; ++n) { const f32x4 a = acc[ai][0][m][n] + ba[n], g = acc[ai][1][m][n] + bg[n];
#pragma unroll
                    for (int j = 0; j < 4; ++j) { o[n][j] = a[j] * sigmoid_f(g[j]); s += o[n][j] * o[n][j]; } }
                u32x4 w; w.x = cvt_pk_bf16(o[0][0], o[0][1]); w.y = cvt_pk_bf16(o[0][2], o[0][3]); w.z = cvt_pk_bf16(o[1][0], o[1][1]); w.w = cvt_pk_bf16(o[1][2], o[1][3]);
                *(u32x4*)(O + (size_t)r * DM + oc0) = w;
                s += __shfl_xor(s, 16); s += __shfl_xor(s, 32);
                if (fq == 0) ss[(size_t)r * 32 + u.pn * 4 + wc] = s;
            }
    }
};
struct EpiUp {
    static constexpr bool PERM = true;
    bf16_t* G; float* E; const float* cw; const float* cb;
    __device__ __forceinline__ void operator()(f32x4 (&acc)[2][2][4][2], const Unit& u, int wr, int wc, int fr, int fq) const {
        const int oc0 = u.pn * 128 + wc * 32 + 8 * fq;
        {
            const int e = (fr < 2) ? fr : fr - 12; const int msel = (fr < 2) ? 0 : 3;
            if (fr < 2 || fr >= 14) {
#pragma unroll
                for (int ai = 0; ai < 2; ++ai) {
                    const int seg = u.pm * 4 + ai * 2 + wr; float* eb = E + ((size_t)seg * 4 + e) * FF2 + oc0;
#pragma unroll
                    for (int bj = 0; bj < 2; ++bj)
#pragma unroll
                        for (int n = 0; n < 2; ++n) { const f32x4 v = (msel == 0) ? acc[ai][bj][0][n] : acc[ai][bj][3][n]; *(f32x4*)(eb + bj * FF + 4 * n) = v; }
                }
            }
        }
#pragma unroll
        for (int n = 0; n < 2; ++n) {
#pragma unroll
            for (int bj = 0; bj < 2; ++bj) {
                const float* cwp = cw + bj * FF + oc0 + 4 * n;
                const f32x4 w0 = *(const f32x4*)(cwp), w1 = *(const f32x4*)(cwp + FF2), w2 = *(const f32x4*)(cwp + 2 * FF2), bb = *(const f32x4*)(cb + bj * FF + oc0 + 4 * n);
#pragma unroll
                for (int ai = 0; ai < 2; ++ai)
#pragma unroll
                    for (int m = 3; m >= 0; --m) {
                        const f32x4 v = acc[ai][bj][m][n]; const f32x4 vp = (m > 0) ? acc[ai][bj][m - 1][n] : v;
                        f32x4 c;
#pragma unroll
                        for (int j = 0; j < 4; ++j) {
                            const float p1 = dpp_f<0x121>(fr == 15 ? vp[j] : v[j]);
                            const float p2 = dpp_f<0x122>(fr >= 14 ? vp[j] : v[j]);
                            c[j] = bb[j] + w0[j] * p2 + w1[j] * p1 + w2[j] * v[j];
                        }
                        asm volatile("" : "+v"(c));
                        acc[ai][bj][m][n] = c;
                    }
                asm volatile("" ::: "memory");
            }
        }
#pragma unroll
        for (int ai = 0; ai < 2; ++ai)
#pragma unroll
            for (int m = 0; m < 4; ++m) {
                const int r = u.pm * 256 + ai * 128 + wr * 64 + m * 16 + fr;
                f32x4 o[2];
#pragma unroll
                for (int n = 0; n < 2; ++n)
#pragma unroll
                    for (int j = 0; j < 4; ++j) o[n][j] = gelu_tanh(acc[ai][0][m][n][j]) * acc[ai][1][m][n][j];
                u32x4 w; w.x = cvt_pk_bf16(o[0][0], o[0][1]); w.y = cvt_pk_bf16(o[0][2], o[0][3]); w.z = cvt_pk_bf16(o[1][0], o[1][1]); w.w = cvt_pk_bf16(o[1][2], o[1][3]);
                if (!(m == 0 && fr < 2)) *(u32x4*)(G + (size_t)r * FF + oc0) = w;
            }
    }
};
}

struct Args { const float* in[30]; float* out; unsigned char* ws; int ph_lo, ph_hi, coop, pad; };
constexpr int NPHASE = 16;
constexpr int LDS_BYTES = 147456;

__device__ __forceinline__ unsigned f2bf(float f) { unsigned u = __builtin_bit_cast(unsigned, f); return (u + 0x7fffu + ((u >> 16) & 1u)) >> 16; }
__device__ __forceinline__ unsigned pk2(float lo, float hi) { return f2bf(lo) | (f2bf(hi) << 16); }
__device__ __forceinline__ void transpose_item(const float* W, int K, int N, bf16_t* WT, int pair_half, LAS float* scr, int item, int lane) {
    const int nblk = N / 32, kb = item / nblk, nb = item % nblk, k0 = 64 * kb, n0 = 32 * nb;
#pragma unroll 8
    for (int i = 0; i < 32; ++i) { const int kk = 2 * i + (lane >> 5); scr[kk * 33 + (lane & 31)] = W[(size_t)(k0 + kk) * N + n0 + (lane & 31)]; }
    asm volatile("s_waitcnt lgkmcnt(0)" ::: "memory");
    int r0 = n0;
    if (pair_half > 0) { const int half = n0 / pair_half, c = n0 % pair_half; r0 = 256 * (c / 128) + 128 * half + (c % 128); }
    const int c = lane & 7;
#pragma unroll
    for (int j = 0; j < 4; ++j) { const int n = (lane >> 3) + 8 * j; const LAS float* s = scr + (8 * c) * 33 + n;
        u32x4 o; o.x = pk2(s[0 * 33], s[1 * 33]); o.y = pk2(s[2 * 33], s[3 * 33]); o.z = pk2(s[4 * 33], s[5 * 33]); o.w = pk2(s[6 * 33], s[7 * 33]);
        *(u32x4*)(WT + (size_t)(r0 + n) * K + k0 + 8 * c) = o; }
    asm volatile("s_waitcnt lgkmcnt(0)" ::: "memory");
}

template <bool HAS_M, bool HAS_NEXT>
__device__ __forceinline__ void row_pass(const float* xin, float* xout, const bf16_t* mrow, const float* ssrow, int nslots, const float* gpost, const float* gnext, bf16_t* arow, int lane) {
    f32x4 v[4];
#pragma unroll
    for (int j = 0; j < 4; ++j) v[j] = *((const f32x4*)xin + lane + 64 * j);
    if constexpr (HAS_M) {
        float s = (lane < nslots) ? ssrow[lane] : 0.f; s = wave_sum(s);
        const float rstd = 1.0f / sqrtf(s * (1.0f / DM) + EPS);
#pragma unroll
        for (int j = 0; j < 4; ++j) {
            const u32x2 mw = *((const u32x2*)mrow + lane + 64 * j); const f32x4 gp = *((const f32x4*)gpost + lane + 64 * j);
            v[j][0] += __uint_as_float(mw.x << 16) * rstd * gp[0]; v[j][1] += __uint_as_float(mw.x & 0xffff0000u) * rstd * gp[1];
            v[j][2] += __uint_as_float(mw.y << 16) * rstd * gp[2]; v[j][3] += __uint_as_float(mw.y & 0xffff0000u) * rstd * gp[3];
            *((f32x4*)xout + lane + 64 * j) = v[j];
        }
    }
    if constexpr (HAS_NEXT) {
        float s2 = 0.f;
#pragma unroll
        for (int j = 0; j < 4; ++j) s2 += (v[j][0] * v[j][0] + v[j][1] * v[j][1]) + (v[j][2] * v[j][2] + v[j][3] * v[j][3]);
        s2 = wave_sum(s2);
        const float rstd2 = 1.0f / sqrtf(s2 * (1.0f / DM) + EPS);
#pragma unroll
        for (int j = 0; j < 4; ++j) { const f32x4 gn = *((const f32x4*)gnext + lane + 64 * j);
            u32x2 w; w.x = cvt_pk_bf16(v[j][0] * rstd2 * gn[0], v[j][1] * rstd2 * gn[1]); w.y = cvt_pk_bf16(v[j][2] * rstd2 * gn[2], v[j][3] * rstd2 * gn[3]);
            *((u32x2*)arow + lane + 64 * j) = w; }
    }
}

__device__ __forceinline__ s16x4 vtr(LAS const unsigned char* p) { return __builtin_bit_cast(s16x4, __builtin_amdgcn_ds_read_tr16_b64_v4i16((LAS s16x4*)p)); }
__device__ __forceinline__ void attn_phase(LAS unsigned char* lds, const bf16_t* Qb, const bf16_t* Kb, const bf16_t* Vb, bf16_t* Ob, const float* sinks, int G, int blk) {
    const int tid = threadIdx.x, lane = tid & 63, w = __builtin_amdgcn_readfirstlane(tid >> 6), r32 = lane & 31, hi = lane >> 5;
    constexpr int KST = 144, VST = 192, KOFF = 0, VOFF = 192 * KST;
    constexpr int NUNITS = NB * 32 * 4 + DB * 4;
    for (int u = blk; u < NUNITS; u += G) {
        int qrow0, krow0, kb0, kvh;
        if (u < NB * 128) { const int b = u >> 7, rem = u & 127, c = rem >> 2; kvh = rem & 3; qrow0 = b * SEQ + c * 64; krow0 = qrow0 - 128; kb0 = c >= 2 ? 0 : 2 * (2 - c); }
        else { const int u2 = u - NB * 128, b = u2 >> 2; kvh = u2 & 3; qrow0 = MP + b * 64; krow0 = MP + b * 192; kb0 = 0; }
        __syncthreads();
#pragma unroll
        for (int i = 0; i < 3; ++i) { const int p = tid + 512 * i, row = p >> 3, ch = p & 7;
            if (row >= kb0 * 32) {
                const size_t go = (size_t)(krow0 + row) * 256 + kvh * 64 + ch * 8;
                const u32x4 kv = *(const u32x4*)(Kb + go), vv = *(const u32x4*)(Vb + go);
                *(LAS u32x4*)(lds + KOFF + row * KST + ch * 16) = kv; *(LAS u32x4*)(lds + VOFF + row * VST + ch * 16) = vv; } }
        const int hq = kvh * 4 + (w >> 1); const size_t qrow = (size_t)qrow0 + (w & 1) * 32 + r32;
        bf16x8 qf[4];
#pragma unroll
        for (int dk = 0; dk < 4; ++dk) qf[dk] = *(const bf16x8*)(Qb + qrow * DM + hq * 64 + dk * 16 + hi * 8);
        __syncthreads();
        f32x16 sc[6];
        float mx = -3.0e38f;
#pragma unroll
        for (int kb = 0; kb < 6; ++kb) {
            if (kb >= kb0) {
                f32x16 a = {};
#pragma unroll
                for (int dk = 0; dk < 4; ++dk) { const bf16x8 kf = *(const LAS bf16x8*)(lds + KOFF + (32 * kb + r32) * KST + (dk * 16 + hi * 8) * 2); a = __builtin_amdgcn_mfma_f32_32x32x16_bf16(kf, qf[dk], a, 0, 0, 0); }
#pragma unroll
                for (int r = 0; r < 16; ++r) mx = fmaxf(mx, a[r]);
                sc[kb] = a;
            }
        }
        mx = fmaxf(mx, __shfl_xor(mx, 32));
        const float sinkl = sinks[hq] * LOG2E; mx = fmaxf(mx, sinkl);
        float ls = 0.f;
#pragma unroll
        for (int kb = 0; kb < 6; ++kb) {
            if (kb >= kb0) {
#pragma unroll
                for (int r = 0; r < 16; ++r) { const float p = __builtin_amdgcn_exp2f(sc[kb][r] - mx); sc[kb][r] = p; ls += p; }
            }
        }
        ls += __shfl_xor(ls, 32);
        const float inv = 1.0f / (ls + __builtin_amdgcn_exp2f(sinkl - mx));
        f32x16 o[2]; o[0] = f32x16{}; o[1] = f32x16{};
        const int vlane = VOFF + (4 * hi + ((lane >> 2) & 3)) * VST + (16 * ((lane >> 4) & 1) + 4 * (lane & 3)) * 2;
#pragma unroll
        for (int kb = 0; kb < 6; ++kb) {
            if (kb >= kb0) {
#pragma unroll
                for (int s = 0; s < 2; ++s) {
                    u32x4 pw; pw.x = cvt_pk_bf16(sc[kb][8 * s + 0], sc[kb][8 * s + 1]); pw.y = cvt_pk_bf16(sc[kb][8 * s + 2], sc[kb][8 * s + 3]); pw.z = cvt_pk_bf16(sc[kb][8 * s + 4], sc[kb][8 * s + 5]); pw.w = cvt_pk_bf16(sc[kb][8 * s + 6], sc[kb][8 * s + 7]);
                    const bf16x8 pf = __builtin_bit_cast(bf16x8, pw);
#pragma unroll
                    for (int db = 0; db < 2; ++db) {
                        LAS const unsigned char* vp = lds + vlane + (32 * kb + 16 * s) * VST + db * 64;
                        const s16x4 lo = vtr(vp), h4 = vtr(vp + 8 * VST);
                        const bf16x8 vf = (bf16x8){lo[0], lo[1], lo[2], lo[3], h4[0], h4[1], h4[2], h4[3]};
                        o[db] = __builtin_amdgcn_mfma_f32_32x32x16_bf16(vf, pf, o[db], 0, 0, 0);
                    }
                }
            }
        }
#pragma unroll
        for (int db = 0; db < 2; ++db)
#pragma unroll
            for (int rq = 0; rq < 4; ++rq) {
                u32x2 wv; wv.x = cvt_pk_bf16(o[db][4 * rq] * inv, o[db][4 * rq + 1] * inv); wv.y = cvt_pk_bf16(o[db][4 * rq + 2] * inv, o[db][4 * rq + 3] * inv);
                *(u32x2*)(Ob + qrow * DM + hq * 64 + 32 * db + 8 * rq + 4 * hi) = wv;
            }
    }
}

struct SsmP { const float *lam_re, *lam_im, *log_dt, *b_re, *b_im, *c_re, *c_im, *dsk, *st_re, *st_im; float *o_rep, *o_imp, *o_res, *o_ims; };
__device__ __forceinline__ void ssm_phase(LAS unsigned char* lds, const bf16_t* A3, bf16_t* Z, const SsmP P, int G, int blk) {
    const int tid = threadIdx.x, lane = tid & 63, w = __builtin_amdgcn_readfirstlane(tid >> 6), p = lane & 31, hi = lane >> 5;
    constexpr int IST = 72;
    LAS unsigned char* img = lds + w * (128 * IST);
    const bool samp = (w >= 4);
    const int nunits = samp ? (DB / 2) * 64 : (NB / 2) * 64, T = samp ? DS : SEQ;
    for (int uu = blk * 4 + (w & 3); uu < nunits; uu += G * 4) {
        const int bp = uu >> 6, g = uu & 63;
        const int rowbase0 = samp ? MP + (2 * bp) * DS : (2 * bp) * SEQ, bstride = T;
        const float dt = expf(P.log_dt[g]);
        float lbr[2], lbi[2], zr[2], zi[2], hr[2], hm[2];
#pragma unroll
        for (int pp = 0; pp < 2; ++pp) {
            const int ps = g * 64 + p + 32 * pp; const float lr = P.lam_re[ps], li = P.lam_im[ps];
            const float mag = expf(lr * dt); lbr[pp] = mag * cosf(li * dt); lbi[pp] = mag * sinf(li * dt);
            const float nr = lbr[pp] - 1.0f, ni = lbi[pp], den = lr * lr + li * li;
            zr[pp] = (nr * lr + ni * li) / den; zi[pp] = (ni * lr - nr * li) / den;
            if (samp) { const int so = ((2 * bp + hi) * 64 + g) * 64 + p + 32 * pp; hr[pp] = P.st_re[so]; hm[pp] = P.st_im[so]; } else { hr[pp] = 0.f; hm[pp] = 0.f; }
        }
        bf16x8 bfrag[4];
#pragma unroll
        for (int pp = 0; pp < 2; ++pp) {
            const float* br = P.b_re + ((size_t)(g * 64 + p + 32 * pp)) * 16 + 8 * hi; const float* bi = P.b_im + ((size_t)(g * 64 + p + 32 * pp)) * 16 + 8 * hi;
            const f32x4 br0 = *(const f32x4*)br, br1 = *(const f32x4*)(br + 4), bi0 = *(const f32x4*)bi, bi1 = *(const f32x4*)(bi + 4);
            u32x4 wre, wim;
            wre.x = cvt_pk_bf16(zr[pp] * br0[0] - zi[pp] * bi0[0], zr[pp] * br0[1] - zi[pp] * bi0[1]); wre.y = cvt_pk_bf16(zr[pp] * br0[2] - zi[pp] * bi0[2], zr[pp] * br0[3] - zi[pp] * bi0[3]);
            wre.z = cvt_pk_bf16(zr[pp] * br1[0] - zi[pp] * bi1[0], zr[pp] * br1[1] - zi[pp] * bi1[1]); wre.w = cvt_pk_bf16(zr[pp] * br1[2] - zi[pp] * bi1[2], zr[pp] * br1[3] - zi[pp] * bi1[3]);
            wim.x = cvt_pk_bf16(zr[pp] * bi0[0] + zi[pp] * br0[0], zr[pp] * bi0[1] + zi[pp] * br0[1]); wim.y = cvt_pk_bf16(zr[pp] * bi0[2] + zi[pp] * br0[2], zr[pp] * bi0[3] + zi[pp] * br0[3]);
            wim.z = cvt_pk_bf16(zr[pp] * bi1[0] + zi[pp] * br1[0], zr[pp] * bi1[1] + zi[pp] * br1[1]); wim.w = cvt_pk_bf16(zr[pp] * bi1[2] + zi[pp] * br1[2], zr[pp] * bi1[3] + zi[pp] * br1[3]);
            bfrag[pp] = __builtin_bit_cast(bf16x8, wre); bfrag[2 + pp] = __builtin_bit_cast(bf16x8, wim);
        }
        const int ci = lane & 15, kg = lane >> 4;
        bf16x8 cfrag[4];
#pragma unroll
        for (int kb = 0; kb < 4; ++kb) {
            const float* cp = ((kb < 2) ? P.c_re : P.c_im) + ((size_t)(g * 16 + ci)) * 64 + 32 * (kb & 1) + 8 * kg; const float sg = (kb < 2) ? 1.f : -1.f;
            const f32x4 c0 = *(const f32x4*)cp, c1 = *(const f32x4*)(cp + 4);
            u32x4 wc_; wc_.x = cvt_pk_bf16(sg * c0[0], sg * c0[1]); wc_.y = cvt_pk_bf16(sg * c0[2], sg * c0[3]); wc_.z = cvt_pk_bf16(sg * c1[0], sg * c1[1]); wc_.w = cvt_pk_bf16(sg * c1[2], sg * c1[3]);
            cfrag[kb] = __builtin_bit_cast(bf16x8, wc_);
        }
        const float dskv = P.dsk[g * 16 + ci];
        const int hip = (p >> 2) & 1, jp = (p & 3) + 4 * (p >> 3);
        const bf16_t* uptr = A3 + ((size_t)(rowbase0 + hip * bstride + jp)) * DM + g * 16 + 8 * hi;
        const int nblk = T / 16;
        bf16x8 uf = *(const bf16x8*)uptr;
        for (int tb = 0; tb < nblk; ++tb) {
            const bf16x8 ucur = uf;
            if (tb + 1 < nblk) uf = *(const bf16x8*)(uptr + (size_t)(tb + 1) * 16 * DM);
            f32x16 X[4];
#pragma unroll
            for (int cb = 0; cb < 4; ++cb) { f32x16 z = {}; X[cb] = __builtin_amdgcn_mfma_f32_32x32x16_bf16(ucur, bfrag[cb], z, 0, 0, 0); }
#pragma unroll
            for (int r = 0; r < 16; ++r) {
#pragma unroll
                for (int pp = 0; pp < 2; ++pp) {
                    const float nr = lbr[pp] * hr[pp] - lbi[pp] * hm[pp] + X[pp][r];
                    const float ni = lbr[pp] * hm[pp] + lbi[pp] * hr[pp] + X[2 + pp][r];
                    hr[pp] = nr; hm[pp] = ni; X[pp][r] = nr; X[2 + pp][r] = ni;
                }
            }
#pragma unroll
            for (int cb = 0; cb < 4; ++cb)
#pragma unroll
                for (int q = 0; q < 4; ++q) {
                    u32x2 wv; wv.x = cvt_pk_bf16(X[cb][4 * q], X[cb][4 * q + 1]); wv.y = cvt_pk_bf16(X[cb][4 * q + 2], X[cb][4 * q + 3]);
                    *(LAS u32x2*)(img + (cb * 32 + p) * IST + (16 * hi + 4 * q) * 2) = wv;
                }
            asm volatile("s_waitcnt lgkmcnt(0)" ::: "memory");
#pragma unroll
            for (int rb = 0; rb < 2; ++rb) {
                f32x4 y = {0.f, 0.f, 0.f, 0.f};
#pragma unroll
                for (int kb = 0; kb < 4; ++kb) {
                    LAS const unsigned char* ap = img + (32 * kb + 8 * kg + (ci >> 2)) * IST + (16 * rb + 4 * (ci & 3)) * 2;
                    const s16x4 lo = vtr(ap), h4 = vtr(ap + 4 * IST);
                    const bf16x8 af = (bf16x8){lo[0], lo[1], lo[2], lo[3], h4[0], h4[1], h4[2], h4[3]};
                    y = __builtin_amdgcn_mfma_f32_16x16x32_bf16(af, cfrag[kb], y, 0, 0, 0);
                }
#pragma unroll
                for (int rg = 0; rg < 4; ++rg) {
                    const size_t row = (size_t)rowbase0 + rb * bstride + tb * 16 + 4 * kg + rg;
                    const float uv = bf2f(A3[row * DM + g * 16 + ci]);
                    const float yy = y[rg] + dskv * uv;
                    Z[row * DM + g * 16 + ci] = (bf16_t)(cvt_pk_bf16(gelu_tanh(yy), 0.f) & 0xffffu);
                }
            }
            asm volatile("s_waitcnt lgkmcnt(0)" ::: "memory");
        }
#pragma unroll
        for (int pp = 0; pp < 2; ++pp) {
            const int so = ((2 * bp + hi) * 64 + g) * 64 + p + 32 * pp;
            if (samp) { P.o_res[so] = hr[pp]; P.o_ims[so] = hm[pp]; } else { P.o_rep[so] = hr[pp]; P.o_imp[so] = hm[pp]; }
        }
    }
}


__device__ __forceinline__ void phase_prologue(LAS unsigned char* lds, const Args& args, unsigned char* ws, float* out, int G, int blk, int wave, int lane, int tid) {
    const int gw = blk * 8 + wave, NGW = G * 8;
    bf16_t* Wqkv = (bf16_t*)(ws + WS_WQKV); bf16_t* Wo = (bf16_t*)(ws + WS_WO); bf16_t* Wglu = (bf16_t*)(ws + WS_WGLU); bf16_t* Wup = (bf16_t*)(ws + WS_WUP); bf16_t* Wdn = (bf16_t*)(ws + WS_WDN);
    float* rope = (float*)(ws + WS_ROPE); bf16_t* Abuf = (bf16_t*)(ws + WS_A); bf16_t* Kbuf = (bf16_t*)(ws + WS_K); bf16_t* Vbuf = (bf16_t*)(ws + WS_V);
    LAS float* scr = (LAS float*)(lds + wave * 16384);
    constexpr int I_QKV = 16 * 48, I_O = 16 * 32, I_GLU = 16 * 64, I_UP = 16 * 176, I_DN = 44 * 32;
    constexpr int NITEMS = I_QKV + I_O + I_GLU + 2 * I_UP + 2 * I_DN;
    for (int it = gw; it < NITEMS; it += NGW) {
        int r = it;
        if (r < I_QKV) { transpose_item(args.in[11], DM, QKVD, Wqkv, 0, scr, r, lane); continue; } r -= I_QKV;
        if (r < I_O) { transpose_item(args.in[14], DM, DM, Wo, 0, scr, r, lane); continue; } r -= I_O;
        if (r < I_GLU) { transpose_item(args.in[24], DM, 2 * DM, Wglu, DM, scr, r, lane); continue; } r -= I_GLU;
        if (r < 2 * I_UP) { const int l = r / I_UP; transpose_item(args.in[26] + (size_t)l * DM * FF2, DM, FF2, Wup + (size_t)l * FF2 * DM, FF, scr, r % I_UP, lane); continue; } r -= 2 * I_UP;
        { const int l = r / I_DN; transpose_item(args.in[29] + (size_t)l * FF * DM, FF, DM, Wdn + (size_t)l * DM * FF, 0, scr, r % I_DN, lane); }
    }
    for (int i = blk * 512 + tid; i < SEQ * 8; i += G * 512) { const int pos = i >> 3, f = i & 7; const float inv_freq = powf(500000.0f, -(float)f * 0.125f); const float ang = (float)pos * inv_freq;
        rope[pos * 16 + f] = cosf(ang); rope[pos * 16 + 8 + f] = sinf(ang); }
    for (int i = blk * 512 + tid; i < DB * 128 * 64; i += G * 512) {
        const int b = i / (128 * 64), rem = i % (128 * 64), row = rem >> 6, c4 = (rem & 63) * 4;
        const f32x4 kv = *(const f32x4*)(args.in[2] + ((size_t)(b * 128 + row)) * 256 + c4), vv = *(const f32x4*)(args.in[3] + ((size_t)(b * 128 + row)) * 256 + c4);
        u32x2 kw, vw; kw.x = cvt_pk_bf16(kv[0], kv[1]); kw.y = cvt_pk_bf16(kv[2], kv[3]); vw.x = cvt_pk_bf16(vv[0], vv[1]); vw.y = cvt_pk_bf16(vv[2], vv[3]);
        const size_t krow = (size_t)MP + b * 192 + row;
        *(u32x2*)(Kbuf + krow * 256 + c4) = kw; *(u32x2*)(Vbuf + krow * 256 + c4) = vw;
        if (row >= 64) { *(f32x4*)(out + O_KS + ((size_t)(b * 128 + row - 64)) * 256 + c4) = kv; *(f32x4*)(out + O_VS + ((size_t)(b * 128 + row - 64)) * 256 + c4) = vv; }
    }
    for (int m = gw; m < MT; m += NGW) { const float* xr = (m < MP) ? args.in[0] + (size_t)m * DM : args.in[1] + (size_t)(m - MP) * DM;
        row_pass<false, true>(xr, nullptr, nullptr, nullptr, 0, nullptr, args.in[7], Abuf + (size_t)m * DM, lane); }
}
template <bool HAS_NEXT>
__device__ __forceinline__ void phase_rows(const float* x_prompt, const float* x_sample, bool from_input, float* out, const bf16_t* Mbuf, const float* ss, int nslots, const float* gpost, const float* gnext, bf16_t* Abuf, int gw, int NGW, int lane) {
    for (int m = gw; m < MT; m += NGW) {
        const float* xr = from_input ? ((m < MP) ? x_prompt + (size_t)m * DM : x_sample + (size_t)(m - MP) * DM) : out + (size_t)m * DM;
        row_pass<true, HAS_NEXT>(xr, out + (size_t)m * DM, Mbuf + (size_t)m * DM, ss + (size_t)m * 32, nslots, gpost, gnext, HAS_NEXT ? Abuf + (size_t)m * DM : nullptr, lane);
    }
}
__device__ __forceinline__ void phase_up(LAS unsigned char* lds, const bf16_t* Abuf, const bf16_t* Wup_l, bf16_t* Gbuf, float* Ebuf, const float* cw, const float* cb, int G, int blk) {
    pg8::Gemm g{Abuf, Wup_l, MT, FF2, DM}; pg8::StaticOrder S; S.init(MT, FF2, G, blk);
    pg8::EpiUp E{Gbuf, Ebuf, cw, cb};
    pg8::gemm_phase<pg8::EpiUp, true, true>(lds, g, S, E);
}
__device__ __forceinline__ void phase_down(LAS unsigned char* lds, const bf16_t* Gbuf, const bf16_t* Wdn_l, bf16_t* Mbuf, float* ss, int G, int blk) {
    pg8::Gemm g{Gbuf, Wdn_l, MT, DM, FF}; pg8::StaticOrder S; S.init(MT, DM, G, blk);
    pg8::EpiPlainSS E{Mbuf, nullptr, ss};
    pg8::gemm_phase<pg8::EpiPlainSS, true, true>(lds, g, S, E);
}
__device__ __forceinline__ void phase_fix(const float* Ebuf, bf16_t* Gbuf, const float* cw, const float* cb, const float* cc, float* out, int l, int G, int blk, int tid) {
    for (int i = blk * 512 + tid; i < NSEG * 2 * (FF / 4); i += G * 512) {
        const int ri = i / (FF / 4), c4 = (i % (FF / 4)) * 4, seg = ri >> 1, j = ri & 1;
        f32x4 o;
        f32x4 cres[2];
#pragma unroll
        for (int hf = 0; hf < 2; ++hf) {
            const int col = hf * FF + c4;
            const f32x4 cur0 = *(const f32x4*)(Ebuf + ((size_t)seg * 4 + 0) * FF2 + col), cur1 = *(const f32x4*)(Ebuf + ((size_t)seg * 4 + 1) * FF2 + col);
            f32x4 p0 = {0.f, 0.f, 0.f, 0.f}, p1 = {0.f, 0.f, 0.f, 0.f};
            if (seg >= MP / 64) { const int b = seg - MP / 64; p0 = *(const f32x4*)(cc + ((size_t)b * 2 + 0) * FF2 + col); p1 = *(const f32x4*)(cc + ((size_t)b * 2 + 1) * FF2 + col); }
            else if ((seg & 31) != 0) { p0 = *(const f32x4*)(Ebuf + ((size_t)(seg - 1) * 4 + 2) * FF2 + col); p1 = *(const f32x4*)(Ebuf + ((size_t)(seg - 1) * 4 + 3) * FF2 + col); }
            const f32x4 w0 = *(const f32x4*)(cw + col), w1 = *(const f32x4*)(cw + FF2 + col), w2 = *(const f32x4*)(cw + 2 * FF2 + col), bb = *(const f32x4*)(cb + col);
            cres[hf] = (j == 0) ? (bb + w0 * p0 + w1 * p1 + w2 * cur0) : (bb + w0 * p1 + w1 * cur0 + w2 * cur1);
        }
#pragma unroll
        for (int q = 0; q < 4; ++q) o[q] = gelu_tanh(cres[0][q]) * cres[1][q];
        u32x2 wv; wv.x = cvt_pk_bf16(o[0], o[1]); wv.y = cvt_pk_bf16(o[2], o[3]);
        *(u32x2*)(Gbuf + ((size_t)seg * 64 + j) * FF + c4) = wv;
    }
    for (int i = blk * 512 + tid; i < (NB + DB) * 2 * (FF2 / 4); i += G * 512) {
        const int ri = i / (FF2 / 4), c4 = (i % (FF2 / 4)) * 4, bb = ri >> 1, e = ri & 1;
        const int seg = (bb < NB) ? bb * 32 + 31 : MP / 64 + (bb - NB);
        const f32x4 v = *(const f32x4*)(Ebuf + ((size_t)seg * 4 + 2 + e) * FF2 + c4);
        float* o = (bb < NB) ? out + O_CP + (((size_t)l * NB + bb) * 2 + e) * FF2 + c4 : out + O_CS + (((size_t)l * DB + (bb - NB)) * 2 + e) * FF2 + c4;
        *(f32x4*)o = v;
    }
}

__global__ void __launch_bounds__(512, 2) fwd_kernel(Args args) {
    extern __shared__ __attribute__((aligned(16))) unsigned char lds_raw[];
    LAS unsigned char* lds = (LAS unsigned char*)lds_raw;
    const int tid = threadIdx.x, lane = tid & 63, wave = __builtin_amdgcn_readfirstlane(tid >> 6);
    const int G = gridDim.x, blk = blockIdx.x;
    const int gw = blk * 8 + wave, NGW = G * 8;
    unsigned char* ws = args.ws; float* out = args.out;
    const float* x_prompt = args.in[0]; const float* x_sample = args.in[1];
    bf16_t* Wqkv = (bf16_t*)(ws + WS_WQKV); bf16_t* Wo = (bf16_t*)(ws + WS_WO); bf16_t* Wglu = (bf16_t*)(ws + WS_WGLU); bf16_t* Wup = (bf16_t*)(ws + WS_WUP); bf16_t* Wdn = (bf16_t*)(ws + WS_WDN);
    float* rope = (float*)(ws + WS_ROPE); float* ss = (float*)(ws + WS_SS);
    bf16_t* Abuf = (bf16_t*)(ws + WS_A); bf16_t* Mbuf = (bf16_t*)(ws + WS_MB); float* Ebuf = (float*)(ws + WS_E); bf16_t* Gbuf = (bf16_t*)(ws + WS_G);
    bf16_t* Qbuf = (bf16_t*)(ws + WS_Q); bf16_t* Kbuf = (bf16_t*)(ws + WS_K); bf16_t* Vbuf = (bf16_t*)(ws + WS_V);


    const int lo = args.ph_lo, hi_ = args.ph_hi;
#define IN(k) (lo <= (k) && (k) < hi_)
#define SEAM(k) do { if (args.coop && (k) + 1 < hi_) cg::this_grid().sync(); } while (0)
    if (IN(0)) { phase_prologue(lds, args, ws, out, G, blk, wave, lane, tid); SEAM(0); }
    if (IN(1)) {
        pg8::Gemm g{Abuf, Wqkv, MT, QKVD, DM}; pg8::StaticOrder S; S.init(MT, QKVD, G, blk);
        pg8::EpiQKV E{Qbuf, Kbuf, Vbuf, args.in[12], rope, out + O_KP, out + O_VP, out + O_KS, out + O_VS};
        pg8::gemm_phase<pg8::EpiQKV, true, true>(lds, g, S, E); SEAM(1); }
    if (IN(2)) { attn_phase(lds, Qbuf, Kbuf, Vbuf, Qbuf, args.in[13], G, blk); SEAM(2); }
    if (IN(3)) {
        pg8::Gemm g{Qbuf, Wo, MT, DM, DM}; pg8::StaticOrder S; S.init(MT, DM, G, blk);
        pg8::EpiPlainSS E{Mbuf, args.in[15], ss};
        pg8::gemm_phase<pg8::EpiPlainSS, true, true>(lds, g, S, E); SEAM(3); }
    if (IN(4)) { phase_rows<true>(x_prompt, x_sample, true, out, Mbuf, ss, 16, args.in[8], args.in[9], Abuf, gw, NGW, lane); SEAM(4); }
    if (IN(5)) { phase_up(lds, Abuf, Wup, Gbuf, Ebuf, args.in[27], args.in[28], G, blk); SEAM(5); }
    if (IN(6)) { phase_fix(Ebuf, Gbuf, args.in[27], args.in[28], args.in[6], out, 0, G, blk, tid); SEAM(6); }
    if (IN(7)) { phase_down(lds, Gbuf, Wdn, Mbuf, ss, G, blk); SEAM(7); }
    if (IN(8)) { phase_rows<true>(x_prompt, x_sample, false, out, Mbuf, ss, 16, args.in[10], args.in[7] + DM, Abuf, gw, NGW, lane); SEAM(8); }
    if (IN(9)) {
        SsmP P{args.in[16], args.in[17], args.in[18], args.in[19], args.in[20], args.in[21], args.in[22], args.in[23], args.in[4], args.in[5], out + O_REP, out + O_IMP, out + O_RES, out + O_IMS};
        ssm_phase(lds, Abuf, Qbuf, P, G, blk); SEAM(9); }
    if (IN(10)) {
        pg8::Gemm g{Qbuf, Wglu, MT, 2 * DM, DM}; pg8::StaticOrder S; S.init(MT, 2 * DM, G, blk);
        pg8::EpiGlu E{Mbuf, args.in[25], ss};
        pg8::gemm_phase<pg8::EpiGlu, true, true>(lds, g, S, E); SEAM(10); }
    if (IN(11)) { phase_rows<true>(x_prompt, x_sample, false, out, Mbuf, ss, 32, args.in[8] + DM, args.in[9] + DM, Abuf, gw, NGW, lane); SEAM(11); }
    if (IN(12)) { phase_up(lds, Abuf, Wup + (size_t)FF2 * DM, Gbuf, Ebuf, args.in[27] + (size_t)3 * FF2, args.in[28] + FF2, G, blk); SEAM(12); }
    if (IN(13)) { phase_fix(Ebuf, Gbuf, args.in[27] + (size_t)3 * FF2, args.in[28] + FF2, args.in[6] + (size_t)DB * 2 * FF2, out, 1, G, blk, tid); SEAM(13); }
    if (IN(14)) { phase_down(lds, Gbuf, Wdn + (size_t)DM * FF, Mbuf, ss, G, blk); SEAM(14); }
    if (IN(15)) { phase_rows<false>(x_prompt, x_sample, false, out, Mbuf, ss, 16, args.in[10] + DM, nullptr, nullptr, gw, NGW, lane); }
#undef IN
#undef SEAM
}

extern "C" void kernel_launch(void* const* d_in, const int* in_sizes, int n_in, void* d_out, int out_size, void* d_ws, size_t ws_size, hipStream_t stream) {
    static int grid = 0;
    if (grid == 0) {
        if (n_in != 30 || (size_t)out_size != O_END || ws_size < WS_END) { fprintf(stderr, "kernel_launch: unexpected shapes: n_in %d out %d ws %zu (need out %zu ws %zu)\n", n_in, out_size, ws_size, (size_t)O_END, (size_t)WS_END); grid = -1; return; }
        int dev = 0, cus = 0, per_cu = 0;
        hipGetDevice(&dev); hipDeviceGetAttribute(&cus, hipDeviceAttributeMultiprocessorCount, dev);
        if (hipFuncSetAttribute((const void*)fwd_kernel, hipFuncAttributeMaxDynamicSharedMemorySize, LDS_BYTES) != hipSuccess) { fprintf(stderr, "kernel_launch: hipFuncSetAttribute failed\n"); grid = -1; return; }
        if (hipOccupancyMaxActiveBlocksPerMultiprocessor(&per_cu, (const void*)fwd_kernel, 512, LDS_BYTES) != hipSuccess || per_cu < 1) { fprintf(stderr, "kernel_launch: occupancy query says %d\n", per_cu); per_cu = 1; }
        (void)hipGetLastError();
        grid = cus * 1;
    }
    if (grid < 0) return;
    Args a{};
    for (int i = 0; i < 30; ++i) a.in[i] = (const float*)d_in[i];
    a.out = (float*)d_out; a.ws = (unsigned char*)d_ws;
#ifndef MK_MULTI
    a.ph_lo = 0; a.ph_hi = NPHASE; a.coop = 1;
    void* kargs[] = {&a};
    hipError_t e = hipLaunchCooperativeKernel((const void*)fwd_kernel, dim3(grid), dim3(512), kargs, LDS_BYTES, stream);
    if (e != hipSuccess) fprintf(stderr, "cooperative launch failed: %s (grid %d)\n", hipGetErrorString(e), grid);
#else
    for (int ph = 0; ph < NPHASE; ++ph) { a.ph_lo = ph; a.ph_hi = ph + 1; a.coop = 0; hipLaunchKernelGGL(fwd_kernel, dim3(grid), dim3(512), LDS_BYTES, stream, a); }
#endif
}
```

```cpp
#include <hip/hip_runtime.h>
#include <hip/hip_cooperative_groups.h>
#include <cstdio>
#include <cstdint>
namespace cg = cooperative_groups;

#define LAS __attribute__((address_space(3)))
typedef unsigned short bf16_t;
typedef short bf16x8 __attribute__((ext_vector_type(8)));
typedef short s16x4 __attribute__((ext_vector_type(4)));
typedef float f32x4 __attribute__((ext_vector_type(4)));
typedef float f32x16 __attribute__((ext_vector_type(16)));
typedef unsigned u32x4 __attribute__((ext_vector_type(4)));
typedef unsigned u32x2 __attribute__((ext_vector_type(2)));

constexpr int DM = 1024, NB = 32, SEQ = 2048, MP = NB * SEQ, DB = 16, DS = 64, MS = DB * DS, MT = MP + MS;
constexpr int QKVD = 1536, FF = 2816, FF2 = 5632, NSEG = MT / 64;
constexpr int KVROWS = MP + DB * 192;
constexpr float EPS = 1e-6f, LOG2E = 1.4426950408889634f, QSCALE = 0.125f * 1.4426950408889634f;
constexpr size_t O_Y = 0, O_KP = (size_t)MT * DM, O_VP = O_KP + (size_t)NB * 128 * 256, O_KS = O_VP + (size_t)NB * 128 * 256, O_VS = O_KS + (size_t)DB * 128 * 256,
                 O_REP = O_VS + (size_t)DB * 128 * 256, O_IMP = O_REP + NB * 4096, O_RES = O_IMP + NB * 4096, O_IMS = O_RES + DB * 4096,
                 O_CP = O_IMS + DB * 4096, O_CS = O_CP + (size_t)2 * NB * 2 * FF2, O_END = O_CS + (size_t)2 * DB * 2 * FF2;
constexpr size_t MiB = 1u << 20;
constexpr size_t WS_WQKV = 1 * MiB, WS_WO = 4 * MiB, WS_WGLU = 6 * MiB, WS_WUP = 10 * MiB, WS_WDN = 32 * MiB, WS_ROPE = 43 * MiB, WS_SS = 44 * MiB,
                 WS_A = 54 * MiB, WS_MB = 185 * MiB, WS_E = 316 * MiB, WS_G = 406 * MiB, WS_Q = WS_G, WS_K = WS_G + 132 * MiB, WS_V = WS_K + 34 * MiB, WS_END = WS_G + 358 * MiB;
static_assert(WS_WUP + (size_t)2 * FF2 * DM * 2 <= WS_WDN && WS_WDN + (size_t)2 * DM * FF * 2 <= WS_ROPE && WS_SS + (size_t)MT * 32 * 4 <= WS_A, "ws map 1");
static_assert(WS_A + (size_t)MT * DM * 2 <= WS_MB && WS_MB + (size_t)MT * DM * 2 <= WS_E && WS_E + (size_t)NSEG * 4 * FF2 * 4 <= WS_G, "ws map 2");
static_assert(WS_Q + (size_t)MT * DM * 2 <= WS_K && WS_K + (size_t)KVROWS * 256 * 2 <= WS_V && WS_V + (size_t)KVROWS * 256 * 2 <= WS_END && WS_G + (size_t)MT * FF * 2 <= WS_END, "ws map 3");

__device__ __forceinline__ unsigned cvt_pk_bf16(float lo, float hi) { unsigned r; asm volatile("v_cvt_pk_bf16_f32 %0, %1, %2" : "=v"(r) : "v"(lo), "v"(hi)); return r; }
__device__ __forceinline__ float bf2f(unsigned short b) { return __uint_as_float((unsigned)b << 16); }
__device__ __forceinline__ float gelu_tanh(float x) {
    const float x2 = x * x, u = x * (0.7978845608f + 0.0356774081f * x2);
    const float e = __builtin_amdgcn_exp2f(-2.885390082f * u);
    return x * __builtin_amdgcn_rcpf(1.0f + e);
}
__device__ __forceinline__ float sigmoid_f(float v) { return __builtin_amdgcn_rcpf(1.0f + __builtin_amdgcn_exp2f(-LOG2E * v)); }
__device__ __forceinline__ float wave_sum(float v) {
#pragma unroll
    for (int o = 1; o < 64; o <<= 1) v += __shfl_xor(v, o);
    return v;
}
template <int CTRL> __device__ __forceinline__ float dpp_f(float x) { return __builtin_bit_cast(float, __builtin_amdgcn_update_dpp(0, __builtin_bit_cast(int, x), CTRL, 0xf, 0xf, false)); }

namespace pg8 {
constexpr int BM = 256, BK = 64, HALF = 128, HTB = HALF * BK * 2, STAGE_BYTES = 8 * HTB, NXCD = 8, WGM = 8;
__host__ __device__ __forceinline__ int lds_byte(int r, int c) { const int st = (r >> 4) * 2 + (c >> 5), rr = r & 15, cc = c & 31, ob = rr * 64 + cc * 2; return st * 1024 + (ob ^ (((ob >> 9) & 1) << 5)); }
__host__ __device__ __forceinline__ void stage_rc(int b, int& R, int& C) { const int st = b / 1024, sb = b % 1024, swz = sb ^ (((sb >> 9) & 1) << 5); R = (st >> 1) * 16 + swz / 64; C = (st & 1) * 32 + (swz % 64) / 2; }
__host__ __device__ __forceinline__ int perm32(int rho) { const int n = rho >> 4, i = rho & 15; return 8 * (i >> 2) + 4 * n + (i & 3); }
struct Unit { int pm, pn; };
struct Gemm { const bf16_t* A; const bf16_t* Bt; int M, N, K; };
struct StaticOrder {
    int nM, nN, nwg, G, c;
    __device__ void init(int M, int N, int G_, int c_) { nM = M / BM; nN = N / BM; nwg = nM * nN; G = G_; c = c_; }
    __device__ bool next(int i, Unit& u) const {
        const long L = (long)i * G + c; if (L >= nwg) return false;
        int wgid = (int)L; { const int q = nwg / NXCD, r = nwg % NXCD, xcd = wgid % NXCD, off = wgid / NXCD; wgid = (xcd < r ? xcd * (q + 1) : r * (q + 1) + (xcd - r) * q) + off; }
        const int nig = WGM * nN, gid = wgid / nig, fm = gid * WGM, gsz = (nM - fm) < WGM ? (nM - fm) : WGM;
        u.pm = fm + ((wgid % nig) % gsz); u.pn = (wgid % nig) / gsz; return true;
    }
};
template <class Epi, bool ALIGN_EPI, bool SP2>
__device__ __forceinline__ void gemm_phase(LAS unsigned char* lds, const Gemm g, const StaticOrder& S, const Epi& E) {
    const int tid = threadIdx.x, wid = __builtin_amdgcn_readfirstlane(tid >> 6), lane = tid & 63, wr = wid >> 2, wc = wid & 3, fr = lane & 15, fq = lane >> 4;
    const int K = g.K, nt = K / BK;
    unsigned voffA[2], voffB[2];
#pragma unroll
    for (int i = 0; i < 2; ++i) { int R, C; stage_rc(tid * 16 + i * 8192, R, C); const int Rb = Epi::PERM ? ((R & ~31) + perm32(R & 31)) : R;
        voffA[i] = (unsigned)(R * K + C) * 2u; voffB[i] = (unsigned)(Rb * K + C) * 2u; }
    const size_t kstep = (size_t)(BK * 2);
    const size_t hstep = (size_t)HALF * K * 2;
    const size_t tstep = 2 * hstep;
    const unsigned ldsw = (unsigned)wid * 1024u;
    const int aoff = lds_byte(wr * 64 + fr, fq * 8), boff = lds_byte(wc * 32 + fr, fq * 8);
#define PG8_SA(b, h) (((b) * 2 + (h)) * HTB)
#define PG8_SB(b, h) ((4 + (b) * 2 + (h)) * HTB)
#define PG8_STAGE(bufoff, gbase, voff) do { _Pragma("unroll") for (int _i = 0; _i < 2; ++_i) \
        __builtin_amdgcn_global_load_lds((const unsigned*)((const char*)(gbase) + (voff)[_i]), (LAS unsigned*)(lds + (bufoff) + ldsw + _i * 8192), 16, 0, 0); } while (0)
#define PG8_LDA(dst, b, h) do { _Pragma("unroll") for (int m = 0; m < 4; ++m) _Pragma("unroll") for (int k = 0; k < 2; ++k) dst[m][k] = *(const LAS bf16x8*)(lds + PG8_SA(b, h) + aoff + m * 2048 + k * 1024); } while (0)
#define PG8_LDB(dst, b, h) do { _Pragma("unroll") for (int n = 0; n < 2; ++n) _Pragma("unroll") for (int k = 0; k < 2; ++k) dst[n][k] = *(const LAS bf16x8*)(lds + PG8_SB(b, h) + boff + n * 2048 + k * 1024); } while (0)
#define PG8_MMA(ai, bj, At, Bt) do { __builtin_amdgcn_s_setprio(1); _Pragma("unroll") for (int m = 0; m < 4; ++m) _Pragma("unroll") for (int n = 0; n < 2; ++n) _Pragma("unroll") for (int k = 0; k < 2; ++k) \
        acc[ai][bj][m][n] = __builtin_amdgcn_mfma_f32_16x16x32_bf16(Bt[n][k], At[m][k], acc[ai][bj][m][n], 0, 0, 0); __builtin_amdgcn_s_setprio(0); } while (0)
#define PG8_WAIT_V(n) asm volatile("s_waitcnt vmcnt(" #n ")" ::: "memory")
#define PG8_WAIT_L(n) asm volatile("s_waitcnt lgkmcnt(" #n ")" ::: "memory")
#define PG8_BAR __builtin_amdgcn_s_barrier()
#define PG8_SCHED __builtin_amdgcn_sched_barrier(0)
    Unit cur, nxt; int ui = 0;
    if (!S.next(0, cur)) return;
    f32x4 acc[2][2][4][2];
#pragma unroll
    for (int a = 0; a < 2; ++a)
#pragma unroll
        for (int b = 0; b < 2; ++b)
#pragma unroll
            for (int m = 0; m < 4; ++m)
#pragma unroll
                for (int n = 0; n < 2; ++n) acc[a][b][m][n] = (f32x4){0.f, 0.f, 0.f, 0.f};
    bf16x8 At[4][2], B0[2][2], B1[2][2];
    const char* cA = (const char*)g.A + (size_t)cur.pm * tstep; const char* cB = (const char*)g.Bt + (size_t)cur.pn * tstep;
    if constexpr (SP2) {
        PG8_STAGE(PG8_SB(0, 0), cB, voffB); PG8_STAGE(PG8_SB(0, 1), cB + hstep, voffB); PG8_STAGE(PG8_SA(0, 0), cA, voffA); PG8_STAGE(PG8_SA(0, 1), cA + hstep, voffA);
        if (wr == 1) PG8_BAR;
        PG8_WAIT_V(2); PG8_BAR;
        PG8_STAGE(PG8_SB(1, 0), cB + kstep, voffB); PG8_STAGE(PG8_SA(1, 0), cA + kstep, voffA); PG8_STAGE(PG8_SB(1, 1), cB + hstep + kstep, voffB);
        PG8_WAIT_V(6); PG8_BAR;
    } else {
        PG8_STAGE(PG8_SB(0, 0), cB, voffB); PG8_STAGE(PG8_SA(0, 0), cA, voffA); PG8_STAGE(PG8_SB(0, 1), cB + hstep, voffB); PG8_STAGE(PG8_SA(0, 1), cA + hstep, voffA);
        if (wr == 1) PG8_BAR;
        PG8_WAIT_V(4); PG8_BAR;
        PG8_STAGE(PG8_SB(1, 0), cB + kstep, voffB); PG8_STAGE(PG8_SA(1, 0), cA + kstep, voffA); PG8_STAGE(PG8_SB(1, 1), cB + hstep + kstep, voffB);
        PG8_WAIT_V(6); PG8_BAR;
    }
    for (;;) {
        const bool has_next = S.next(ui + 1, nxt);
        const char* nA = has_next ? (const char*)g.A + (size_t)nxt.pm * tstep : cA; const char* nB = has_next ? (const char*)g.Bt + (size_t)nxt.pn * tstep : cB;
        for (int t = 0; t < nt; t += 2) {
            const bool last = (t == nt - 2);
            const char* a1 = cA + (size_t)(t + 1) * kstep;
            const char* a2 = last ? nA : cA + (size_t)(t + 2) * kstep; const char* b2 = last ? nB : cB + (size_t)(t + 2) * kstep;
            const char* a3 = a2 + kstep; const char* b3 = b2 + kstep;
            if constexpr (SP2) {
            PG8_LDB(B0, 0, 0); PG8_LDB(B1, 0, 1); PG8_SCHED; PG8_LDA(At, 0, 0); PG8_STAGE(PG8_SA(1, 1), a1 + hstep, voffA);
            PG8_WAIT_V(8); PG8_WAIT_L(0); PG8_BAR; PG8_MMA(0, 0, At, B0); PG8_MMA(0, 1, At, B1); PG8_BAR; PG8_SCHED;
            PG8_LDA(At, 0, 1); PG8_STAGE(PG8_SB(0, 0), b2, voffB); PG8_STAGE(PG8_SB(0, 1), b2 + hstep, voffB); PG8_STAGE(PG8_SA(0, 0), a2, voffA);
            PG8_WAIT_V(8); PG8_WAIT_L(0); PG8_BAR; PG8_MMA(1, 0, At, B0); PG8_MMA(1, 1, At, B1); PG8_BAR; PG8_SCHED;
            PG8_LDB(B0, 1, 0); PG8_LDB(B1, 1, 1); PG8_SCHED; PG8_LDA(At, 1, 0); PG8_STAGE(PG8_SA(0, 1), a2 + hstep, voffA);
            PG8_WAIT_V(8); PG8_WAIT_L(0); PG8_BAR; PG8_MMA(0, 0, At, B0); PG8_MMA(0, 1, At, B1); PG8_BAR; PG8_SCHED;
            PG8_LDA(At, 1, 1); PG8_STAGE(PG8_SB(1, 0), b3, voffB); PG8_STAGE(PG8_SB(1, 1), b3 + hstep, voffB); PG8_STAGE(PG8_SA(1, 0), a3, voffA);
            PG8_WAIT_V(8); PG8_WAIT_L(0); PG8_BAR; PG8_MMA(1, 0, At, B0); PG8_MMA(1, 1, At, B1); PG8_BAR; PG8_SCHED;
            } else {
            PG8_LDB(B0, 0, 0); PG8_SCHED; PG8_LDA(At, 0, 0); PG8_STAGE(PG8_SA(1, 1), a1 + hstep, voffA);
            PG8_WAIT_L(8); PG8_BAR; PG8_WAIT_L(0); PG8_MMA(0, 0, At, B0); PG8_BAR; PG8_SCHED;
            PG8_LDB(B1, 0, 1); PG8_STAGE(PG8_SB(0, 0), b2, voffB);
            PG8_BAR; PG8_WAIT_L(0); PG8_MMA(0, 1, At, B1); PG8_BAR;
            PG8_LDA(At, 0, 1); PG8_STAGE(PG8_SA(0, 0), a2, voffA);
            PG8_BAR; PG8_WAIT_L(0); PG8_MMA(1, 0, At, B0); PG8_BAR; PG8_SCHED;
            PG8_STAGE(PG8_SB(0, 1), b2 + hstep, voffB);
            PG8_WAIT_V(6); PG8_BAR; PG8_MMA(1, 1, At, B1); PG8_BAR;
            PG8_LDB(B0, 1, 0); PG8_SCHED; PG8_LDA(At, 1, 0); PG8_STAGE(PG8_SA(0, 1), a2 + hstep, voffA);
            PG8_WAIT_L(8); PG8_BAR; PG8_WAIT_L(0); PG8_MMA(0, 0, At, B0); PG8_BAR; PG8_SCHED;
            PG8_LDB(B1, 1, 1); PG8_STAGE(PG8_SB(1, 0), b3, voffB);
            PG8_BAR; PG8_WAIT_L(0); PG8_MMA(0, 1, At, B1); PG8_BAR;
            PG8_LDA(At, 1, 1); PG8_STAGE(PG8_SA(1, 0), a3, voffA);
            PG8_BAR; PG8_WAIT_L(0); PG8_MMA(1, 0, At, B0); PG8_BAR; PG8_SCHED;
            PG8_STAGE(PG8_SB(1, 1), b3 + hstep, voffB);
            PG8_WAIT_V(6); PG8_BAR; PG8_MMA(1, 1, At, B1); PG8_BAR;
            }
        }
        if constexpr (ALIGN_EPI) { if (wr == 0) PG8_BAR; }
        E(acc, cur, wr, wc, fr, fq);
        if (!has_next) break;
#pragma unroll
        for (int a = 0; a < 2; ++a)
#pragma unroll
            for (int b = 0; b < 2; ++b)
#pragma unroll
                for (int m = 0; m < 4; ++m)
#pragma unroll
                    for (int n = 0; n < 2; ++n) acc[a][b][m][n] = (f32x4){0.f, 0.f, 0.f, 0.f};
        cur = nxt; cA = nA; cB = nB; ++ui;
        if constexpr (ALIGN_EPI) { if (wr == 1) PG8_BAR; }
    }
    PG8_WAIT_V(0);
    if constexpr (!ALIGN_EPI) { if (wr == 0) PG8_BAR; }
    PG8_BAR;
#undef PG8_SA
#undef PG8_SB
#undef PG8_STAGE
#undef PG8_LDA
#undef PG8_LDB
#undef PG8_MMA
#undef PG8_WAIT_V
#undef PG8_WAIT_L
#undef PG8_BAR
#undef PG8_SCHED
}

struct EpiQKV {
    static constexpr bool PERM = true;
    bf16_t* Q; bf16_t* Kb; bf16_t* Vb; const float* bias; const float* rope; float* kp; float* vp; float* ks; float* vs;
    __device__ __forceinline__ void operator()(const f32x4 (&acc)[2][2][4][2], const Unit& u, int wr, int wc, int fr, int fq) const {
        const int kind = u.pn < 4 ? 0 : u.pn - 3;
        const int lc0 = wc * 32 + 8 * fq;
        f32x4 bv[2][2];
#pragma unroll
        for (int bj = 0; bj < 2; ++bj)
#pragma unroll
            for (int n = 0; n < 2; ++n) bv[bj][n] = *(const f32x4*)(bias + u.pn * 256 + bj * 128 + lc0 + 4 * n);
        const bool dorope = (kind < 2) && ((wc & 1) == 0);
        const float sgn = (fq == 0) ? -1.f : 1.f;
#pragma unroll
        for (int ai = 0; ai < 2; ++ai)
#pragma unroll
            for (int m = 0; m < 4; ++m) {
                const int r = u.pm * 256 + ai * 128 + wr * 64 + m * 16 + fr;
                const bool prompt = r < MP;
                const int t = prompt ? (r & 2047) : ((r - MP) & 63), b = prompt ? (r >> 11) : ((r - MP) >> 6);
                const int pos = prompt ? t : 1024 + t;
                f32x4 cs[2], sn[2];
                if (dorope) { cs[0] = *(const f32x4*)(rope + pos * 16); cs[1] = *(const f32x4*)(rope + pos * 16 + 4); sn[0] = *(const f32x4*)(rope + pos * 16 + 8); sn[1] = *(const f32x4*)(rope + pos * 16 + 12); }
#pragma unroll
                for (int bj = 0; bj < 2; ++bj) {
                    f32x4 v[2];
#pragma unroll
                    for (int n = 0; n < 2; ++n) {
                        v[n] = acc[ai][bj][m][n] + bv[bj][n];
                        if (dorope) {
#pragma unroll
                            for (int j = 0; j < 4; ++j) { const float p = __shfl_xor(v[n][j], 16); const float rv = v[n][j] * cs[n][j] + sgn * p * sn[n][j]; v[n][j] = (fq < 2) ? rv : v[n][j]; }
                        }
                    }
                    if (kind == 0) {
                        u32x4 w; w.x = cvt_pk_bf16(v[0][0] * QSCALE, v[0][1] * QSCALE); w.y = cvt_pk_bf16(v[0][2] * QSCALE, v[0][3] * QSCALE); w.z = cvt_pk_bf16(v[1][0] * QSCALE, v[1][1] * QSCALE); w.w = cvt_pk_bf16(v[1][2] * QSCALE, v[1][3] * QSCALE);
                        *(u32x4*)(Q + (size_t)r * DM + u.pn * 256 + bj * 128 + lc0) = w;
                    } else {
                        const int col = bj * 128 + lc0;
                        const size_t krow = prompt ? (size_t)r : (size_t)MP + b * 192 + 128 + t;
                        u32x4 w; w.x = cvt_pk_bf16(v[0][0], v[0][1]); w.y = cvt_pk_bf16(v[0][2], v[0][3]); w.z = cvt_pk_bf16(v[1][0], v[1][1]); w.w = cvt_pk_bf16(v[1][2], v[1][3]);
                        *(u32x4*)((kind == 1 ? Kb : Vb) + krow * 256 + col) = w;
                        float* o = nullptr;
                        if (prompt) { if (t >= SEQ - 128) o = (kind == 1 ? kp : vp) + ((size_t)(b * 128 + t - (SEQ - 128)) * 256 + col); }
                        else o = (kind == 1 ? ks : vs) + ((size_t)(b * 128 + 64 + t) * 256 + col);
                        if (o) { *(f32x4*)o = v[0]; *(f32x4*)(o + 4) = v[1]; }
                    }
                }
            }
    }
};
struct EpiPlainSS {
    static constexpr bool PERM = true;
    bf16_t* O; const float* bias; float* ss;
    __device__ __forceinline__ void operator()(const f32x4 (&acc)[2][2][4][2], const Unit& u, int wr, int wc, int fr, int fq) const {
        const int col0 = u.pn * 256 + wc * 32 + 8 * fq;
        f32x4 bv[2][2];
#pragma unroll
        for (int bj = 0; bj < 2; ++bj)
#pragma unroll
            for (int n = 0; n < 2; ++n) bv[bj][n] = bias ? *(const f32x4*)(bias + col0 + bj * 128 + 4 * n) : (f32x4){0.f, 0.f, 0.f, 0.f};
#pragma unroll
        for (int ai = 0; ai < 2; ++ai)
#pragma unroll
            for (int m = 0; m < 4; ++m) {
                const int r = u.pm * 256 + ai * 128 + wr * 64 + m * 16 + fr; float s = 0.f;
#pragma unroll
                for (int bj = 0; bj < 2; ++bj) {
                    const f32x4 v0 = acc[ai][bj][m][0] + bv[bj][0], v1 = acc[ai][bj][m][1] + bv[bj][1];
                    s += (v0[0] * v0[0] + v0[1] * v0[1]) + (v0[2] * v0[2] + v0[3] * v0[3]) + (v1[0] * v1[0] + v1[1] * v1[1]) + (v1[2] * v1[2] + v1[3] * v1[3]);
                    u32x4 w; w.x = cvt_pk_bf16(v0[0], v0[1]); w.y = cvt_pk_bf16(v0[2], v0[3]); w.z = cvt_pk_bf16(v1[0], v1[1]); w.w = cvt_pk_bf16(v1[2], v1[3]);
                    *(u32x4*)(O + (size_t)r * DM + col0 + bj * 128) = w;
                }
                s += __shfl_xor(s, 16); s += __shfl_xor(s, 32);
                if (fq == 0) ss[(size_t)r * 32 + u.pn * 4 + wc] = s;
            }
    }
};
struct EpiGlu {
    static constexpr bool PERM = true;
    bf16_t* O; const float* bias; float* ss;
    __device__ __forceinline__ void operator()(const f32x4 (&acc)[2][2][4][2], const Unit& u, int wr, int wc, int fr, int fq) const {
        const int oc0 = u.pn * 128 + wc * 32 + 8 * fq;
        f32x4 ba[2], bg[2];
#pragma unroll
        for (int n = 0; n < 2; ++n) { ba[n] = *(const f32x4*)(bias + oc0 + 4 * n); bg[n] = *(const f32x4*)(bias + DM + oc0 + 4 * n); }
#pragma unroll
        for (int ai = 0; ai < 2; ++ai)
#pragma unroll
            for (int m = 0; m < 4; ++m) {
                const int r = u.pm * 256 + ai * 128 + wr * 64 + m * 16 + fr; float s = 0.f; f32x4 o[2];
#pragma unroll
                for (int n = 0; n < 2; ++n) { const f32x4 a = acc[ai][0][m][n] + ba[n], g = acc[ai][1][m][n] + bg[n];
#pragma unroll
                    for (int j = 0; j < 4; ++j) { o[n][j] = a[j] * sigmoid_f(g[j]); s += o[n][j] * o[n][j]; } }
                u32x4 w; w.x = cvt_pk_bf16(o[0][0], o[0][1]); w.y = cvt_pk_bf16(o[0][2], o[0][3]); w.z = cvt_pk_bf16(o[1][0], o[1][1]); w.w = cvt_pk_bf16(o[1][2], o[1][3]);
                *(u32x4*)(O + (size_t)r * DM + oc0) = w;
                s += __shfl_xor(s, 16); s += __shfl_xor(s, 32);
                if (fq == 0) ss[(size_t)r * 32 + u.pn * 4 + wc] = s;
            }
    }
};
struct EpiUp {
    static constexpr bool PERM = true;
    bf16_t* G; float* E; const float* cw; const float* cb;
    __device__ __forceinline__ void operator()(f32x4 (&acc)[2][2][4][2], const Unit& u, int wr, int wc, int fr, int fq) const {
        const int oc0 = u.pn * 128 + wc * 32 + 8 * fq;
        {
            const int e = (fr < 2) ? fr : fr - 12; const int msel = (fr < 2) ? 0 : 3;
            if (fr < 2 || fr >= 14) {
#pragma unroll
                for (int ai = 0; ai < 2; ++ai) {
                    const int seg = u.pm * 4 + ai * 2 + wr; float* eb = E + ((size_t)seg * 4 + e) * FF2 + oc0;
#pragma unroll
                    for (int bj = 0; bj < 2; ++bj)
#pragma unroll
                        for (int n = 0; n < 2; ++n) { const f32x4 v = (msel == 0) ? acc[ai][bj][0][n] : acc[ai][bj][3][n]; *(f32x4*)(eb + bj * FF + 4 * n) = v; }
                }
            }
        }
#pragma unroll
        for (int n = 0; n < 2; ++n) {
#pragma unroll
            for (int bj = 0; bj < 2; ++bj) {
                const float* cwp = cw + bj * FF + oc0 + 4 * n;
                const f32x4 w0 = *(const f32x4*)(cwp), w1 = *(const f32x4*)(cwp + FF2), w2 = *(const f32x4*)(cwp + 2 * FF2), bb = *(const f32x4*)(cb + bj * FF + oc0 + 4 * n);
#pragma unroll
                for (int ai = 0; ai < 2; ++ai)
#pragma unroll
                    for (int m = 3; m >= 0; --m) {
                        const f32x4 v = acc[ai][bj][m][n]; const f32x4 vp = (m > 0) ? acc[ai][bj][m - 1][n] : v;
                        f32x4 c;
#pragma unroll
                        for (int j = 0; j < 4; ++j) {
                            const float p1 = dpp_f<0x121>(fr == 15 ? vp[j] : v[j]);
                            const float p2 = dpp_f<0x122>(fr >= 14 ? vp[j] : v[j]);
                            c[j] = bb[j] + w0[j] * p2 + w1[j] * p1 + w2[j] * v[j];
                        }
                        asm volatile("" : "+v"(c));
                        acc[ai][bj][m][n] = c;
                    }
                asm volatile("" ::: "memory");
            }
        }
#pragma unroll
        for (int ai = 0; ai < 2; ++ai)
#pragma unroll
            for (int m = 0; m < 4; ++m) {
                const int r = u.pm * 256 + ai * 128 + wr * 64 + m * 16 + fr;
                f32x4 o[2];
#pragma unroll
                for (int n = 0; n < 2; ++n)
#pragma unroll
                    for (int j = 0; j < 4; ++j) o[n][j] = gelu_tanh(acc[ai][0][m][n][j]) * acc[ai][1][m][n][j];
                u32x4 w; w.x = cvt_pk_bf16(o[0][0], o[0][1]); w.y = cvt_pk_bf16(o[0][2], o[0][3]); w.z = cvt_pk_bf16(o[1][0], o[1][1]); w.w = cvt_pk_bf16(o[1][2], o[1][3]);
                if (!(m == 0 && fr < 2)) *(u32x4*)(G + (size_t)r * FF + oc0) = w;
            }
    }
};
}

#ifndef PROBE_REPMASK
#define PROBE_REPMASK 0
#endif
struct Args { const float* in[30]; float* out; unsigned char* ws; int ph_lo, ph_hi, coop, repmask; };
constexpr int NPHASE = 16;
constexpr int LDS_BYTES = 147456;

__device__ __forceinline__ unsigned f2bf(float f) { unsigned u = __builtin_bit_cast(unsigned, f); return (u + 0x7fffu + ((u >> 16) & 1u)) >> 16; }
__device__ __forceinline__ unsigned pk2(float lo, float hi) { return f2bf(lo) | (f2bf(hi) << 16); }
__device__ __forceinline__ void transpose_item(const float* W, int K, int N, bf16_t* WT, int pair_half, LAS float* scr, int item, int lane) {
    const int nblk = N / 32, kb = item / nblk, nb = item % nblk, k0 = 64 * kb, n0 = 32 * nb;
#pragma unroll 8
    for (int i = 0; i < 32; ++i) { const int kk = 2 * i + (lane >> 5); scr[kk * 33 + (lane & 31)] = W[(size_t)(k0 + kk) * N + n0 + (lane & 31)]; }
    asm volatile("s_waitcnt lgkmcnt(0)" ::: "memory");
    int r0 = n0;
    if (pair_half > 0) { const int half = n0 / pair_half, c = n0 % pair_half; r0 = 256 * (c / 128) + 128 * half + (c % 128); }
    const int c = lane & 7;
#pragma unroll
    for (int j = 0; j < 4; ++j) { const int n = (lane >> 3) + 8 * j; const LAS float* s = scr + (8 * c) * 33 + n;
        u32x4 o; o.x = pk2(s[0 * 33], s[1 * 33]); o.y = pk2(s[2 * 33], s[3 * 33]); o.z = pk2(s[4 * 33], s[5 * 33]); o.w = pk2(s[6 * 33], s[7 * 33]);
        *(u32x4*)(WT + (size_t)(r0 + n) * K + k0 + 8 * c) = o; }
    asm volatile("s_waitcnt lgkmcnt(0)" ::: "memory");
}

template <bool HAS_M, bool HAS_NEXT>
__device__ __forceinline__ void row_pass(const float* xin, float* xout, const bf16_t* mrow, const float* ssrow, int nslots, const float* gpost, const float* gnext, bf16_t* arow, int lane) {
    f32x4 v[4];
#pragma unroll
    for (int j = 0; j < 4; ++j) v[j] = *((const f32x4*)xin + lane + 64 * j);
    if constexpr (HAS_M) {
        float s = (lane < nslots) ? ssrow[lane] : 0.f; s = wave_sum(s);
        const float rstd = 1.0f / sqrtf(s * (1.0f / DM) + EPS);
#pragma unroll
        for (int j = 0; j < 4; ++j) {
            const u32x2 mw = *((const u32x2*)mrow + lane + 64 * j); const f32x4 gp = *((const f32x4*)gpost + lane + 64 * j);
            v[j][0] += __uint_as_float(mw.x << 16) * rstd * gp[0]; v[j][1] += __uint_as_float(mw.x & 0xffff0000u) * rstd * gp[1];
            v[j][2] += __uint_as_float(mw.y << 16) * rstd * gp[2]; v[j][3] += __uint_as_float(mw.y & 0xffff0000u) * rstd * gp[3];
            *((f32x4*)xout + lane + 64 * j) = v[j];
        }
    }
    if constexpr (HAS_NEXT) {
        float s2 = 0.f;
#pragma unroll
        for (int j = 0; j < 4; ++j) s2 += (v[j][0] * v[j][0] + v[j][1] * v[j][1]) + (v[j][2] * v[j][2] + v[j][3] * v[j][3]);
        s2 = wave_sum(s2);
        const float rstd2 = 1.0f / sqrtf(s2 * (1.0f / DM) + EPS);
#pragma unroll
        for (int j = 0; j < 4; ++j) { const f32x4 gn = *((const f32x4*)gnext + lane + 64 * j);
            u32x2 w; w.x = cvt_pk_bf16(v[j][0] * rstd2 * gn[0], v[j][1] * rstd2 * gn[1]); w.y = cvt_pk_bf16(v[j][2] * rstd2 * gn[2], v[j][3] * rstd2 * gn[3]);
            *((u32x2*)arow + lane + 64 * j) = w; }
    }
}

__device__ __forceinline__ s16x4 vtr(LAS const unsigned char* p) { return __builtin_bit_cast(s16x4, __builtin_amdgcn_ds_read_tr16_b64_v4i16((LAS s16x4*)p)); }
__device__ __forceinline__ void attn_phase(LAS unsigned char* lds, const bf16_t* Qb, const bf16_t* Kb, const bf16_t* Vb, bf16_t* Ob, const float* sinks, int G, int blk) {
    const int tid = threadIdx.x, lane = tid & 63, w = __builtin_amdgcn_readfirstlane(tid >> 6), r32 = lane & 31, hi = lane >> 5;
    constexpr int KST = 144, VST = 192, KOFF = 0, VOFF = 192 * KST;
    constexpr int NUNITS = NB * 32 * 4 + DB * 4;
    for (int u = blk; u < NUNITS; u += G) {
        int qrow0, krow0, kb0, kvh;
        if (u < NB * 128) { const int b = u >> 7, rem = u & 127, c = rem >> 2; kvh = rem & 3; qrow0 = b * SEQ + c * 64; krow0 = qrow0 - 128; kb0 = c >= 2 ? 0 : 2 * (2 - c); }
        else { const int u2 = u - NB * 128, b = u2 >> 2; kvh = u2 & 3; qrow0 = MP + b * 64; krow0 = MP + b * 192; kb0 = 0; }
        __syncthreads();
#pragma unroll
        for (int i = 0; i < 3; ++i) { const int p = tid + 512 * i, row = p >> 3, ch = p & 7;
            if (row >= kb0 * 32) {
                const size_t go = (size_t)(krow0 + row) * 256 + kvh * 64 + ch * 8;
                const u32x4 kv = *(const u32x4*)(Kb + go), vv = *(const u32x4*)(Vb + go);
                *(LAS u32x4*)(lds + KOFF + row * KST + ch * 16) = kv; *(LAS u32x4*)(lds + VOFF + row * VST + ch * 16) = vv; } }
        const int hq = kvh * 4 + (w >> 1); const size_t qrow = (size_t)qrow0 + (w & 1) * 32 + r32;
        bf16x8 qf[4];
#pragma unroll
        for (int dk = 0; dk < 4; ++dk) qf[dk] = *(const bf16x8*)(Qb + qrow * DM + hq * 64 + dk * 16 + hi * 8);
        __syncthreads();
        f32x16 sc[6];
        float mx = -3.0e38f;
#pragma unroll
        for (int kb = 0; kb < 6; ++kb) {
            if (kb >= kb0) {
                f32x16 a = {};
#pragma unroll
                for (int dk = 0; dk < 4; ++dk) { const bf16x8 kf = *(const LAS bf16x8*)(lds + KOFF + (32 * kb + r32) * KST + (dk * 16 + hi * 8) * 2); a = __builtin_amdgcn_mfma_f32_32x32x16_bf16(kf, qf[dk], a, 0, 0, 0); }
#pragma unroll
                for (int r = 0; r < 16; ++r) mx = fmaxf(mx, a[r]);
                sc[kb] = a;
            }
        }
        mx = fmaxf(mx, __shfl_xor(mx, 32));
        const float sinkl = sinks[hq] * LOG2E; mx = fmaxf(mx, sinkl);
        float ls = 0.f;
#pragma unroll
        for (int kb = 0; kb < 6; ++kb) {
            if (kb >= kb0) {
#pragma unroll
                for (int r = 0; r < 16; ++r) { const float p = __builtin_amdgcn_exp2f(sc[kb][r] - mx); sc[kb][r] = p; ls += p; }
            }
        }
        ls += __shfl_xor(ls, 32);
        const float inv = 1.0f / (ls + __builtin_amdgcn_exp2f(sinkl - mx));
        f32x16 o[2]; o[0] = f32x16{}; o[1] = f32x16{};
        const int vlane = VOFF + (4 * hi + ((lane >> 2) & 3)) * VST + (16 * ((lane >> 4) & 1) + 4 * (lane & 3)) * 2;
#pragma unroll
        for (int kb = 0; kb < 6; ++kb) {
            if (kb >= kb0) {
#pragma unroll
                for (int s = 0; s < 2; ++s) {
                    u32x4 pw; pw.x = cvt_pk_bf16(sc[kb][8 * s + 0], sc[kb][8 * s + 1]); pw.y = cvt_pk_bf16(sc[kb][8 * s + 2], sc[kb][8 * s + 3]); pw.z = cvt_pk_bf16(sc[kb][8 * s + 4], sc[kb][8 * s + 5]); pw.w = cvt_pk_bf16(sc[kb][8 * s + 6], sc[kb][8 * s + 7]);
                    const bf16x8 pf = __builtin_bit_cast(bf16x8, pw);
#pragma unroll
                    for (int db = 0; db < 2; ++db) {
                        LAS const unsigned char* vp = lds + vlane + (32 * kb + 16 * s) * VST + db * 64;
                        const s16x4 lo = vtr(vp), h4 = vtr(vp + 8 * VST);
                        const bf16x8 vf = (bf16x8){lo[0], lo[1], lo[2], lo[3], h4[0], h4[1], h4[2], h4[3]};
                        o[db] = __builtin_amdgcn_mfma_f32_32x32x16_bf16(vf, pf, o[db], 0, 0, 0);
                    }
                }
            }
        }
#pragma unroll
        for (int db = 0; db < 2; ++db)
#pragma unroll
            for (int rq = 0; rq < 4; ++rq) {
                u32x2 wv; wv.x = cvt_pk_bf16(o[db][4 * rq] * inv, o[db][4 * rq + 1] * inv); wv.y = cvt_pk_bf16(o[db][4 * rq + 2] * inv, o[db][4 * rq + 3] * inv);
                *(u32x2*)(Ob + qrow * DM + hq * 64 + 32 * db + 8 * rq + 4 * hi) = wv;
            }
    }
}

struct SsmP { const float *lam_re, *lam_im, *log_dt, *b_re, *b_im, *c_re, *c_im, *dsk, *st_re, *st_im; float *o_rep, *o_imp, *o_res, *o_ims; };
__device__ __forceinline__ void ssm_phase(LAS unsigned char* lds, const bf16_t* A3, bf16_t* Z, const SsmP P, int G, int blk) {
    const int tid = threadIdx.x, lane = tid & 63, w = __builtin_amdgcn_readfirstlane(tid >> 6), p = lane & 31, hi = lane >> 5;
    constexpr int IST = 72;
    LAS unsigned char* img = lds + w * (128 * IST);
    const bool samp = (w >= 4);
    const int nunits = samp ? (DB / 2) * 64 : (NB / 2) * 64, T = samp ? DS : SEQ;
    for (int uu = blk * 4 + (w & 3); uu < nunits; uu += G * 4) {
        const int bp = uu >> 6, g = uu & 63;
        const int rowbase0 = samp ? MP + (2 * bp) * DS : (2 * bp) * SEQ, bstride = T;
        const float dt = expf(P.log_dt[g]);
        float lbr[2], lbi[2], zr[2], zi[2], hr[2], hm[2];
#pragma unroll
        for (int pp = 0; pp < 2; ++pp) {
            const int ps = g * 64 + p + 32 * pp; const float lr = P.lam_re[ps], li = P.lam_im[ps];
            const float mag = expf(lr * dt); lbr[pp] = mag * cosf(li * dt); lbi[pp] = mag * sinf(li * dt);
            const float nr = lbr[pp] - 1.0f, ni = lbi[pp], den = lr * lr + li * li;
            zr[pp] = (nr * lr + ni * li) / den; zi[pp] = (ni * lr - nr * li) / den;
            if (samp) { const int so = ((2 * bp + hi) * 64 + g) * 64 + p + 32 * pp; hr[pp] = P.st_re[so]; hm[pp] = P.st_im[so]; } else { hr[pp] = 0.f; hm[pp] = 0.f; }
        }
        bf16x8 bfrag[4];
#pragma unroll
        for (int pp = 0; pp < 2; ++pp) {
            const float* br = P.b_re + ((size_t)(g * 64 + p + 32 * pp)) * 16 + 8 * hi; const float* bi = P.b_im + ((size_t)(g * 64 + p + 32 * pp)) * 16 + 8 * hi;
            const f32x4 br0 = *(const f32x4*)br, br1 = *(const f32x4*)(br + 4), bi0 = *(const f32x4*)bi, bi1 = *(const f32x4*)(bi + 4);
            u32x4 wre, wim;
            wre.x = cvt_pk_bf16(zr[pp] * br0[0] - zi[pp] * bi0[0], zr[pp] * br0[1] - zi[pp] * bi0[1]); wre.y = cvt_pk_bf16(zr[pp] * br0[2] - zi[pp] * bi0[2], zr[pp] * br0[3] - zi[pp] * bi0[3]);
            wre.z = cvt_pk_bf16(zr[pp] * br1[0] - zi[pp] * bi1[0], zr[pp] * br1[1] - zi[pp] * bi1[1]); wre.w = cvt_pk_bf16(zr[pp] * br1[2] - zi[pp] * bi1[2], zr[pp] * br1[3] - zi[pp] * bi1[3]);
            wim.x = cvt_pk_bf16(zr[pp] * bi0[0] + zi[pp] * br0[0], zr[pp] * bi0[1] + zi[pp] * br0[1]); wim.y = cvt_pk_bf16(zr[pp] * bi0[2] + zi[pp] * br0[2], zr[pp] * bi0[3] + zi[pp] * br0[3]);
            wim.z = cvt_pk_bf16(zr[pp] * bi1[0] + zi[pp] * br1[0], zr[pp] * bi1[1] + zi[pp] * br1[1]); wim.w = cvt_pk_bf16(zr[pp] * bi1[2] + zi[pp] * br1[2], zr[pp] * bi1[3] + zi[pp] * br1[3]);
            bfrag[pp] = __builtin_bit_cast(bf16x8, wre); bfrag[2 + pp] = __builtin_bit_cast(bf16x8, wim);
        }
        const int ci = lane & 15, kg = lane >> 4;
        bf16x8 cfrag[4];
#pragma unroll
        for (int kb = 0; kb < 4; ++kb) {
            const float* cp = ((kb < 2) ? P.c_re : P.c_im) + ((size_t)(g * 16 + ci)) * 64 + 32 * (kb & 1) + 8 * kg; const float sg = (kb < 2) ? 1.f : -1.f;
            const f32x4 c0 = *(const f32x4*)cp, c1 = *(const f32x4*)(cp + 4);
            u32x4 wc_; wc_.x = cvt_pk_bf16(sg * c0[0], sg * c0[1]); wc_.y = cvt_pk_bf16(sg * c0[2], sg * c0[3]); wc_.z = cvt_pk_bf16(sg * c1[0], sg * c1[1]); wc_.w = cvt_pk_bf16(sg * c1[2], sg * c1[3]);
            cfrag[kb] = __builtin_bit_cast(bf16x8, wc_);
        }
        const f32x4 dsk4 = *(const f32x4*)(P.dsk + g * 16 + 4 * kg);
        const int hip = (p >> 2) & 1, jp = (p & 3) + 4 * (p >> 3);
        const bf16_t* uptr = A3 + ((size_t)(rowbase0 + hip * bstride + jp)) * DM + g * 16 + 8 * hi;
        const size_t yoff = ((size_t)(rowbase0 + ci)) * DM + g * 16 + 4 * kg; const size_t boff = (size_t)bstride * DM;
        const int nblk = T / 16;
        bf16x8 uf = *(const bf16x8*)uptr;
        u32x2 un0 = *(const u32x2*)(A3 + yoff), un1 = *(const u32x2*)(A3 + yoff + boff);
        for (int tb = 0; tb < nblk; ++tb) {
            const bf16x8 ucur = uf; const u32x2 uc0 = un0, uc1 = un1;
            if (tb + 1 < nblk) { uf = *(const bf16x8*)(uptr + (size_t)(tb + 1) * 16 * DM); un0 = *(const u32x2*)(A3 + yoff + (size_t)(tb + 1) * 16 * DM); un1 = *(const u32x2*)(A3 + yoff + boff + (size_t)(tb + 1) * 16 * DM); }
            f32x16 X[4];
#pragma unroll
            for (int cb = 0; cb < 4; ++cb) { f32x16 z = {}; X[cb] = __builtin_amdgcn_mfma_f32_32x32x16_bf16(ucur, bfrag[cb], z, 0, 0, 0); }
#pragma unroll
            for (int r = 0; r < 16; ++r) {
#pragma unroll
                for (int pp = 0; pp < 2; ++pp) {
                    const float nr = lbr[pp] * hr[pp] - lbi[pp] * hm[pp] + X[pp][r];
                    const float ni = lbr[pp] * hm[pp] + lbi[pp] * hr[pp] + X[2 + pp][r];
                    hr[pp] = nr; hm[pp] = ni; X[pp][r] = nr; X[2 + pp][r] = ni;
                }
            }
#pragma unroll
            for (int cb = 0; cb < 4; ++cb)
#pragma unroll
                for (int q = 0; q < 4; ++q) {
                    u32x2 wv; wv.x = cvt_pk_bf16(X[cb][4 * q], X[cb][4 * q + 1]); wv.y = cvt_pk_bf16(X[cb][4 * q + 2], X[cb][4 * q + 3]);
                    *(LAS u32x2*)(img + (cb * 32 + p) * IST + (16 * hi + 4 * q) * 2) = wv;
                }
            asm volatile("s_waitcnt lgkmcnt(0)" ::: "memory");
#pragma unroll
            for (int rb = 0; rb < 2; ++rb) {
                f32x4 y = {0.f, 0.f, 0.f, 0.f};
#pragma unroll
                for (int kb = 0; kb < 4; ++kb) {
                    LAS const unsigned char* ap = img + (32 * kb + 8 * kg + (ci >> 2)) * IST + (16 * rb + 4 * (ci & 3)) * 2;
                    const s16x4 lo = vtr(ap), h4 = vtr(ap + 4 * IST);
                    const bf16x8 af = (bf16x8){lo[0], lo[1], lo[2], lo[3], h4[0], h4[1], h4[2], h4[3]};
                    y = __builtin_amdgcn_mfma_f32_16x16x32_bf16(cfrag[kb], af, y, 0, 0, 0);
                }
                const u32x2 uw = rb ? uc1 : uc0;
                const float z0 = gelu_tanh(y[0] + dsk4[0] * __uint_as_float(uw.x << 16)), z1 = gelu_tanh(y[1] + dsk4[1] * __uint_as_float(uw.x & 0xffff0000u));
                const float z2 = gelu_tanh(y[2] + dsk4[2] * __uint_as_float(uw.y << 16)), z3 = gelu_tanh(y[3] + dsk4[3] * __uint_as_float(uw.y & 0xffff0000u));
                u32x2 zw; zw.x = cvt_pk_bf16(z0, z1); zw.y = cvt_pk_bf16(z2, z3);
                *(u32x2*)(Z + yoff + (rb ? boff : 0) + (size_t)tb * 16 * DM) = zw;
            }
            asm volatile("" ::: "memory");
        }
#pragma unroll
        for (int pp = 0; pp < 2; ++pp) {
            const int so = ((2 * bp + hi) * 64 + g) * 64 + p + 32 * pp;
            if (samp) { P.o_res[so] = hr[pp]; P.o_ims[so] = hm[pp]; } else { P.o_rep[so] = hr[pp]; P.o_imp[so] = hm[pp]; }
        }
    }
}


#define XB_TMO      128
#define XB_XCNT(j)  (256  + 64 * (j))
#define XB_XSUB(j)  (1280 + 64 * (j))
#define XB_XGEN(j)  (2304 + 64 * (j))
#define XB_TOP      3328
#define XB_TOPGEN   3392
#define XCD_BAR_WORDS 3456
#define XB_SPIN_CAP (1u << 18)
__device__ __forceinline__ unsigned xb_ld(unsigned* p)              { return __hip_atomic_load(p, __ATOMIC_RELAXED, __HIP_MEMORY_SCOPE_AGENT); }
__device__ __forceinline__ unsigned xb_add(unsigned* p, unsigned v) { return __hip_atomic_fetch_add(p, v, __ATOMIC_RELAXED, __HIP_MEMORY_SCOPE_AGENT); }
__device__ __forceinline__ unsigned xb_xcc_id() { return (unsigned)__builtin_amdgcn_s_getreg((3 << 11) | 20) & 0xFu; }
#define XB_SPIN(cond, bar) do { unsigned _sp = 0; while (cond) { __builtin_amdgcn_s_sleep(1); \
    if ((++_sp & 255u) == 0u) { if (xb_ld(&(bar)[XB_TMO])) break; if (_sp > XB_SPIN_CAP) { atomicAdd(&(bar)[XB_TMO], 1u); break; } } } } while (0)
struct XcdBarrier { unsigned* bar; unsigned x; volatile LAS unsigned* st; };
__device__ __forceinline__ XcdBarrier xcd_barrier_post(unsigned* bar, volatile LAS unsigned* st) {
    XcdBarrier b; b.bar = bar; b.x = xb_xcc_id(); b.st = st;
    if (threadIdx.x == 0) (void)xb_add(&bar[XB_XCNT(b.x)], 1u);
    return b;
}
__device__ __forceinline__ void xcd_barrier_complete(unsigned* bar, unsigned x, unsigned& nloc, unsigned& nx) {
    const unsigned G = gridDim.x * gridDim.y * gridDim.z;
    unsigned sum, cnt, mine, sp = 0u;
    for (;;) {
        sum = 0u; cnt = 0u; mine = 0u;
#pragma unroll
        for (unsigned j = 0; j < 16; ++j) { const unsigned c = xb_ld(&bar[XB_XCNT(j)]); sum += c; cnt += (c > 0u) ? 1u : 0u; mine = (j == x) ? c : mine; }
        if (sum == G) break;
        __builtin_amdgcn_s_sleep(1);
        if ((++sp & 255u) == 0u) { if (xb_ld(&bar[XB_TMO])) break; if (sp > XB_SPIN_CAP) { atomicAdd(&bar[XB_TMO], 1u); break; } }
    }
    nloc = mine > 0u ? mine : 1u; nx = cnt > 0u ? cnt : 1u;
}
__device__ __forceinline__ void xcd_barrier(const XcdBarrier& b) {
    asm volatile("s_waitcnt vmcnt(0)" ::: "memory");
    __syncthreads();
    if (threadIdx.x == 0) {
        unsigned* bar = b.bar;
        __builtin_amdgcn_s_waitcnt(0);
        unsigned nloc = b.st[0], nx = b.st[1];
        if (nloc == 0u) { xcd_barrier_complete(bar, b.x, nloc, nx); b.st[0] = nloc; b.st[1] = nx; }
        const unsigned old = xb_add(&bar[XB_XSUB(b.x)], 1u);
        const unsigned gen = old / nloc;
        if (old + 1u == (gen + 1u) * nloc) {
            __builtin_amdgcn_fence(__ATOMIC_RELEASE, "agent");
            asm volatile("s_waitcnt vmcnt(0)" ::: "memory");
            const unsigned og = xb_add(&bar[XB_TOP], 1u);
            const unsigned tg = og / nx;
            if (og + 1u == (tg + 1u) * nx) xb_add(&bar[XB_TOPGEN], 1u);
            else XB_SPIN(xb_ld(&bar[XB_TOPGEN]) == tg, bar);
            __builtin_amdgcn_fence(__ATOMIC_ACQUIRE, "agent");
            xb_add(&bar[XB_XGEN(b.x)], 1u);
            asm volatile("s_waitcnt vmcnt(0)" ::: "memory");
        } else {
            XB_SPIN(xb_ld(&bar[XB_XGEN(b.x)]) == gen, bar);
            __builtin_amdgcn_fence(__ATOMIC_ACQUIRE, "agent");
            asm volatile("s_waitcnt vmcnt(0)" ::: "memory");
        }
    }
    __syncthreads();
}

__device__ __forceinline__ void phase_prologue(LAS unsigned char* lds, const Args& args, unsigned char* ws, float* out, int G, int blk, int wave, int lane, int tid) {
    const int gw = blk * 8 + wave, NGW = G * 8;
    bf16_t* Wqkv = (bf16_t*)(ws + WS_WQKV); bf16_t* Wo = (bf16_t*)(ws + WS_WO); bf16_t* Wglu = (bf16_t*)(ws + WS_WGLU); bf16_t* Wup = (bf16_t*)(ws + WS_WUP); bf16_t* Wdn = (bf16_t*)(ws + WS_WDN);
    float* rope = (float*)(ws + WS_ROPE); bf16_t* Abuf = (bf16_t*)(ws + WS_A); bf16_t* Kbuf = (bf16_t*)(ws + WS_K); bf16_t* Vbuf = (bf16_t*)(ws + WS_V);
    LAS float* scr = (LAS float*)(lds + wave * 16384);
    constexpr int I_QKV = 16 * 48, I_O = 16 * 32, I_GLU = 16 * 64, I_UP = 16 * 176, I_DN = 44 * 32;
    constexpr int NITEMS = I_QKV + I_O + I_GLU + 2 * I_UP + 2 * I_DN;
    for (int it = gw; it < NITEMS; it += NGW) {
        int r = it;
        if (r < I_QKV) { transpose_item(args.in[11], DM, QKVD, Wqkv, 0, scr, r, lane); continue; } r -= I_QKV;
        if (r < I_O) { transpose_item(args.in[14], DM, DM, Wo, 0, scr, r, lane); continue; } r -= I_O;
        if (r < I_GLU) { transpose_item(args.in[24], DM, 2 * DM, Wglu, DM, scr, r, lane); continue; } r -= I_GLU;
        if (r < 2 * I_UP) { const int l = r / I_UP; transpose_item(args.in[26] + (size_t)l * DM * FF2, DM, FF2, Wup + (size_t)l * FF2 * DM, FF, scr, r % I_UP, lane); continue; } r -= 2 * I_UP;
        { const int l = r / I_DN; transpose_item(args.in[29] + (size_t)l * FF * DM, FF, DM, Wdn + (size_t)l * DM * FF, 0, scr, r % I_DN, lane); }
    }
    for (int i = blk * 512 + tid; i < SEQ * 8; i += G * 512) { const int pos = i >> 3, f = i & 7; const float inv_freq = powf(500000.0f, -(float)f * 0.125f); const float ang = (float)pos * inv_freq;
        rope[pos * 16 + f] = cosf(ang); rope[pos * 16 + 8 + f] = sinf(ang); }
    for (int i = blk * 512 + tid; i < DB * 128 * 64; i += G * 512) {
        const int b = i / (128 * 64), rem = i % (128 * 64), row = rem >> 6, c4 = (rem & 63) * 4;
        const f32x4 kv = *(const f32x4*)(args.in[2] + ((size_t)(b * 128 + row)) * 256 + c4), vv = *(const f32x4*)(args.in[3] + ((size_t)(b * 128 + row)) * 256 + c4);
        u32x2 kw, vw; kw.x = cvt_pk_bf16(kv[0], kv[1]); kw.y = cvt_pk_bf16(kv[2], kv[3]); vw.x = cvt_pk_bf16(vv[0], vv[1]); vw.y = cvt_pk_bf16(vv[2], vv[3]);
        const size_t krow = (size_t)MP + b * 192 + row;
        *(u32x2*)(Kbuf + krow * 256 + c4) = kw; *(u32x2*)(Vbuf + krow * 256 + c4) = vw;
        if (row >= 64) { *(f32x4*)(out + O_KS + ((size_t)(b * 128 + row - 64)) * 256 + c4) = kv; *(f32x4*)(out + O_VS + ((size_t)(b * 128 + row - 64)) * 256 + c4) = vv; }
    }
    for (int m = gw; m < MT; m += NGW) { const float* xr = (m < MP) ? args.in[0] + (size_t)m * DM : args.in[1] + (size_t)(m - MP) * DM;
        row_pass<false, true>(xr, nullptr, nullptr, nullptr, 0, nullptr, args.in[7], Abuf + (size_t)m * DM, lane); }
}
template <bool HAS_NEXT>
__device__ __forceinline__ void phase_rows(const float* x_prompt, const float* x_sample, bool from_input, float* out, const bf16_t* Mbuf, const float* ss, int nslots, const float* gpost, const float* gnext, bf16_t* Abuf, int gw, int NGW, int lane) {
    for (int m = gw; m < MT; m += NGW) {
        const float* xr = from_input ? ((m < MP) ? x_prompt + (size_t)m * DM : x_sample + (size_t)(m - MP) * DM) : out + (size_t)m * DM;
        row_pass<true, HAS_NEXT>(xr, out + (size_t)m * DM, Mbuf + (size_t)m * DM, ss + (size_t)m * 32, nslots, gpost, gnext, HAS_NEXT ? Abuf + (size_t)m * DM : nullptr, lane);
    }
}
__device__ __forceinline__ void phase_up(LAS unsigned char* lds, const bf16_t* Abuf, const bf16_t* Wup_l, bf16_t* Gbuf, float* Ebuf, const float* cw, const float* cb, int G, int blk) {
    pg8::Gemm g{Abuf, Wup_l, MT, FF2, DM}; pg8::StaticOrder S; S.init(MT, FF2, G, blk);
    pg8::EpiUp E{Gbuf, Ebuf, cw, cb};
    pg8::gemm_phase<pg8::EpiUp, true, true>(lds, g, S, E);
}
__device__ __forceinline__ void phase_down(LAS unsigned char* lds, const bf16_t* Gbuf, const bf16_t* Wdn_l, bf16_t* Mbuf, float* ss, int G, int blk) {
    pg8::Gemm g{Gbuf, Wdn_l, MT, DM, FF}; pg8::StaticOrder S; S.init(MT, DM, G, blk);
    pg8::EpiPlainSS E{Mbuf, nullptr, ss};
    pg8::gemm_phase<pg8::EpiPlainSS, true, true>(lds, g, S, E);
}
__device__ __forceinline__ void phase_fix(const float* Ebuf, bf16_t* Gbuf, const float* cw, const float* cb, const float* cc, float* out, int l, int G, int blk, int tid) {
    for (int i = blk * 512 + tid; i < NSEG * 2 * (FF / 4); i += G * 512) {
        const int ri = i / (FF / 4), c4 = (i % (FF / 4)) * 4, seg = ri >> 1, j = ri & 1;
        f32x4 o;
        f32x4 cres[2];
#pragma unroll
        for (int hf = 0; hf < 2; ++hf) {
            const int col = hf * FF + c4;
            const f32x4 cur0 = *(const f32x4*)(Ebuf + ((size_t)seg * 4 + 0) * FF2 + col), cur1 = *(const f32x4*)(Ebuf + ((size_t)seg * 4 + 1) * FF2 + col);
            f32x4 p0 = {0.f, 0.f, 0.f, 0.f}, p1 = {0.f, 0.f, 0.f, 0.f};
            if (seg >= MP / 64) { const int b = seg - MP / 64; p0 = *(const f32x4*)(cc + ((size_t)b * 2 + 0) * FF2 + col); p1 = *(const f32x4*)(cc + ((size_t)b * 2 + 1) * FF2 + col); }
            else if ((seg & 31) != 0) { p0 = *(const f32x4*)(Ebuf + ((size_t)(seg - 1) * 4 + 2) * FF2 + col); p1 = *(const f32x4*)(Ebuf + ((size_t)(seg - 1) * 4 + 3) * FF2 + col); }
            const f32x4 w0 = *(const f32x4*)(cw + col), w1 = *(const f32x4*)(cw + FF2 + col), w2 = *(const f32x4*)(cw + 2 * FF2 + col), bb = *(const f32x4*)(cb + col);
            cres[hf] = (j == 0) ? (bb + w0 * p0 + w1 * p1 + w2 * cur0) : (bb + w0 * p1 + w1 * cur0 + w2 * cur1);
        }
#pragma unroll
        for (int q = 0; q < 4; ++q) o[q] = gelu_tanh(cres[0][q]) * cres[1][q];
        u32x2 wv; wv.x = cvt_pk_bf16(o[0], o[1]); wv.y = cvt_pk_bf16(o[2], o[3]);
        *(u32x2*)(Gbuf + ((size_t)seg * 64 + j) * FF + c4) = wv;
    }
    for (int i = blk * 512 + tid; i < (NB + DB) * 2 * (FF2 / 4); i += G * 512) {
        const int ri = i / (FF2 / 4), c4 = (i % (FF2 / 4)) * 4, bb = ri >> 1, e = ri & 1;
        const int seg = (bb < NB) ? bb * 32 + 31 : MP / 64 + (bb - NB);
        const f32x4 v = *(const f32x4*)(Ebuf + ((size_t)seg * 4 + 2 + e) * FF2 + c4);
        float* o = (bb < NB) ? out + O_CP + (((size_t)l * NB + bb) * 2 + e) * FF2 + c4 : out + O_CS + (((size_t)l * DB + (bb - NB)) * 2 + e) * FF2 + c4;
        *(f32x4*)o = v;
    }
}

__global__ void __launch_bounds__(512, 2) fwd_kernel(Args args) {
    extern __shared__ __attribute__((aligned(16))) unsigned char lds_raw[];
    LAS unsigned char* lds = (LAS unsigned char*)lds_raw;
    const int tid = threadIdx.x, lane = tid & 63, wave = __builtin_amdgcn_readfirstlane(tid >> 6);
    const int G = gridDim.x, blk = blockIdx.x;
    const int gw = blk * 8 + wave, NGW = G * 8;
    unsigned char* ws = args.ws; float* out = args.out;
    const float* x_prompt = args.in[0]; const float* x_sample = args.in[1];
    bf16_t* Wqkv = (bf16_t*)(ws + WS_WQKV); bf16_t* Wo = (bf16_t*)(ws + WS_WO); bf16_t* Wglu = (bf16_t*)(ws + WS_WGLU); bf16_t* Wup = (bf16_t*)(ws + WS_WUP); bf16_t* Wdn = (bf16_t*)(ws + WS_WDN);
    float* rope = (float*)(ws + WS_ROPE); float* ss = (float*)(ws + WS_SS);
    bf16_t* Abuf = (bf16_t*)(ws + WS_A); bf16_t* Mbuf = (bf16_t*)(ws + WS_MB); float* Ebuf = (float*)(ws + WS_E); bf16_t* Gbuf = (bf16_t*)(ws + WS_G);
    bf16_t* Qbuf = (bf16_t*)(ws + WS_Q); bf16_t* Kbuf = (bf16_t*)(ws + WS_K); bf16_t* Vbuf = (bf16_t*)(ws + WS_V);


    const int lo = args.ph_lo, hi_ = args.ph_hi;
    volatile LAS unsigned* misc = (volatile LAS unsigned*)(lds + 131072 + 1024);
    if (tid < 2) misc[tid] = 0u;
    __syncthreads();
    XcdBarrier xbar; xbar.bar = (unsigned*)ws; xbar.x = 0; xbar.st = nullptr;
    if (args.coop) xbar = xcd_barrier_post((unsigned*)ws, misc);
    if (args.coop == 2) cg::this_grid().sync();
#define IN(k) (lo <= (k) && (k) < hi_)
#define SEAM(k) do { if (args.coop && (k) + 1 < hi_) xcd_barrier(xbar); } while (0)
#define REP(k) _Pragma("unroll") for (int rep_ = 0; rep_ <= ((PROBE_REPMASK >> (k)) & 1); ++rep_)
    if (IN(0)) { REP(0) { phase_prologue(lds, args, ws, out, G, blk, wave, lane, tid); } SEAM(0); }
    if (IN(1)) { REP(1) {
        pg8::Gemm g{Abuf, Wqkv, MT, QKVD, DM}; pg8::StaticOrder S; S.init(MT, QKVD, G, blk);
        pg8::EpiQKV E{Qbuf, Kbuf, Vbuf, args.in[12], rope, out + O_KP, out + O_VP, out + O_KS, out + O_VS};
        pg8::gemm_phase<pg8::EpiQKV, true, true>(lds, g, S, E); } SEAM(1); }
    if (IN(2)) { REP(2) { attn_phase(lds, Qbuf, Kbuf, Vbuf, Qbuf, args.in[13], G, blk); } SEAM(2); }
    if (IN(3)) { REP(3) {
        pg8::Gemm g{Qbuf, Wo, MT, DM, DM}; pg8::StaticOrder S; S.init(MT, DM, G, blk);
        pg8::EpiPlainSS E{Mbuf, args.in[15], ss};
        pg8::gemm_phase<pg8::EpiPlainSS, true, true>(lds, g, S, E); } SEAM(3); }
    if (IN(4)) { REP(4) { phase_rows<true>(x_prompt, x_sample, true, out, Mbuf, ss, 16, args.in[8], args.in[9], Abuf, gw, NGW, lane); } SEAM(4); }
    if (IN(5)) { REP(5) { phase_up(lds, Abuf, Wup, Gbuf, Ebuf, args.in[27], args.in[28], G, blk); } SEAM(5); }
    if (IN(6)) { REP(6) { phase_fix(Ebuf, Gbuf, args.in[27], args.in[28], args.in[6], out, 0, G, blk, tid); } SEAM(6); }
    if (IN(7)) { REP(7) { phase_down(lds, Gbuf, Wdn, Mbuf, ss, G, blk); } SEAM(7); }
    if (IN(8)) { REP(8) { phase_rows<true>(x_prompt, x_sample, false, out, Mbuf, ss, 16, args.in[10], args.in[7] + DM, Abuf, gw, NGW, lane); } SEAM(8); }
    if (IN(9)) { REP(9) {
        SsmP P{args.in[16], args.in[17], args.in[18], args.in[19], args.in[20], args.in[21], args.in[22], args.in[23], args.in[4], args.in[5], out + O_REP, out + O_IMP, out + O_RES, out + O_IMS};
        ssm_phase(lds, Abuf, Qbuf, P, G, blk); } SEAM(9); }
    if (IN(10)) { REP(10) {
        pg8::Gemm g{Qbuf, Wglu, MT, 2 * DM, DM}; pg8::StaticOrder S; S.init(MT, 2 * DM, G, blk);
        pg8::EpiGlu E{Mbuf, args.in[25], ss};
        pg8::gemm_phase<pg8::EpiGlu, true, true>(lds, g, S, E); } SEAM(10); }
    if (IN(11)) { REP(11) { phase_rows<true>(x_prompt, x_sample, false, out, Mbuf, ss, 32, args.in[8] + DM, args.in[9] + DM, Abuf, gw, NGW, lane); } SEAM(11); }
    if (IN(12)) { REP(12) { phase_up(lds, Abuf, Wup + (size_t)FF2 * DM, Gbuf, Ebuf, args.in[27] + (size_t)3 * FF2, args.in[28] + FF2, G, blk); } SEAM(12); }
    if (IN(13)) { REP(13) { phase_fix(Ebuf, Gbuf, args.in[27] + (size_t)3 * FF2, args.in[28] + FF2, args.in[6] + (size_t)DB * 2 * FF2, out, 1, G, blk, tid); } SEAM(13); }
    if (IN(14)) { REP(14) { phase_down(lds, Gbuf, Wdn + (size_t)DM * FF, Mbuf, ss, G, blk); } SEAM(14); }
    if (IN(15)) { REP(15) { phase_rows<false>(x_prompt, x_sample, false, out, Mbuf, ss, 16, args.in[10] + DM, nullptr, nullptr, gw, NGW, lane); } }
#undef IN
#undef SEAM
#undef REP
}

extern "C" void kernel_launch(void* const* d_in, const int* in_sizes, int n_in, void* d_out, int out_size, void* d_ws, size_t ws_size, hipStream_t stream) {
    static int grid = 0;
    if (grid == 0) {
        if (n_in != 30 || (size_t)out_size != O_END || ws_size < WS_END) { fprintf(stderr, "kernel_launch: unexpected shapes: n_in %d out %d ws %zu (need out %zu ws %zu)\n", n_in, out_size, ws_size, (size_t)O_END, (size_t)WS_END); grid = -1; return; }
        int dev = 0, cus = 0, per_cu = 0;
        hipGetDevice(&dev); hipDeviceGetAttribute(&cus, hipDeviceAttributeMultiprocessorCount, dev);
        if (hipFuncSetAttribute((const void*)fwd_kernel, hipFuncAttributeMaxDynamicSharedMemorySize, LDS_BYTES) != hipSuccess) { fprintf(stderr, "kernel_launch: hipFuncSetAttribute failed\n"); grid = -1; return; }
        if (hipOccupancyMaxActiveBlocksPerMultiprocessor(&per_cu, (const void*)fwd_kernel, 512, LDS_BYTES) != hipSuccess || per_cu < 1) { fprintf(stderr, "kernel_launch: occupancy query says %d\n", per_cu); per_cu = 1; }
        (void)hipGetLastError();
        grid = cus * 1;
    }
    if (grid < 0) return;
    Args a{};
    for (int i = 0; i < 30; ++i) a.in[i] = (const float*)d_in[i];
    a.out = (float*)d_out; a.ws = (unsigned char*)d_ws;
#ifndef MK_MULTI
    if (hipMemsetAsync(d_ws, 0, 16384, stream) != hipSuccess) { fprintf(stderr, "kernel_launch: memset failed\n"); return; }
    a.ph_lo = 0; a.ph_hi = NPHASE; a.coop = 1;
    void* kargs[] = {&a};
    hipError_t e = hipLaunchCooperativeKernel((const void*)fwd_kernel, dim3(grid), dim3(512), kargs, LDS_BYTES, stream);
    if (e != hipSuccess) fprintf(stderr, "cooperative launch failed: %s (grid %d)\n", hipGetErrorString(e), grid);
#else
    for (int ph = 0; ph < NPHASE; ++ph) { a.ph_lo = ph; a.ph_hi = ph + 1; a.coop = 0; hipLaunchKernelGGL(fwd_kernel, dim3(grid), dim3(512), LDS_BYTES, stream, a); }
#endif
}
```

```cpp
#include <hip/hip_runtime.h>
#include <hip/hip_cooperative_groups.h>
#include <cstdio>
#include <cstdint>
namespace cg = cooperative_groups;

#define LAS __attribute__((address_space(3)))
typedef unsigned short bf16_t;
typedef short bf16x8 __attribute__((ext_vector_type(8)));
typedef short s16x4 __attribute__((ext_vector_type(4)));
typedef float f32x4 __attribute__((ext_vector_type(4)));
typedef float f32x16 __attribute__((ext_vector_type(16)));
typedef unsigned u32x4 __attribute__((ext_vector_type(4)));
typedef unsigned u32x2 __attribute__((ext_vector_type(2)));

constexpr int DM = 1024, NB = 32, SEQ = 2048, MP = NB * SEQ, DB = 16, DS = 64, MS = DB * DS, MT = MP + MS;
constexpr int QKVD = 1536, FF = 2816, FF2 = 5632, NSEG = MT / 64;
constexpr int KVROWS = MP + DB * 192;
constexpr float EPS = 1e-6f, LOG2E = 1.4426950408889634f, QSCALE = 0.125f * 1.4426950408889634f;
constexpr size_t O_Y = 0, O_KP = (size_t)MT * DM, O_VP = O_KP + (size_t)NB * 128 * 256, O_KS = O_VP + (size_t)NB * 128 * 256, O_VS = O_KS + (size_t)DB * 128 * 256,
                 O_REP = O_VS + (size_t)DB * 128 * 256, O_IMP = O_REP + NB * 4096, O_RES = O_IMP + NB * 4096, O_IMS = O_RES + DB * 4096,
                 O_CP = O_IMS + DB * 4096, O_CS = O_CP + (size_t)2 * NB * 2 * FF2, O_END = O_CS + (size_t)2 * DB * 2 * FF2;
constexpr size_t MiB = 1u << 20;
constexpr size_t WS_WQKV = 1 * MiB, WS_WO = 4 * MiB, WS_WGLU = 6 * MiB, WS_WUP = 10 * MiB, WS_WDN = 32 * MiB, WS_ROPE = 43 * MiB, WS_SS = 44 * MiB,
                 WS_A = 54 * MiB, WS_MB = 185 * MiB, WS_E = 316 * MiB, WS_G = 406 * MiB, WS_Q = WS_G, WS_K = WS_G + 132 * MiB, WS_V = WS_K + 34 * MiB, WS_X16 = WS_G + 358 * MiB, WS_END = WS_X16 + 131 * MiB;
static_assert(WS_WUP + (size_t)2 * FF2 * DM * 2 <= WS_WDN && WS_WDN + (size_t)2 * DM * FF * 2 <= WS_ROPE && WS_SS + (size_t)MT * 32 * 4 <= WS_A, "ws map 1");
static_assert(WS_A + (size_t)MT * DM * 2 <= WS_MB && WS_MB + (size_t)MT * DM * 2 <= WS_E && WS_E + (size_t)NSEG * 4 * FF2 * 4 <= WS_G, "ws map 2");
static_assert(WS_X16 + (size_t)MT * DM * 2 <= WS_END, "ws map 4");
static_assert(WS_Q + (size_t)MT * DM * 2 <= WS_K && WS_K + (size_t)KVROWS * 256 * 2 <= WS_V && WS_V + (size_t)KVROWS * 256 * 2 <= WS_END && WS_G + (size_t)MT * FF * 2 <= WS_END, "ws map 3");

__device__ __forceinline__ unsigned cvt_pk_bf16(float lo, float hi) { unsigned r; asm volatile("v_cvt_pk_bf16_f32 %0, %1, %2" : "=v"(r) : "v"(lo), "v"(hi)); return r; }
__device__ __forceinline__ float bf2f(unsigned short b) { return __uint_as_float((unsigned)b << 16); }
__device__ __forceinline__ float gelu_tanh(float x) {
    const float x2 = x * x, u = x * (0.7978845608f + 0.0356774081f * x2);
    const float e = __builtin_amdgcn_exp2f(-2.885390082f * u);
    return x * __builtin_amdgcn_rcpf(1.0f + e);
}
__device__ __forceinline__ float sigmoid_f(float v) { return __builtin_amdgcn_rcpf(1.0f + __builtin_amdgcn_exp2f(-LOG2E * v)); }
__device__ __forceinline__ float wave_sum(float v) {
#pragma unroll
    for (int o = 1; o < 64; o <<= 1) v += __shfl_xor(v, o);
    return v;
}
template <int CTRL> __device__ __forceinline__ float dpp_f(float x) { return __builtin_bit_cast(float, __builtin_amdgcn_update_dpp(0, __builtin_bit_cast(int, x), CTRL, 0xf, 0xf, false)); }

namespace pg8 {
constexpr int BM = 256, BK = 64, HALF = 128, HTB = HALF * BK * 2, STAGE_BYTES = 8 * HTB, NXCD = 8, WGM = 8;
__host__ __device__ __forceinline__ int lds_byte(int r, int c) { const int st = (r >> 4) * 2 + (c >> 5), rr = r & 15, cc = c & 31, ob = rr * 64 + cc * 2; return st * 1024 + (ob ^ (((ob >> 9) & 1) << 5)); }
__host__ __device__ __forceinline__ void stage_rc(int b, int& R, int& C) { const int st = b / 1024, sb = b % 1024, swz = sb ^ (((sb >> 9) & 1) << 5); R = (st >> 1) * 16 + swz / 64; C = (st & 1) * 32 + (swz % 64) / 2; }
__host__ __device__ __forceinline__ int perm32(int rho) { const int n = rho >> 4, i = rho & 15; return 8 * (i >> 2) + 4 * n + (i & 3); }
struct Unit { int pm, pn; };
struct Gemm { const bf16_t* A; const bf16_t* Bt; int M, N, K; };
struct StaticOrder {
    int nM, nN, nwg, G, c;
    __device__ void init(int M, int N, int G_, int c_) { nM = M / BM; nN = N / BM; nwg = nM * nN; G = G_; c = c_; }
    __device__ bool next(int i, Unit& u) const {
        const long L = (long)i * G + c; if (L >= nwg) return false;
        int wgid = (int)L; { const int q = nwg / NXCD, r = nwg % NXCD, xcd = wgid % NXCD, off = wgid / NXCD; wgid = (xcd < r ? xcd * (q + 1) : r * (q + 1) + (xcd - r) * q) + off; }
        const int nig = WGM * nN, gid = wgid / nig, fm = gid * WGM, gsz = (nM - fm) < WGM ? (nM - fm) : WGM;
        u.pm = fm + ((wgid % nig) % gsz); u.pn = (wgid % nig) / gsz; return true;
    }
};
template <class Epi, bool ALIGN_EPI, bool SP2>
__device__ __forceinline__ void gemm_phase(LAS unsigned char* lds, const Gemm g, const StaticOrder& S, const Epi& E) {
    const int tid = threadIdx.x, wid = __builtin_amdgcn_readfirstlane(tid >> 6), lane = tid & 63, wr = wid >> 2, wc = wid & 3, fr = lane & 15, fq = lane >> 4;
    const int K = g.K, nt = K / BK;
    unsigned voffA[2], voffB[2];
#pragma unroll
    for (int i = 0; i < 2; ++i) { int R, C; stage_rc(tid * 16 + i * 8192, R, C); const int Rb = Epi::PERM ? ((R & ~31) + perm32(R & 31)) : R;
        voffA[i] = (unsigned)(R * K + C) * 2u; voffB[i] = (unsigned)(Rb * K + C) * 2u; }
    const size_t kstep = (size_t)(BK * 2);
    const size_t hstep = (size_t)HALF * K * 2;
    const size_t tstep = 2 * hstep;
    const unsigned ldsw = (unsigned)wid * 1024u;
    const int aoff = lds_byte(wr * 64 + fr, fq * 8), boff = lds_byte(wc * 32 + fr, fq * 8);
#define PG8_SA(b, h) (((b) * 2 + (h)) * HTB)
#define PG8_SB(b, h) ((4 + (b) * 2 + (h)) * HTB)
#define PG8_STAGE(bufoff, gbase, voff) do { _Pragma("unroll") for (int _i = 0; _i < 2; ++_i) \
        __builtin_amdgcn_global_load_lds((const unsigned*)((const char*)(gbase) + (voff)[_i]), (LAS unsigned*)(lds + (bufoff) + ldsw + _i * 8192), 16, 0, 0); } while (0)
#define PG8_LDA(dst, b, h) do { _Pragma("unroll") for (int m = 0; m < 4; ++m) _Pragma("unroll") for (int k = 0; k < 2; ++k) dst[m][k] = *(const LAS bf16x8*)(lds + PG8_SA(b, h) + aoff + m * 2048 + k * 1024); } while (0)
#define PG8_LDB(dst, b, h) do { _Pragma("unroll") for (int n = 0; n < 2; ++n) _Pragma("unroll") for (int k = 0; k < 2; ++k) dst[n][k] = *(const LAS bf16x8*)(lds + PG8_SB(b, h) + boff + n * 2048 + k * 1024); } while (0)
#define PG8_MMA(ai, bj, At, Bt) do { __builtin_amdgcn_s_setprio(1); _Pragma("unroll") for (int m = 0; m < 4; ++m) _Pragma("unroll") for (int n = 0; n < 2; ++n) _Pragma("unroll") for (int k = 0; k < 2; ++k) \
        acc[ai][bj][m][n] = __builtin_amdgcn_mfma_f32_16x16x32_bf16(Bt[n][k], At[m][k], acc[ai][bj][m][n], 0, 0, 0); __builtin_amdgcn_s_setprio(0); } while (0)
#define PG8_WAIT_V(n) asm volatile("s_waitcnt vmcnt(" #n ")" ::: "memory")
#define PG8_WAIT_L(n) asm volatile("s_waitcnt lgkmcnt(" #n ")" ::: "memory")
#define PG8_BAR __builtin_amdgcn_s_barrier()
#define PG8_SCHED __builtin_amdgcn_sched_barrier(0)
    Unit cur, nxt; int ui = 0;
    if (!S.next(0, cur)) return;
    f32x4 acc[2][2][4][2];
#pragma unroll
    for (int a = 0; a < 2; ++a)
#pragma unroll
        for (int b = 0; b < 2; ++b)
#pragma unroll
            for (int m = 0; m < 4; ++m)
#pragma unroll
                for (int n = 0; n < 2; ++n) acc[a][b][m][n] = (f32x4){0.f, 0.f, 0.f, 0.f};
    bf16x8 At[4][2], B0[2][2], B1[2][2];
    const char* cA = (const char*)g.A + (size_t)cur.pm * tstep; const char* cB = (const char*)g.Bt + (size_t)cur.pn * tstep;
    if constexpr (SP2) {
        PG8_STAGE(PG8_SB(0, 0), cB, voffB); PG8_STAGE(PG8_SB(0, 1), cB + hstep, voffB); PG8_STAGE(PG8_SA(0, 0), cA, voffA); PG8_STAGE(PG8_SA(0, 1), cA + hstep, voffA);
        if (wr == 1) PG8_BAR;
        PG8_WAIT_V(2); PG8_BAR;
        PG8_STAGE(PG8_SB(1, 0), cB + kstep, voffB); PG8_STAGE(PG8_SA(1, 0), cA + kstep, voffA); PG8_STAGE(PG8_SB(1, 1), cB + hstep + kstep, voffB);
        PG8_WAIT_V(6); PG8_BAR;
    } else {
        PG8_STAGE(PG8_SB(0, 0), cB, voffB); PG8_STAGE(PG8_SA(0, 0), cA, voffA); PG8_STAGE(PG8_SB(0, 1), cB + hstep, voffB); PG8_STAGE(PG8_SA(0, 1), cA + hstep, voffA);
        if (wr == 1) PG8_BAR;
        PG8_WAIT_V(4); PG8_BAR;
        PG8_STAGE(PG8_SB(1, 0), cB + kstep, voffB); PG8_STAGE(PG8_SA(1, 0), cA + kstep, voffA); PG8_STAGE(PG8_SB(1, 1), cB + hstep + kstep, voffB);
        PG8_WAIT_V(6); PG8_BAR;
    }
    for (;;) {
        const bool has_next = S.next(ui + 1, nxt);
        const char* nA = has_next ? (const char*)g.A + (size_t)nxt.pm * tstep : cA; const char* nB = has_next ? (const char*)g.Bt + (size_t)nxt.pn * tstep : cB;
        for (int t = 0; t < nt; t += 2) {
            const bool last = (t == nt - 2);
            const char* a1 = cA + (size_t)(t + 1) * kstep;
            const char* a2 = last ? nA : cA + (size_t)(t + 2) * kstep; const char* b2 = last ? nB : cB + (size_t)(t + 2) * kstep;
            const char* a3 = a2 + kstep; const char* b3 = b2 + kstep;
            if constexpr (SP2) {
            PG8_LDB(B0, 0, 0); PG8_LDB(B1, 0, 1); PG8_SCHED; PG8_LDA(At, 0, 0); PG8_STAGE(PG8_SA(1, 1), a1 + hstep, voffA);
            PG8_WAIT_V(8); PG8_WAIT_L(0); PG8_BAR; PG8_MMA(0, 0, At, B0); PG8_MMA(0, 1, At, B1); PG8_BAR; PG8_SCHED;
            PG8_LDA(At, 0, 1); PG8_STAGE(PG8_SB(0, 0), b2, voffB); PG8_STAGE(PG8_SB(0, 1), b2 + hstep, voffB); PG8_STAGE(PG8_SA(0, 0), a2, voffA);
            PG8_WAIT_V(8); PG8_WAIT_L(0); PG8_BAR; PG8_MMA(1, 0, At, B0); PG8_MMA(1, 1, At, B1); PG8_BAR; PG8_SCHED;
            PG8_LDB(B0, 1, 0); PG8_LDB(B1, 1, 1); PG8_SCHED; PG8_LDA(At, 1, 0); PG8_STAGE(PG8_SA(0, 1), a2 + hstep, voffA);
            PG8_WAIT_V(8); PG8_WAIT_L(0); PG8_BAR; PG8_MMA(0, 0, At, B0); PG8_MMA(0, 1, At, B1); PG8_BAR; PG8_SCHED;
            PG8_LDA(At, 1, 1); PG8_STAGE(PG8_SB(1, 0), b3, voffB); PG8_STAGE(PG8_SB(1, 1), b3 + hstep, voffB); PG8_STAGE(PG8_SA(1, 0), a3, voffA);
            PG8_WAIT_V(8); PG8_WAIT_L(0); PG8_BAR; PG8_MMA(1, 0, At, B0); PG8_MMA(1, 1, At, B1); PG8_BAR; PG8_SCHED;
            } else {
            PG8_LDB(B0, 0, 0); PG8_SCHED; PG8_LDA(At, 0, 0); PG8_STAGE(PG8_SA(1, 1), a1 + hstep, voffA);
            PG8_WAIT_L(8); PG8_BAR; PG8_WAIT_L(0); PG8_MMA(0, 0, At, B0); PG8_BAR; PG8_SCHED;
            PG8_LDB(B1, 0, 1); PG8_STAGE(PG8_SB(0, 0), b2, voffB);
            PG8_BAR; PG8_WAIT_L(0); PG8_MMA(0, 1, At, B1); PG8_BAR;
            PG8_LDA(At, 0, 1); PG8_STAGE(PG8_SA(0, 0), a2, voffA);
            PG8_BAR; PG8_WAIT_L(0); PG8_MMA(1, 0, At, B0); PG8_BAR; PG8_SCHED;
            PG8_STAGE(PG8_SB(0, 1), b2 + hstep, voffB);
            PG8_WAIT_V(6); PG8_BAR; PG8_MMA(1, 1, At, B1); PG8_BAR;
            PG8_LDB(B0, 1, 0); PG8_SCHED; PG8_LDA(At, 1, 0); PG8_STAGE(PG8_SA(0, 1), a2 + hstep, voffA);
            PG8_WAIT_L(8); PG8_BAR; PG8_WAIT_L(0); PG8_MMA(0, 0, At, B0); PG8_BAR; PG8_SCHED;
            PG8_LDB(B1, 1, 1); PG8_STAGE(PG8_SB(1, 0), b3, voffB);
            PG8_BAR; PG8_WAIT_L(0); PG8_MMA(0, 1, At, B1); PG8_BAR;
            PG8_LDA(At, 1, 1); PG8_STAGE(PG8_SA(1, 0), a3, voffA);
            PG8_BAR; PG8_WAIT_L(0); PG8_MMA(1, 0, At, B0); PG8_BAR; PG8_SCHED;
            PG8_STAGE(PG8_SB(1, 1), b3 + hstep, voffB);
            PG8_WAIT_V(6); PG8_BAR; PG8_MMA(1, 1, At, B1); PG8_BAR;
            }
        }
        if constexpr (ALIGN_EPI) { if (wr == 0) PG8_BAR; }
        E(acc, cur, wr, wc, fr, fq);
        if (!has_next) break;
#pragma unroll
        for (int a = 0; a < 2; ++a)
#pragma unroll
            for (int b = 0; b < 2; ++b)
#pragma unroll
                for (int m = 0; m < 4; ++m)
#pragma unroll
                    for (int n = 0; n < 2; ++n) acc[a][b][m][n] = (f32x4){0.f, 0.f, 0.f, 0.f};
        cur = nxt; cA = nA; cB = nB; ++ui;
        if constexpr (ALIGN_EPI) { if (wr == 1) PG8_BAR; }
    }
    PG8_WAIT_V(0);
    if constexpr (!ALIGN_EPI) { if (wr == 0) PG8_BAR; }
    PG8_BAR;
#undef PG8_SA
#undef PG8_SB
#undef PG8_STAGE
#undef PG8_LDA
#undef PG8_LDB
#undef PG8_MMA
#undef PG8_WAIT_V
#undef PG8_WAIT_L
#undef PG8_BAR
#undef PG8_SCHED
}

struct EpiQKV {
    static constexpr bool PERM = true;
    bf16_t* Q; bf16_t* Kb; bf16_t* Vb; const float* bias; const float* rope; float* kp; float* vp; float* ks; float* vs;
    __device__ __forceinline__ void operator()(const f32x4 (&acc)[2][2][4][2], const Unit& u, int wr, int wc, int fr, int fq) const {
        const int kind = u.pn < 4 ? 0 : u.pn - 3;
        const int lc0 = wc * 32 + 8 * fq;
        f32x4 bv[2][2];
#pragma unroll
        for (int bj = 0; bj < 2; ++bj)
#pragma unroll
            for (int n = 0; n < 2; ++n) bv[bj][n] = *(const f32x4*)(bias + u.pn * 256 + bj * 128 + lc0 + 4 * n);
        const bool dorope = (kind < 2) && ((wc & 1) == 0);
        const float sgn = (fq == 0) ? -1.f : 1.f;
#pragma unroll
        for (int ai = 0; ai < 2; ++ai)
#pragma unroll
            for (int m = 0; m < 4; ++m) {
                const int r = u.pm * 256 + ai * 128 + wr * 64 + m * 16 + fr;
                const bool prompt = r < MP;
                const int t = prompt ? (r & 2047) : ((r - MP) & 63), b = prompt ? (r >> 11) : ((r - MP) >> 6);
                const int pos = prompt ? t : 1024 + t;
                f32x4 cs[2], sn[2];
                if (dorope) { cs[0] = *(const f32x4*)(rope + pos * 16); cs[1] = *(const f32x4*)(rope + pos * 16 + 4); sn[0] = *(const f32x4*)(rope + pos * 16 + 8); sn[1] = *(const f32x4*)(rope + pos * 16 + 12); }
#pragma unroll
                for (int bj = 0; bj < 2; ++bj) {
                    f32x4 v[2];
#pragma unroll
                    for (int n = 0; n < 2; ++n) {
                        v[n] = acc[ai][bj][m][n] + bv[bj][n];
                        if (dorope) {
#pragma unroll
                            for (int j = 0; j < 4; ++j) { const float p = __shfl_xor(v[n][j], 16); const float rv = v[n][j] * cs[n][j] + sgn * p * sn[n][j]; v[n][j] = (fq < 2) ? rv : v[n][j]; }
                        }
                    }
                    if (kind == 0) {
                        u32x4 w; w.x = cvt_pk_bf16(v[0][0] * QSCALE, v[0][1] * QSCALE); w.y = cvt_pk_bf16(v[0][2] * QSCALE, v[0][3] * QSCALE); w.z = cvt_pk_bf16(v[1][0] * QSCALE, v[1][1] * QSCALE); w.w = cvt_pk_bf16(v[1][2] * QSCALE, v[1][3] * QSCALE);
                        *(u32x4*)(Q + (size_t)r * DM + u.pn * 256 + bj * 128 + lc0) = w;
                    } else {
                        const int col = bj * 128 + lc0;
                        const size_t krow = prompt ? (size_t)r : (size_t)MP + b * 192 + 128 + t;
                        u32x4 w; w.x = cvt_pk_bf16(v[0][0], v[0][1]); w.y = cvt_pk_bf16(v[0][2], v[0][3]); w.z = cvt_pk_bf16(v[1][0], v[1][1]); w.w = cvt_pk_bf16(v[1][2], v[1][3]);
                        *(u32x4*)((kind == 1 ? Kb : Vb) + krow * 256 + col) = w;
                        float* o = nullptr;
                        if (prompt) { if (t >= SEQ - 128) o = (kind == 1 ? kp : vp) + ((size_t)(b * 128 + t - (SEQ - 128)) * 256 + col); }
                        else o = (kind == 1 ? ks : vs) + ((size_t)(b * 128 + 64 + t) * 256 + col);
                        if (o) { *(f32x4*)o = v[0]; *(f32x4*)(o + 4) = v[1]; }
                    }
                }
            }
    }
};
struct EpiPlainSS {
    static constexpr bool PERM = true;
    bf16_t* O; const float* bias; float* ss;
    __device__ __forceinline__ void operator()(const f32x4 (&acc)[2][2][4][2], const Unit& u, int wr, int wc, int fr, int fq) const {
        const int col0 = u.pn * 256 + wc * 32 + 8 * fq;
        f32x4 bv[2][2];
#pragma unroll
        for (int bj = 0; bj < 2; ++bj)
#pragma unroll
            for (int n = 0; n < 2; ++n) bv[bj][n] = bias ? *(const f32x4*)(bias + col0 + bj * 128 + 4 * n) : (f32x4){0.f, 0.f, 0.f, 0.f};
#pragma unroll
        for (int ai = 0; ai < 2; ++ai)
#pragma unroll
            for (int m = 0; m < 4; ++m) {
                const int r = u.pm * 256 + ai * 128 + wr * 64 + m * 16 + fr; float s = 0.f;
#pragma unroll
                for (int bj = 0; bj < 2; ++bj) {
                    const f32x4 v0 = acc[ai][bj][m][0] + bv[bj][0], v1 = acc[ai][bj][m][1] + bv[bj][1];
                    s += (v0[0] * v0[0] + v0[1] * v0[1]) + (v0[2] * v0[2] + v0[3] * v0[3]) + (v1[0] * v1[0] + v1[1] * v1[1]) + (v1[2] * v1[2] + v1[3] * v1[3]);
                    u32x4 w; w.x = cvt_pk_bf16(v0[0], v0[1]); w.y = cvt_pk_bf16(v0[2], v0[3]); w.z = cvt_pk_bf16(v1[0], v1[1]); w.w = cvt_pk_bf16(v1[2], v1[3]);
                    *(u32x4*)(O + (size_t)r * DM + col0 + bj * 128) = w;
                }
                s += __shfl_xor(s, 16); s += __shfl_xor(s, 32);
                if (fq == 0) ss[(size_t)r * 32 + u.pn * 4 + wc] = s;
            }
    }
};
struct EpiGlu {
    static constexpr bool PERM = true;
    bf16_t* O; const float* bias; float* ss;
    __device__ __forceinline__ void operator()(const f32x4 (&acc)[2][2][4][2], const Unit& u, int wr, int wc, int fr, int fq) const {
        const int oc0 = u.pn * 128 + wc * 32 + 8 * fq;
        f32x4 ba[2], bg[2];
#pragma unroll
        for (int n = 0; n < 2; ++n) { ba[n] = *(const f32x4*)(bias + oc0 + 4 * n); bg[n] = *(const f32x4*)(bias + DM + oc0 + 4 * n); }
#pragma unroll
        for (int ai = 0; ai < 2; ++ai)
#pragma unroll
            for (int m = 0; m < 4; ++m) {
                const int r = u.pm * 256 + ai * 128 + wr * 64 + m * 16 + fr; float s = 0.f; f32x4 o[2];
#pragma unroll
                for (int n = 0; n < 2; ++n) { const f32x4 a = acc[ai][0][m][n] + ba[n], g = acc[ai][1][m][n] + bg[n];
#pragma unroll
                    for (int j = 0; j < 4; ++j) { o[n][j] = a[j] * sigmoid_f(g[j]); s += o[n][j] * o[n][j]; } }
                u32x4 w; w.x = cvt_pk_bf16(o[0][0], o[0][1]); w.y = cvt_pk_bf16(o[0][2], o[0][3]); w.z = cvt_pk_bf16(o[1][0], o[1][1]); w.w = cvt_pk_bf16(o[1][2], o[1][3]);
                *(u32x4*)(O + (size_t)r * DM + oc0) = w;
                s += __shfl_xor(s, 16); s += __shfl_xor(s, 32);
                if (fq == 0) ss[(size_t)r * 32 + u.pn * 4 + wc] = s;
            }
    }
};
struct EpiUp {
    static constexpr bool PERM = true;
    bf16_t* G; float* E; const float* cw; const float* cb;
    __device__ __forceinline__ void operator()(f32x4 (&acc)[2][2][4][2], const Unit& u, int wr, int wc, int fr, int fq) const {
        const int oc0 = u.pn * 128 + wc * 32 + 8 * fq;
        {
            const int e = (fr < 2) ? fr : fr - 12; const int msel = (fr < 2) ? 0 : 3;
            if (fr < 2 || fr >= 14) {
#pragma unroll
                for (int ai = 0; ai < 2; ++ai) {
                    const int seg = u.pm * 4 + ai * 2 + wr; float* eb = E + ((size_t)seg * 4 + e) * FF2 + oc0;
#pragma unroll
                    for (int bj = 0; bj < 2; ++bj)
#pragma unroll
                        for (int n = 0; n < 2; ++n) { const f32x4 v = (msel == 0) ? acc[ai][bj][0][n] : acc[ai][bj][3][n]; *(f32x4*)(eb + bj * FF + 4 * n) = v; }
                }
            }
        }
#pragma unroll
        for (int n = 0; n < 2; ++n) {
#pragma unroll
            for (int bj = 0; bj < 2; ++bj) {
                const float* cwp = cw + bj * FF + oc0 + 4 * n;
                const f32x4 w0 = *(const f32x4*)(cwp), w1 = *(const f32x4*)(cwp + FF2), w2 = *(const f32x4*)(cwp + 2 * FF2), bb = *(const f32x4*)(cb + bj * FF + oc0 + 4 * n);
#pragma unroll
                for (int ai = 0; ai < 2; ++ai)
#pragma unroll
                    for (int m = 3; m >= 0; --m) {
                        const f32x4 v = acc[ai][bj][m][n]; const f32x4 vp = (m > 0) ? acc[ai][bj][m - 1][n] : v;
                        f32x4 c;
#pragma unroll
                        for (int j = 0; j < 4; ++j) {
                            const float p1 = dpp_f<0x121>(fr == 15 ? vp[j] : v[j]);
                            const float p2 = dpp_f<0x122>(fr >= 14 ? vp[j] : v[j]);
                            c[j] = bb[j] + w0[j] * p2 + w1[j] * p1 + w2[j] * v[j];
                        }
                        asm volatile("" : "+v"(c));
                        acc[ai][bj][m][n] = c;
                    }
                asm volatile("" ::: "memory");
            }
        }
#pragma unroll
        for (int ai = 0; ai < 2; ++ai)
#pragma unroll
            for (int m = 0; m < 4; ++m) {
                const int r = u.pm * 256 + ai * 128 + wr * 64 + m * 16 + fr;
                f32x4 o[2];
#pragma unroll
                for (int n = 0; n < 2; ++n)
#pragma unroll
                    for (int j = 0; j < 4; ++j) o[n][j] = gelu_tanh(acc[ai][0][m][n][j]) * acc[ai][1][m][n][j];
                u32x4 w; w.x = cvt_pk_bf16(o[0][0], o[0][1]); w.y = cvt_pk_bf16(o[0][2], o[0][3]); w.z = cvt_pk_bf16(o[1][0], o[1][1]); w.w = cvt_pk_bf16(o[1][2], o[1][3]);
                if (!(m == 0 && fr < 2)) *(u32x4*)(G + (size_t)r * FF + oc0) = w;
            }
    }
};
}

#ifndef PROBE_REPMASK
#define PROBE_REPMASK 0
#endif
struct Args { const float* in[30]; float* out; unsigned char* ws; int ph_lo, ph_hi, coop, repmask; };
constexpr int NPHASE = 16;
constexpr int LDS_BYTES = 147456;

__device__ __forceinline__ unsigned f2bf(float f) { unsigned u = __builtin_bit_cast(unsigned, f); return (u + 0x7fffu + ((u >> 16) & 1u)) >> 16; }
__device__ __forceinline__ unsigned pk2(float lo, float hi) { return f2bf(lo) | (f2bf(hi) << 16); }
__device__ __forceinline__ void transpose_item(const float* W, int K, int N, bf16_t* WT, int pair_half, LAS float* scr, int item, int lane) {
    const int nblk = N / 32, kb = item / nblk, nb = item % nblk, k0 = 64 * kb, n0 = 32 * nb;
#pragma unroll 8
    for (int i = 0; i < 32; ++i) { const int kk = 2 * i + (lane >> 5); scr[kk * 33 + (lane & 31)] = W[(size_t)(k0 + kk) * N + n0 + (lane & 31)]; }
    asm volatile("s_waitcnt lgkmcnt(0)" ::: "memory");
    int r0 = n0;
    if (pair_half > 0) { const int half = n0 / pair_half, c = n0 % pair_half; r0 = 256 * (c / 128) + 128 * half + (c % 128); }
    const int c = lane & 7;
#pragma unroll
    for (int j = 0; j < 4; ++j) { const int n = (lane >> 3) + 8 * j; const LAS float* s = scr + (8 * c) * 33 + n;
        u32x4 o; o.x = pk2(s[0 * 33], s[1 * 33]); o.y = pk2(s[2 * 33], s[3 * 33]); o.z = pk2(s[4 * 33], s[5 * 33]); o.w = pk2(s[6 * 33], s[7 * 33]);
        *(u32x4*)(WT + (size_t)(r0 + n) * K + k0 + 8 * c) = o; }
    asm volatile("s_waitcnt lgkmcnt(0)" ::: "memory");
}

template <bool HAS_M, bool HAS_NEXT, bool XIN_F32, bool XOUT_F32>
__device__ __forceinline__ void row_pass(const void* xin, void* xout, const bf16_t* mrow, const float* ssrow, int nslots, const float* gpost, const float* gnext, bf16_t* arow, int lane) {
    f32x4 v[4];
#pragma unroll
    for (int j = 0; j < 4; ++j) {
        if constexpr (XIN_F32) v[j] = *((const f32x4*)xin + lane + 64 * j);
        else { const u32x2 xw = *((const u32x2*)xin + lane + 64 * j); v[j][0] = __uint_as_float(xw.x << 16); v[j][1] = __uint_as_float(xw.x & 0xffff0000u); v[j][2] = __uint_as_float(xw.y << 16); v[j][3] = __uint_as_float(xw.y & 0xffff0000u); }
    }
    if constexpr (HAS_M) {
        float s = (lane < nslots) ? ssrow[lane] : 0.f; s = wave_sum(s);
        const float rstd = 1.0f / sqrtf(s * (1.0f / DM) + EPS);
#pragma unroll
        for (int j = 0; j < 4; ++j) {
            const u32x2 mw = *((const u32x2*)mrow + lane + 64 * j); const f32x4 gp = *((const f32x4*)gpost + lane + 64 * j);
            v[j][0] += __uint_as_float(mw.x << 16) * rstd * gp[0]; v[j][1] += __uint_as_float(mw.x & 0xffff0000u) * rstd * gp[1];
            v[j][2] += __uint_as_float(mw.y << 16) * rstd * gp[2]; v[j][3] += __uint_as_float(mw.y & 0xffff0000u) * rstd * gp[3];
            if constexpr (XOUT_F32) *((f32x4*)xout + lane + 64 * j) = v[j];
            else { u32x2 w; w.x = cvt_pk_bf16(v[j][0], v[j][1]); w.y = cvt_pk_bf16(v[j][2], v[j][3]); *((u32x2*)xout + lane + 64 * j) = w; }
        }
    }
    if constexpr (HAS_NEXT) {
        float s2 = 0.f;
#pragma unroll
        for (int j = 0; j < 4; ++j) s2 += (v[j][0] * v[j][0] + v[j][1] * v[j][1]) + (v[j][2] * v[j][2] + v[j][3] * v[j][3]);
        s2 = wave_sum(s2);
        const float rstd2 = 1.0f / sqrtf(s2 * (1.0f / DM) + EPS);
#pragma unroll
        for (int j = 0; j < 4; ++j) { const f32x4 gn = *((const f32x4*)gnext + lane + 64 * j);
            u32x2 w; w.x = cvt_pk_bf16(v[j][0] * rstd2 * gn[0], v[j][1] * rstd2 * gn[1]); w.y = cvt_pk_bf16(v[j][2] * rstd2 * gn[2], v[j][3] * rstd2 * gn[3]);
            *((u32x2*)arow + lane + 64 * j) = w; }
    }
}

__device__ __forceinline__ s16x4 vtr(LAS const unsigned char* p) { return __builtin_bit_cast(s16x4, __builtin_amdgcn_ds_read_tr16_b64_v4i16((LAS s16x4*)p)); }
__device__ __forceinline__ void attn_unit_coords(int u, int& qrow0, int& krow0, int& kb0, int& kvh) {
    if (u < NB * 128) { const int b = u >> 7, rem = u & 127, c = rem >> 2; kvh = rem & 3; qrow0 = b * SEQ + c * 64; krow0 = qrow0 - 128; kb0 = c >= 2 ? 0 : 2 * (2 - c); }
    else { const int u2 = u - NB * 128, b = u2 >> 2; kvh = u2 & 3; qrow0 = MP + b * 64; krow0 = MP + b * 192; kb0 = 0; }
}
__device__ __forceinline__ void attn_phase(LAS unsigned char* lds, const bf16_t* Qb, const bf16_t* Kb, const bf16_t* Vb, bf16_t* Ob, const float* sinks, int G, int blk) {
    const int tid = threadIdx.x, lane = tid & 63, w = __builtin_amdgcn_readfirstlane(tid >> 6), r32 = lane & 31, hi = lane >> 5;
    constexpr int KST = 144, VST = 192, KOFF = 0, VOFF = 192 * KST, OOFF = VOFF + 192 * VST, OST = 136;
    constexpr int NUNITS = NB * 32 * 4 + DB * 4;
    LAS unsigned char* ostage = lds + OOFF + w * (32 * OST);
    u32x4 kreg[3], vreg[3]; bf16x8 qnext[4];
    int qrow0 = 0, krow0 = 0, kb0 = 0, kvh = 0;
#define ATTN_LOAD(UU) do { int q0_, k0_, b0_, h0_; attn_unit_coords((UU), q0_, k0_, b0_, h0_); \
        _Pragma("unroll") for (int i = 0; i < 3; ++i) { const int p_ = tid + 512 * i, row_ = p_ >> 3, ch_ = p_ & 7; \
            if (row_ >= b0_ * 32) { const size_t go_ = (size_t)(k0_ + row_) * 256 + h0_ * 64 + ch_ * 8; kreg[i] = *(const u32x4*)(Kb + go_); vreg[i] = *(const u32x4*)(Vb + go_); } } \
        { const size_t qr_ = (size_t)q0_ + (w & 1) * 32 + r32; const int hq_ = h0_ * 4 + (w >> 1); \
          _Pragma("unroll") for (int dk = 0; dk < 4; ++dk) qnext[dk] = *(const bf16x8*)(Qb + qr_ * DM + hq_ * 64 + dk * 16 + hi * 8); } } while (0)
    if (blk < NUNITS) ATTN_LOAD(blk);
    for (int u = blk; u < NUNITS; u += G) {
        attn_unit_coords(u, qrow0, krow0, kb0, kvh);
        __syncthreads();
#pragma unroll
        for (int i = 0; i < 3; ++i) { const int p = tid + 512 * i, row = p >> 3, ch = p & 7;
            if (row >= kb0 * 32) { *(LAS u32x4*)(lds + KOFF + row * KST + ch * 16) = kreg[i]; *(LAS u32x4*)(lds + VOFF + row * VST + ch * 16) = vreg[i]; } }
        bf16x8 qf[4];
#pragma unroll
        for (int dk = 0; dk < 4; ++dk) qf[dk] = qnext[dk];
        const int hq = kvh * 4 + (w >> 1); const size_t qrowb = (size_t)qrow0 + (w & 1) * 32;
        __syncthreads();
        if (u + G < NUNITS) ATTN_LOAD(u + G);
        f32x16 sc[6];
        float mx = -3.0e38f;
#pragma unroll
        for (int kb = 0; kb < 6; ++kb) {
            if (kb >= kb0) {
                f32x16 a = {};
#pragma unroll
                for (int dk = 0; dk < 4; ++dk) { const bf16x8 kf = *(const LAS bf16x8*)(lds + KOFF + (32 * kb + r32) * KST + (dk * 16 + hi * 8) * 2); a = __builtin_amdgcn_mfma_f32_32x32x16_bf16(kf, qf[dk], a, 0, 0, 0); }
#pragma unroll
                for (int r = 0; r < 16; ++r) mx = fmaxf(mx, a[r]);
                sc[kb] = a;
            }
        }
        mx = fmaxf(mx, __shfl_xor(mx, 32));
        const float sinkl = sinks[hq] * LOG2E; mx = fmaxf(mx, sinkl);
        float ls = 0.f;
#pragma unroll
        for (int kb = 0; kb < 6; ++kb) {
            if (kb >= kb0) {
#pragma unroll
                for (int r = 0; r < 16; ++r) { const float p = __builtin_amdgcn_exp2f(sc[kb][r] - mx); sc[kb][r] = p; ls += p; }
            }
        }
        ls += __shfl_xor(ls, 32);
        const float inv = 1.0f / (ls + __builtin_amdgcn_exp2f(sinkl - mx));
        f32x16 o[2]; o[0] = f32x16{}; o[1] = f32x16{};
        const int vlane = VOFF + (4 * hi + ((lane >> 2) & 3)) * VST + (16 * ((lane >> 4) & 1) + 4 * (lane & 3)) * 2;
#pragma unroll
        for (int kb = 0; kb < 6; ++kb) {
            if (kb >= kb0) {
#pragma unroll
                for (int s = 0; s < 2; ++s) {
                    u32x4 pw; pw.x = cvt_pk_bf16(sc[kb][8 * s + 0], sc[kb][8 * s + 1]); pw.y = cvt_pk_bf16(sc[kb][8 * s + 2], sc[kb][8 * s + 3]); pw.z = cvt_pk_bf16(sc[kb][8 * s + 4], sc[kb][8 * s + 5]); pw.w = cvt_pk_bf16(sc[kb][8 * s + 6], sc[kb][8 * s + 7]);
                    const bf16x8 pf = __builtin_bit_cast(bf16x8, pw);
#pragma unroll
                    for (int db = 0; db < 2; ++db) {
                        LAS const unsigned char* vp = lds + vlane + (32 * kb + 16 * s) * VST + db * 64;
                        const s16x4 lo = vtr(vp), h4 = vtr(vp + 8 * VST);
                        const bf16x8 vf = (bf16x8){lo[0], lo[1], lo[2], lo[3], h4[0], h4[1], h4[2], h4[3]};
                        o[db] = __builtin_amdgcn_mfma_f32_32x32x16_bf16(vf, pf, o[db], 0, 0, 0);
                    }
                }
            }
        }
#pragma unroll
        for (int db = 0; db < 2; ++db)
#pragma unroll
            for (int rq = 0; rq < 4; ++rq) {
                u32x2 wv; wv.x = cvt_pk_bf16(o[db][4 * rq] * inv, o[db][4 * rq + 1] * inv); wv.y = cvt_pk_bf16(o[db][4 * rq + 2] * inv, o[db][4 * rq + 3] * inv);
                *(LAS u32x2*)(ostage + r32 * OST + (32 * db + 8 * rq + 4 * hi) * 2) = wv;
            }
        asm volatile("s_waitcnt lgkmcnt(0)" ::: "memory");
#pragma unroll
        for (int i = 0; i < 4; ++i) { const int row = i * 8 + (lane >> 3), ch = lane & 7;
            const u32x2 a = *(const LAS u32x2*)(ostage + row * OST + ch * 16), b = *(const LAS u32x2*)(ostage + row * OST + ch * 16 + 8);
            u32x4 v; v.x = a.x; v.y = a.y; v.z = b.x; v.w = b.y;
            *(u32x4*)(Ob + (qrowb + row) * DM + hq * 64 + ch * 8) = v; }
        asm volatile("s_waitcnt lgkmcnt(0)" ::: "memory");
    }
#undef ATTN_LOAD
}

struct SsmP { const float *lam_re, *lam_im, *log_dt, *b_re, *b_im, *c_re, *c_im, *dsk, *st_re, *st_im; float *o_rep, *o_imp, *o_res, *o_ims; };
__device__ __forceinline__ void ssm_phase(LAS unsigned char* lds, const bf16_t* A3, bf16_t* Z, const SsmP P, int G, int blk) {
    const int tid = threadIdx.x, lane = tid & 63, w = __builtin_amdgcn_readfirstlane(tid >> 6), p = lane & 31, hi = lane >> 5;
    constexpr int IST = 72;
    LAS unsigned char* img = lds + w * (128 * IST);
    const bool samp = (w >= 4);
    const int nunits = samp ? (DB / 2) * 64 : (NB / 2) * 64, T = samp ? DS : SEQ;
    for (int uu = blk * 4 + (w & 3); uu < nunits; uu += G * 4) {
        const int bp = uu >> 6, g = uu & 63;
        const int rowbase0 = samp ? MP + (2 * bp) * DS : (2 * bp) * SEQ, bstride = T;
        const float dt = expf(P.log_dt[g]);
        float lbr[2], lbi[2], zr[2], zi[2], hr[2], hm[2];
#pragma unroll
        for (int pp = 0; pp < 2; ++pp) {
            const int ps = g * 64 + p + 32 * pp; const float lr = P.lam_re[ps], li = P.lam_im[ps];
            const float mag = expf(lr * dt); lbr[pp] = mag * cosf(li * dt); lbi[pp] = mag * sinf(li * dt);
            const float nr = lbr[pp] - 1.0f, ni = lbi[pp], den = lr * lr + li * li;
            zr[pp] = (nr * lr + ni * li) / den; zi[pp] = (ni * lr - nr * li) / den;
            if (samp) { const int so = ((2 * bp + hi) * 64 + g) * 64 + p + 32 * pp; hr[pp] = P.st_re[so]; hm[pp] = P.st_im[so]; } else { hr[pp] = 0.f; hm[pp] = 0.f; }
        }
        bf16x8 bfrag[4];
#pragma unroll
        for (int pp = 0; pp < 2; ++pp) {
            const float* br = P.b_re + ((size_t)(g * 64 + p + 32 * pp)) * 16 + 8 * hi; const float* bi = P.b_im + ((size_t)(g * 64 + p + 32 * pp)) * 16 + 8 * hi;
            const f32x4 br0 = *(const f32x4*)br, br1 = *(const f32x4*)(br + 4), bi0 = *(const f32x4*)bi, bi1 = *(const f32x4*)(bi + 4);
            u32x4 wre, wim;
            wre.x = cvt_pk_bf16(zr[pp] * br0[0] - zi[pp] * bi0[0], zr[pp] * br0[1] - zi[pp] * bi0[1]); wre.y = cvt_pk_bf16(zr[pp] * br0[2] - zi[pp] * bi0[2], zr[pp] * br0[3] - zi[pp] * bi0[3]);
            wre.z = cvt_pk_bf16(zr[pp] * br1[0] - zi[pp] * bi1[0], zr[pp] * br1[1] - zi[pp] * bi1[1]); wre.w = cvt_pk_bf16(zr[pp] * br1[2] - zi[pp] * bi1[2], zr[pp] * br1[3] - zi[pp] * bi1[3]);
            wim.x = cvt_pk_bf16(zr[pp] * bi0[0] + zi[pp] * br0[0], zr[pp] * bi0[1] + zi[pp] * br0[1]); wim.y = cvt_pk_bf16(zr[pp] * bi0[2] + zi[pp] * br0[2], zr[pp] * bi0[3] + zi[pp] * br0[3]);
            wim.z = cvt_pk_bf16(zr[pp] * bi1[0] + zi[pp] * br1[0], zr[pp] * bi1[1] + zi[pp] * br1[1]); wim.w = cvt_pk_bf16(zr[pp] * bi1[2] + zi[pp] * br1[2], zr[pp] * bi1[3] + zi[pp] * br1[3]);
            bfrag[pp] = __builtin_bit_cast(bf16x8, wre); bfrag[2 + pp] = __builtin_bit_cast(bf16x8, wim);
        }
        const int ci = lane & 15, kg = lane >> 4;
        bf16x8 cfrag[4];
#pragma unroll
        for (int kb = 0; kb < 4; ++kb) {
            const float* cp = ((kb < 2) ? P.c_re : P.c_im) + ((size_t)(g * 16 + ci)) * 64 + 32 * (kb & 1) + 8 * kg; const float sg = (kb < 2) ? 1.f : -1.f;
            const f32x4 c0 = *(const f32x4*)cp, c1 = *(const f32x4*)(cp + 4);
            u32x4 wc_; wc_.x = cvt_pk_bf16(sg * c0[0], sg * c0[1]); wc_.y = cvt_pk_bf16(sg * c0[2], sg * c0[3]); wc_.z = cvt_pk_bf16(sg * c1[0], sg * c1[1]); wc_.w = cvt_pk_bf16(sg * c1[2], sg * c1[3]);
            cfrag[kb] = __builtin_bit_cast(bf16x8, wc_);
        }
        const f32x4 dsk4 = *(const f32x4*)(P.dsk + g * 16 + 4 * kg);
        const int hip = (p >> 2) & 1, jp = (p & 3) + 4 * (p >> 3);
        const bf16_t* uptr = A3 + ((size_t)(rowbase0 + hip * bstride + jp)) * DM + g * 16 + 8 * hi;
        const size_t yoff = ((size_t)(rowbase0 + ci)) * DM + g * 16 + 4 * kg; const size_t boff = (size_t)bstride * DM;
        const int nblk = T / 16;
        bf16x8 ufA = *(const bf16x8*)uptr, ufB = *(const bf16x8*)(uptr + (size_t)16 * DM), ufC = *(const bf16x8*)(uptr + (size_t)32 * DM);
        u32x2 unA0 = *(const u32x2*)(A3 + yoff), unA1 = *(const u32x2*)(A3 + yoff + boff);
        u32x2 unB0 = *(const u32x2*)(A3 + yoff + (size_t)16 * DM), unB1 = *(const u32x2*)(A3 + yoff + boff + (size_t)16 * DM);
        u32x2 unC0 = *(const u32x2*)(A3 + yoff + (size_t)32 * DM), unC1 = *(const u32x2*)(A3 + yoff + boff + (size_t)32 * DM);
        for (int tb = 0; tb < nblk; ++tb) {
            const bf16x8 ucur = ufA; const u32x2 uc0 = unA0, uc1 = unA1;
            ufA = ufB; unA0 = unB0; unA1 = unB1; ufB = ufC; unB0 = unC0; unB1 = unC1;
            if (tb + 3 < nblk) { ufC = *(const bf16x8*)(uptr + (size_t)(tb + 3) * 16 * DM); unC0 = *(const u32x2*)(A3 + yoff + (size_t)(tb + 3) * 16 * DM); unC1 = *(const u32x2*)(A3 + yoff + boff + (size_t)(tb + 3) * 16 * DM); }
            f32x16 X[4];
#pragma unroll
            for (int cb = 0; cb < 4; ++cb) { f32x16 z = {}; X[cb] = __builtin_amdgcn_mfma_f32_32x32x16_bf16(ucur, bfrag[cb], z, 0, 0, 0); }
#pragma unroll
            for (int r = 0; r < 16; ++r) {
#pragma unroll
                for (int pp = 0; pp < 2; ++pp) {
                    const float nr = lbr[pp] * hr[pp] - lbi[pp] * hm[pp] + X[pp][r];
                    const float ni = lbr[pp] * hm[pp] + lbi[pp] * hr[pp] + X[2 + pp][r];
                    hr[pp] = nr; hm[pp] = ni; X[pp][r] = nr; X[2 + pp][r] = ni;
                }
            }
#pragma unroll
            for (int cb = 0; cb < 4; ++cb)
#pragma unroll
                for (int q = 0; q < 4; ++q) {
                    u32x2 wv; wv.x = cvt_pk_bf16(X[cb][4 * q], X[cb][4 * q + 1]); wv.y = cvt_pk_bf16(X[cb][4 * q + 2], X[cb][4 * q + 3]);
                    *(LAS u32x2*)(img + (cb * 32 + p) * IST + (16 * hi + 4 * q) * 2) = wv;
                }
            asm volatile("s_waitcnt lgkmcnt(0)" ::: "memory");
#pragma unroll
            for (int rb = 0; rb < 2; ++rb) {
                f32x4 y = {0.f, 0.f, 0.f, 0.f};
#pragma unroll
                for (int kb = 0; kb < 4; ++kb) {
                    LAS const unsigned char* ap = img + (32 * kb + 8 * kg + (ci >> 2)) * IST + (16 * rb + 4 * (ci & 3)) * 2;
                    const s16x4 lo = vtr(ap), h4 = vtr(ap + 4 * IST);
                    const bf16x8 af = (bf16x8){lo[0], lo[1], lo[2], lo[3], h4[0], h4[1], h4[2], h4[3]};
                    y = __builtin_amdgcn_mfma_f32_16x16x32_bf16(cfrag[kb], af, y, 0, 0, 0);
                }
                const u32x2 uw = rb ? uc1 : uc0;
                const float z0 = gelu_tanh(y[0] + dsk4[0] * __uint_as_float(uw.x << 16)), z1 = gelu_tanh(y[1] + dsk4[1] * __uint_as_float(uw.x & 0xffff0000u));
                const float z2 = gelu_tanh(y[2] + dsk4[2] * __uint_as_float(uw.y << 16)), z3 = gelu_tanh(y[3] + dsk4[3] * __uint_as_float(uw.y & 0xffff0000u));
                u32x2 zw; zw.x = cvt_pk_bf16(z0, z1); zw.y = cvt_pk_bf16(z2, z3);
                *(u32x2*)(Z + yoff + (rb ? boff : 0) + (size_t)tb * 16 * DM) = zw;
            }
            asm volatile("" ::: "memory");
        }
#pragma unroll
        for (int pp = 0; pp < 2; ++pp) {
            const int so = ((2 * bp + hi) * 64 + g) * 64 + p + 32 * pp;
            if (samp) { P.o_res[so] = hr[pp]; P.o_ims[so] = hm[pp]; } else { P.o_rep[so] = hr[pp]; P.o_imp[so] = hm[pp]; }
        }
    }
}


#define XB_TMO      128
#define XB_XCNT(j)  (256  + 64 * (j))
#define XB_XSUB(j)  (1280 + 64 * (j))
#define XB_XGEN(j)  (2304 + 64 * (j))
#define XB_TOP      3328
#define XB_TOPGEN   3392
#define XCD_BAR_WORDS 3456
#define XB_SPIN_CAP (1u << 18)
__device__ __forceinline__ unsigned xb_ld(unsigned* p)              { return __hip_atomic_load(p, __ATOMIC_RELAXED, __HIP_MEMORY_SCOPE_AGENT); }
__device__ __forceinline__ unsigned xb_add(unsigned* p, unsigned v) { return __hip_atomic_fetch_add(p, v, __ATOMIC_RELAXED, __HIP_MEMORY_SCOPE_AGENT); }
__device__ __forceinline__ unsigned xb_xcc_id() { return (unsigned)__builtin_amdgcn_s_getreg((3 << 11) | 20) & 0xFu; }
#define XB_SPIN(cond, bar) do { unsigned _sp = 0; while (cond) { __builtin_amdgcn_s_sleep(1); \
    if ((++_sp & 255u) == 0u) { if (xb_ld(&(bar)[XB_TMO])) break; if (_sp > XB_SPIN_CAP) { atomicAdd(&(bar)[XB_TMO], 1u); break; } } } } while (0)
struct XcdBarrier { unsigned* bar; unsigned x; volatile LAS unsigned* st; };
__device__ __forceinline__ XcdBarrier xcd_barrier_post(unsigned* bar, volatile LAS unsigned* st) {
    XcdBarrier b; b.bar = bar; b.x = xb_xcc_id(); b.st = st;
    if (threadIdx.x == 0) (void)xb_add(&bar[XB_XCNT(b.x)], 1u);
    return b;
}
__device__ __forceinline__ void xcd_barrier_complete(unsigned* bar, unsigned x, unsigned& nloc, unsigned& nx) {
    const unsigned G = gridDim.x * gridDim.y * gridDim.z;
    unsigned sum, cnt, mine, sp = 0u;
    for (;;) {
        sum = 0u; cnt = 0u; mine = 0u;
#pragma unroll
        for (unsigned j = 0; j < 16; ++j) { const unsigned c = xb_ld(&bar[XB_XCNT(j)]); sum += c; cnt += (c > 0u) ? 1u : 0u; mine = (j == x) ? c : mine; }
        if (sum == G) break;
        __builtin_amdgcn_s_sleep(1);
        if ((++sp & 255u) == 0u) { if (xb_ld(&bar[XB_TMO])) break; if (sp > XB_SPIN_CAP) { atomicAdd(&bar[XB_TMO], 1u); break; } }
    }
    nloc = mine > 0u ? mine : 1u; nx = cnt > 0u ? cnt : 1u;
}
__device__ __forceinline__ void xcd_barrier(const XcdBarrier& b) {
    asm volatile("s_waitcnt vmcnt(0)" ::: "memory");
    __syncthreads();
    if (threadIdx.x == 0) {
        unsigned* bar = b.bar;
        __builtin_amdgcn_s_waitcnt(0);
        unsigned nloc = b.st[0], nx = b.st[1];
        if (nloc == 0u) { xcd_barrier_complete(bar, b.x, nloc, nx); b.st[0] = nloc; b.st[1] = nx; }
        const unsigned old = xb_add(&bar[XB_XSUB(b.x)], 1u);
        const unsigned gen = old / nloc;
        if (old + 1u == (gen + 1u) * nloc) {
            __builtin_amdgcn_fence(__ATOMIC_RELEASE, "agent");
            asm volatile("s_waitcnt vmcnt(0)" ::: "memory");
            const unsigned og = xb_add(&bar[XB_TOP], 1u);
            const unsigned tg = og / nx;
            if (og + 1u == (tg + 1u) * nx) xb_add(&bar[XB_TOPGEN], 1u);
            else XB_SPIN(xb_ld(&bar[XB_TOPGEN]) == tg, bar);
            __builtin_amdgcn_fence(__ATOMIC_ACQUIRE, "agent");
            xb_add(&bar[XB_XGEN(b.x)], 1u);
            asm volatile("s_waitcnt vmcnt(0)" ::: "memory");
        } else {
            XB_SPIN(xb_ld(&bar[XB_XGEN(b.x)]) == gen, bar);
            __builtin_amdgcn_fence(__ATOMIC_ACQUIRE, "agent");
            asm volatile("s_waitcnt vmcnt(0)" ::: "memory");
        }
    }
    __syncthreads();
}

__device__ __forceinline__ void phase_prologue(LAS unsigned char* lds, const Args& args, unsigned char* ws, float* out, int G, int blk, int wave, int lane, int tid) {
    const int gw = blk * 8 + wave, NGW = G * 8;
    bf16_t* Wqkv = (bf16_t*)(ws + WS_WQKV); bf16_t* Wo = (bf16_t*)(ws + WS_WO); bf16_t* Wglu = (bf16_t*)(ws + WS_WGLU); bf16_t* Wup = (bf16_t*)(ws + WS_WUP); bf16_t* Wdn = (bf16_t*)(ws + WS_WDN);
    float* rope = (float*)(ws + WS_ROPE); bf16_t* Abuf = (bf16_t*)(ws + WS_A); bf16_t* Kbuf = (bf16_t*)(ws + WS_K); bf16_t* Vbuf = (bf16_t*)(ws + WS_V);
    LAS float* scr = (LAS float*)(lds + wave * 16384);
    constexpr int I_QKV = 16 * 48, I_O = 16 * 32, I_GLU = 16 * 64, I_UP = 16 * 176, I_DN = 44 * 32;
    constexpr int NITEMS = I_QKV + I_O + I_GLU + 2 * I_UP + 2 * I_DN;
    for (int it = gw; it < NITEMS; it += NGW) {
        int r = it;
        if (r < I_QKV) { transpose_item(args.in[11], DM, QKVD, Wqkv, 0, scr, r, lane); continue; } r -= I_QKV;
        if (r < I_O) { transpose_item(args.in[14], DM, DM, Wo, 0, scr, r, lane); continue; } r -= I_O;
        if (r < I_GLU) { transpose_item(args.in[24], DM, 2 * DM, Wglu, DM, scr, r, lane); continue; } r -= I_GLU;
        if (r < 2 * I_UP) { const int l = r / I_UP; transpose_item(args.in[26] + (size_t)l * DM * FF2, DM, FF2, Wup + (size_t)l * FF2 * DM, FF, scr, r % I_UP, lane); continue; } r -= 2 * I_UP;
        { const int l = r / I_DN; transpose_item(args.in[29] + (size_t)l * FF * DM, FF, DM, Wdn + (size_t)l * DM * FF, 0, scr, r % I_DN, lane); }
    }
    for (int i = blk * 512 + tid; i < SEQ * 8; i += G * 512) { const int pos = i >> 3, f = i & 7; const float inv_freq = powf(500000.0f, -(float)f * 0.125f); const float ang = (float)pos * inv_freq;
        rope[pos * 16 + f] = cosf(ang); rope[pos * 16 + 8 + f] = sinf(ang); }
    for (int i = blk * 512 + tid; i < DB * 128 * 64; i += G * 512) {
        const int b = i / (128 * 64), rem = i % (128 * 64), row = rem >> 6, c4 = (rem & 63) * 4;
        const f32x4 kv = *(const f32x4*)(args.in[2] + ((size_t)(b * 128 + row)) * 256 + c4), vv = *(const f32x4*)(args.in[3] + ((size_t)(b * 128 + row)) * 256 + c4);
        u32x2 kw, vw; kw.x = cvt_pk_bf16(kv[0], kv[1]); kw.y = cvt_pk_bf16(kv[2], kv[3]); vw.x = cvt_pk_bf16(vv[0], vv[1]); vw.y = cvt_pk_bf16(vv[2], vv[3]);
        const size_t krow = (size_t)MP + b * 192 + row;
        *(u32x2*)(Kbuf + krow * 256 + c4) = kw; *(u32x2*)(Vbuf + krow * 256 + c4) = vw;
        if (row >= 64) { *(f32x4*)(out + O_KS + ((size_t)(b * 128 + row - 64)) * 256 + c4) = kv; *(f32x4*)(out + O_VS + ((size_t)(b * 128 + row - 64)) * 256 + c4) = vv; }
    }
    for (int m = gw; m < MT; m += NGW) { const float* xr = (m < MP) ? args.in[0] + (size_t)m * DM : args.in[1] + (size_t)(m - MP) * DM;
        row_pass<false, true, true, true>(xr, nullptr, nullptr, nullptr, 0, nullptr, args.in[7], Abuf + (size_t)m * DM, lane); }
}
template <int MODE>
__device__ __forceinline__ void phase_rows(const float* x_prompt, const float* x_sample, bf16_t* X16, float* out, const bf16_t* Mbuf, const float* ss, int nslots, const float* gpost, const float* gnext, bf16_t* Abuf, int gw, int NGW, int lane) {
    for (int m = gw; m < MT; m += NGW) {
        if constexpr (MODE == 0) { const float* xr = (m < MP) ? x_prompt + (size_t)m * DM : x_sample + (size_t)(m - MP) * DM;
            row_pass<true, true, true, false>(xr, X16 + (size_t)m * DM, Mbuf + (size_t)m * DM, ss + (size_t)m * 32, nslots, gpost, gnext, Abuf + (size_t)m * DM, lane); }
        else if constexpr (MODE == 1) row_pass<true, true, false, false>(X16 + (size_t)m * DM, X16 + (size_t)m * DM, Mbuf + (size_t)m * DM, ss + (size_t)m * 32, nslots, gpost, gnext, Abuf + (size_t)m * DM, lane);
        else row_pass<true, false, false, true>(X16 + (size_t)m * DM, out + (size_t)m * DM, Mbuf + (size_t)m * DM, ss + (size_t)m * 32, nslots, gpost, nullptr, nullptr, lane);
    }
}
__device__ __forceinline__ void phase_up(LAS unsigned char* lds, const bf16_t* Abuf, const bf16_t* Wup_l, bf16_t* Gbuf, float* Ebuf, const float* cw, const float* cb, int G, int blk) {
    pg8::Gemm g{Abuf, Wup_l, MT, FF2, DM}; pg8::StaticOrder S; S.init(MT, FF2, G, blk);
    pg8::EpiUp E{Gbuf, Ebuf, cw, cb};
    pg8::gemm_phase<pg8::EpiUp, true, true>(lds, g, S, E);
}
__device__ __forceinline__ void phase_down(LAS unsigned char* lds, const bf16_t* Gbuf, const bf16_t* Wdn_l, bf16_t* Mbuf, float* ss, int G, int blk) {
    pg8::Gemm g{Gbuf, Wdn_l, MT, DM, FF}; pg8::StaticOrder S; S.init(MT, DM, G, blk);
    pg8::EpiPlainSS E{Mbuf, nullptr, ss};
    pg8::gemm_phase<pg8::EpiPlainSS, true, true>(lds, g, S, E);
}
__device__ __forceinline__ void phase_fix(const float* Ebuf, bf16_t* Gbuf, const float* cw, const float* cb, const float* cc, float* out, int l, int G, int blk, int tid) {
    for (int i = blk * 512 + tid; i < NSEG * 2 * (FF / 4); i += G * 512) {
        const int ri = i / (FF / 4), c4 = (i % (FF / 4)) * 4, seg = ri >> 1, j = ri & 1;
        f32x4 o;
        f32x4 cres[2];
#pragma unroll
        for (int hf = 0; hf < 2; ++hf) {
            const int col = hf * FF + c4;
            const f32x4 cur0 = *(const f32x4*)(Ebuf + ((size_t)seg * 4 + 0) * FF2 + col), cur1 = *(const f32x4*)(Ebuf + ((size_t)seg * 4 + 1) * FF2 + col);
            f32x4 p0 = {0.f, 0.f, 0.f, 0.f}, p1 = {0.f, 0.f, 0.f, 0.f};
            if (seg >= MP / 64) { const int b = seg - MP / 64; p0 = *(const f32x4*)(cc + ((size_t)b * 2 + 0) * FF2 + col); p1 = *(const f32x4*)(cc + ((size_t)b * 2 + 1) * FF2 + col); }
            else if ((seg & 31) != 0) { p0 = *(const f32x4*)(Ebuf + ((size_t)(seg - 1) * 4 + 2) * FF2 + col); p1 = *(const f32x4*)(Ebuf + ((size_t)(seg - 1) * 4 + 3) * FF2 + col); }
            const f32x4 w0 = *(const f32x4*)(cw + col), w1 = *(const f32x4*)(cw + FF2 + col), w2 = *(const f32x4*)(cw + 2 * FF2 + col), bb = *(const f32x4*)(cb + col);
            cres[hf] = (j == 0) ? (bb + w0 * p0 + w1 * p1 + w2 * cur0) : (bb + w0 * p1 + w1 * cur0 + w2 * cur1);
        }
#pragma unroll
        for (int q = 0; q < 4; ++q) o[q] = gelu_tanh(cres[0][q]) * cres[1][q];
        u32x2 wv; wv.x = cvt_pk_bf16(o[0], o[1]); wv.y = cvt_pk_bf16(o[2], o[3]);
        *(u32x2*)(Gbuf + ((size_t)seg * 64 + j) * FF + c4) = wv;
    }
    for (int i = blk * 512 + tid; i < (NB + DB) * 2 * (FF2 / 4); i += G * 512) {
        const int ri = i / (FF2 / 4), c4 = (i % (FF2 / 4)) * 4, bb = ri >> 1, e = ri & 1;
        const int seg = (bb < NB) ? bb * 32 + 31 : MP / 64 + (bb - NB);
        const f32x4 v = *(const f32x4*)(Ebuf + ((size_t)seg * 4 + 2 + e) * FF2 + c4);
        float* o = (bb < NB) ? out + O_CP + (((size_t)l * NB + bb) * 2 + e) * FF2 + c4 : out + O_CS + (((size_t)l * DB + (bb - NB)) * 2 + e) * FF2 + c4;
        *(f32x4*)o = v;
    }
}

__global__ void __launch_bounds__(512, 2) fwd_kernel(Args args) {
    extern __shared__ __attribute__((aligned(16))) unsigned char lds_raw[];
    LAS unsigned char* lds = (LAS unsigned char*)lds_raw;
    const int tid = threadIdx.x, lane = tid & 63, wave = __builtin_amdgcn_readfirstlane(tid >> 6);
    const int G = gridDim.x, blk = blockIdx.x;
    const int gw = blk * 8 + wave, NGW = G * 8;
    unsigned char* ws = args.ws; float* out = args.out;
    const float* x_prompt = args.in[0]; const float* x_sample = args.in[1];
    bf16_t* Wqkv = (bf16_t*)(ws + WS_WQKV); bf16_t* Wo = (bf16_t*)(ws + WS_WO); bf16_t* Wglu = (bf16_t*)(ws + WS_WGLU); bf16_t* Wup = (bf16_t*)(ws + WS_WUP); bf16_t* Wdn = (bf16_t*)(ws + WS_WDN);
    float* rope = (float*)(ws + WS_ROPE); float* ss = (float*)(ws + WS_SS);
    bf16_t* Abuf = (bf16_t*)(ws + WS_A); bf16_t* Mbuf = (bf16_t*)(ws + WS_MB); float* Ebuf = (float*)(ws + WS_E); bf16_t* Gbuf = (bf16_t*)(ws + WS_G);
    bf16_t* X16 = (bf16_t*)(ws + WS_X16);
    bf16_t* Qbuf = (bf16_t*)(ws + WS_Q); bf16_t* Kbuf = (bf16_t*)(ws + WS_K); bf16_t* Vbuf = (bf16_t*)(ws + WS_V);


    const int lo = args.ph_lo, hi_ = args.ph_hi;
    volatile LAS unsigned* misc = (volatile LAS unsigned*)(lds + 131072 + 1024);
    if (tid < 2) misc[tid] = 0u;
    __syncthreads();
    XcdBarrier xbar; xbar.bar = (unsigned*)ws; xbar.x = 0; xbar.st = nullptr;
    if (args.coop) xbar = xcd_barrier_post((unsigned*)ws, misc);
    if (args.coop == 2) cg::this_grid().sync();
#define IN(k) (lo <= (k) && (k) < hi_)
#define SEAM(k) do { if (args.coop && (k) + 1 < hi_) xcd_barrier(xbar); } while (0)
#define REP(k) _Pragma("unroll") for (int rep_ = 0; rep_ <= ((PROBE_REPMASK >> (k)) & 1); ++rep_)
    if (IN(0)) { REP(0) { phase_prologue(lds, args, ws, out, G, blk, wave, lane, tid); } SEAM(0); }
    if (IN(1)) { REP(1) {
        pg8::Gemm g{Abuf, Wqkv, MT, QKVD, DM}; pg8::StaticOrder S; S.init(MT, QKVD, G, blk);
        pg8::EpiQKV E{Qbuf, Kbuf, Vbuf, args.in[12], rope, out + O_KP, out + O_VP, out + O_KS, out + O_VS};
        pg8::gemm_phase<pg8::EpiQKV, true, true>(lds, g, S, E); } SEAM(1); }
    if (IN(2)) { REP(2) { attn_phase(lds, Qbuf, Kbuf, Vbuf, Abuf, args.in[13], G, blk); } SEAM(2); }
    if (IN(3)) { REP(3) {
        pg8::Gemm g{Abuf, Wo, MT, DM, DM}; pg8::StaticOrder S; S.init(MT, DM, G, blk);
        pg8::EpiPlainSS E{Mbuf, args.in[15], ss};
        pg8::gemm_phase<pg8::EpiPlainSS, true, true>(lds, g, S, E); } SEAM(3); }
    if (IN(4)) { REP(4) { phase_rows<0>(x_prompt, x_sample, X16, out, Mbuf, ss, 16, args.in[8], args.in[9], Abuf, gw, NGW, lane); } SEAM(4); }
    if (IN(5)) { REP(5) { phase_up(lds, Abuf, Wup, Gbuf, Ebuf, args.in[27], args.in[28], G, blk); } SEAM(5); }
    if (IN(6)) { REP(6) { phase_fix(Ebuf, Gbuf, args.in[27], args.in[28], args.in[6], out, 0, G, blk, tid); } SEAM(6); }
    if (IN(7)) { REP(7) { phase_down(lds, Gbuf, Wdn, Mbuf, ss, G, blk); } SEAM(7); }
    if (IN(8)) { REP(8) { phase_rows<1>(x_prompt, x_sample, X16, out, Mbuf, ss, 16, args.in[10], args.in[7] + DM, Abuf, gw, NGW, lane); } SEAM(8); }
    if (IN(9)) { REP(9) {
        SsmP P{args.in[16], args.in[17], args.in[18], args.in[19], args.in[20], args.in[21], args.in[22], args.in[23], args.in[4], args.in[5], out + O_REP, out + O_IMP, out + O_RES, out + O_IMS};
        ssm_phase(lds, Abuf, Qbuf, P, G, blk); } SEAM(9); }
    if (IN(10)) { REP(10) {
        pg8::Gemm g{Qbuf, Wglu, MT, 2 * DM, DM}; pg8::StaticOrder S; S.init(MT, 2 * DM, G, blk);
        pg8::EpiGlu E{Mbuf, args.in[25], ss};
        pg8::gemm_phase<pg8::EpiGlu, true, true>(lds, g, S, E); } SEAM(10); }
    if (IN(11)) { REP(11) { phase_rows<1>(x_prompt, x_sample, X16, out, Mbuf, ss, 32, args.in[8] + DM, args.in[9] + DM, Abuf, gw, NGW, lane); } SEAM(11); }
    if (IN(12)) { REP(12) { phase_up(lds, Abuf, Wup + (size_t)FF2 * DM, Gbuf, Ebuf, args.in[27] + (size_t)3 * FF2, args.in[28] + FF2, G, blk); } SEAM(12); }
    if (IN(13)) { REP(13) { phase_fix(Ebuf, Gbuf, args.in[27] + (size_t)3 * FF2, args.in[28] + FF2, args.in[6] + (size_t)DB * 2 * FF2, out, 1, G, blk, tid); } SEAM(13); }
    if (IN(14)) { REP(14) { phase_down(lds, Gbuf, Wdn + (size_t)DM * FF, Mbuf, ss, G, blk); } SEAM(14); }
    if (IN(15)) { REP(15) { phase_rows<2>(x_prompt, x_sample, X16, out, Mbuf, ss, 16, args.in[10] + DM, nullptr, nullptr, gw, NGW, lane); } }
#undef IN
#undef SEAM
#undef REP
}

extern "C" void kernel_launch(void* const* d_in, const int* in_sizes, int n_in, void* d_out, int out_size, void* d_ws, size_t ws_size, hipStream_t stream) {
    static int grid = 0;
    if (grid == 0) {
        if (n_in != 30 || (size_t)out_size != O_END || ws_size < WS_END) { fprintf(stderr, "kernel_launch: unexpected shapes: n_in %d out %d ws %zu (need out %zu ws %zu)\n", n_in, out_size, ws_size, (size_t)O_END, (size_t)WS_END); grid = -1; return; }
        int dev = 0, cus = 0, per_cu = 0;
        hipGetDevice(&dev); hipDeviceGetAttribute(&cus, hipDeviceAttributeMultiprocessorCount, dev);
        if (hipFuncSetAttribute((const void*)fwd_kernel, hipFuncAttributeMaxDynamicSharedMemorySize, LDS_BYTES) != hipSuccess) { fprintf(stderr, "kernel_launch: hipFuncSetAttribute failed\n"); grid = -1; return; }
        if (hipOccupancyMaxActiveBlocksPerMultiprocessor(&per_cu, (const void*)fwd_kernel, 512, LDS_BYTES) != hipSuccess || per_cu < 1) { fprintf(stderr, "kernel_launch: occupancy query says %d\n", per_cu); per_cu = 1; }
        (void)hipGetLastError();
        grid = cus * 1;
    }
    if (grid < 0) return;
    Args a{};
    for (int i = 0; i < 30; ++i) a.in[i] = (const float*)d_in[i];
    a.out = (float*)d_out; a.ws = (unsigned char*)d_ws;
#ifndef MK_MULTI
    if (hipMemsetAsync(d_ws, 0, 16384, stream) != hipSuccess) { fprintf(stderr, "kernel_launch: memset failed\n"); return; }
    a.ph_lo = 0; a.ph_hi = NPHASE; a.coop = 1;
    void* kargs[] = {&a};
    hipError_t e = hipLaunchCooperativeKernel((const void*)fwd_kernel, dim3(grid), dim3(512), kargs, LDS_BYTES, stream);
    if (e != hipSuccess) fprintf(stderr, "cooperative launch failed: %s (grid %d)\n", hipGetErrorString(e), grid);
#else
    for (int ph = 0; ph < NPHASE; ++ph) { a.ph_lo = ph; a.ph_hi = ph + 1; a.coop = 0; hipLaunchKernelGGL(fwd_kernel, dim3(grid), dim3(512), LDS_BYTES, stream, a); }
#endif
}
```

```cpp
#include <hip/hip_runtime.h>
#include <hip/hip_cooperative_groups.h>
#include <cstdio>
#include <cstdint>
namespace cg = cooperative_groups;

#define LAS __attribute__((address_space(3)))
typedef unsigned short bf16_t;
typedef short bf16x8 __attribute__((ext_vector_type(8)));
typedef short s16x4 __attribute__((ext_vector_type(4)));
typedef float f32x4 __attribute__((ext_vector_type(4)));
typedef float f32x16 __attribute__((ext_vector_type(16)));
typedef unsigned u32x4 __attribute__((ext_vector_type(4)));
typedef unsigned u32x2 __attribute__((ext_vector_type(2)));

constexpr int DM = 1024, NB = 32, SEQ = 2048, MP = NB * SEQ, DB = 16, DS = 64, MS = DB * DS, MT = MP + MS;
constexpr int QKVD = 1536, FF = 2816, FF2 = 5632, NSEG = MT / 64;
constexpr int KVROWS = MP + DB * 192;
constexpr float EPS = 1e-6f, LOG2E = 1.4426950408889634f, QSCALE = 0.125f * 1.4426950408889634f;
constexpr size_t O_Y = 0, O_KP = (size_t)MT * DM, O_VP = O_KP + (size_t)NB * 128 * 256, O_KS = O_VP + (size_t)NB * 128 * 256, O_VS = O_KS + (size_t)DB * 128 * 256,
                 O_REP = O_VS + (size_t)DB * 128 * 256, O_IMP = O_REP + NB * 4096, O_RES = O_IMP + NB * 4096, O_IMS = O_RES + DB * 4096,
                 O_CP = O_IMS + DB * 4096, O_CS = O_CP + (size_t)2 * NB * 2 * FF2, O_END = O_CS + (size_t)2 * DB * 2 * FF2;
constexpr size_t MiB = 1u << 20;
constexpr size_t WS_WQKV = 1 * MiB, WS_WO = 4 * MiB, WS_WGLU = 6 * MiB, WS_WUP = 10 * MiB, WS_WDN = 32 * MiB, WS_ROPE = 43 * MiB, WS_SS = 44 * MiB,
                 WS_A = 54 * MiB, WS_MB = 185 * MiB, WS_E = 316 * MiB, WS_G = 406 * MiB, WS_Q = WS_G, WS_K = WS_G + 132 * MiB, WS_V = WS_K + 34 * MiB, WS_X16 = WS_G + 358 * MiB, WS_SACC = WS_X16 + 131 * MiB, WS_END = WS_SACC + 44 * MiB;
static_assert(WS_WUP + (size_t)2 * FF2 * DM * 2 <= WS_WDN && WS_WDN + (size_t)2 * DM * FF * 2 <= WS_ROPE && WS_SS + (size_t)MT * 32 * 4 <= WS_A, "ws map 1");
static_assert(WS_A + (size_t)MT * DM * 2 <= WS_MB && WS_MB + (size_t)MT * DM * 2 <= WS_E && WS_E + (size_t)NSEG * 4 * FF2 * 4 <= WS_G, "ws map 2");
static_assert(WS_X16 + (size_t)MT * DM * 2 <= WS_END, "ws map 4");
static_assert(WS_Q + (size_t)MT * DM * 2 <= WS_K && WS_K + (size_t)KVROWS * 256 * 2 <= WS_V && WS_V + (size_t)KVROWS * 256 * 2 <= WS_END && WS_G + (size_t)MT * FF * 2 <= WS_END, "ws map 3");

__device__ __forceinline__ unsigned cvt_pk_bf16(float lo, float hi) { unsigned r; asm volatile("v_cvt_pk_bf16_f32 %0, %1, %2" : "=v"(r) : "v"(lo), "v"(hi)); return r; }
__device__ __forceinline__ float bf2f(unsigned short b) { return __uint_as_float((unsigned)b << 16); }
__device__ __forceinline__ float gelu_tanh(float x) {
    const float x2 = x * x, u = x * (0.7978845608f + 0.0356774081f * x2);
    const float e = __builtin_amdgcn_exp2f(-2.885390082f * u);
    return x * __builtin_amdgcn_rcpf(1.0f + e);
}
__device__ __forceinline__ float sigmoid_f(float v) { return __builtin_amdgcn_rcpf(1.0f + __builtin_amdgcn_exp2f(-LOG2E * v)); }
__device__ __forceinline__ float wave_sum(float v) {
#pragma unroll
    for (int o = 1; o < 64; o <<= 1) v += __shfl_xor(v, o);
    return v;
}
template <int CTRL> __device__ __forceinline__ float dpp_f(float x) { return __builtin_bit_cast(float, __builtin_amdgcn_update_dpp(0, __builtin_bit_cast(int, x), CTRL, 0xf, 0xf, false)); }

namespace pg8 {
constexpr int BM = 256, BK = 64, HALF = 128, HTB = HALF * BK * 2, STAGE_BYTES = 8 * HTB, NXCD = 8, WGM = 8;
__host__ __device__ __forceinline__ int lds_byte(int r, int c) { const int st = (r >> 4) * 2 + (c >> 5), rr = r & 15, cc = c & 31, ob = rr * 64 + cc * 2; return st * 1024 + (ob ^ (((ob >> 9) & 1) << 5)); }
__host__ __device__ __forceinline__ void stage_rc(int b, int& R, int& C) { const int st = b / 1024, sb = b % 1024, swz = sb ^ (((sb >> 9) & 1) << 5); R = (st >> 1) * 16 + swz / 64; C = (st & 1) * 32 + (swz % 64) / 2; }
__host__ __device__ __forceinline__ int perm32(int rho) { const int n = rho >> 4, i = rho & 15; return 8 * (i >> 2) + 4 * n + (i & 3); }
struct Unit { int pm, pn, kt0, nkt; };
struct Gemm { const bf16_t* A; const bf16_t* Bt; int M, N, K; };
struct StaticOrder {
    int nM, nN, nwg, G, c, nMf, ns, ktiles, nfull;
    __device__ void init(int M, int N, int K, int G_, int c_, int nMf_ = -1, int ns_ = 1) { nM = M / BM; nN = N / BM; G = G_; c = c_; ktiles = K / BK; nMf = nMf_ < 0 ? nM : nMf_; ns = ns_; nfull = nMf * nN; nwg = nfull + (nM - nMf) * nN * ns; }
    __device__ __forceinline__ bool next(int i, Unit& u) const {
        const long L = (long)i * G + c; if (L >= nwg) return false;
        int pm, pn, kt0 = 0, nkt = ktiles;
        if (L >= nfull) { const int s = (int)L - nfull, tile = s / ns, sl = s - tile * ns; pm = nMf + tile / nN; pn = tile % nN; nkt = ktiles / ns; kt0 = sl * nkt; }
        else {
            int wgid = (int)L; { const int q = nfull / NXCD, r = nfull % NXCD, xcd = wgid % NXCD, off = wgid / NXCD; wgid = (xcd < r ? xcd * (q + 1) : r * (q + 1) + (xcd - r) * q) + off; }
            const int nig = WGM * nN, gid = wgid / nig, fm = gid * WGM, gsz = (nMf - fm) < WGM ? (nMf - fm) : WGM;
            pm = fm + ((wgid % nig) % gsz); pn = (wgid % nig) / gsz;
        }
        u = Unit{pm, pn, kt0, nkt}; return true;
    }
};
template <class Epi, bool ALIGN_EPI, bool SP2>
__device__ __forceinline__ void gemm_phase(LAS unsigned char* lds, const Gemm g, const StaticOrder& S, const Epi& E) {
    const int tid = threadIdx.x, wid = __builtin_amdgcn_readfirstlane(tid >> 6), lane = tid & 63, wr = wid >> 2, wc = wid & 3, fr = lane & 15, fq = lane >> 4;
    const int K = g.K;
    unsigned voffA[2], voffB[2];
#pragma unroll
    for (int i = 0; i < 2; ++i) { int R, C; stage_rc(tid * 16 + i * 8192, R, C); const int Rb = Epi::PERM ? ((R & ~31) + perm32(R & 31)) : R;
        voffA[i] = (unsigned)(R * K + C) * 2u; voffB[i] = (unsigned)(Rb * K + C) * 2u; }
    const size_t kstep = (size_t)(BK * 2);
    const size_t hstep = (size_t)HALF * K * 2;
    const size_t tstep = 2 * hstep;
    const unsigned ldsw = (unsigned)wid * 1024u;
    const int aoff = lds_byte(wr * 64 + fr, fq * 8), boff = lds_byte(wc * 32 + fr, fq * 8);
#define PG8_SA(b, h) (((b) * 2 + (h)) * HTB)
#define PG8_SB(b, h) ((4 + (b) * 2 + (h)) * HTB)
#define PG8_STAGE(bufoff, gbase, voff) do { _Pragma("unroll") for (int _i = 0; _i < 2; ++_i) \
        __builtin_amdgcn_global_load_lds((const unsigned*)((const char*)(gbase) + (voff)[_i]), (LAS unsigned*)(lds + (bufoff) + ldsw + _i * 8192), 16, 0, 0); } while (0)
#define PG8_LDA(dst, b, h) do { _Pragma("unroll") for (int m = 0; m < 4; ++m) _Pragma("unroll") for (int k = 0; k < 2; ++k) dst[m][k] = *(const LAS bf16x8*)(lds + PG8_SA(b, h) + aoff + m * 2048 + k * 1024); } while (0)
#define PG8_LDB(dst, b, h) do { _Pragma("unroll") for (int n = 0; n < 2; ++n) _Pragma("unroll") for (int k = 0; k < 2; ++k) dst[n][k] = *(const LAS bf16x8*)(lds + PG8_SB(b, h) + boff + n * 2048 + k * 1024); } while (0)
#define PG8_MMA(ai, bj, At, Bt) do { __builtin_amdgcn_s_setprio(1); _Pragma("unroll") for (int m = 0; m < 4; ++m) _Pragma("unroll") for (int n = 0; n < 2; ++n) _Pragma("unroll") for (int k = 0; k < 2; ++k) \
        acc[ai][bj][m][n] = __builtin_amdgcn_mfma_f32_16x16x32_bf16(Bt[n][k], At[m][k], acc[ai][bj][m][n], 0, 0, 0); __builtin_amdgcn_s_setprio(0); } while (0)
#define PG8_WAIT_V(n) asm volatile("s_waitcnt vmcnt(" #n ")" ::: "memory")
#define PG8_WAIT_L(n) asm volatile("s_waitcnt lgkmcnt(" #n ")" ::: "memory")
#define PG8_BAR __builtin_amdgcn_s_barrier()
#define PG8_SCHED __builtin_amdgcn_sched_barrier(0)
    Unit cur, nxt; int ui = 0;
    if (!S.next(0, cur)) return;
    f32x4 acc[2][2][4][2];
#pragma unroll
    for (int a = 0; a < 2; ++a)
#pragma unroll
        for (int b = 0; b < 2; ++b)
#pragma unroll
            for (int m = 0; m < 4; ++m)
#pragma unroll
                for (int n = 0; n < 2; ++n) acc[a][b][m][n] = (f32x4){0.f, 0.f, 0.f, 0.f};
    bf16x8 At[4][2], B0[2][2], B1[2][2];
    const char* cA = (const char*)g.A + (size_t)cur.pm * tstep + (size_t)cur.kt0 * kstep; const char* cB = (const char*)g.Bt + (size_t)cur.pn * tstep + (size_t)cur.kt0 * kstep;
    if constexpr (SP2) {
        PG8_STAGE(PG8_SB(0, 0), cB, voffB); PG8_STAGE(PG8_SB(0, 1), cB + hstep, voffB); PG8_STAGE(PG8_SA(0, 0), cA, voffA); PG8_STAGE(PG8_SA(0, 1), cA + hstep, voffA);
        if (wr == 1) PG8_BAR;
        PG8_WAIT_V(2); PG8_BAR;
        PG8_STAGE(PG8_SB(1, 0), cB + kstep, voffB); PG8_STAGE(PG8_SA(1, 0), cA + kstep, voffA); PG8_STAGE(PG8_SB(1, 1), cB + hstep + kstep, voffB);
        PG8_WAIT_V(6); PG8_BAR;
    } else {
        PG8_STAGE(PG8_SB(0, 0), cB, voffB); PG8_STAGE(PG8_SA(0, 0), cA, voffA); PG8_STAGE(PG8_SB(0, 1), cB + hstep, voffB); PG8_STAGE(PG8_SA(0, 1), cA + hstep, voffA);
        if (wr == 1) PG8_BAR;
        PG8_WAIT_V(4); PG8_BAR;
        PG8_STAGE(PG8_SB(1, 0), cB + kstep, voffB); PG8_STAGE(PG8_SA(1, 0), cA + kstep, voffA); PG8_STAGE(PG8_SB(1, 1), cB + hstep + kstep, voffB);
        PG8_WAIT_V(6); PG8_BAR;
    }
    for (;;) {
        const bool has_next = S.next(ui + 1, nxt);
        const char* nA = has_next ? (const char*)g.A + (size_t)nxt.pm * tstep + (size_t)nxt.kt0 * kstep : cA; const char* nB = has_next ? (const char*)g.Bt + (size_t)nxt.pn * tstep + (size_t)nxt.kt0 * kstep : cB;
        const int nt = cur.nkt;
        for (int t = 0; t < nt; t += 2) {
            const bool last = (t == nt - 2);
            const char* a1 = cA + (size_t)(t + 1) * kstep;
            const char* a2 = last ? nA : cA + (size_t)(t + 2) * kstep; const char* b2 = last ? nB : cB + (size_t)(t + 2) * kstep;
            const char* a3 = a2 + kstep; const char* b3 = b2 + kstep;
            if constexpr (SP2) {
            PG8_LDB(B0, 0, 0); PG8_LDB(B1, 0, 1); PG8_SCHED; PG8_LDA(At, 0, 0); PG8_STAGE(PG8_SA(1, 1), a1 + hstep, voffA);
            PG8_WAIT_V(8); PG8_WAIT_L(0); PG8_BAR; PG8_MMA(0, 0, At, B0); PG8_MMA(0, 1, At, B1); PG8_BAR; PG8_SCHED;
            PG8_LDA(At, 0, 1); PG8_STAGE(PG8_SB(0, 0), b2, voffB); PG8_STAGE(PG8_SB(0, 1), b2 + hstep, voffB); PG8_STAGE(PG8_SA(0, 0), a2, voffA);
            PG8_WAIT_V(8); PG8_WAIT_L(0); PG8_BAR; PG8_MMA(1, 0, At, B0); PG8_MMA(1, 1, At, B1); PG8_BAR; PG8_SCHED;
            PG8_LDB(B0, 1, 0); PG8_LDB(B1, 1, 1); PG8_SCHED; PG8_LDA(At, 1, 0); PG8_STAGE(PG8_SA(0, 1), a2 + hstep, voffA);
            PG8_WAIT_V(8); PG8_WAIT_L(0); PG8_BAR; PG8_MMA(0, 0, At, B0); PG8_MMA(0, 1, At, B1); PG8_BAR; PG8_SCHED;
            PG8_LDA(At, 1, 1); PG8_STAGE(PG8_SB(1, 0), b3, voffB); PG8_STAGE(PG8_SB(1, 1), b3 + hstep, voffB); PG8_STAGE(PG8_SA(1, 0), a3, voffA);
            PG8_WAIT_V(8); PG8_WAIT_L(0); PG8_BAR; PG8_MMA(1, 0, At, B0); PG8_MMA(1, 1, At, B1); PG8_BAR; PG8_SCHED;
            } else {
            PG8_LDB(B0, 0, 0); PG8_SCHED; PG8_LDA(At, 0, 0); PG8_STAGE(PG8_SA(1, 1), a1 + hstep, voffA);
            PG8_WAIT_L(8); PG8_BAR; PG8_WAIT_L(0); PG8_MMA(0, 0, At, B0); PG8_BAR; PG8_SCHED;
            PG8_LDB(B1, 0, 1); PG8_STAGE(PG8_SB(0, 0), b2, voffB);
            PG8_BAR; PG8_WAIT_L(0); PG8_MMA(0, 1, At, B1); PG8_BAR;
            PG8_LDA(At, 0, 1); PG8_STAGE(PG8_SA(0, 0), a2, voffA);
            PG8_BAR; PG8_WAIT_L(0); PG8_MMA(1, 0, At, B0); PG8_BAR; PG8_SCHED;
            PG8_STAGE(PG8_SB(0, 1), b2 + hstep, voffB);
            PG8_WAIT_V(6); PG8_BAR; PG8_MMA(1, 1, At, B1); PG8_BAR;
            PG8_LDB(B0, 1, 0); PG8_SCHED; PG8_LDA(At, 1, 0); PG8_STAGE(PG8_SA(0, 1), a2 + hstep, voffA);
            PG8_WAIT_L(8); PG8_BAR; PG8_WAIT_L(0); PG8_MMA(0, 0, At, B0); PG8_BAR; PG8_SCHED;
            PG8_LDB(B1, 1, 1); PG8_STAGE(PG8_SB(1, 0), b3, voffB);
            PG8_BAR; PG8_WAIT_L(0); PG8_MMA(0, 1, At, B1); PG8_BAR;
            PG8_LDA(At, 1, 1); PG8_STAGE(PG8_SA(1, 0), a3, voffA);
            PG8_BAR; PG8_WAIT_L(0); PG8_MMA(1, 0, At, B0); PG8_BAR; PG8_SCHED;
            PG8_STAGE(PG8_SB(1, 1), b3 + hstep, voffB);
            PG8_WAIT_V(6); PG8_BAR; PG8_MMA(1, 1, At, B1); PG8_BAR;
            }
        }
        if constexpr (ALIGN_EPI) { if (wr == 0) PG8_BAR; }
        E(acc, cur, wr, wc, fr, fq);
        if (!has_next) break;
#pragma unroll
        for (int a = 0; a < 2; ++a)
#pragma unroll
            for (int b = 0; b < 2; ++b)
#pragma unroll
                for (int m = 0; m < 4; ++m)
#pragma unroll
                    for (int n = 0; n < 2; ++n) acc[a][b][m][n] = (f32x4){0.f, 0.f, 0.f, 0.f};
        cur = nxt; cA = nA; cB = nB; ++ui;
        if constexpr (ALIGN_EPI) { if (wr == 1) PG8_BAR; }
    }
    PG8_WAIT_V(0);
    if constexpr (!ALIGN_EPI) { if (wr == 0) PG8_BAR; }
    PG8_BAR;
#undef PG8_SA
#undef PG8_SB
#undef PG8_STAGE
#undef PG8_LDA
#undef PG8_LDB
#undef PG8_MMA
#undef PG8_WAIT_V
#undef PG8_WAIT_L
#undef PG8_BAR
#undef PG8_SCHED
}

struct EpiQKV {
    static constexpr bool PERM = true;
    bf16_t* Q; bf16_t* Kb; bf16_t* Vb; const float* bias; const float* rope; float* kp; float* vp; float* ks; float* vs;
    __device__ __forceinline__ void operator()(const f32x4 (&acc)[2][2][4][2], const Unit& u, int wr, int wc, int fr, int fq) const {
        const int kind = u.pn < 4 ? 0 : u.pn - 3;
        const int lc0 = wc * 32 + 8 * fq;
        f32x4 bv[2][2];
#pragma unroll
        for (int bj = 0; bj < 2; ++bj)
#pragma unroll
            for (int n = 0; n < 2; ++n) bv[bj][n] = *(const f32x4*)(bias + u.pn * 256 + bj * 128 + lc0 + 4 * n);
        const bool dorope = (kind < 2) && ((wc & 1) == 0);
        const float sgn = (fq == 0) ? -1.f : 1.f;
#pragma unroll
        for (int ai = 0; ai < 2; ++ai)
#pragma unroll
            for (int m = 0; m < 4; ++m) {
                const int r = u.pm * 256 + ai * 128 + wr * 64 + m * 16 + fr;
                const bool prompt = r < MP;
                const int t = prompt ? (r & 2047) : ((r - MP) & 63), b = prompt ? (r >> 11) : ((r - MP) >> 6);
                const int pos = prompt ? t : 1024 + t;
                f32x4 cs[2], sn[2];
                if (dorope) { cs[0] = *(const f32x4*)(rope + pos * 16); cs[1] = *(const f32x4*)(rope + pos * 16 + 4); sn[0] = *(const f32x4*)(rope + pos * 16 + 8); sn[1] = *(const f32x4*)(rope + pos * 16 + 12); }
#pragma unroll
                for (int bj = 0; bj < 2; ++bj) {
                    f32x4 v[2];
#pragma unroll
                    for (int n = 0; n < 2; ++n) {
                        v[n] = acc[ai][bj][m][n] + bv[bj][n];
                        if (dorope) {
#pragma unroll
                            for (int j = 0; j < 4; ++j) { const float p = __shfl_xor(v[n][j], 16); const float rv = v[n][j] * cs[n][j] + sgn * p * sn[n][j]; v[n][j] = (fq < 2) ? rv : v[n][j]; }
                        }
                    }
                    if (kind == 0) {
                        u32x4 w; w.x = cvt_pk_bf16(v[0][0] * QSCALE, v[0][1] * QSCALE); w.y = cvt_pk_bf16(v[0][2] * QSCALE, v[0][3] * QSCALE); w.z = cvt_pk_bf16(v[1][0] * QSCALE, v[1][1] * QSCALE); w.w = cvt_pk_bf16(v[1][2] * QSCALE, v[1][3] * QSCALE);
                        *(u32x4*)(Q + (size_t)r * DM + u.pn * 256 + bj * 128 + lc0) = w;
                    } else {
                        const int col = bj * 128 + lc0;
                        const size_t krow = prompt ? (size_t)r : (size_t)MP + b * 192 + 128 + t;
                        u32x4 w; w.x = cvt_pk_bf16(v[0][0], v[0][1]); w.y = cvt_pk_bf16(v[0][2], v[0][3]); w.z = cvt_pk_bf16(v[1][0], v[1][1]); w.w = cvt_pk_bf16(v[1][2], v[1][3]);
                        *(u32x4*)((kind == 1 ? Kb : Vb) + krow * 256 + col) = w;
                        float* o = nullptr;
                        if (prompt) { if (t >= SEQ - 128) o = (kind == 1 ? kp : vp) + ((size_t)(b * 128 + t - (SEQ - 128)) * 256 + col); }
                        else o = (kind == 1 ? ks : vs) + ((size_t)(b * 128 + 64 + t) * 256 + col);
                        if (o) { *(f32x4*)o = v[0]; *(f32x4*)(o + 4) = v[1]; }
                    }
                }
            }
    }
};
struct EpiPlainSS {
    static constexpr bool PERM = true;
    bf16_t* O; const float* bias; float* ss; float* sacc; int ktiles;
    __device__ __forceinline__ void operator()(const f32x4 (&acc)[2][2][4][2], const Unit& u, int wr, int wc, int fr, int fq) const {
        const int col0 = u.pn * 256 + wc * 32 + 8 * fq;
        if (u.nkt != ktiles) {
            const int slice = u.kt0 / u.nkt;
#pragma unroll
            for (int ai = 0; ai < 2; ++ai)
#pragma unroll
                for (int m = 0; m < 4; ++m) {
                    const int r = u.pm * 256 + ai * 128 + wr * 64 + m * 16 + fr - MP; float* sp = sacc + ((size_t)slice * MS + r) * DM + col0;
#pragma unroll
                    for (int bj = 0; bj < 2; ++bj) { *(f32x4*)(sp + bj * 128) = acc[ai][bj][m][0]; *(f32x4*)(sp + bj * 128 + 4) = acc[ai][bj][m][1]; }
                }
            return;
        }
        f32x4 bv[2][2];
#pragma unroll
        for (int bj = 0; bj < 2; ++bj)
#pragma unroll
            for (int n = 0; n < 2; ++n) bv[bj][n] = bias ? *(const f32x4*)(bias + col0 + bj * 128 + 4 * n) : (f32x4){0.f, 0.f, 0.f, 0.f};
#pragma unroll
        for (int ai = 0; ai < 2; ++ai)
#pragma unroll
            for (int m = 0; m < 4; ++m) {
                const int r = u.pm * 256 + ai * 128 + wr * 64 + m * 16 + fr; float s = 0.f;
#pragma unroll
                for (int bj = 0; bj < 2; ++bj) {
                    const f32x4 v0 = acc[ai][bj][m][0] + bv[bj][0], v1 = acc[ai][bj][m][1] + bv[bj][1];
                    s += (v0[0] * v0[0] + v0[1] * v0[1]) + (v0[2] * v0[2] + v0[3] * v0[3]) + (v1[0] * v1[0] + v1[1] * v1[1]) + (v1[2] * v1[2] + v1[3] * v1[3]);
                    u32x4 w; w.x = cvt_pk_bf16(v0[0], v0[1]); w.y = cvt_pk_bf16(v0[2], v0[3]); w.z = cvt_pk_bf16(v1[0], v1[1]); w.w = cvt_pk_bf16(v1[2], v1[3]);
                    *(u32x4*)(O + (size_t)r * DM + col0 + bj * 128) = w;
                }
                s += __shfl_xor(s, 16); s += __shfl_xor(s, 32);
                if (fq == 0) ss[(size_t)r * 32 + u.pn * 4 + wc] = s;
            }
    }
};
struct EpiGlu {
    static constexpr bool PERM = true;
    bf16_t* O; const float* bias; float* ss;
    __device__ __forceinline__ void operator()(const f32x4 (&acc)[2][2][4][2], const Unit& u, int wr, int wc, int fr, int fq) const {
        const int oc0 = u.pn * 128 + wc * 32 + 8 * fq;
        f32x4 ba[2], bg[2];
#pragma unroll
        for (int n = 0; n < 2; ++n) { ba[n] = *(const f32x4*)(bias + oc0 + 4 * n); bg[n] = *(const f32x4*)(bias + DM + oc0 + 4 * n); }
#pragma unroll
        for (int ai = 0; ai < 2; ++ai)
#pragma unroll
            for (int m = 0; m < 4; ++m) {
                const int r = u.pm * 256 + ai * 128 + wr * 64 + m * 16 + fr; float s = 0.f; f32x4 o[2];
#pragma unroll
                for (int n = 0; n < 2; ++n) { const f32x4 a = acc[ai][0][m][n] + ba[n], g = acc[ai][1][m][n] + bg[n];
#pragma unroll
                    for (int j = 0; j < 4; ++j) { o[n][j] = a[j] * sigmoid_f(g[j]); s += o[n][j] * o[n][j]; } }
                u32x4 w; w.x = cvt_pk_bf16(o[0][0], o[0][1]); w.y = cvt_pk_bf16(o[0][2], o[0][3]); w.z = cvt_pk_bf16(o[1][0], o[1][1]); w.w = cvt_pk_bf16(o[1][2], o[1][3]);
                *(u32x4*)(O + (size_t)r * DM + oc0) = w;
                s += __shfl_xor(s, 16); s += __shfl_xor(s, 32);
                if (fq == 0) ss[(size_t)r * 32 + u.pn * 4 + wc] = s;
            }
    }
};
struct EpiUp {
    static constexpr bool PERM = true;
    bf16_t* G; float* E; const float* cw; const float* cb;
    __device__ __forceinline__ void operator()(f32x4 (&acc)[2][2][4][2], const Unit& u, int wr, int wc, int fr, int fq) const {
        const int oc0 = u.pn * 128 + wc * 32 + 8 * fq;
        {
            const int e = (fr < 2) ? fr : fr - 12; const int msel = (fr < 2) ? 0 : 3;
            if (fr < 2 || fr >= 14) {
#pragma unroll
                for (int ai = 0; ai < 2; ++ai) {
                    const int seg = u.pm * 4 + ai * 2 + wr; float* eb = E + ((size_t)seg * 4 + e) * FF2 + oc0;
#pragma unroll
                    for (int bj = 0; bj < 2; ++bj)
#pragma unroll
                        for (int n = 0; n < 2; ++n) { const f32x4 v = (msel == 0) ? acc[ai][bj][0][n] : acc[ai][bj][3][n]; *(f32x4*)(eb + bj * FF + 4 * n) = v; }
                }
            }
        }
#pragma unroll
        for (int n = 0; n < 2; ++n) {
#pragma unroll
            for (int bj = 0; bj < 2; ++bj) {
                const float* cwp = cw + bj * FF + oc0 + 4 * n;
                const f32x4 w0 = *(const f32x4*)(cwp), w1 = *(const f32x4*)(cwp + FF2), w2 = *(const f32x4*)(cwp + 2 * FF2), bb = *(const f32x4*)(cb + bj * FF + oc0 + 4 * n);
#pragma unroll
                for (int ai = 0; ai < 2; ++ai)
#pragma unroll
                    for (int m = 3; m >= 0; --m) {
                        const f32x4 v = acc[ai][bj][m][n]; const f32x4 vp = (m > 0) ? acc[ai][bj][m - 1][n] : v;
                        f32x4 c;
#pragma unroll
                        for (int j = 0; j < 4; ++j) {
                            const float p1 = dpp_f<0x121>(fr == 15 ? vp[j] : v[j]);
                            const float p2 = dpp_f<0x122>(fr >= 14 ? vp[j] : v[j]);
                            c[j] = bb[j] + w0[j] * p2 + w1[j] * p1 + w2[j] * v[j];
                        }
                        asm volatile("" : "+v"(c));
                        acc[ai][bj][m][n] = c;
                    }
                asm volatile("" ::: "memory");
            }
        }
#pragma unroll
        for (int ai = 0; ai < 2; ++ai)
#pragma unroll
            for (int m = 0; m < 4; ++m) {
                const int r = u.pm * 256 + ai * 128 + wr * 64 + m * 16 + fr;
                f32x4 o[2];
#pragma unroll
                for (int n = 0; n < 2; ++n)
#pragma unroll
                    for (int j = 0; j < 4; ++j) o[n][j] = gelu_tanh(acc[ai][0][m][n][j]) * acc[ai][1][m][n][j];
                u32x4 w; w.x = cvt_pk_bf16(o[0][0], o[0][1]); w.y = cvt_pk_bf16(o[0][2], o[0][3]); w.z = cvt_pk_bf16(o[1][0], o[1][1]); w.w = cvt_pk_bf16(o[1][2], o[1][3]);
                if (!(m == 0 && fr < 2)) *(u32x4*)(G + (size_t)r * FF + oc0) = w;
            }
    }
};
}

#ifndef PROBE_REPMASK
#define PROBE_REPMASK 0
#endif
struct Args { const float* in[30]; float* out; unsigned char* ws; int ph_lo, ph_hi, coop, repmask; };
constexpr int NPHASE = 16;
constexpr int LDS_BYTES = 147456;

__device__ __forceinline__ unsigned f2bf(float f) { unsigned u = __builtin_bit_cast(unsigned, f); return (u + 0x7fffu + ((u >> 16) & 1u)) >> 16; }
__device__ __forceinline__ unsigned pk2(float lo, float hi) { return f2bf(lo) | (f2bf(hi) << 16); }
__device__ __forceinline__ void transpose_item(const float* W, int K, int N, bf16_t* WT, int pair_half, LAS float* scr, int item, int lane) {
    const int nblk = N / 32, kb = item / nblk, nb = item % nblk, k0 = 64 * kb, n0 = 32 * nb;
#pragma unroll 8
    for (int i = 0; i < 32; ++i) { const int kk = 2 * i + (lane >> 5); scr[kk * 33 + (lane & 31)] = W[(size_t)(k0 + kk) * N + n0 + (lane & 31)]; }
    asm volatile("s_waitcnt lgkmcnt(0)" ::: "memory");
    int r0 = n0;
    if (pair_half > 0) { const int half = n0 / pair_half, c = n0 % pair_half; r0 = 256 * (c / 128) + 128 * half + (c % 128); }
    const int c = lane & 7;
#pragma unroll
    for (int j = 0; j < 4; ++j) { const int n = (lane >> 3) + 8 * j; const LAS float* s = scr + (8 * c) * 33 + n;
        u32x4 o; o.x = pk2(s[0 * 33], s[1 * 33]); o.y = pk2(s[2 * 33], s[3 * 33]); o.z = pk2(s[4 * 33], s[5 * 33]); o.w = pk2(s[6 * 33], s[7 * 33]);
        *(u32x4*)(WT + (size_t)(r0 + n) * K + k0 + 8 * c) = o; }
    asm volatile("s_waitcnt lgkmcnt(0)" ::: "memory");
}

template <bool HAS_M, bool HAS_NEXT, bool XIN_F32, bool XOUT_F32, bool M_F32 = false>
__device__ __forceinline__ void row_pass(const void* xin, void* xout, const bf16_t* mrow, const float* ssrow, int nslots, const float* gpost, const float* gnext, bf16_t* arow, int lane, const float* saccrow = nullptr, const float* mbias = nullptr) {
    f32x4 v[4];
#pragma unroll
    for (int j = 0; j < 4; ++j) {
        if constexpr (XIN_F32) v[j] = *((const f32x4*)xin + lane + 64 * j);
        else { const u32x2 xw = *((const u32x2*)xin + lane + 64 * j); v[j][0] = __uint_as_float(xw.x << 16); v[j][1] = __uint_as_float(xw.x & 0xffff0000u); v[j][2] = __uint_as_float(xw.y << 16); v[j][3] = __uint_as_float(xw.y & 0xffff0000u); }
    }
    if constexpr (HAS_M) {
        f32x4 mv[4]; float s;
        if constexpr (M_F32) {
            s = 0.f;
#pragma unroll
            for (int j = 0; j < 4; ++j) { mv[j] = mbias ? *((const f32x4*)mbias + lane + 64 * j) : (f32x4){0.f, 0.f, 0.f, 0.f};
                for (int sl = 0; sl < nslots; ++sl) mv[j] += *((const f32x4*)(saccrow + (size_t)sl * MS * DM) + lane + 64 * j);
                s += (mv[j][0] * mv[j][0] + mv[j][1] * mv[j][1]) + (mv[j][2] * mv[j][2] + mv[j][3] * mv[j][3]); }
        } else {
            s = (lane < nslots) ? ssrow[lane] : 0.f;
#pragma unroll
            for (int j = 0; j < 4; ++j) { const u32x2 mw = *((const u32x2*)mrow + lane + 64 * j);
                mv[j][0] = __uint_as_float(mw.x << 16); mv[j][1] = __uint_as_float(mw.x & 0xffff0000u); mv[j][2] = __uint_as_float(mw.y << 16); mv[j][3] = __uint_as_float(mw.y & 0xffff0000u); }
        }
        s = wave_sum(s);
        const float rstd = 1.0f / sqrtf(s * (1.0f / DM) + EPS);
#pragma unroll
        for (int j = 0; j < 4; ++j) {
            const f32x4 gp = *((const f32x4*)gpost + lane + 64 * j);
            v[j] += mv[j] * rstd * gp;
            if constexpr (XOUT_F32) *((f32x4*)xout + lane + 64 * j) = v[j];
            else { u32x2 w; w.x = cvt_pk_bf16(v[j][0], v[j][1]); w.y = cvt_pk_bf16(v[j][2], v[j][3]); *((u32x2*)xout + lane + 64 * j) = w; }
        }
    }
    if constexpr (HAS_NEXT) {
        float s2 = 0.f;
#pragma unroll
        for (int j = 0; j < 4; ++j) s2 += (v[j][0] * v[j][0] + v[j][1] * v[j][1]) + (v[j][2] * v[j][2] + v[j][3] * v[j][3]);
        s2 = wave_sum(s2);
        const float rstd2 = 1.0f / sqrtf(s2 * (1.0f / DM) + EPS);
#pragma unroll
        for (int j = 0; j < 4; ++j) { const f32x4 gn = *((const f32x4*)gnext + lane + 64 * j);
            u32x2 w; w.x = cvt_pk_bf16(v[j][0] * rstd2 * gn[0], v[j][1] * rstd2 * gn[1]); w.y = cvt_pk_bf16(v[j][2] * rstd2 * gn[2], v[j][3] * rstd2 * gn[3]);
            *((u32x2*)arow + lane + 64 * j) = w; }
    }
}

__device__ __forceinline__ s16x4 vtr(LAS const unsigned char* p) { return __builtin_bit_cast(s16x4, __builtin_amdgcn_ds_read_tr16_b64_v4i16((LAS s16x4*)p)); }
__device__ __forceinline__ void attn_unit_coords(int u, int& qrow0, int& krow0, int& kb0, int& kvh) {
    if (u < NB * 128) { const int b = u >> 7, rem = u & 127, c = rem >> 2; kvh = rem & 3; qrow0 = b * SEQ + c * 64; krow0 = qrow0 - 128; kb0 = c >= 2 ? 0 : 2 * (2 - c); }
    else { const int u2 = u - NB * 128, b = u2 >> 2; kvh = u2 & 3; qrow0 = MP + b * 64; krow0 = MP + b * 192; kb0 = 0; }
}
__device__ __forceinline__ void attn_phase(LAS unsigned char* lds, const bf16_t* Qb, const bf16_t* Kb, const bf16_t* Vb, bf16_t* Ob, const float* sinks, int G, int blk) {
    const int tid = threadIdx.x, lane = tid & 63, w = __builtin_amdgcn_readfirstlane(tid >> 6), r32 = lane & 31, hi = lane >> 5;
    constexpr int KST = 144, VST = 192, KOFF = 0, VOFF = 192 * KST, OOFF = VOFF + 192 * VST, OST = 136;
    constexpr int NUNITS = NB * 32 * 4 + DB * 4;
    LAS unsigned char* ostage = lds + OOFF + w * (32 * OST);
    u32x4 kreg[3], vreg[3]; bf16x8 qnext[4];
    int qrow0 = 0, krow0 = 0, kb0 = 0, kvh = 0;
#define ATTN_LOAD(UU) do { int q0_, k0_, b0_, h0_; attn_unit_coords((UU), q0_, k0_, b0_, h0_); \
        _Pragma("unroll") for (int i = 0; i < 3; ++i) { const int p_ = tid + 512 * i, row_ = p_ >> 3, ch_ = p_ & 7; \
            if (row_ >= b0_ * 32) { const size_t go_ = (size_t)(k0_ + row_) * 256 + h0_ * 64 + ch_ * 8; kreg[i] = *(const u32x4*)(Kb + go_); vreg[i] = *(const u32x4*)(Vb + go_); } } \
        { const size_t qr_ = (size_t)q0_ + (w & 1) * 32 + r32; const int hq_ = h0_ * 4 + (w >> 1); \
          _Pragma("unroll") for (int dk = 0; dk < 4; ++dk) qnext[dk] = *(const bf16x8*)(Qb + qr_ * DM + hq_ * 64 + dk * 16 + hi * 8); } } while (0)
    if (blk < NUNITS) ATTN_LOAD(blk);
    for (int u = blk; u < NUNITS; u += G) {
        attn_unit_coords(u, qrow0, krow0, kb0, kvh);
        __syncthreads();
#pragma unroll
        for (int i = 0; i < 3; ++i) { const int p = tid + 512 * i, row = p >> 3, ch = p & 7;
            if (row >= kb0 * 32) { *(LAS u32x4*)(lds + KOFF + row * KST + ch * 16) = kreg[i]; *(LAS u32x4*)(lds + VOFF + row * VST + ch * 16) = vreg[i]; } }
        bf16x8 qf[4];
#pragma unroll
        for (int dk = 0; dk < 4; ++dk) qf[dk] = qnext[dk];
        const int hq = kvh * 4 + (w >> 1); const size_t qrowb = (size_t)qrow0 + (w & 1) * 32;
        __syncthreads();
        if (u + G < NUNITS) ATTN_LOAD(u + G);
        f32x16 sc[6];
        float mx = -3.0e38f;
#pragma unroll
        for (int kb = 0; kb < 6; ++kb) {
            if (kb >= kb0) {
                f32x16 a = {};
#pragma unroll
                for (int dk = 0; dk < 4; ++dk) { const bf16x8 kf = *(const LAS bf16x8*)(lds + KOFF + (32 * kb + r32) * KST + (dk * 16 + hi * 8) * 2); a = __builtin_amdgcn_mfma_f32_32x32x16_bf16(kf, qf[dk], a, 0, 0, 0); }
#pragma unroll
                for (int r = 0; r < 16; ++r) mx = fmaxf(mx, a[r]);
                sc[kb] = a;
            }
        }
        mx = fmaxf(mx, __shfl_xor(mx, 32));
        const float sinkl = sinks[hq] * LOG2E; mx = fmaxf(mx, sinkl);
        float ls = 0.f;
#pragma unroll
        for (int kb = 0; kb < 6; ++kb) {
            if (kb >= kb0) {
#pragma unroll
                for (int r = 0; r < 16; ++r) { const float p = __builtin_amdgcn_exp2f(sc[kb][r] - mx); sc[kb][r] = p; ls += p; }
            }
        }
        ls += __shfl_xor(ls, 32);
        const float inv = 1.0f / (ls + __builtin_amdgcn_exp2f(sinkl - mx));
        f32x16 o[2]; o[0] = f32x16{}; o[1] = f32x16{};
        const int vlane = VOFF + (4 * hi + ((lane >> 2) & 3)) * VST + (16 * ((lane >> 4) & 1) + 4 * (lane & 3)) * 2;
#pragma unroll
        for (int kb = 0; kb < 6; ++kb) {
            if (kb >= kb0) {
#pragma unroll
                for (int s = 0; s < 2; ++s) {
                    u32x4 pw; pw.x = cvt_pk_bf16(sc[kb][8 * s + 0], sc[kb][8 * s + 1]); pw.y = cvt_pk_bf16(sc[kb][8 * s + 2], sc[kb][8 * s + 3]); pw.z = cvt_pk_bf16(sc[kb][8 * s + 4], sc[kb][8 * s + 5]); pw.w = cvt_pk_bf16(sc[kb][8 * s + 6], sc[kb][8 * s + 7]);
                    const bf16x8 pf = __builtin_bit_cast(bf16x8, pw);
#pragma unroll
                    for (int db = 0; db < 2; ++db) {
                        LAS const unsigned char* vp = lds + vlane + (32 * kb + 16 * s) * VST + db * 64;
                        const s16x4 lo = vtr(vp), h4 = vtr(vp + 8 * VST);
                        const bf16x8 vf = (bf16x8){lo[0], lo[1], lo[2], lo[3], h4[0], h4[1], h4[2], h4[3]};
                        o[db] = __builtin_amdgcn_mfma_f32_32x32x16_bf16(vf, pf, o[db], 0, 0, 0);
                    }
                }
            }
        }
#pragma unroll
        for (int db = 0; db < 2; ++db)
#pragma unroll
            for (int rq = 0; rq < 4; ++rq) {
                u32x2 wv; wv.x = cvt_pk_bf16(o[db][4 * rq] * inv, o[db][4 * rq + 1] * inv); wv.y = cvt_pk_bf16(o[db][4 * rq + 2] * inv, o[db][4 * rq + 3] * inv);
                *(LAS u32x2*)(ostage + r32 * OST + (32 * db + 8 * rq + 4 * hi) * 2) = wv;
            }
        asm volatile("s_waitcnt lgkmcnt(0)" ::: "memory");
#pragma unroll
        for (int i = 0; i < 4; ++i) { const int row = i * 8 + (lane >> 3), ch = lane & 7;
            const u32x2 a = *(const LAS u32x2*)(ostage + row * OST + ch * 16), b = *(const LAS u32x2*)(ostage + row * OST + ch * 16 + 8);
            u32x4 v; v.x = a.x; v.y = a.y; v.z = b.x; v.w = b.y;
            *(u32x4*)(Ob + (qrowb + row) * DM + hq * 64 + ch * 8) = v; }
        asm volatile("s_waitcnt lgkmcnt(0)" ::: "memory");
    }
#undef ATTN_LOAD
}

struct SsmP { const float *lam_re, *lam_im, *log_dt, *b_re, *b_im, *c_re, *c_im, *dsk, *st_re, *st_im; float *o_rep, *o_imp, *o_res, *o_ims; };
__device__ __forceinline__ void ssm_phase(LAS unsigned char* lds, const bf16_t* A3, bf16_t* Z, const SsmP P, int G, int blk) {
    const int tid = threadIdx.x, lane = tid & 63, w = __builtin_amdgcn_readfirstlane(tid >> 6), p = lane & 31, hi = lane >> 5;
    constexpr int IST = 72;
    LAS unsigned char* img = lds + w * (128 * IST);
    const bool samp = (w >= 4);
    const int nunits = samp ? (DB / 2) * 64 : (NB / 2) * 64, T = samp ? DS : SEQ;
    for (int uu = blk * 4 + (w & 3); uu < nunits; uu += G * 4) {
        const int bp = uu >> 6, g = uu & 63;
        const int rowbase0 = samp ? MP + (2 * bp) * DS : (2 * bp) * SEQ, bstride = T;
        const float dt = expf(P.log_dt[g]);
        float lbr[2], lbi[2], zr[2], zi[2], hr[2], hm[2];
#pragma unroll
        for (int pp = 0; pp < 2; ++pp) {
            const int ps = g * 64 + p + 32 * pp; const float lr = P.lam_re[ps], li = P.lam_im[ps];
            const float mag = expf(lr * dt); lbr[pp] = mag * cosf(li * dt); lbi[pp] = mag * sinf(li * dt);
            const float nr = lbr[pp] - 1.0f, ni = lbi[pp], den = lr * lr + li * li;
            zr[pp] = (nr * lr + ni * li) / den; zi[pp] = (ni * lr - nr * li) / den;
            if (samp) { const int so = ((2 * bp + hi) * 64 + g) * 64 + p + 32 * pp; hr[pp] = P.st_re[so]; hm[pp] = P.st_im[so]; } else { hr[pp] = 0.f; hm[pp] = 0.f; }
        }
        bf16x8 bfrag[4];
#pragma unroll
        for (int pp = 0; pp < 2; ++pp) {
            const float* br = P.b_re + ((size_t)(g * 64 + p + 32 * pp)) * 16 + 8 * hi; const float* bi = P.b_im + ((size_t)(g * 64 + p + 32 * pp)) * 16 + 8 * hi;
            const f32x4 br0 = *(const f32x4*)br, br1 = *(const f32x4*)(br + 4), bi0 = *(const f32x4*)bi, bi1 = *(const f32x4*)(bi + 4);
            u32x4 wre, wim;
            wre.x = cvt_pk_bf16(zr[pp] * br0[0] - zi[pp] * bi0[0], zr[pp] * br0[1] - zi[pp] * bi0[1]); wre.y = cvt_pk_bf16(zr[pp] * br0[2] - zi[pp] * bi0[2], zr[pp] * br0[3] - zi[pp] * bi0[3]);
            wre.z = cvt_pk_bf16(zr[pp] * br1[0] - zi[pp] * bi1[0], zr[pp] * br1[1] - zi[pp] * bi1[1]); wre.w = cvt_pk_bf16(zr[pp] * br1[2] - zi[pp] * bi1[2], zr[pp] * br1[3] - zi[pp] * bi1[3]);
            wim.x = cvt_pk_bf16(zr[pp] * bi0[0] + zi[pp] * br0[0], zr[pp] * bi0[1] + zi[pp] * br0[1]); wim.y = cvt_pk_bf16(zr[pp] * bi0[2] + zi[pp] * br0[2], zr[pp] * bi0[3] + zi[pp] * br0[3]);
            wim.z = cvt_pk_bf16(zr[pp] * bi1[0] + zi[pp] * br1[0], zr[pp] * bi1[1] + zi[pp] * br1[1]); wim.w = cvt_pk_bf16(zr[pp] * bi1[2] + zi[pp] * br1[2], zr[pp] * bi1[3] + zi[pp] * br1[3]);
            bfrag[pp] = __builtin_bit_cast(bf16x8, wre); bfrag[2 + pp] = __builtin_bit_cast(bf16x8, wim);
        }
        const int ci = lane & 15, kg = lane >> 4;
        bf16x8 cfrag[4];
#pragma unroll
        for (int kb = 0; kb < 4; ++kb) {
            const float* cp = ((kb < 2) ? P.c_re : P.c_im) + ((size_t)(g * 16 + ci)) * 64 + 32 * (kb & 1) + 8 * kg; const float sg = (kb < 2) ? 1.f : -1.f;
            const f32x4 c0 = *(const f32x4*)cp, c1 = *(const f32x4*)(cp + 4);
            u32x4 wc_; wc_.x = cvt_pk_bf16(sg * c0[0], sg * c0[1]); wc_.y = cvt_pk_bf16(sg * c0[2], sg * c0[3]); wc_.z = cvt_pk_bf16(sg * c1[0], sg * c1[1]); wc_.w = cvt_pk_bf16(sg * c1[2], sg * c1[3]);
            cfrag[kb] = __builtin_bit_cast(bf16x8, wc_);
        }
        const f32x4 dsk4 = *(const f32x4*)(P.dsk + g * 16 + 4 * kg);
        const int hip = (p >> 2) & 1, jp = (p & 3) + 4 * (p >> 3);
        const bf16_t* uptr = A3 + ((size_t)(rowbase0 + hip * bstride + jp)) * DM + g * 16 + 8 * hi;
        const size_t yoff = ((size_t)(rowbase0 + ci)) * DM + g * 16 + 4 * kg; const size_t boff = (size_t)bstride * DM;
        const int nblk = T / 16;
        bf16x8 ufA = *(const bf16x8*)uptr, ufB = *(const bf16x8*)(uptr + (size_t)16 * DM), ufC = *(const bf16x8*)(uptr + (size_t)32 * DM);
        u32x2 unA0 = *(const u32x2*)(A3 + yoff), unA1 = *(const u32x2*)(A3 + yoff + boff);
        u32x2 unB0 = *(const u32x2*)(A3 + yoff + (size_t)16 * DM), unB1 = *(const u32x2*)(A3 + yoff + boff + (size_t)16 * DM);
        u32x2 unC0 = *(const u32x2*)(A3 + yoff + (size_t)32 * DM), unC1 = *(const u32x2*)(A3 + yoff + boff + (size_t)32 * DM);
        for (int tb = 0; tb < nblk; ++tb) {
            const bf16x8 ucur = ufA; const u32x2 uc0 = unA0, uc1 = unA1;
            ufA = ufB; unA0 = unB0; unA1 = unB1; ufB = ufC; unB0 = unC0; unB1 = unC1;
            if (tb + 3 < nblk) { ufC = *(const bf16x8*)(uptr + (size_t)(tb + 3) * 16 * DM); unC0 = *(const u32x2*)(A3 + yoff + (size_t)(tb + 3) * 16 * DM); unC1 = *(const u32x2*)(A3 + yoff + boff + (size_t)(tb + 3) * 16 * DM); }
            f32x16 X[4];
#pragma unroll
            for (int cb = 0; cb < 4; ++cb) { f32x16 z = {}; X[cb] = __builtin_amdgcn_mfma_f32_32x32x16_bf16(ucur, bfrag[cb], z, 0, 0, 0); }
#pragma unroll
            for (int r = 0; r < 16; ++r) {
#pragma unroll
                for (int pp = 0; pp < 2; ++pp) {
                    const float nr = lbr[pp] * hr[pp] - lbi[pp] * hm[pp] + X[pp][r];
                    const float ni = lbr[pp] * hm[pp] + lbi[pp] * hr[pp] + X[2 + pp][r];
                    hr[pp] = nr; hm[pp] = ni; X[pp][r] = nr; X[2 + pp][r] = ni;
                }
            }
#pragma unroll
            for (int cb = 0; cb < 4; ++cb)
#pragma unroll
                for (int q = 0; q < 4; ++q) {
                    u32x2 wv; wv.x = cvt_pk_bf16(X[cb][4 * q], X[cb][4 * q + 1]); wv.y = cvt_pk_bf16(X[cb][4 * q + 2], X[cb][4 * q + 3]);
                    *(LAS u32x2*)(img + (cb * 32 + p) * IST + (16 * hi + 4 * q) * 2) = wv;
                }
            asm volatile("s_waitcnt lgkmcnt(0)" ::: "memory");
#pragma unroll
            for (int rb = 0; rb < 2; ++rb) {
                f32x4 y = {0.f, 0.f, 0.f, 0.f};
#pragma unroll
                for (int kb = 0; kb < 4; ++kb) {
                    LAS const unsigned char* ap = img + (32 * kb + 8 * kg + (ci >> 2)) * IST + (16 * rb + 4 * (ci & 3)) * 2;
                    const s16x4 lo = vtr(ap), h4 = vtr(ap + 4 * IST);
                    const bf16x8 af = (bf16x8){lo[0], lo[1], lo[2], lo[3], h4[0], h4[1], h4[2], h4[3]};
                    y = __builtin_amdgcn_mfma_f32_16x16x32_bf16(cfrag[kb], af, y, 0, 0, 0);
                }
                const u32x2 uw = rb ? uc1 : uc0;
                const float z0 = gelu_tanh(y[0] + dsk4[0] * __uint_as_float(uw.x << 16)), z1 = gelu_tanh(y[1] + dsk4[1] * __uint_as_float(uw.x & 0xffff0000u));
                const float z2 = gelu_tanh(y[2] + dsk4[2] * __uint_as_float(uw.y << 16)), z3 = gelu_tanh(y[3] + dsk4[3] * __uint_as_float(uw.y & 0xffff0000u));
                u32x2 zw; zw.x = cvt_pk_bf16(z0, z1); zw.y = cvt_pk_bf16(z2, z3);
                *(u32x2*)(Z + yoff + (rb ? boff : 0) + (size_t)tb * 16 * DM) = zw;
            }
            asm volatile("" ::: "memory");
        }
#pragma unroll
        for (int pp = 0; pp < 2; ++pp) {
            const int so = ((2 * bp + hi) * 64 + g) * 64 + p + 32 * pp;
            if (samp) { P.o_res[so] = hr[pp]; P.o_ims[so] = hm[pp]; } else { P.o_rep[so] = hr[pp]; P.o_imp[so] = hm[pp]; }
        }
    }
}


#define XB_TMO      128
#define XB_XCNT(j)  (256  + 64 * (j))
#define XB_XSUB(j)  (1280 + 64 * (j))
#define XB_XGEN(j)  (2304 + 64 * (j))
#define XB_TOP      3328
#define XB_TOPGEN   3392
#define XCD_BAR_WORDS 3456
#define XB_SPIN_CAP (1u << 18)
__device__ __forceinline__ unsigned xb_ld(unsigned* p)              { return __hip_atomic_load(p, __ATOMIC_RELAXED, __HIP_MEMORY_SCOPE_AGENT); }
__device__ __forceinline__ unsigned xb_add(unsigned* p, unsigned v) { return __hip_atomic_fetch_add(p, v, __ATOMIC_RELAXED, __HIP_MEMORY_SCOPE_AGENT); }
__device__ __forceinline__ unsigned xb_xcc_id() { return (unsigned)__builtin_amdgcn_s_getreg((3 << 11) | 20) & 0xFu; }
#define XB_SPIN(cond, bar) do { unsigned _sp = 0; while (cond) { __builtin_amdgcn_s_sleep(1); \
    if ((++_sp & 255u) == 0u) { if (xb_ld(&(bar)[XB_TMO])) break; if (_sp > XB_SPIN_CAP) { atomicAdd(&(bar)[XB_TMO], 1u); break; } } } } while (0)
struct XcdBarrier { unsigned* bar; unsigned x; volatile LAS unsigned* st; };
__device__ __forceinline__ XcdBarrier xcd_barrier_post(unsigned* bar, volatile LAS unsigned* st) {
    XcdBarrier b; b.bar = bar; b.x = xb_xcc_id(); b.st = st;
    if (threadIdx.x == 0) (void)xb_add(&bar[XB_XCNT(b.x)], 1u);
    return b;
}
__device__ __forceinline__ void xcd_barrier_complete(unsigned* bar, unsigned x, unsigned& nloc, unsigned& nx) {
    const unsigned G = gridDim.x * gridDim.y * gridDim.z;
    unsigned sum, cnt, mine, sp = 0u;
    for (;;) {
        sum = 0u; cnt = 0u; mine = 0u;
#pragma unroll
        for (unsigned j = 0; j < 16; ++j) { const unsigned c = xb_ld(&bar[XB_XCNT(j)]); sum += c; cnt += (c > 0u) ? 1u : 0u; mine = (j == x) ? c : mine; }
        if (sum == G) break;
        __builtin_amdgcn_s_sleep(1);
        if ((++sp & 255u) == 0u) { if (xb_ld(&bar[XB_TMO])) break; if (sp > XB_SPIN_CAP) { atomicAdd(&bar[XB_TMO], 1u); break; } }
    }
    nloc = mine > 0u ? mine : 1u; nx = cnt > 0u ? cnt : 1u;
}
__device__ __forceinline__ void xcd_barrier(const XcdBarrier& b) {
    asm volatile("s_waitcnt vmcnt(0)" ::: "memory");
    __syncthreads();
    if (threadIdx.x == 0) {
        unsigned* bar = b.bar;
        __builtin_amdgcn_s_waitcnt(0);
        unsigned nloc = b.st[0], nx = b.st[1];
        if (nloc == 0u) { xcd_barrier_complete(bar, b.x, nloc, nx); b.st[0] = nloc; b.st[1] = nx; }
        const unsigned old = xb_add(&bar[XB_XSUB(b.x)], 1u);
        const unsigned gen = old / nloc;
        if (old + 1u == (gen + 1u) * nloc) {
            __builtin_amdgcn_fence(__ATOMIC_RELEASE, "agent");
            asm volatile("s_waitcnt vmcnt(0)" ::: "memory");
            const unsigned og = xb_add(&bar[XB_TOP], 1u);
            const unsigned tg = og / nx;
            if (og + 1u == (tg + 1u) * nx) xb_add(&bar[XB_TOPGEN], 1u);
            else XB_SPIN(xb_ld(&bar[XB_TOPGEN]) == tg, bar);
            __builtin_amdgcn_fence(__ATOMIC_ACQUIRE, "agent");
            xb_add(&bar[XB_XGEN(b.x)], 1u);
            asm volatile("s_waitcnt vmcnt(0)" ::: "memory");
        } else {
            XB_SPIN(xb_ld(&bar[XB_XGEN(b.x)]) == gen, bar);
            __builtin_amdgcn_fence(__ATOMIC_ACQUIRE, "agent");
            asm volatile("s_waitcnt vmcnt(0)" ::: "memory");
        }
    }
    __syncthreads();
}

__device__ __forceinline__ void phase_prologue(LAS unsigned char* lds, const Args& args, unsigned char* ws, float* out, int G, int blk, int wave, int lane, int tid) {
    const int gw = blk * 8 + wave, NGW = G * 8;
    bf16_t* Wqkv = (bf16_t*)(ws + WS_WQKV); bf16_t* Wo = (bf16_t*)(ws + WS_WO); bf16_t* Wglu = (bf16_t*)(ws + WS_WGLU); bf16_t* Wup = (bf16_t*)(ws + WS_WUP); bf16_t* Wdn = (bf16_t*)(ws + WS_WDN);
    float* rope = (float*)(ws + WS_ROPE); bf16_t* Abuf = (bf16_t*)(ws + WS_A); bf16_t* Kbuf = (bf16_t*)(ws + WS_K); bf16_t* Vbuf = (bf16_t*)(ws + WS_V);
    LAS float* scr = (LAS float*)(lds + wave * 16384);
    constexpr int I_QKV = 16 * 48, I_O = 16 * 32, I_GLU = 16 * 64, I_UP = 16 * 176, I_DN = 44 * 32;
    constexpr int NITEMS = I_QKV + I_O + I_GLU + 2 * I_UP + 2 * I_DN;
    for (int it = gw; it < NITEMS; it += NGW) {
        int r = it;
        if (r < I_QKV) { transpose_item(args.in[11], DM, QKVD, Wqkv, 0, scr, r, lane); continue; } r -= I_QKV;
        if (r < I_O) { transpose_item(args.in[14], DM, DM, Wo, 0, scr, r, lane); continue; } r -= I_O;
        if (r < I_GLU) { transpose_item(args.in[24], DM, 2 * DM, Wglu, DM, scr, r, lane); continue; } r -= I_GLU;
        if (r < 2 * I_UP) { const int l = r / I_UP; transpose_item(args.in[26] + (size_t)l * DM * FF2, DM, FF2, Wup + (size_t)l * FF2 * DM, FF, scr, r % I_UP, lane); continue; } r -= 2 * I_UP;
        { const int l = r / I_DN; transpose_item(args.in[29] + (size_t)l * FF * DM, FF, DM, Wdn + (size_t)l * DM * FF, 0, scr, r % I_DN, lane); }
    }
    for (int i = blk * 512 + tid; i < SEQ * 8; i += G * 512) { const int pos = i >> 3, f = i & 7; const float inv_freq = powf(500000.0f, -(float)f * 0.125f); const float ang = (float)pos * inv_freq;
        rope[pos * 16 + f] = cosf(ang); rope[pos * 16 + 8 + f] = sinf(ang); }
    for (int i = blk * 512 + tid; i < DB * 128 * 64; i += G * 512) {
        const int b = i / (128 * 64), rem = i % (128 * 64), row = rem >> 6, c4 = (rem & 63) * 4;
        const f32x4 kv = *(const f32x4*)(args.in[2] + ((size_t)(b * 128 + row)) * 256 + c4), vv = *(const f32x4*)(args.in[3] + ((size_t)(b * 128 + row)) * 256 + c4);
        u32x2 kw, vw; kw.x = cvt_pk_bf16(kv[0], kv[1]); kw.y = cvt_pk_bf16(kv[2], kv[3]); vw.x = cvt_pk_bf16(vv[0], vv[1]); vw.y = cvt_pk_bf16(vv[2], vv[3]);
        const size_t krow = (size_t)MP + b * 192 + row;
        *(u32x2*)(Kbuf + krow * 256 + c4) = kw; *(u32x2*)(Vbuf + krow * 256 + c4) = vw;
        if (row >= 64) { *(f32x4*)(out + O_KS + ((size_t)(b * 128 + row - 64)) * 256 + c4) = kv; *(f32x4*)(out + O_VS + ((size_t)(b * 128 + row - 64)) * 256 + c4) = vv; }
    }
    for (int m = gw; m < MT; m += NGW) { const float* xr = (m < MP) ? args.in[0] + (size_t)m * DM : args.in[1] + (size_t)(m - MP) * DM;
        row_pass<false, true, true, true>(xr, nullptr, nullptr, nullptr, 0, nullptr, args.in[7], Abuf + (size_t)m * DM, lane); }
}
template <int MODE>
__device__ __forceinline__ void phase_rows(const float* x_prompt, const float* x_sample, bf16_t* X16, float* out, const bf16_t* Mbuf, const float* ss, int nslots, const float* gpost, const float* gnext, bf16_t* Abuf, int gw, int NGW, int lane, const float* sacc, const float* mbias, int ns) {
    for (int m = gw; m < MT; m += NGW) {
        const bool sp = (sacc != nullptr) && (m >= MP); const float* sr = sp ? sacc + (size_t)(m - MP) * DM : nullptr;
        if constexpr (MODE == 0) { const float* xr = (m < MP) ? x_prompt + (size_t)m * DM : x_sample + (size_t)(m - MP) * DM;
            if (sp) row_pass<true, true, true, false, true>(xr, X16 + (size_t)m * DM, nullptr, nullptr, ns, gpost, gnext, Abuf + (size_t)m * DM, lane, sr, mbias);
            else row_pass<true, true, true, false>(xr, X16 + (size_t)m * DM, Mbuf + (size_t)m * DM, ss + (size_t)m * 32, nslots, gpost, gnext, Abuf + (size_t)m * DM, lane); }
        else if constexpr (MODE == 1) {
            if (sp) row_pass<true, true, false, false, true>(X16 + (size_t)m * DM, X16 + (size_t)m * DM, nullptr, nullptr, ns, gpost, gnext, Abuf + (size_t)m * DM, lane, sr, mbias);
            else row_pass<true, true, false, false>(X16 + (size_t)m * DM, X16 + (size_t)m * DM, Mbuf + (size_t)m * DM, ss + (size_t)m * 32, nslots, gpost, gnext, Abuf + (size_t)m * DM, lane); }
        else {
            if (sp) row_pass<true, false, false, true, true>(X16 + (size_t)m * DM, out + (size_t)m * DM, nullptr, nullptr, ns, gpost, nullptr, nullptr, lane, sr, mbias);
            else row_pass<true, false, false, true>(X16 + (size_t)m * DM, out + (size_t)m * DM, Mbuf + (size_t)m * DM, ss + (size_t)m * 32, nslots, gpost, nullptr, nullptr, lane); }
    }
}
__device__ __forceinline__ void phase_up(LAS unsigned char* lds, const bf16_t* Abuf, const bf16_t* Wup_l, bf16_t* Gbuf, float* Ebuf, const float* cw, const float* cb, int G, int blk) {
    pg8::Gemm g{Abuf, Wup_l, MT, FF2, DM}; pg8::StaticOrder S; S.init(MT, FF2, DM, G, blk);
    pg8::EpiUp E{Gbuf, Ebuf, cw, cb};
    pg8::gemm_phase<pg8::EpiUp, true, true>(lds, g, S, E);
}
__device__ __forceinline__ void phase_down(LAS unsigned char* lds, const bf16_t* Gbuf, const bf16_t* Wdn_l, bf16_t* Mbuf, float* ss, float* sacc, int G, int blk) {
    pg8::Gemm g{Gbuf, Wdn_l, MT, DM, FF}; pg8::StaticOrder S; S.init(MT, DM, FF, G, blk, MP / 256, 11);
    pg8::EpiPlainSS E{Mbuf, nullptr, ss, sacc, FF / 64};
    pg8::gemm_phase<pg8::EpiPlainSS, true, true>(lds, g, S, E);
}
__device__ __forceinline__ void phase_fix(const float* Ebuf, bf16_t* Gbuf, const float* cw, const float* cb, const float* cc, float* out, int l, int G, int blk, int tid) {
    for (int i = blk * 512 + tid; i < NSEG * 2 * (FF / 4); i += G * 512) {
        const int ri = i / (FF / 4), c4 = (i % (FF / 4)) * 4, seg = ri >> 1, j = ri & 1;
        f32x4 o;
        f32x4 cres[2];
#pragma unroll
        for (int hf = 0; hf < 2; ++hf) {
            const int col = hf * FF + c4;
            const f32x4 cur0 = *(const f32x4*)(Ebuf + ((size_t)seg * 4 + 0) * FF2 + col), cur1 = *(const f32x4*)(Ebuf + ((size_t)seg * 4 + 1) * FF2 + col);
            f32x4 p0 = {0.f, 0.f, 0.f, 0.f}, p1 = {0.f, 0.f, 0.f, 0.f};
            if (seg >= MP / 64) { const int b = seg - MP / 64; p0 = *(const f32x4*)(cc + ((size_t)b * 2 + 0) * FF2 + col); p1 = *(const f32x4*)(cc + ((size_t)b * 2 + 1) * FF2 + col); }
            else if ((seg & 31) != 0) { p0 = *(const f32x4*)(Ebuf + ((size_t)(seg - 1) * 4 + 2) * FF2 + col); p1 = *(const f32x4*)(Ebuf + ((size_t)(seg - 1) * 4 + 3) * FF2 + col); }
            const f32x4 w0 = *(const f32x4*)(cw + col), w1 = *(const f32x4*)(cw + FF2 + col), w2 = *(const f32x4*)(cw + 2 * FF2 + col), bb = *(const f32x4*)(cb + col);
            cres[hf] = (j == 0) ? (bb + w0 * p0 + w1 * p1 + w2 * cur0) : (bb + w0 * p1 + w1 * cur0 + w2 * cur1);
        }
#pragma unroll
        for (int q = 0; q < 4; ++q) o[q] = gelu_tanh(cres[0][q]) * cres[1][q];
        u32x2 wv; wv.x = cvt_pk_bf16(o[0], o[1]); wv.y = cvt_pk_bf16(o[2], o[3]);
        *(u32x2*)(Gbuf + ((size_t)seg * 64 + j) * FF + c4) = wv;
    }
    for (int i = blk * 512 + tid; i < (NB + DB) * 2 * (FF2 / 4); i += G * 512) {
        const int ri = i / (FF2 / 4), c4 = (i % (FF2 / 4)) * 4, bb = ri >> 1, e = ri & 1;
        const int seg = (bb < NB) ? bb * 32 + 31 : MP / 64 + (bb - NB);
        const f32x4 v = *(const f32x4*)(Ebuf + ((size_t)seg * 4 + 2 + e) * FF2 + c4);
        float* o = (bb < NB) ? out + O_CP + (((size_t)l * NB + bb) * 2 + e) * FF2 + c4 : out + O_CS + (((size_t)l * DB + (bb - NB)) * 2 + e) * FF2 + c4;
        *(f32x4*)o = v;
    }
}

__global__ void __launch_bounds__(512, 2) fwd_kernel(Args args) {
    extern __shared__ __attribute__((aligned(16))) unsigned char lds_raw[];
    LAS unsigned char* lds = (LAS unsigned char*)lds_raw;
    const int tid = threadIdx.x, lane = tid & 63, wave = __builtin_amdgcn_readfirstlane(tid >> 6);
    const int G = gridDim.x, blk = blockIdx.x;
    const int gw = blk * 8 + wave, NGW = G * 8;
    unsigned char* ws = args.ws; float* out = args.out;
    const float* x_prompt = args.in[0]; const float* x_sample = args.in[1];
    bf16_t* Wqkv = (bf16_t*)(ws + WS_WQKV); bf16_t* Wo = (bf16_t*)(ws + WS_WO); bf16_t* Wglu = (bf16_t*)(ws + WS_WGLU); bf16_t* Wup = (bf16_t*)(ws + WS_WUP); bf16_t* Wdn = (bf16_t*)(ws + WS_WDN);
    float* rope = (float*)(ws + WS_ROPE); float* ss = (float*)(ws + WS_SS);
    bf16_t* Abuf = (bf16_t*)(ws + WS_A); bf16_t* Mbuf = (bf16_t*)(ws + WS_MB); float* Ebuf = (float*)(ws + WS_E); bf16_t* Gbuf = (bf16_t*)(ws + WS_G);
    bf16_t* X16 = (bf16_t*)(ws + WS_X16); float* sacc = (float*)(ws + WS_SACC);
    bf16_t* Qbuf = (bf16_t*)(ws + WS_Q); bf16_t* Kbuf = (bf16_t*)(ws + WS_K); bf16_t* Vbuf = (bf16_t*)(ws + WS_V);


    const int lo = args.ph_lo, hi_ = args.ph_hi;
    volatile LAS unsigned* misc = (volatile LAS unsigned*)(lds + 131072 + 1024);
    if (tid < 2) misc[tid] = 0u;
    __syncthreads();
    XcdBarrier xbar; xbar.bar = (unsigned*)ws; xbar.x = 0; xbar.st = nullptr;
    if (args.coop) xbar = xcd_barrier_post((unsigned*)ws, misc);
    if (args.coop == 2) cg::this_grid().sync();
#define IN(k) (lo <= (k) && (k) < hi_)
#define SEAM(k) do { if (args.coop && (k) + 1 < hi_) xcd_barrier(xbar); } while (0)
#define REP(k) _Pragma("unroll") for (int rep_ = 0; rep_ <= ((PROBE_REPMASK >> (k)) & 1); ++rep_)
    if (IN(0)) { REP(0) { phase_prologue(lds, args, ws, out, G, blk, wave, lane, tid); } SEAM(0); }
    if (IN(1)) { REP(1) {
        pg8::Gemm g{Abuf, Wqkv, MT, QKVD, DM}; pg8::StaticOrder S; S.init(MT, QKVD, DM, G, blk);
        pg8::EpiQKV E{Qbuf, Kbuf, Vbuf, args.in[12], rope, out + O_KP, out + O_VP, out + O_KS, out + O_VS};
        pg8::gemm_phase<pg8::EpiQKV, true, true>(lds, g, S, E); } SEAM(1); }
    if (IN(2)) { REP(2) { attn_phase(lds, Qbuf, Kbuf, Vbuf, Abuf, args.in[13], G, blk); } SEAM(2); }
    if (IN(3)) { REP(3) {
        pg8::Gemm g{Abuf, Wo, MT, DM, DM}; pg8::StaticOrder S; S.init(MT, DM, DM, G, blk, MP / 256, 4);
        pg8::EpiPlainSS E{Mbuf, args.in[15], ss, sacc, DM / 64};
        pg8::gemm_phase<pg8::EpiPlainSS, true, true>(lds, g, S, E); } SEAM(3); }
    if (IN(4)) { REP(4) { phase_rows<0>(x_prompt, x_sample, X16, out, Mbuf, ss, 16, args.in[8], args.in[9], Abuf, gw, NGW, lane, sacc, args.in[15], 4); } SEAM(4); }
    if (IN(5)) { REP(5) { phase_up(lds, Abuf, Wup, Gbuf, Ebuf, args.in[27], args.in[28], G, blk); } SEAM(5); }
    if (IN(6)) { REP(6) { phase_fix(Ebuf, Gbuf, args.in[27], args.in[28], args.in[6], out, 0, G, blk, tid); } SEAM(6); }
    if (IN(7)) { REP(7) { phase_down(lds, Gbuf, Wdn, Mbuf, ss, sacc, G, blk); } SEAM(7); }
    if (IN(8)) { REP(8) { phase_rows<1>(x_prompt, x_sample, X16, out, Mbuf, ss, 16, args.in[10], args.in[7] + DM, Abuf, gw, NGW, lane, sacc, nullptr, 11); } SEAM(8); }
    if (IN(9)) { REP(9) {
        SsmP P{args.in[16], args.in[17], args.in[18], args.in[19], args.in[20], args.in[21], args.in[22], args.in[23], args.in[4], args.in[5], out + O_REP, out + O_IMP, out + O_RES, out + O_IMS};
        ssm_phase(lds, Abuf, Qbuf, P, G, blk); } SEAM(9); }
    if (IN(10)) { REP(10) {
        pg8::Gemm g{Qbuf, Wglu, MT, 2 * DM, DM}; pg8::StaticOrder S; S.init(MT, 2 * DM, DM, G, blk);
        pg8::EpiGlu E{Mbuf, args.in[25], ss};
        pg8::gemm_phase<pg8::EpiGlu, true, true>(lds, g, S, E); } SEAM(10); }
    if (IN(11)) { REP(11) { phase_rows<1>(x_prompt, x_sample, X16, out, Mbuf, ss, 32, args.in[8] + DM, args.in[9] + DM, Abuf, gw, NGW, lane, nullptr, nullptr, 0); } SEAM(11); }
    if (IN(12)) { REP(12) { phase_up(lds, Abuf, Wup + (size_t)FF2 * DM, Gbuf, Ebuf, args.in[27] + (size_t)3 * FF2, args.in[28] + FF2, G, blk); } SEAM(12); }
    if (IN(13)) { REP(13) { phase_fix(Ebuf, Gbuf, args.in[27] + (size_t)3 * FF2, args.in[28] + FF2, args.in[6] + (size_t)DB * 2 * FF2, out, 1, G, blk, tid); } SEAM(13); }
    if (IN(14)) { REP(14) { phase_down(lds, Gbuf, Wdn + (size_t)DM * FF, Mbuf, ss, sacc, G, blk); } SEAM(14); }
    if (IN(15)) { REP(15) { phase_rows<2>(x_prompt, x_sample, X16, out, Mbuf, ss, 16, args.in[10] + DM, nullptr, nullptr, gw, NGW, lane, sacc, nullptr, 11); } }
#undef IN
#undef SEAM
#undef REP
}

extern "C" void kernel_launch(void* const* d_in, const int* in_sizes, int n_in, void* d_out, int out_size, void* d_ws, size_t ws_size, hipStream_t stream) {
    static int grid = 0;
    if (grid == 0) {
        if (n_in != 30 || (size_t)out_size != O_END || ws_size < WS_END) { fprintf(stderr, "kernel_launch: unexpected shapes: n_in %d out %d ws %zu (need out %zu ws %zu)\n", n_in, out_size, ws_size, (size_t)O_END, (size_t)WS_END); grid = -1; return; }
        int dev = 0, cus = 0, per_cu = 0;
        hipGetDevice(&dev); hipDeviceGetAttribute(&cus, hipDeviceAttributeMultiprocessorCount, dev);
        if (hipFuncSetAttribute((const void*)fwd_kernel, hipFuncAttributeMaxDynamicSharedMemorySize, LDS_BYTES) != hipSuccess) { fprintf(stderr, "kernel_launch: hipFuncSetAttribute failed\n"); grid = -1; return; }
        if (hipOccupancyMaxActiveBlocksPerMultiprocessor(&per_cu, (const void*)fwd_kernel, 512, LDS_BYTES) != hipSuccess || per_cu < 1) { fprintf(stderr, "kernel_launch: occupancy query says %d\n", per_cu); per_cu = 1; }
        (void)hipGetLastError();
        grid = cus * 1;
    }
    if (grid < 0) return;
    Args a{};
    for (int i = 0; i < 30; ++i) a.in[i] = (const float*)d_in[i];
    a.out = (float*)d_out; a.ws = (unsigned char*)d_ws;
#ifndef MK_MULTI
    if (hipMemsetAsync(d_ws, 0, 16384, stream) != hipSuccess) { fprintf(stderr, "kernel_launch: memset failed\n"); return; }
    a.ph_lo = 0; a.ph_hi = NPHASE; a.coop = 1;
    void* kargs[] = {&a};
    hipError_t e = hipLaunchCooperativeKernel((const void*)fwd_kernel, dim3(grid), dim3(512), kargs, LDS_BYTES, stream);
    if (e != hipSuccess) fprintf(stderr, "cooperative launch failed: %s (grid %d)\n", hipGetErrorString(e), grid);
#else
    for (int ph = 0; ph < NPHASE; ++ph) { a.ph_lo = ph; a.ph_hi = ph + 1; a.coop = 0; hipLaunchKernelGGL(fwd_kernel, dim3(grid), dim3(512), LDS_BYTES, stream, a); }
#endif
}
```

```cpp
#include <hip/hip_runtime.h>
#include <hip/hip_cooperative_groups.h>
#include <cstdio>
#include <cstdint>
namespace cg = cooperative_groups;

#define LAS __attribute__((address_space(3)))
typedef unsigned short bf16_t;
typedef short bf16x8 __attribute__((ext_vector_type(8)));
typedef short s16x4 __attribute__((ext_vector_type(4)));
typedef float f32x4 __attribute__((ext_vector_type(4)));
typedef float f32x16 __attribute__((ext_vector_type(16)));
typedef unsigned u32x4 __attribute__((ext_vector_type(4)));
typedef unsigned u32x2 __attribute__((ext_vector_type(2)));

constexpr int DM = 1024, NB = 32, SEQ = 2048, MP = NB * SEQ, DB = 16, DS = 64, MS = DB * DS, MT = MP + MS;
constexpr int QKVD = 1536, FF = 2816, FF2 = 5632, NSEG = MT / 64;
constexpr int KVROWS = MP + DB * 192;
constexpr float EPS = 1e-6f, LOG2E = 1.4426950408889634f, QSCALE = 0.125f * 1.4426950408889634f;
constexpr size_t O_Y = 0, O_KP = (size_t)MT * DM, O_VP = O_KP + (size_t)NB * 128 * 256, O_KS = O_VP + (size_t)NB * 128 * 256, O_VS = O_KS + (size_t)DB * 128 * 256,
                 O_REP = O_VS + (size_t)DB * 128 * 256, O_IMP = O_REP + NB * 4096, O_RES = O_IMP + NB * 4096, O_IMS = O_RES + DB * 4096,
                 O_CP = O_IMS + DB * 4096, O_CS = O_CP + (size_t)2 * NB * 2 * FF2, O_END = O_CS + (size_t)2 * DB * 2 * FF2;
constexpr size_t MiB = 1u << 20;
constexpr size_t WS_WQKV = 1 * MiB, WS_WO = 4 * MiB, WS_WGLU = 6 * MiB, WS_WUP = 10 * MiB, WS_WDN = 32 * MiB, WS_ROPE = 43 * MiB, WS_SS = 44 * MiB,
                 WS_A = 54 * MiB, WS_MB = 185 * MiB, WS_E = 316 * MiB, WS_G = 406 * MiB, WS_Q = WS_G, WS_K = WS_G + 132 * MiB, WS_V = WS_K + 34 * MiB, WS_X16 = WS_G + 358 * MiB, WS_SACC = WS_X16 + 131 * MiB, WS_END = WS_SACC + 44 * MiB;
static_assert(WS_WUP + (size_t)2 * FF2 * DM * 2 <= WS_WDN && WS_WDN + (size_t)2 * DM * FF * 2 <= WS_ROPE && WS_SS + (size_t)MT * 32 * 4 <= WS_A, "ws map 1");
static_assert(WS_A + (size_t)MT * DM * 2 <= WS_MB && WS_MB + (size_t)MT * DM * 2 <= WS_E && WS_E + (size_t)NSEG * 4 * FF2 * 4 <= WS_G, "ws map 2");
static_assert(WS_X16 + (size_t)MT * DM * 2 <= WS_END, "ws map 4");
static_assert(WS_Q + (size_t)MT * DM * 2 <= WS_K && WS_K + (size_t)KVROWS * 256 * 2 <= WS_V && WS_V + (size_t)KVROWS * 256 * 2 <= WS_END && WS_G + (size_t)MT * FF * 2 <= WS_END, "ws map 3");

__device__ __forceinline__ unsigned cvt_pk_bf16(float lo, float hi) { unsigned r; asm volatile("v_cvt_pk_bf16_f32 %0, %1, %2" : "=v"(r) : "v"(lo), "v"(hi)); return r; }
__device__ __forceinline__ float bf2f(unsigned short b) { return __uint_as_float((unsigned)b << 16); }
__device__ __forceinline__ float gelu_tanh(float x) {
    const float x2 = x * x, u = x * (0.7978845608f + 0.0356774081f * x2);
    const float e = __builtin_amdgcn_exp2f(-2.885390082f * u);
    return x * __builtin_amdgcn_rcpf(1.0f + e);
}
__device__ __forceinline__ float sigmoid_f(float v) { return __builtin_amdgcn_rcpf(1.0f + __builtin_amdgcn_exp2f(-LOG2E * v)); }
__device__ __forceinline__ float wave_sum(float v) {
#pragma unroll
    for (int o = 1; o < 64; o <<= 1) v += __shfl_xor(v, o);
    return v;
}
template <int CTRL> __device__ __forceinline__ float dpp_f(float x) { return __builtin_bit_cast(float, __builtin_amdgcn_update_dpp(0, __builtin_bit_cast(int, x), CTRL, 0xf, 0xf, false)); }

namespace pg8 {
constexpr int BM = 256, BK = 64, HALF = 128, HTB = HALF * BK * 2, STAGE_BYTES = 8 * HTB, NXCD = 8, WGM = 8;
__host__ __device__ __forceinline__ int lds_byte(int r, int c) { const int st = (r >> 4) * 2 + (c >> 5), rr = r & 15, cc = c & 31, ob = rr * 64 + cc * 2; return st * 1024 + (ob ^ (((ob >> 9) & 1) << 5)); }
__host__ __device__ __forceinline__ void stage_rc(int b, int& R, int& C) { const int st = b / 1024, sb = b % 1024, swz = sb ^ (((sb >> 9) & 1) << 5); R = (st >> 1) * 16 + swz / 64; C = (st & 1) * 32 + (swz % 64) / 2; }
__host__ __device__ __forceinline__ int perm32(int rho) { const int n = rho >> 4, i = rho & 15; return 8 * (i >> 2) + 4 * n + (i & 3); }
struct Unit { int pm, pn, kt0, nkt; };
struct Gemm { const bf16_t* A; const bf16_t* Bt; int M, N, K; };
struct StaticOrder {
    int nM, nN, nwg, G, c, nMf, ns, ktiles, nfull;
    __device__ void init(int M, int N, int K, int G_, int c_, int nMf_ = -1, int ns_ = 1) { nM = M / BM; nN = N / BM; G = G_; c = c_; ktiles = K / BK; nMf = nMf_ < 0 ? nM : nMf_; ns = ns_; nfull = nMf * nN; nwg = nfull + (nM - nMf) * nN * ns; }
    __device__ __forceinline__ bool next(int i, Unit& u) const {
        const long L = (long)i * G + c; if (L >= nwg) return false;
        int pm, pn, kt0 = 0, nkt = ktiles;
        if (L >= nfull) { const int s = (int)L - nfull, tile = s / ns, sl = s - tile * ns; pm = nMf + tile / nN; pn = tile % nN; nkt = ktiles / ns; kt0 = sl * nkt; }
        else {
            int wgid = (int)L; { const int q = nfull / NXCD, r = nfull % NXCD, xcd = wgid % NXCD, off = wgid / NXCD; wgid = (xcd < r ? xcd * (q + 1) : r * (q + 1) + (xcd - r) * q) + off; }
            const int nig = WGM * nN, gid = wgid / nig, fm = gid * WGM, gsz = (nMf - fm) < WGM ? (nMf - fm) : WGM;
            pm = fm + ((wgid % nig) % gsz); pn = (wgid % nig) / gsz;
        }
        u = Unit{pm, pn, kt0, nkt}; return true;
    }
};
template <class Epi, bool ALIGN_EPI, bool SP2>
__device__ __forceinline__ void gemm_phase(LAS unsigned char* lds, const Gemm g, const StaticOrder& S, const Epi& E) {
    const int tid = threadIdx.x, wid = __builtin_amdgcn_readfirstlane(tid >> 6), lane = tid & 63, wr = wid >> 2, wc = wid & 3, fr = lane & 15, fq = lane >> 4;
    const int K = g.K;
    unsigned voffA[2], voffB[2];
#pragma unroll
    for (int i = 0; i < 2; ++i) { int R, C; stage_rc(tid * 16 + i * 8192, R, C); const int Rb = Epi::PERM ? ((R & ~31) + perm32(R & 31)) : R;
        voffA[i] = (unsigned)(R * K + C) * 2u; voffB[i] = (unsigned)(Rb * K + C) * 2u; }
    const size_t kstep = (size_t)(BK * 2);
    const size_t hstep = (size_t)HALF * K * 2;
    const size_t tstep = 2 * hstep;
    const unsigned ldsw = (unsigned)wid * 1024u;
    const int aoff = lds_byte(wr * 64 + fr, fq * 8), boff = lds_byte(wc * 32 + fr, fq * 8);
#define PG8_SA(b, h) (((b) * 2 + (h)) * HTB)
#define PG8_SB(b, h) ((4 + (b) * 2 + (h)) * HTB)
#define PG8_STAGE(bufoff, gbase, voff) do { _Pragma("unroll") for (int _i = 0; _i < 2; ++_i) \
        __builtin_amdgcn_global_load_lds((const unsigned*)((const char*)(gbase) + (voff)[_i]), (LAS unsigned*)(lds + (bufoff) + ldsw + _i * 8192), 16, 0, 0); } while (0)
#define PG8_LDA(dst, b, h) do { _Pragma("unroll") for (int m = 0; m < 4; ++m) _Pragma("unroll") for (int k = 0; k < 2; ++k) dst[m][k] = *(const LAS bf16x8*)(lds + PG8_SA(b, h) + aoff + m * 2048 + k * 1024); } while (0)
#define PG8_LDB(dst, b, h) do { _Pragma("unroll") for (int n = 0; n < 2; ++n) _Pragma("unroll") for (int k = 0; k < 2; ++k) dst[n][k] = *(const LAS bf16x8*)(lds + PG8_SB(b, h) + boff + n * 2048 + k * 1024); } while (0)
#define PG8_MMA(ai, bj, At, Bt) do { __builtin_amdgcn_s_setprio(1); _Pragma("unroll") for (int m = 0; m < 4; ++m) _Pragma("unroll") for (int n = 0; n < 2; ++n) _Pragma("unroll") for (int k = 0; k < 2; ++k) \
        acc[ai][bj][m][n] = __builtin_amdgcn_mfma_f32_16x16x32_bf16(Bt[n][k], At[m][k], acc[ai][bj][m][n], 0, 0, 0); __builtin_amdgcn_s_setprio(0); } while (0)
#define PG8_WAIT_V(n) asm volatile("s_waitcnt vmcnt(" #n ")" ::: "memory")
#define PG8_WAIT_L(n) asm volatile("s_waitcnt lgkmcnt(" #n ")" ::: "memory")
#define PG8_BAR __builtin_amdgcn_s_barrier()
#define PG8_SCHED __builtin_amdgcn_sched_barrier(0)
    Unit cur, nxt; int ui = 0;
    if (!S.next(0, cur)) return;
    f32x4 acc[2][2][4][2];
#pragma unroll
    for (int a = 0; a < 2; ++a)
#pragma unroll
        for (int b = 0; b < 2; ++b)
#pragma unroll
            for (int m = 0; m < 4; ++m)
#pragma unroll
                for (int n = 0; n < 2; ++n) acc[a][b][m][n] = (f32x4){0.f, 0.f, 0.f, 0.f};
    bf16x8 At[4][2], B0[2][2], B1[2][2];
    const char* cA = (const char*)g.A + (size_t)cur.pm * tstep + (size_t)cur.kt0 * kstep; const char* cB = (const char*)g.Bt + (size_t)cur.pn * tstep + (size_t)cur.kt0 * kstep;
    if constexpr (SP2) {
        PG8_STAGE(PG8_SB(0, 0), cB, voffB); PG8_STAGE(PG8_SB(0, 1), cB + hstep, voffB); PG8_STAGE(PG8_SA(0, 0), cA, voffA); PG8_STAGE(PG8_SA(0, 1), cA + hstep, voffA);
        if (wr == 1) PG8_BAR;
        PG8_WAIT_V(2); PG8_BAR;
        PG8_STAGE(PG8_SB(1, 0), cB + kstep, voffB); PG8_STAGE(PG8_SA(1, 0), cA + kstep, voffA); PG8_STAGE(PG8_SB(1, 1), cB + hstep + kstep, voffB);
        PG8_WAIT_V(6); PG8_BAR;
    } else {
        PG8_STAGE(PG8_SB(0, 0), cB, voffB); PG8_STAGE(PG8_SA(0, 0), cA, voffA); PG8_STAGE(PG8_SB(0, 1), cB + hstep, voffB); PG8_STAGE(PG8_SA(0, 1), cA + hstep, voffA);
        if (wr == 1) PG8_BAR;
        PG8_WAIT_V(4); PG8_BAR;
        PG8_STAGE(PG8_SB(1, 0), cB + kstep, voffB); PG8_STAGE(PG8_SA(1, 0), cA + kstep, voffA); PG8_STAGE(PG8_SB(1, 1), cB + hstep + kstep, voffB);
        PG8_WAIT_V(6); PG8_BAR;
    }
    for (;;) {
        const bool has_next = S.next(ui + 1, nxt);
        const char* nA = has_next ? (const char*)g.A + (size_t)nxt.pm * tstep + (size_t)nxt.kt0 * kstep : cA; const char* nB = has_next ? (const char*)g.Bt + (size_t)nxt.pn * tstep + (size_t)nxt.kt0 * kstep : cB;
        const int nt = cur.nkt;
        for (int t = 0; t < nt; t += 2) {
            const bool last = (t == nt - 2);
            const char* a1 = cA + (size_t)(t + 1) * kstep;
            const char* a2 = last ? nA : cA + (size_t)(t + 2) * kstep; const char* b2 = last ? nB : cB + (size_t)(t + 2) * kstep;
            const char* a3 = a2 + kstep; const char* b3 = b2 + kstep;
            if constexpr (SP2) {
            PG8_LDB(B0, 0, 0); PG8_LDB(B1, 0, 1); PG8_SCHED; PG8_LDA(At, 0, 0); PG8_STAGE(PG8_SA(1, 1), a1 + hstep, voffA);
            PG8_WAIT_V(8); PG8_WAIT_L(0); PG8_BAR; PG8_MMA(0, 0, At, B0); PG8_MMA(0, 1, At, B1); PG8_BAR; PG8_SCHED;
            PG8_LDA(At, 0, 1); PG8_STAGE(PG8_SB(0, 0), b2, voffB); PG8_STAGE(PG8_SB(0, 1), b2 + hstep, voffB); PG8_STAGE(PG8_SA(0, 0), a2, voffA);
            PG8_WAIT_V(8); PG8_WAIT_L(0); PG8_BAR; PG8_MMA(1, 0, At, B0); PG8_MMA(1, 1, At, B1); PG8_BAR; PG8_SCHED;
            PG8_LDB(B0, 1, 0); PG8_LDB(B1, 1, 1); PG8_SCHED; PG8_LDA(At, 1, 0); PG8_STAGE(PG8_SA(0, 1), a2 + hstep, voffA);
            PG8_WAIT_V(8); PG8_WAIT_L(0); PG8_BAR; PG8_MMA(0, 0, At, B0); PG8_MMA(0, 1, At, B1); PG8_BAR; PG8_SCHED;
            PG8_LDA(At, 1, 1); PG8_STAGE(PG8_SB(1, 0), b3, voffB); PG8_STAGE(PG8_SB(1, 1), b3 + hstep, voffB); PG8_STAGE(PG8_SA(1, 0), a3, voffA);
            PG8_WAIT_V(8); PG8_WAIT_L(0); PG8_BAR; PG8_MMA(1, 0, At, B0); PG8_MMA(1, 1, At, B1); PG8_BAR; PG8_SCHED;
            } else {
            PG8_LDB(B0, 0, 0); PG8_SCHED; PG8_LDA(At, 0, 0); PG8_STAGE(PG8_SA(1, 1), a1 + hstep, voffA);
            PG8_WAIT_L(8); PG8_BAR; PG8_WAIT_L(0); PG8_MMA(0, 0, At, B0); PG8_BAR; PG8_SCHED;
            PG8_LDB(B1, 0, 1); PG8_STAGE(PG8_SB(0, 0), b2, voffB);
            PG8_BAR; PG8_WAIT_L(0); PG8_MMA(0, 1, At, B1); PG8_BAR;
            PG8_LDA(At, 0, 1); PG8_STAGE(PG8_SA(0, 0), a2, voffA);
            PG8_BAR; PG8_WAIT_L(0); PG8_MMA(1, 0, At, B0); PG8_BAR; PG8_SCHED;
            PG8_STAGE(PG8_SB(0, 1), b2 + hstep, voffB);
            PG8_WAIT_V(6); PG8_BAR; PG8_MMA(1, 1, At, B1); PG8_BAR;
            PG8_LDB(B0, 1, 0); PG8_SCHED; PG8_LDA(At, 1, 0); PG8_STAGE(PG8_SA(0, 1), a2 + hstep, voffA);
            PG8_WAIT_L(8); PG8_BAR; PG8_WAIT_L(0); PG8_MMA(0, 0, At, B0); PG8_BAR; PG8_SCHED;
            PG8_LDB(B1, 1, 1); PG8_STAGE(PG8_SB(1, 0), b3, voffB);
            PG8_BAR; PG8_WAIT_L(0); PG8_MMA(0, 1, At, B1); PG8_BAR;
            PG8_LDA(At, 1, 1); PG8_STAGE(PG8_SA(1, 0), a3, voffA);
            PG8_BAR; PG8_WAIT_L(0); PG8_MMA(1, 0, At, B0); PG8_BAR; PG8_SCHED;
            PG8_STAGE(PG8_SB(1, 1), b3 + hstep, voffB);
            PG8_WAIT_V(6); PG8_BAR; PG8_MMA(1, 1, At, B1); PG8_BAR;
            }
        }
        if constexpr (ALIGN_EPI) { if (wr == 0) PG8_BAR; }
        E(acc, cur, wr, wc, fr, fq);
        if (!has_next) break;
#pragma unroll
        for (int a = 0; a < 2; ++a)
#pragma unroll
            for (int b = 0; b < 2; ++b)
#pragma unroll
                for (int m = 0; m < 4; ++m)
#pragma unroll
                    for (int n = 0; n < 2; ++n) acc[a][b][m][n] = (f32x4){0.f, 0.f, 0.f, 0.f};
        cur = nxt; cA = nA; cB = nB; ++ui;
        if constexpr (ALIGN_EPI) { if (wr == 1) PG8_BAR; }
    }
    PG8_WAIT_V(0);
    if constexpr (!ALIGN_EPI) { if (wr == 0) PG8_BAR; }
    PG8_BAR;
#undef PG8_SA
#undef PG8_SB
#undef PG8_STAGE
#undef PG8_LDA
#undef PG8_LDB
#undef PG8_MMA
#undef PG8_WAIT_V
#undef PG8_WAIT_L
#undef PG8_BAR
#undef PG8_SCHED
}

struct EpiQKV {
    static constexpr bool PERM = true;
    bf16_t* Q; bf16_t* Kb; bf16_t* Vb; const float* bias; const float* rope; float* kp; float* vp; float* ks; float* vs;
    __device__ __forceinline__ void operator()(const f32x4 (&acc)[2][2][4][2], const Unit& u, int wr, int wc, int fr, int fq) const {
        const int kind = u.pn < 4 ? 0 : u.pn - 3;
        const int lc0 = wc * 32 + 8 * fq;
        f32x4 bv[2][2];
#pragma unroll
        for (int bj = 0; bj < 2; ++bj)
#pragma unroll
            for (int n = 0; n < 2; ++n) bv[bj][n] = *(const f32x4*)(bias + u.pn * 256 + bj * 128 + lc0 + 4 * n);
        const bool dorope = (kind < 2) && ((wc & 1) == 0);
        const float sgn = (fq == 0) ? -1.f : 1.f;
#pragma unroll
        for (int ai = 0; ai < 2; ++ai)
#pragma unroll
            for (int m = 0; m < 4; ++m) {
                const int r = u.pm * 256 + ai * 128 + wr * 64 + m * 16 + fr;
                const bool prompt = r < MP;
                const int t = prompt ? (r & 2047) : ((r - MP) & 63), b = prompt ? (r >> 11) : ((r - MP) >> 6);
                const int pos = prompt ? t : 1024 + t;
                f32x4 cs[2], sn[2];
                if (dorope) { cs[0] = *(const f32x4*)(rope + pos * 16); cs[1] = *(const f32x4*)(rope + pos * 16 + 4); sn[0] = *(const f32x4*)(rope + pos * 16 + 8); sn[1] = *(const f32x4*)(rope + pos * 16 + 12); }
#pragma unroll
                for (int bj = 0; bj < 2; ++bj) {
                    f32x4 v[2];
#pragma unroll
                    for (int n = 0; n < 2; ++n) {
                        v[n] = acc[ai][bj][m][n] + bv[bj][n];
                        if (dorope) {
#pragma unroll
                            for (int j = 0; j < 4; ++j) { const float p = __shfl_xor(v[n][j], 16); const float rv = v[n][j] * cs[n][j] + sgn * p * sn[n][j]; v[n][j] = (fq < 2) ? rv : v[n][j]; }
                        }
                    }
                    if (kind == 0) {
                        u32x4 w; w.x = cvt_pk_bf16(v[0][0] * QSCALE, v[0][1] * QSCALE); w.y = cvt_pk_bf16(v[0][2] * QSCALE, v[0][3] * QSCALE); w.z = cvt_pk_bf16(v[1][0] * QSCALE, v[1][1] * QSCALE); w.w = cvt_pk_bf16(v[1][2] * QSCALE, v[1][3] * QSCALE);
                        *(u32x4*)(Q + (size_t)r * DM + u.pn * 256 + bj * 128 + lc0) = w;
                    } else {
                        const int col = bj * 128 + lc0;
                        const size_t krow = prompt ? (size_t)r : (size_t)MP + b * 192 + 128 + t;
                        u32x4 w; w.x = cvt_pk_bf16(v[0][0], v[0][1]); w.y = cvt_pk_bf16(v[0][2], v[0][3]); w.z = cvt_pk_bf16(v[1][0], v[1][1]); w.w = cvt_pk_bf16(v[1][2], v[1][3]);
                        *(u32x4*)((kind == 1 ? Kb : Vb) + krow * 256 + col) = w;
                        float* o = nullptr;
                        if (prompt) { if (t >= SEQ - 128) o = (kind == 1 ? kp : vp) + ((size_t)(b * 128 + t - (SEQ - 128)) * 256 + col); }
                        else o = (kind == 1 ? ks : vs) + ((size_t)(b * 128 + 64 + t) * 256 + col);
                        if (o) { *(f32x4*)o = v[0]; *(f32x4*)(o + 4) = v[1]; }
                    }
                }
            }
    }
};
struct EpiPlainSS {
    static constexpr bool PERM = true;
    bf16_t* O; const float* bias; float* ss; float* sacc; int ktiles;
    __device__ __forceinline__ void operator()(const f32x4 (&acc)[2][2][4][2], const Unit& u, int wr, int wc, int fr, int fq) const {
        const int col0 = u.pn * 256 + wc * 32 + 8 * fq;
        if (u.nkt != ktiles) {
            const int slice = u.kt0 / u.nkt;
#pragma unroll
            for (int ai = 0; ai < 2; ++ai)
#pragma unroll
                for (int m = 0; m < 4; ++m) {
                    const int r = u.pm * 256 + ai * 128 + wr * 64 + m * 16 + fr - MP; float* sp = sacc + ((size_t)slice * MS + r) * DM + col0;
#pragma unroll
                    for (int bj = 0; bj < 2; ++bj) { *(f32x4*)(sp + bj * 128) = acc[ai][bj][m][0]; *(f32x4*)(sp + bj * 128 + 4) = acc[ai][bj][m][1]; }
                }
            return;
        }
        f32x4 bv[2][2];
#pragma unroll
        for (int bj = 0; bj < 2; ++bj)
#pragma unroll
            for (int n = 0; n < 2; ++n) bv[bj][n] = bias ? *(const f32x4*)(bias + col0 + bj * 128 + 4 * n) : (f32x4){0.f, 0.f, 0.f, 0.f};
#pragma unroll
        for (int ai = 0; ai < 2; ++ai)
#pragma unroll
            for (int m = 0; m < 4; ++m) {
                const int r = u.pm * 256 + ai * 128 + wr * 64 + m * 16 + fr; float s = 0.f;
#pragma unroll
                for (int bj = 0; bj < 2; ++bj) {
                    const f32x4 v0 = acc[ai][bj][m][0] + bv[bj][0], v1 = acc[ai][bj][m][1] + bv[bj][1];
                    s += (v0[0] * v0[0] + v0[1] * v0[1]) + (v0[2] * v0[2] + v0[3] * v0[3]) + (v1[0] * v1[0] + v1[1] * v1[1]) + (v1[2] * v1[2] + v1[3] * v1[3]);
                    u32x4 w; w.x = cvt_pk_bf16(v0[0], v0[1]); w.y = cvt_pk_bf16(v0[2], v0[3]); w.z = cvt_pk_bf16(v1[0], v1[1]); w.w = cvt_pk_bf16(v1[2], v1[3]);
                    *(u32x4*)(O + (size_t)r * DM + col0 + bj * 128) = w;
                }
                s += __shfl_xor(s, 16); s += __shfl_xor(s, 32);
                if (fq == 0) ss[(size_t)r * 32 + u.pn * 4 + wc] = s;
            }
    }
};
struct EpiGlu {
    static constexpr bool PERM = true;
    bf16_t* O; const float* bias; float* ss;
    __device__ __forceinline__ void operator()(const f32x4 (&acc)[2][2][4][2], const Unit& u, int wr, int wc, int fr, int fq) const {
        const int oc0 = u.pn * 128 + wc * 32 + 8 * fq;
        f32x4 ba[2], bg[2];
#pragma unroll
        for (int n = 0; n < 2; ++n) { ba[n] = *(const f32x4*)(bias + oc0 + 4 * n); bg[n] = *(const f32x4*)(bias + DM + oc0 + 4 * n); }
#pragma unroll
        for (int ai = 0; ai < 2; ++ai)
#pragma unroll
            for (int m = 0; m < 4; ++m) {
                const int r = u.pm * 256 + ai * 128 + wr * 64 + m * 16 + fr; float s = 0.f; f32x4 o[2];
#pragma unroll
                for (int n = 0; n < 2; ++n) { const f32x4 a = acc[ai][0][m][n] + ba[n], g = acc[ai][1][m][n] + bg[n];
#pragma unroll
                    for (int j = 0; j < 4; ++j) { o[n][j] = a[j] * sigmoid_f(g[j]); s += o[n][j] * o[n][j]; } }
                u32x4 w; w.x = cvt_pk_bf16(o[0][0], o[0][1]); w.y = cvt_pk_bf16(o[0][2], o[0][3]); w.z = cvt_pk_bf16(o[1][0], o[1][1]); w.w = cvt_pk_bf16(o[1][2], o[1][3]);
                *(u32x4*)(O + (size_t)r * DM + oc0) = w;
                s += __shfl_xor(s, 16); s += __shfl_xor(s, 32);
                if (fq == 0) ss[(size_t)r * 32 + u.pn * 4 + wc] = s;
            }
    }
};
struct EpiUp {
    static constexpr bool PERM = true;
    bf16_t* G; float* E; const float* cw; const float* cb;
    __device__ __forceinline__ void operator()(f32x4 (&acc)[2][2][4][2], const Unit& u, int wr, int wc, int fr, int fq) const {
        const int oc0 = u.pn * 128 + wc * 32 + 8 * fq;
        {
            const int e = (fr < 2) ? fr : fr - 12; const int msel = (fr < 2) ? 0 : 3;
            if (fr < 2 || fr >= 14) {
#pragma unroll
                for (int ai = 0; ai < 2; ++ai) {
                    const int seg = u.pm * 4 + ai * 2 + wr; float* eb = E + ((size_t)seg * 4 + e) * FF2 + oc0;
#pragma unroll
                    for (int bj = 0; bj < 2; ++bj)
#pragma unroll
                        for (int n = 0; n < 2; ++n) { const f32x4 v = (msel == 0) ? acc[ai][bj][0][n] : acc[ai][bj][3][n]; *(f32x4*)(eb + bj * FF + 4 * n) = v; }
                }
            }
        }
#pragma unroll
        for (int n = 0; n < 2; ++n) {
#pragma unroll
            for (int bj = 0; bj < 2; ++bj) {
                const float* cwp = cw + bj * FF + oc0 + 4 * n;
                const f32x4 w0 = *(const f32x4*)(cwp), w1 = *(const f32x4*)(cwp + FF2), w2 = *(const f32x4*)(cwp + 2 * FF2), bb = *(const f32x4*)(cb + bj * FF + oc0 + 4 * n);
#pragma unroll
                for (int ai = 0; ai < 2; ++ai)
#pragma unroll
                    for (int m = 3; m >= 0; --m) {
                        const f32x4 v = acc[ai][bj][m][n]; const f32x4 vp = (m > 0) ? acc[ai][bj][m - 1][n] : v;
                        f32x4 c;
#pragma unroll
                        for (int j = 0; j < 4; ++j) {
                            const float p1 = dpp_f<0x121>(fr == 15 ? vp[j] : v[j]);
                            const float p2 = dpp_f<0x122>(fr >= 14 ? vp[j] : v[j]);
                            c[j] = bb[j] + w0[j] * p2 + w1[j] * p1 + w2[j] * v[j];
                        }
                        asm volatile("" : "+v"(c));
                        acc[ai][bj][m][n] = c;
                    }
                asm volatile("" ::: "memory");
            }
        }
#pragma unroll
        for (int ai = 0; ai < 2; ++ai)
#pragma unroll
            for (int m = 0; m < 4; ++m) {
                const int r = u.pm * 256 + ai * 128 + wr * 64 + m * 16 + fr;
                f32x4 o[2];
#pragma unroll
                for (int n = 0; n < 2; ++n)
#pragma unroll
                    for (int j = 0; j < 4; ++j) o[n][j] = gelu_tanh(acc[ai][0][m][n][j]) * acc[ai][1][m][n][j];
                u32x4 w; w.x = cvt_pk_bf16(o[0][0], o[0][1]); w.y = cvt_pk_bf16(o[0][2], o[0][3]); w.z = cvt_pk_bf16(o[1][0], o[1][1]); w.w = cvt_pk_bf16(o[1][2], o[1][3]);
                if (!(m == 0 && fr < 2)) *(u32x4*)(G + (size_t)r * FF + oc0) = w;
            }
    }
};
}

#ifndef PROBE_REPMASK
#define PROBE_REPMASK 0
#endif
struct Args { const float* in[30]; float* out; unsigned char* ws; int ph_lo, ph_hi, coop, repmask; };
constexpr int NPHASE = 16;
constexpr int LDS_BYTES = 147456;

__device__ __forceinline__ unsigned f2bf(float f) { unsigned u = __builtin_bit_cast(unsigned, f); return (u + 0x7fffu + ((u >> 16) & 1u)) >> 16; }
__device__ __forceinline__ unsigned pk2(float lo, float hi) { return f2bf(lo) | (f2bf(hi) << 16); }
__device__ __forceinline__ void transpose_item(const float* W, int K, int N, bf16_t* WT, int pair_half, LAS float* scr, int item, int lane) {
    const int nblk = N / 32, kb = item / nblk, nb = item % nblk, k0 = 64 * kb, n0 = 32 * nb;
#pragma unroll 8
    for (int i = 0; i < 32; ++i) { const int kk = 2 * i + (lane >> 5); scr[kk * 33 + (lane & 31)] = W[(size_t)(k0 + kk) * N + n0 + (lane & 31)]; }
    asm volatile("s_waitcnt lgkmcnt(0)" ::: "memory");
    int r0 = n0;
    if (pair_half > 0) { const int half = n0 / pair_half, c = n0 % pair_half; r0 = 256 * (c / 128) + 128 * half + (c % 128); }
    const int c = lane & 7;
#pragma unroll
    for (int j = 0; j < 4; ++j) { const int n = (lane >> 3) + 8 * j; const LAS float* s = scr + (8 * c) * 33 + n;
        u32x4 o; o.x = pk2(s[0 * 33], s[1 * 33]); o.y = pk2(s[2 * 33], s[3 * 33]); o.z = pk2(s[4 * 33], s[5 * 33]); o.w = pk2(s[6 * 33], s[7 * 33]);
        *(u32x4*)(WT + (size_t)(r0 + n) * K + k0 + 8 * c) = o; }
    asm volatile("s_waitcnt lgkmcnt(0)" ::: "memory");
}

template <bool HAS_M, bool HAS_NEXT, bool XIN_F32, bool XOUT_F32, bool M_F32 = false>
__device__ __forceinline__ void row_pass(const void* xin, void* xout, const bf16_t* mrow, const float* ssrow, int nslots, const float* gpost, const float* gnext, bf16_t* arow, int lane, const float* saccrow = nullptr, const float* mbias = nullptr) {
    f32x4 v[4];
#pragma unroll
    for (int j = 0; j < 4; ++j) {
        if constexpr (XIN_F32) v[j] = *((const f32x4*)xin + lane + 64 * j);
        else { const u32x2 xw = *((const u32x2*)xin + lane + 64 * j); v[j][0] = __uint_as_float(xw.x << 16); v[j][1] = __uint_as_float(xw.x & 0xffff0000u); v[j][2] = __uint_as_float(xw.y << 16); v[j][3] = __uint_as_float(xw.y & 0xffff0000u); }
    }
    if constexpr (HAS_M) {
        f32x4 mv[4]; float s;
        if constexpr (M_F32) {
            s = 0.f;
#pragma unroll
            for (int j = 0; j < 4; ++j) { mv[j] = mbias ? *((const f32x4*)mbias + lane + 64 * j) : (f32x4){0.f, 0.f, 0.f, 0.f};
                for (int sl = 0; sl < nslots; ++sl) mv[j] += *((const f32x4*)(saccrow + (size_t)sl * MS * DM) + lane + 64 * j);
                s += (mv[j][0] * mv[j][0] + mv[j][1] * mv[j][1]) + (mv[j][2] * mv[j][2] + mv[j][3] * mv[j][3]); }
        } else {
            s = (lane < nslots) ? ssrow[lane] : 0.f;
#pragma unroll
            for (int j = 0; j < 4; ++j) { const u32x2 mw = *((const u32x2*)mrow + lane + 64 * j);
                mv[j][0] = __uint_as_float(mw.x << 16); mv[j][1] = __uint_as_float(mw.x & 0xffff0000u); mv[j][2] = __uint_as_float(mw.y << 16); mv[j][3] = __uint_as_float(mw.y & 0xffff0000u); }
        }
        s = wave_sum(s);
        const float rstd = 1.0f / sqrtf(s * (1.0f / DM) + EPS);
#pragma unroll
        for (int j = 0; j < 4; ++j) {
            const f32x4 gp = *((const f32x4*)gpost + lane + 64 * j);
            v[j] += mv[j] * rstd * gp;
            if constexpr (XOUT_F32) *((f32x4*)xout + lane + 64 * j) = v[j];
            else { u32x2 w; w.x = cvt_pk_bf16(v[j][0], v[j][1]); w.y = cvt_pk_bf16(v[j][2], v[j][3]); *((u32x2*)xout + lane + 64 * j) = w; }
        }
    }
    if constexpr (HAS_NEXT) {
        float s2 = 0.f;
#pragma unroll
        for (int j = 0; j < 4; ++j) s2 += (v[j][0] * v[j][0] + v[j][1] * v[j][1]) + (v[j][2] * v[j][2] + v[j][3] * v[j][3]);
        s2 = wave_sum(s2);
        const float rstd2 = 1.0f / sqrtf(s2 * (1.0f / DM) + EPS);
#pragma unroll
        for (int j = 0; j < 4; ++j) { const f32x4 gn = *((const f32x4*)gnext + lane + 64 * j);
            u32x2 w; w.x = cvt_pk_bf16(v[j][0] * rstd2 * gn[0], v[j][1] * rstd2 * gn[1]); w.y = cvt_pk_bf16(v[j][2] * rstd2 * gn[2], v[j][3] * rstd2 * gn[3]);
            *((u32x2*)arow + lane + 64 * j) = w; }
    }
}

__device__ __forceinline__ s16x4 vtr(LAS const unsigned char* p) { return __builtin_bit_cast(s16x4, __builtin_amdgcn_ds_read_tr16_b64_v4i16((LAS s16x4*)p)); }
__device__ __forceinline__ void attn_unit_coords(int u, int& qrow0, int& krow0, int& kb0, int& kvh) {
    if (u < NB * 128) { const int b = u >> 7, rem = u & 127, c = rem >> 2; kvh = rem & 3; qrow0 = b * SEQ + c * 64; krow0 = qrow0 - 128; kb0 = c >= 2 ? 0 : 2 * (2 - c); }
    else { const int u2 = u - NB * 128, b = u2 >> 2; kvh = u2 & 3; qrow0 = MP + b * 64; krow0 = MP + b * 192; kb0 = 0; }
}
__device__ __forceinline__ void attn_phase(LAS unsigned char* lds, const bf16_t* Qb, const bf16_t* Kb, const bf16_t* Vb, bf16_t* Ob, const float* sinks, int G, int blk) {
    const int tid = threadIdx.x, lane = tid & 63, w = __builtin_amdgcn_readfirstlane(tid >> 6), r32 = lane & 31, hi = lane >> 5;
    constexpr int KST = 144, VST = 192, KOFF = 0, VOFF = 192 * KST, OOFF = VOFF + 192 * VST, OST = 136;
    constexpr int NUNITS = NB * 32 * 4 + DB * 4;
    LAS unsigned char* ostage = lds + OOFF + w * (32 * OST);
    u32x4 kreg[3], vreg[3]; bf16x8 qnext[4];
    int qrow0 = 0, krow0 = 0, kb0 = 0, kvh = 0;
#define ATTN_LOAD(UU) do { int q0_, k0_, b0_, h0_; attn_unit_coords((UU), q0_, k0_, b0_, h0_); \
        _Pragma("unroll") for (int i = 0; i < 3; ++i) { const int p_ = tid + 512 * i, row_ = p_ >> 3, ch_ = p_ & 7; \
            if (row_ >= b0_ * 32) { const size_t go_ = (size_t)(k0_ + row_) * 256 + h0_ * 64 + ch_ * 8; kreg[i] = *(const u32x4*)(Kb + go_); vreg[i] = *(const u32x4*)(Vb + go_); } } \
        { const size_t qr_ = (size_t)q0_ + (w & 1) * 32 + r32; const int hq_ = h0_ * 4 + (w >> 1); \
          _Pragma("unroll") for (int dk = 0; dk < 4; ++dk) qnext[dk] = *(const bf16x8*)(Qb + qr_ * DM + hq_ * 64 + dk * 16 + hi * 8); } } while (0)
    if (blk < NUNITS) ATTN_LOAD(blk);
    for (int u = blk; u < NUNITS; u += G) {
        attn_unit_coords(u, qrow0, krow0, kb0, kvh);
        __syncthreads();
#pragma unroll
        for (int i = 0; i < 3; ++i) { const int p = tid + 512 * i, row = p >> 3, ch = p & 7;
            if (row >= kb0 * 32) { *(LAS u32x4*)(lds + KOFF + row * KST + ch * 16) = kreg[i]; *(LAS u32x4*)(lds + VOFF + row * VST + ch * 16) = vreg[i]; } }
        bf16x8 qf[4];
#pragma unroll
        for (int dk = 0; dk < 4; ++dk) qf[dk] = qnext[dk];
        const int hq = kvh * 4 + (w >> 1); const size_t qrowb = (size_t)qrow0 + (w & 1) * 32;
        __syncthreads();
        if (u + G < NUNITS) ATTN_LOAD(u + G);
        f32x16 sc[6];
        float mx = -3.0e38f;
#pragma unroll
        for (int kb = 0; kb < 6; ++kb) {
            if (kb >= kb0) {
                f32x16 a = {};
#pragma unroll
                for (int dk = 0; dk < 4; ++dk) { const bf16x8 kf = *(const LAS bf16x8*)(lds + KOFF + (32 * kb + r32) * KST + (dk * 16 + hi * 8) * 2); a = __builtin_amdgcn_mfma_f32_32x32x16_bf16(kf, qf[dk], a, 0, 0, 0); }
#pragma unroll
                for (int r = 0; r < 16; ++r) mx = fmaxf(mx, a[r]);
                sc[kb] = a;
            }
        }
        mx = fmaxf(mx, __shfl_xor(mx, 32));
        const float sinkl = sinks[hq] * LOG2E; mx = fmaxf(mx, sinkl);
        float ls = 0.f;
#pragma unroll
        for (int kb = 0; kb < 6; ++kb) {
            if (kb >= kb0) {
#pragma unroll
                for (int r = 0; r < 16; ++r) { const float p = __builtin_amdgcn_exp2f(sc[kb][r] - mx); sc[kb][r] = p; ls += p; }
            }
        }
        ls += __shfl_xor(ls, 32);
        const float inv = 1.0f / (ls + __builtin_amdgcn_exp2f(sinkl - mx));
        f32x16 o[2]; o[0] = f32x16{}; o[1] = f32x16{};
        const int vlane = VOFF + (4 * hi + ((lane >> 2) & 3)) * VST + (16 * ((lane >> 4) & 1) + 4 * (lane & 3)) * 2;
#pragma unroll
        for (int kb = 0; kb < 6; ++kb) {
            if (kb >= kb0) {
#pragma unroll
                for (int s = 0; s < 2; ++s) {
                    u32x4 pw; pw.x = cvt_pk_bf16(sc[kb][8 * s + 0], sc[kb][8 * s + 1]); pw.y = cvt_pk_bf16(sc[kb][8 * s + 2], sc[kb][8 * s + 3]); pw.z = cvt_pk_bf16(sc[kb][8 * s + 4], sc[kb][8 * s + 5]); pw.w = cvt_pk_bf16(sc[kb][8 * s + 6], sc[kb][8 * s + 7]);
                    const bf16x8 pf = __builtin_bit_cast(bf16x8, pw);
#pragma unroll
                    for (int db = 0; db < 2; ++db) {
                        LAS const unsigned char* vp = lds + vlane + (32 * kb + 16 * s) * VST + db * 64;
                        const s16x4 lo = vtr(vp), h4 = vtr(vp + 8 * VST);
                        const bf16x8 vf = (bf16x8){lo[0], lo[1], lo[2], lo[3], h4[0], h4[1], h4[2], h4[3]};
                        o[db] = __builtin_amdgcn_mfma_f32_32x32x16_bf16(vf, pf, o[db], 0, 0, 0);
                    }
                }
            }
        }
#pragma unroll
        for (int db = 0; db < 2; ++db)
#pragma unroll
            for (int rq = 0; rq < 4; ++rq) {
                u32x2 wv; wv.x = cvt_pk_bf16(o[db][4 * rq] * inv, o[db][4 * rq + 1] * inv); wv.y = cvt_pk_bf16(o[db][4 * rq + 2] * inv, o[db][4 * rq + 3] * inv);
                *(LAS u32x2*)(ostage + r32 * OST + (32 * db + 8 * rq + 4 * hi) * 2) = wv;
            }
        asm volatile("s_waitcnt lgkmcnt(0)" ::: "memory");
#pragma unroll
        for (int i = 0; i < 4; ++i) { const int row = i * 8 + (lane >> 3), ch = lane & 7;
            const u32x2 a = *(const LAS u32x2*)(ostage + row * OST + ch * 16), b = *(const LAS u32x2*)(ostage + row * OST + ch * 16 + 8);
            u32x4 v; v.x = a.x; v.y = a.y; v.z = b.x; v.w = b.y;
            *(u32x4*)(Ob + (qrowb + row) * DM + hq * 64 + ch * 8) = v; }
        asm volatile("s_waitcnt lgkmcnt(0)" ::: "memory");
    }
#undef ATTN_LOAD
}

struct SsmP { const float *lam_re, *lam_im, *log_dt, *b_re, *b_im, *c_re, *c_im, *dsk, *st_re, *st_im; float *o_rep, *o_imp, *o_res, *o_ims; };
__device__ __forceinline__ void ssm_phase(LAS unsigned char* lds, const bf16_t* A3, bf16_t* Z, const SsmP P, int G, int blk) {
    const int tid = threadIdx.x, lane = tid & 63, w = __builtin_amdgcn_readfirstlane(tid >> 6), p = lane & 31, hi = lane >> 5;
    constexpr int IST = 72;
    LAS unsigned char* img = lds + w * (128 * IST);
    const bool samp = (w >= 4);
    const int nunits = samp ? (DB / 2) * 64 : (NB / 2) * 64, T = samp ? DS : SEQ;
    for (int uu = blk * 4 + (w & 3); uu < nunits; uu += G * 4) {
        const int bp = uu >> 6, g = uu & 63;
        const int rowbase0 = samp ? MP + (2 * bp) * DS : (2 * bp) * SEQ, bstride = T;
        const float dt = expf(P.log_dt[g]);
        float lbr[2], lbi[2], zr[2], zi[2], hr[2], hm[2];
#pragma unroll
        for (int pp = 0; pp < 2; ++pp) {
            const int ps = g * 64 + p + 32 * pp; const float lr = P.lam_re[ps], li = P.lam_im[ps];
            const float mag = expf(lr * dt); lbr[pp] = mag * cosf(li * dt); lbi[pp] = mag * sinf(li * dt);
            const float nr = lbr[pp] - 1.0f, ni = lbi[pp], den = lr * lr + li * li;
            zr[pp] = (nr * lr + ni * li) / den; zi[pp] = (ni * lr - nr * li) / den;
            if (samp) { const int so = ((2 * bp + hi) * 64 + g) * 64 + p + 32 * pp; hr[pp] = P.st_re[so]; hm[pp] = P.st_im[so]; } else { hr[pp] = 0.f; hm[pp] = 0.f; }
        }
        bf16x8 bfrag[4];
#pragma unroll
        for (int pp = 0; pp < 2; ++pp) {
            const float* br = P.b_re + ((size_t)(g * 64 + p + 32 * pp)) * 16 + 8 * hi; const float* bi = P.b_im + ((size_t)(g * 64 + p + 32 * pp)) * 16 + 8 * hi;
            const f32x4 br0 = *(const f32x4*)br, br1 = *(const f32x4*)(br + 4), bi0 = *(const f32x4*)bi, bi1 = *(const f32x4*)(bi + 4);
            u32x4 wre, wim;
            wre.x = cvt_pk_bf16(zr[pp] * br0[0] - zi[pp] * bi0[0], zr[pp] * br0[1] - zi[pp] * bi0[1]); wre.y = cvt_pk_bf16(zr[pp] * br0[2] - zi[pp] * bi0[2], zr[pp] * br0[3] - zi[pp] * bi0[3]);
            wre.z = cvt_pk_bf16(zr[pp] * br1[0] - zi[pp] * bi1[0], zr[pp] * br1[1] - zi[pp] * bi1[1]); wre.w = cvt_pk_bf16(zr[pp] * br1[2] - zi[pp] * bi1[2], zr[pp] * br1[3] - zi[pp] * bi1[3]);
            wim.x = cvt_pk_bf16(zr[pp] * bi0[0] + zi[pp] * br0[0], zr[pp] * bi0[1] + zi[pp] * br0[1]); wim.y = cvt_pk_bf16(zr[pp] * bi0[2] + zi[pp] * br0[2], zr[pp] * bi0[3] + zi[pp] * br0[3]);
            wim.z = cvt_pk_bf16(zr[pp] * bi1[0] + zi[pp] * br1[0], zr[pp] * bi1[1] + zi[pp] * br1[1]); wim.w = cvt_pk_bf16(zr[pp] * bi1[2] + zi[pp] * br1[2], zr[pp] * bi1[3] + zi[pp] * br1[3]);
            bfrag[pp] = __builtin_bit_cast(bf16x8, wre); bfrag[2 + pp] = __builtin_bit_cast(bf16x8, wim);
        }
        const int ci = lane & 15, kg = lane >> 4;
        bf16x8 cfrag[4];
#pragma unroll
        for (int kb = 0; kb < 4; ++kb) {
            const float* cp = ((kb < 2) ? P.c_re : P.c_im) + ((size_t)(g * 16 + ci)) * 64 + 32 * (kb & 1) + 8 * kg; const float sg = (kb < 2) ? 1.f : -1.f;
            const f32x4 c0 = *(const f32x4*)cp, c1 = *(const f32x4*)(cp + 4);
            u32x4 wc_; wc_.x = cvt_pk_bf16(sg * c0[0], sg * c0[1]); wc_.y = cvt_pk_bf16(sg * c0[2], sg * c0[3]); wc_.z = cvt_pk_bf16(sg * c1[0], sg * c1[1]); wc_.w = cvt_pk_bf16(sg * c1[2], sg * c1[3]);
            cfrag[kb] = __builtin_bit_cast(bf16x8, wc_);
        }
        const f32x4 dsk4 = *(const f32x4*)(P.dsk + g * 16 + 4 * kg);
        const int hip = (p >> 2) & 1, jp = (p & 3) + 4 * (p >> 3);
        const bf16_t* uptr = A3 + ((size_t)(rowbase0 + hip * bstride + jp)) * DM + g * 16 + 8 * hi;
        const size_t yoff = ((size_t)(rowbase0 + ci)) * DM + g * 16 + 4 * kg; const size_t boff = (size_t)bstride * DM;
        const int nblk = T / 16;
        bf16x8 ufA = *(const bf16x8*)uptr, ufB = *(const bf16x8*)(uptr + (size_t)16 * DM), ufC = *(const bf16x8*)(uptr + (size_t)32 * DM);
        u32x2 unA0 = *(const u32x2*)(A3 + yoff), unA1 = *(const u32x2*)(A3 + yoff + boff);
        u32x2 unB0 = *(const u32x2*)(A3 + yoff + (size_t)16 * DM), unB1 = *(const u32x2*)(A3 + yoff + boff + (size_t)16 * DM);
        u32x2 unC0 = *(const u32x2*)(A3 + yoff + (size_t)32 * DM), unC1 = *(const u32x2*)(A3 + yoff + boff + (size_t)32 * DM);
        for (int tb = 0; tb < nblk; ++tb) {
            const bf16x8 ucur = ufA; const u32x2 uc0 = unA0, uc1 = unA1;
            ufA = ufB; unA0 = unB0; unA1 = unB1; ufB = ufC; unB0 = unC0; unB1 = unC1;
            if (tb + 3 < nblk) { ufC = *(const bf16x8*)(uptr + (size_t)(tb + 3) * 16 * DM); unC0 = *(const u32x2*)(A3 + yoff + (size_t)(tb + 3) * 16 * DM); unC1 = *(const u32x2*)(A3 + yoff + boff + (size_t)(tb + 3) * 16 * DM); }
            f32x16 X[4];
#pragma unroll
            for (int cb = 0; cb < 4; ++cb) { f32x16 z = {}; X[cb] = __builtin_amdgcn_mfma_f32_32x32x16_bf16(ucur, bfrag[cb], z, 0, 0, 0); }
#pragma unroll
            for (int r = 0; r < 16; ++r) {
#pragma unroll
                for (int pp = 0; pp < 2; ++pp) {
                    const float nr = lbr[pp] * hr[pp] - lbi[pp] * hm[pp] + X[pp][r];
                    const float ni = lbr[pp] * hm[pp] + lbi[pp] * hr[pp] + X[2 + pp][r];
                    hr[pp] = nr; hm[pp] = ni; X[pp][r] = nr; X[2 + pp][r] = ni;
                }
            }
#pragma unroll
            for (int cb = 0; cb < 4; ++cb)
#pragma unroll
                for (int q = 0; q < 4; ++q) {
                    u32x2 wv; wv.x = cvt_pk_bf16(X[cb][4 * q], X[cb][4 * q + 1]); wv.y = cvt_pk_bf16(X[cb][4 * q + 2], X[cb][4 * q + 3]);
                    *(LAS u32x2*)(img + (cb * 32 + p) * IST + (16 * hi + 4 * q) * 2) = wv;
                }
            asm volatile("s_waitcnt lgkmcnt(0)" ::: "memory");
#pragma unroll
            for (int rb = 0; rb < 2; ++rb) {
                f32x4 y = {0.f, 0.f, 0.f, 0.f};
#pragma unroll
                for (int kb = 0; kb < 4; ++kb) {
                    LAS const unsigned char* ap = img + (32 * kb + 8 * kg + (ci >> 2)) * IST + (16 * rb + 4 * (ci & 3)) * 2;
                    const s16x4 lo = vtr(ap), h4 = vtr(ap + 4 * IST);
                    const bf16x8 af = (bf16x8){lo[0], lo[1], lo[2], lo[3], h4[0], h4[1], h4[2], h4[3]};
                    y = __builtin_amdgcn_mfma_f32_16x16x32_bf16(cfrag[kb], af, y, 0, 0, 0);
                }
                const u32x2 uw = rb ? uc1 : uc0;
                const float z0 = gelu_tanh(y[0] + dsk4[0] * __uint_as_float(uw.x << 16)), z1 = gelu_tanh(y[1] + dsk4[1] * __uint_as_float(uw.x & 0xffff0000u));
                const float z2 = gelu_tanh(y[2] + dsk4[2] * __uint_as_float(uw.y << 16)), z3 = gelu_tanh(y[3] + dsk4[3] * __uint_as_float(uw.y & 0xffff0000u));
                u32x2 zw; zw.x = cvt_pk_bf16(z0, z1); zw.y = cvt_pk_bf16(z2, z3);
                *(u32x2*)(Z + yoff + (rb ? boff : 0) + (size_t)tb * 16 * DM) = zw;
            }
            asm volatile("" ::: "memory");
        }
#pragma unroll
        for (int pp = 0; pp < 2; ++pp) {
            const int so = ((2 * bp + hi) * 64 + g) * 64 + p + 32 * pp;
            if (samp) { P.o_res[so] = hr[pp]; P.o_ims[so] = hm[pp]; } else { P.o_rep[so] = hr[pp]; P.o_imp[so] = hm[pp]; }
        }
    }
}


#define XB_TMO      128
#define XB_XCNT(j)  (256  + 64 * (j))
#define XB_XSUB(j)  (1280 + 64 * (j))
#define XB_XGEN(j)  (2304 + 64 * (j))
#define XB_TOP      3328
#define XB_TOPGEN   3392
#define XCD_BAR_WORDS 3456
#define XB_SPIN_CAP (1u << 18)
__device__ __forceinline__ unsigned xb_ld(unsigned* p)              { return __hip_atomic_load(p, __ATOMIC_RELAXED, __HIP_MEMORY_SCOPE_AGENT); }
__device__ __forceinline__ unsigned xb_add(unsigned* p, unsigned v) { return __hip_atomic_fetch_add(p, v, __ATOMIC_RELAXED, __HIP_MEMORY_SCOPE_AGENT); }
__device__ __forceinline__ unsigned xb_xcc_id() { return (unsigned)__builtin_amdgcn_s_getreg((3 << 11) | 20) & 0xFu; }
#define XB_SPIN(cond, bar) do { unsigned _sp = 0; while (cond) { __builtin_amdgcn_s_sleep(1); \
    if ((++_sp & 255u) == 0u) { if (xb_ld(&(bar)[XB_TMO])) break; if (_sp > XB_SPIN_CAP) { atomicAdd(&(bar)[XB_TMO], 1u); break; } } } } while (0)
struct XcdBarrier { unsigned* bar; unsigned x; volatile LAS unsigned* st; };
__device__ __forceinline__ XcdBarrier xcd_barrier_post(unsigned* bar, volatile LAS unsigned* st) {
    XcdBarrier b; b.bar = bar; b.x = xb_xcc_id(); b.st = st;
    if (threadIdx.x == 0) (void)xb_add(&bar[XB_XCNT(b.x)], 1u);
    return b;
}
__device__ __forceinline__ void xcd_barrier_complete(unsigned* bar, unsigned x, unsigned& nloc, unsigned& nx) {
    const unsigned G = gridDim.x * gridDim.y * gridDim.z;
    unsigned sum, cnt, mine, sp = 0u;
    for (;;) {
        sum = 0u; cnt = 0u; mine = 0u;
#pragma unroll
        for (unsigned j = 0; j < 16; ++j) { const unsigned c = xb_ld(&bar[XB_XCNT(j)]); sum += c; cnt += (c > 0u) ? 1u : 0u; mine = (j == x) ? c : mine; }
        if (sum == G) break;
        __builtin_amdgcn_s_sleep(1);
        if ((++sp & 255u) == 0u) { if (xb_ld(&bar[XB_TMO])) break; if (sp > XB_SPIN_CAP) { atomicAdd(&bar[XB_TMO], 1u); break; } }
    }
    nloc = mine > 0u ? mine : 1u; nx = cnt > 0u ? cnt : 1u;
}
__device__ __forceinline__ void xcd_barrier(const XcdBarrier& b) {
    asm volatile("s_waitcnt vmcnt(0)" ::: "memory");
    __syncthreads();
    if (threadIdx.x == 0) {
        unsigned* bar = b.bar;
        __builtin_amdgcn_s_waitcnt(0);
        unsigned nloc = b.st[0], nx = b.st[1];
        if (nloc == 0u) { xcd_barrier_complete(bar, b.x, nloc, nx); b.st[0] = nloc; b.st[1] = nx; }
        const unsigned old = xb_add(&bar[XB_XSUB(b.x)], 1u);
        const unsigned gen = old / nloc;
        if (old + 1u == (gen + 1u) * nloc) {
            __builtin_amdgcn_fence(__ATOMIC_RELEASE, "agent");
            asm volatile("s_waitcnt vmcnt(0)" ::: "memory");
            const unsigned og = xb_add(&bar[XB_TOP], 1u);
            const unsigned tg = og / nx;
            if (og + 1u == (tg + 1u) * nx) xb_add(&bar[XB_TOPGEN], 1u);
            else XB_SPIN(xb_ld(&bar[XB_TOPGEN]) == tg, bar);
            __builtin_amdgcn_fence(__ATOMIC_ACQUIRE, "agent");
            xb_add(&bar[XB_XGEN(b.x)], 1u);
            asm volatile("s_waitcnt vmcnt(0)" ::: "memory");
        } else {
            XB_SPIN(xb_ld(&bar[XB_XGEN(b.x)]) == gen, bar);
            __builtin_amdgcn_fence(__ATOMIC_ACQUIRE, "agent");
            asm volatile("s_waitcnt vmcnt(0)" ::: "memory");
        }
    }
    __syncthreads();
}

__device__ __forceinline__ void phase_prologue(LAS unsigned char* lds, const Args& args, unsigned char* ws, float* out, int G, int blk, int wave, int lane, int tid) {
    const int gw = blk * 8 + wave, NGW = G * 8;
    bf16_t* Wqkv = (bf16_t*)(ws + WS_WQKV); bf16_t* Wo = (bf16_t*)(ws + WS_WO); bf16_t* Wglu = (bf16_t*)(ws + WS_WGLU); bf16_t* Wup = (bf16_t*)(ws + WS_WUP); bf16_t* Wdn = (bf16_t*)(ws + WS_WDN);
    float* rope = (float*)(ws + WS_ROPE); bf16_t* Abuf = (bf16_t*)(ws + WS_A); bf16_t* Kbuf = (bf16_t*)(ws + WS_K); bf16_t* Vbuf = (bf16_t*)(ws + WS_V);
    LAS float* scr = (LAS float*)(lds + wave * 16384);
    constexpr int I_QKV = 16 * 48, I_O = 16 * 32, I_GLU = 16 * 64, I_UP = 16 * 176, I_DN = 44 * 32;
    constexpr int NITEMS = I_QKV + I_O + I_GLU + 2 * I_UP + 2 * I_DN;
    for (int it = gw; it < NITEMS; it += NGW) {
        int r = it;
        if (r < I_QKV) { transpose_item(args.in[11], DM, QKVD, Wqkv, 0, scr, r, lane); continue; } r -= I_QKV;
        if (r < I_O) { transpose_item(args.in[14], DM, DM, Wo, 0, scr, r, lane); continue; } r -= I_O;
        if (r < I_GLU) { transpose_item(args.in[24], DM, 2 * DM, Wglu, DM, scr, r, lane); continue; } r -= I_GLU;
        if (r < 2 * I_UP) { const int l = r / I_UP; transpose_item(args.in[26] + (size_t)l * DM * FF2, DM, FF2, Wup + (size_t)l * FF2 * DM, FF, scr, r % I_UP, lane); continue; } r -= 2 * I_UP;
        { const int l = r / I_DN; transpose_item(args.in[29] + (size_t)l * FF * DM, FF, DM, Wdn + (size_t)l * DM * FF, 0, scr, r % I_DN, lane); }
    }
    for (int i = blk * 512 + tid; i < SEQ * 8; i += G * 512) { const int pos = i >> 3, f = i & 7; const float inv_freq = powf(500000.0f, -(float)f * 0.125f); const float ang = (float)pos * inv_freq;
        rope[pos * 16 + f] = cosf(ang); rope[pos * 16 + 8 + f] = sinf(ang); }
    for (int i = blk * 512 + tid; i < DB * 128 * 64; i += G * 512) {
        const int b = i / (128 * 64), rem = i % (128 * 64), row = rem >> 6, c4 = (rem & 63) * 4;
        const f32x4 kv = *(const f32x4*)(args.in[2] + ((size_t)(b * 128 + row)) * 256 + c4), vv = *(const f32x4*)(args.in[3] + ((size_t)(b * 128 + row)) * 256 + c4);
        u32x2 kw, vw; kw.x = cvt_pk_bf16(kv[0], kv[1]); kw.y = cvt_pk_bf16(kv[2], kv[3]); vw.x = cvt_pk_bf16(vv[0], vv[1]); vw.y = cvt_pk_bf16(vv[2], vv[3]);
        const size_t krow = (size_t)MP + b * 192 + row;
        *(u32x2*)(Kbuf + krow * 256 + c4) = kw; *(u32x2*)(Vbuf + krow * 256 + c4) = vw;
        if (row >= 64) { *(f32x4*)(out + O_KS + ((size_t)(b * 128 + row - 64)) * 256 + c4) = kv; *(f32x4*)(out + O_VS + ((size_t)(b * 128 + row - 64)) * 256 + c4) = vv; }
    }
    {
        f32x4 gn[4], xa[4], xb_[4];
#pragma unroll
        for (int j = 0; j < 4; ++j) gn[j] = *((const f32x4*)args.in[7] + lane + 64 * j);
#define P0_X(mm) (((mm) < MP) ? args.in[0] + (size_t)(mm) * DM : args.in[1] + (size_t)((mm) - MP) * DM)
        int m = gw;
        if (m < MT) {
#pragma unroll
            for (int j = 0; j < 4; ++j) xa[j] = *((const f32x4*)P0_X(m) + lane + 64 * j);
        }
        for (; m < MT; m += NGW) {
            const int mn = m + NGW;
            if (mn < MT) {
#pragma unroll
                for (int j = 0; j < 4; ++j) xb_[j] = *((const f32x4*)P0_X(mn) + lane + 64 * j);
            }
            float s2 = 0.f;
#pragma unroll
            for (int j = 0; j < 4; ++j) s2 += (xa[j][0] * xa[j][0] + xa[j][1] * xa[j][1]) + (xa[j][2] * xa[j][2] + xa[j][3] * xa[j][3]);
            const float rstd2 = 1.0f / sqrtf(wave_sum(s2) * (1.0f / DM) + EPS);
#pragma unroll
            for (int j = 0; j < 4; ++j) { u32x2 w; w.x = cvt_pk_bf16(xa[j][0] * rstd2 * gn[j][0], xa[j][1] * rstd2 * gn[j][1]); w.y = cvt_pk_bf16(xa[j][2] * rstd2 * gn[j][2], xa[j][3] * rstd2 * gn[j][3]);
                *((u32x2*)(Abuf + (size_t)m * DM) + lane + 64 * j) = w; xa[j] = xb_[j]; }
        }
#undef P0_X
    }
}

template <bool XIN_F32>
__device__ __forceinline__ void rp_load(const void* xrow, const bf16_t* mrow, const float* ssrow, int nslots, int lane, f32x4 (&xf)[4], u32x2 (&xb)[4], u32x2 (&mw)[4], float& ssv) {
#pragma unroll
    for (int j = 0; j < 4; ++j) {
        if constexpr (XIN_F32) xf[j] = *((const f32x4*)xrow + lane + 64 * j); else xb[j] = *((const u32x2*)xrow + lane + 64 * j);
        mw[j] = *((const u32x2*)mrow + lane + 64 * j);
    }
    ssv = (lane < nslots) ? ssrow[lane] : 0.f;
}
template <int MODE>
__device__ __forceinline__ void rp_finish(const f32x4 (&xf)[4], const u32x2 (&xb)[4], const u32x2 (&mw)[4], float ssv, const f32x4 (&gp)[4], const f32x4 (&gn)[4], void* xout, bf16_t* arow, int lane) {
    f32x4 v[4];
    const float rstd = 1.0f / sqrtf(wave_sum(ssv) * (1.0f / DM) + EPS);
    float s2 = 0.f;
#pragma unroll
    for (int j = 0; j < 4; ++j) {
        if constexpr (MODE == 0) v[j] = xf[j];
        else { v[j][0] = __uint_as_float(xb[j].x << 16); v[j][1] = __uint_as_float(xb[j].x & 0xffff0000u); v[j][2] = __uint_as_float(xb[j].y << 16); v[j][3] = __uint_as_float(xb[j].y & 0xffff0000u); }
        f32x4 mv; mv[0] = __uint_as_float(mw[j].x << 16); mv[1] = __uint_as_float(mw[j].x & 0xffff0000u); mv[2] = __uint_as_float(mw[j].y << 16); mv[3] = __uint_as_float(mw[j].y & 0xffff0000u);
        v[j] += mv * rstd * gp[j];
        if constexpr (MODE == 2) *((f32x4*)xout + lane + 64 * j) = v[j];
        else { u32x2 w; w.x = cvt_pk_bf16(v[j][0], v[j][1]); w.y = cvt_pk_bf16(v[j][2], v[j][3]); *((u32x2*)xout + lane + 64 * j) = w; }
        s2 += (v[j][0] * v[j][0] + v[j][1] * v[j][1]) + (v[j][2] * v[j][2] + v[j][3] * v[j][3]);
    }
    if constexpr (MODE != 2) {
        const float rstd2 = 1.0f / sqrtf(wave_sum(s2) * (1.0f / DM) + EPS);
#pragma unroll
        for (int j = 0; j < 4; ++j) { u32x2 w; w.x = cvt_pk_bf16(v[j][0] * rstd2 * gn[j][0], v[j][1] * rstd2 * gn[j][1]); w.y = cvt_pk_bf16(v[j][2] * rstd2 * gn[j][2], v[j][3] * rstd2 * gn[j][3]);
            *((u32x2*)arow + lane + 64 * j) = w; }
    }
}
template <int MODE>
__device__ __forceinline__ void phase_rows(const float* x_prompt, const float* x_sample, bf16_t* X16, float* out, const bf16_t* Mbuf, const float* ss, int nslots, const float* gpost, const float* gnext, bf16_t* Abuf, int gw, int NGW, int lane, const float* sacc, const float* mbias, int ns) {
    int m = gw;
    {
        f32x4 gp[4], gn[4];
#pragma unroll
        for (int j = 0; j < 4; ++j) { gp[j] = *((const f32x4*)gpost + lane + 64 * j); gn[j] = (MODE != 2) ? *((const f32x4*)gnext + lane + 64 * j) : (f32x4){0.f, 0.f, 0.f, 0.f}; }
        f32x4 xfA[4], xfB[4]; u32x2 xbA[4], xbB[4], mwA[4], mwB[4]; float ssA = 0.f, ssB = 0.f;
#define RP_X(mm) ((MODE == 0) ? (const void*)(x_prompt + (size_t)(mm) * DM) : (const void*)(X16 + (size_t)(mm) * DM))
        if (m < MP) rp_load<MODE == 0>(RP_X(m), Mbuf + (size_t)m * DM, ss + (size_t)m * 32, nslots, lane, xfA, xbA, mwA, ssA);
        for (; m < MP; m += NGW) {
            const int mn = m + NGW;
            if (mn < MP) rp_load<MODE == 0>(RP_X(mn), Mbuf + (size_t)mn * DM, ss + (size_t)mn * 32, nslots, lane, xfB, xbB, mwB, ssB);
            rp_finish<MODE>(xfA, xbA, mwA, ssA, gp, gn, (MODE == 2) ? (void*)(out + (size_t)m * DM) : (void*)(X16 + (size_t)m * DM), Abuf + (size_t)m * DM, lane);
#pragma unroll
            for (int j = 0; j < 4; ++j) { xfA[j] = xfB[j]; xbA[j] = xbB[j]; mwA[j] = mwB[j]; }
            ssA = ssB;
        }
#undef RP_X
    }
    for (; m < MT; m += NGW) {
        const bool sp = (sacc != nullptr) && (m >= MP); const float* sr = sp ? sacc + (size_t)(m - MP) * DM : nullptr;
        if constexpr (MODE == 0) { const float* xr = (m < MP) ? x_prompt + (size_t)m * DM : x_sample + (size_t)(m - MP) * DM;
            if (sp) row_pass<true, true, true, false, true>(xr, X16 + (size_t)m * DM, nullptr, nullptr, ns, gpost, gnext, Abuf + (size_t)m * DM, lane, sr, mbias);
            else row_pass<true, true, true, false>(xr, X16 + (size_t)m * DM, Mbuf + (size_t)m * DM, ss + (size_t)m * 32, nslots, gpost, gnext, Abuf + (size_t)m * DM, lane); }
        else if constexpr (MODE == 1) {
            if (sp) row_pass<true, true, false, false, true>(X16 + (size_t)m * DM, X16 + (size_t)m * DM, nullptr, nullptr, ns, gpost, gnext, Abuf + (size_t)m * DM, lane, sr, mbias);
            else row_pass<true, true, false, false>(X16 + (size_t)m * DM, X16 + (size_t)m * DM, Mbuf + (size_t)m * DM, ss + (size_t)m * 32, nslots, gpost, gnext, Abuf + (size_t)m * DM, lane); }
        else {
            if (sp) row_pass<true, false, false, true, true>(X16 + (size_t)m * DM, out + (size_t)m * DM, nullptr, nullptr, ns, gpost, nullptr, nullptr, lane, sr, mbias);
            else row_pass<true, false, false, true>(X16 + (size_t)m * DM, out + (size_t)m * DM, Mbuf + (size_t)m * DM, ss + (size_t)m * 32, nslots, gpost, nullptr, nullptr, lane); }
    }
}
__device__ __forceinline__ void phase_up(LAS unsigned char* lds, const bf16_t* Abuf, const bf16_t* Wup_l, bf16_t* Gbuf, float* Ebuf, const float* cw, const float* cb, int G, int blk) {
    pg8::Gemm g{Abuf, Wup_l, MT, FF2, DM}; pg8::StaticOrder S; S.init(MT, FF2, DM, G, blk);
    pg8::EpiUp E{Gbuf, Ebuf, cw, cb};
    pg8::gemm_phase<pg8::EpiUp, true, true>(lds, g, S, E);
}
__device__ __forceinline__ void phase_down(LAS unsigned char* lds, const bf16_t* Gbuf, const bf16_t* Wdn_l, bf16_t* Mbuf, float* ss, float* sacc, int G, int blk) {
    pg8::Gemm g{Gbuf, Wdn_l, MT, DM, FF}; pg8::StaticOrder S; S.init(MT, DM, FF, G, blk, MP / 256, 11);
    pg8::EpiPlainSS E{Mbuf, nullptr, ss, sacc, FF / 64};
    pg8::gemm_phase<pg8::EpiPlainSS, true, true>(lds, g, S, E);
}
__device__ __forceinline__ void phase_fix(const float* Ebuf, bf16_t* Gbuf, const float* cw, const float* cb, const float* cc, float* out, int l, int G, int blk, int tid) {
    for (int i = blk * 512 + tid; i < NSEG * 2 * (FF / 4); i += G * 512) {
        const int ri = i / (FF / 4), c4 = (i % (FF / 4)) * 4, seg = ri >> 1, j = ri & 1;
        f32x4 o;
        f32x4 cres[2];
#pragma unroll
        for (int hf = 0; hf < 2; ++hf) {
            const int col = hf * FF + c4;
            const f32x4 cur0 = *(const f32x4*)(Ebuf + ((size_t)seg * 4 + 0) * FF2 + col), cur1 = *(const f32x4*)(Ebuf + ((size_t)seg * 4 + 1) * FF2 + col);
            f32x4 p0 = {0.f, 0.f, 0.f, 0.f}, p1 = {0.f, 0.f, 0.f, 0.f};
            if (seg >= MP / 64) { const int b = seg - MP / 64; p0 = *(const f32x4*)(cc + ((size_t)b * 2 + 0) * FF2 + col); p1 = *(const f32x4*)(cc + ((size_t)b * 2 + 1) * FF2 + col); }
            else if ((seg & 31) != 0) { p0 = *(const f32x4*)(Ebuf + ((size_t)(seg - 1) * 4 + 2) * FF2 + col); p1 = *(const f32x4*)(Ebuf + ((size_t)(seg - 1) * 4 + 3) * FF2 + col); }
            const f32x4 w0 = *(const f32x4*)(cw + col), w1 = *(const f32x4*)(cw + FF2 + col), w2 = *(const f32x4*)(cw + 2 * FF2 + col), bb = *(const f32x4*)(cb + col);
            cres[hf] = (j == 0) ? (bb + w0 * p0 + w1 * p1 + w2 * cur0) : (bb + w0 * p1 + w1 * cur0 + w2 * cur1);
        }
#pragma unroll
        for (int q = 0; q < 4; ++q) o[q] = gelu_tanh(cres[0][q]) * cres[1][q];
        u32x2 wv; wv.x = cvt_pk_bf16(o[0], o[1]); wv.y = cvt_pk_bf16(o[2], o[3]);
        *(u32x2*)(Gbuf + ((size_t)seg * 64 + j) * FF + c4) = wv;
    }
    for (int i = blk * 512 + tid; i < (NB + DB) * 2 * (FF2 / 4); i += G * 512) {
        const int ri = i / (FF2 / 4), c4 = (i % (FF2 / 4)) * 4, bb = ri >> 1, e = ri & 1;
        const int seg = (bb < NB) ? bb * 32 + 31 : MP / 64 + (bb - NB);
        const f32x4 v = *(const f32x4*)(Ebuf + ((size_t)seg * 4 + 2 + e) * FF2 + c4);
        float* o = (bb < NB) ? out + O_CP + (((size_t)l * NB + bb) * 2 + e) * FF2 + c4 : out + O_CS + (((size_t)l * DB + (bb - NB)) * 2 + e) * FF2 + c4;
        *(f32x4*)o = v;
    }
}

__global__ void __launch_bounds__(512, 2) fwd_kernel(Args args) {
    extern __shared__ __attribute__((aligned(16))) unsigned char lds_raw[];
    LAS unsigned char* lds = (LAS unsigned char*)lds_raw;
    const int tid = threadIdx.x, lane = tid & 63, wave = __builtin_amdgcn_readfirstlane(tid >> 6);
    const int G = gridDim.x, blk = blockIdx.x;
    const int gw = blk * 8 + wave, NGW = G * 8;
    unsigned char* ws = args.ws; float* out = args.out;
    const float* x_prompt = args.in[0]; const float* x_sample = args.in[1];
    bf16_t* Wqkv = (bf16_t*)(ws + WS_WQKV); bf16_t* Wo = (bf16_t*)(ws + WS_WO); bf16_t* Wglu = (bf16_t*)(ws + WS_WGLU); bf16_t* Wup = (bf16_t*)(ws + WS_WUP); bf16_t* Wdn = (bf16_t*)(ws + WS_WDN);
    float* rope = (float*)(ws + WS_ROPE); float* ss = (float*)(ws + WS_SS);
    bf16_t* Abuf = (bf16_t*)(ws + WS_A); bf16_t* Mbuf = (bf16_t*)(ws + WS_MB); float* Ebuf = (float*)(ws + WS_E); bf16_t* Gbuf = (bf16_t*)(ws + WS_G);
    bf16_t* X16 = (bf16_t*)(ws + WS_X16); float* sacc = (float*)(ws + WS_SACC);
    bf16_t* Qbuf = (bf16_t*)(ws + WS_Q); bf16_t* Kbuf = (bf16_t*)(ws + WS_K); bf16_t* Vbuf = (bf16_t*)(ws + WS_V);


    const int lo = args.ph_lo, hi_ = args.ph_hi;
    volatile LAS unsigned* misc = (volatile LAS unsigned*)(lds + 131072 + 1024);
    if (tid < 2) misc[tid] = 0u;
    __syncthreads();
    XcdBarrier xbar; xbar.bar = (unsigned*)ws; xbar.x = 0; xbar.st = nullptr;
    if (args.coop) xbar = xcd_barrier_post((unsigned*)ws, misc);
    if (args.coop == 2) cg::this_grid().sync();
#define IN(k) (lo <= (k) && (k) < hi_)
#define SEAM(k) do { if (args.coop && (k) + 1 < hi_) xcd_barrier(xbar); } while (0)
#define REP(k) _Pragma("unroll") for (int rep_ = 0; rep_ <= ((PROBE_REPMASK >> (k)) & 1); ++rep_)
    if (IN(0)) { REP(0) { phase_prologue(lds, args, ws, out, G, blk, wave, lane, tid); } SEAM(0); }
    if (IN(1)) { REP(1) {
        pg8::Gemm g{Abuf, Wqkv, MT, QKVD, DM}; pg8::StaticOrder S; S.init(MT, QKVD, DM, G, blk);
        pg8::EpiQKV E{Qbuf, Kbuf, Vbuf, args.in[12], rope, out + O_KP, out + O_VP, out + O_KS, out + O_VS};
        pg8::gemm_phase<pg8::EpiQKV, true, true>(lds, g, S, E); } SEAM(1); }
    if (IN(2)) { REP(2) { attn_phase(lds, Qbuf, Kbuf, Vbuf, Abuf, args.in[13], G, blk); } SEAM(2); }
    if (IN(3)) { REP(3) {
        pg8::Gemm g{Abuf, Wo, MT, DM, DM}; pg8::StaticOrder S; S.init(MT, DM, DM, G, blk, MP / 256, 4);
        pg8::EpiPlainSS E{Mbuf, args.in[15], ss, sacc, DM / 64};
        pg8::gemm_phase<pg8::EpiPlainSS, true, true>(lds, g, S, E); } SEAM(3); }
    if (IN(4)) { REP(4) { phase_rows<0>(x_prompt, x_sample, X16, out, Mbuf, ss, 16, args.in[8], args.in[9], Abuf, gw, NGW, lane, sacc, args.in[15], 4); } SEAM(4); }
    if (IN(5)) { REP(5) { phase_up(lds, Abuf, Wup, Gbuf, Ebuf, args.in[27], args.in[28], G, blk); } SEAM(5); }
    if (IN(6)) { REP(6) { phase_fix(Ebuf, Gbuf, args.in[27], args.in[28], args.in[6], out, 0, G, blk, tid); } SEAM(6); }
    if (IN(7)) { REP(7) { phase_down(lds, Gbuf, Wdn, Mbuf, ss, sacc, G, blk); } SEAM(7); }
    if (IN(8)) { REP(8) { phase_rows<1>(x_prompt, x_sample, X16, out, Mbuf, ss, 16, args.in[10], args.in[7] + DM, Abuf, gw, NGW, lane, sacc, nullptr, 11); } SEAM(8); }
    if (IN(9)) { REP(9) {
        SsmP P{args.in[16], args.in[17], args.in[18], args.in[19], args.in[20], args.in[21], args.in[22], args.in[23], args.in[4], args.in[5], out + O_REP, out + O_IMP, out + O_RES, out + O_IMS};
        ssm_phase(lds, Abuf, Qbuf, P, G, blk); } SEAM(9); }
    if (IN(10)) { REP(10) {
        pg8::Gemm g{Qbuf, Wglu, MT, 2 * DM, DM}; pg8::StaticOrder S; S.init(MT, 2 * DM, DM, G, blk);
        pg8::EpiGlu E{Mbuf, args.in[25], ss};
        pg8::gemm_phase<pg8::EpiGlu, true, true>(lds, g, S, E); } SEAM(10); }
    if (IN(11)) { REP(11) { phase_rows<1>(x_prompt, x_sample, X16, out, Mbuf, ss, 32, args.in[8] + DM, args.in[9] + DM, Abuf, gw, NGW, lane, nullptr, nullptr, 0); } SEAM(11); }
    if (IN(12)) { REP(12) { phase_up(lds, Abuf, Wup + (size_t)FF2 * DM, Gbuf, Ebuf, args.in[27] + (size_t)3 * FF2, args.in[28] + FF2, G, blk); } SEAM(12); }
    if (IN(13)) { REP(13) { phase_fix(Ebuf, Gbuf, args.in[27] + (size_t)3 * FF2, args.in[28] + FF2, args.in[6] + (size_t)DB * 2 * FF2, out, 1, G, blk, tid); } SEAM(13); }
    if (IN(14)) { REP(14) { phase_down(lds, Gbuf, Wdn + (size_t)DM * FF, Mbuf, ss, sacc, G, blk); } SEAM(14); }
    if (IN(15)) { REP(15) { phase_rows<2>(x_prompt, x_sample, X16, out, Mbuf, ss, 16, args.in[10] + DM, nullptr, nullptr, gw, NGW, lane, sacc, nullptr, 11); } }
#undef IN
#undef SEAM
#undef REP
}

extern "C" void kernel_launch(void* const* d_in, const int* in_sizes, int n_in, void* d_out, int out_size, void* d_ws, size_t ws_size, hipStream_t stream) {
    static int grid = 0;
    if (grid == 0) {
        if (n_in != 30 || (size_t)out_size != O_END || ws_size < WS_END) { fprintf(stderr, "kernel_launch: unexpected shapes: n_in %d out %d ws %zu (need out %zu ws %zu)\n", n_in, out_size, ws_size, (size_t)O_END, (size_t)WS_END); grid = -1; return; }
        int dev = 0, cus = 0, per_cu = 0;
        hipGetDevice(&dev); hipDeviceGetAttribute(&cus, hipDeviceAttributeMultiprocessorCount, dev);
        if (hipFuncSetAttribute((const void*)fwd_kernel, hipFuncAttributeMaxDynamicSharedMemorySize, LDS_BYTES) != hipSuccess) { fprintf(stderr, "kernel_launch: hipFuncSetAttribute failed\n"); grid = -1; return; }
        if (hipOccupancyMaxActiveBlocksPerMultiprocessor(&per_cu, (const void*)fwd_kernel, 512, LDS_BYTES) != hipSuccess || per_cu < 1) { fprintf(stderr, "kernel_launch: occupancy query says %d\n", per_cu); per_cu = 1; }
        (void)hipGetLastError();
        grid = cus * 1;
    }
    if (grid < 0) return;
    Args a{};
    for (int i = 0; i < 30; ++i) a.in[i] = (const float*)d_in[i];
    a.out = (float*)d_out; a.ws = (unsigned char*)d_ws;
#ifndef MK_MULTI
    if (hipMemsetAsync(d_ws, 0, 16384, stream) != hipSuccess) { fprintf(stderr, "kernel_launch: memset failed\n"); return; }
    a.ph_lo = 0; a.ph_hi = NPHASE; a.coop = 1;
    void* kargs[] = {&a};
    hipError_t e = hipLaunchCooperativeKernel((const void*)fwd_kernel, dim3(grid), dim3(512), kargs, LDS_BYTES, stream);
    if (e != hipSuccess) fprintf(stderr, "cooperative launch failed: %s (grid %d)\n", hipGetErrorString(e), grid);
#else
    for (int ph = 0; ph < NPHASE; ++ph) { a.ph_lo = ph; a.ph_hi = ph + 1; a.coop = 0; hipLaunchKernelGGL(fwd_kernel, dim3(grid), dim3(512), LDS_BYTES, stream, a); }
#endif
}
```

```cpp
#include <hip/hip_runtime.h>
#include <hip/hip_cooperative_groups.h>
#include <cstdio>
#include <cstdint>
namespace cg = cooperative_groups;

#define LAS __attribute__((address_space(3)))
typedef unsigned short bf16_t;
typedef short bf16x8 __attribute__((ext_vector_type(8)));
typedef short s16x4 __attribute__((ext_vector_type(4)));
typedef float f32x4 __attribute__((ext_vector_type(4)));
typedef float f32x16 __attribute__((ext_vector_type(16)));
typedef unsigned u32x4 __attribute__((ext_vector_type(4)));
typedef unsigned u32x2 __attribute__((ext_vector_type(2)));

constexpr int DM = 1024, NB = 32, SEQ = 2048, MP = NB * SEQ, DB = 16, DS = 64, MS = DB * DS, MT = MP + MS;
constexpr int QKVD = 1536, FF = 2816, FF2 = 5632, NSEG = MT / 64;
constexpr int KVROWS = MP + DB * 192;
constexpr float EPS = 1e-6f, LOG2E = 1.4426950408889634f, QSCALE = 0.125f * 1.4426950408889634f;
constexpr size_t O_Y = 0, O_KP = (size_t)MT * DM, O_VP = O_KP + (size_t)NB * 128 * 256, O_KS = O_VP + (size_t)NB * 128 * 256, O_VS = O_KS + (size_t)DB * 128 * 256,
                 O_REP = O_VS + (size_t)DB * 128 * 256, O_IMP = O_REP + NB * 4096, O_RES = O_IMP + NB * 4096, O_IMS = O_RES + DB * 4096,
                 O_CP = O_IMS + DB * 4096, O_CS = O_CP + (size_t)2 * NB * 2 * FF2, O_END = O_CS + (size_t)2 * DB * 2 * FF2;
constexpr size_t MiB = 1u << 20;
constexpr size_t WS_WQKV = 1 * MiB, WS_WO = 4 * MiB, WS_WGLU = 6 * MiB, WS_WUP = 10 * MiB, WS_WDN = 32 * MiB, WS_ROPE = 43 * MiB, WS_SS = 44 * MiB,
                 WS_A = 54 * MiB, WS_MB = 185 * MiB, WS_E = 316 * MiB, WS_G = 406 * MiB, WS_Q = WS_G, WS_K = WS_G + 132 * MiB, WS_V = WS_K + 34 * MiB, WS_X16 = WS_G + 358 * MiB, WS_SACC = WS_X16 + 131 * MiB, WS_END = WS_SACC + 44 * MiB;
static_assert(WS_WUP + (size_t)2 * FF2 * DM * 2 <= WS_WDN && WS_WDN + (size_t)2 * DM * FF * 2 <= WS_ROPE && WS_SS + (size_t)MT * 32 * 4 <= WS_A, "ws map 1");
static_assert(WS_A + (size_t)MT * DM * 2 <= WS_MB && WS_MB + (size_t)MT * DM * 2 <= WS_E && WS_E + (size_t)NSEG * 4 * FF2 * 4 <= WS_G, "ws map 2");
static_assert(WS_X16 + (size_t)MT * DM * 2 <= WS_END, "ws map 4");
static_assert(WS_Q + (size_t)MT * DM * 2 <= WS_K && WS_K + (size_t)KVROWS * 256 * 2 <= WS_V && WS_V + (size_t)KVROWS * 256 * 2 <= WS_END && WS_G + (size_t)MT * FF * 2 <= WS_END, "ws map 3");

__device__ __forceinline__ unsigned cvt_pk_bf16(float lo, float hi) { unsigned r; asm volatile("v_cvt_pk_bf16_f32 %0, %1, %2" : "=v"(r) : "v"(lo), "v"(hi)); return r; }
__device__ __forceinline__ float bf2f(unsigned short b) { return __uint_as_float((unsigned)b << 16); }
__device__ __forceinline__ float gelu_tanh(float x) {
    const float x2 = x * x, u = x * (0.7978845608f + 0.0356774081f * x2);
    const float e = __builtin_amdgcn_exp2f(-2.885390082f * u);
    return x * __builtin_amdgcn_rcpf(1.0f + e);
}
__device__ __forceinline__ float sigmoid_f(float v) { return __builtin_amdgcn_rcpf(1.0f + __builtin_amdgcn_exp2f(-LOG2E * v)); }
__device__ __forceinline__ float wave_sum(float v) {
#pragma unroll
    for (int o = 1; o < 64; o <<= 1) v += __shfl_xor(v, o);
    return v;
}
template <int CTRL> __device__ __forceinline__ float dpp_f(float x) { return __builtin_bit_cast(float, __builtin_amdgcn_update_dpp(0, __builtin_bit_cast(int, x), CTRL, 0xf, 0xf, false)); }

namespace pg8 {
constexpr int BM = 256, BK = 64, HALF = 128, HTB = HALF * BK * 2, STAGE_BYTES = 8 * HTB, NXCD = 8, WGM = 8;
__host__ __device__ __forceinline__ int lds_byte(int r, int c) { const int st = (r >> 4) * 2 + (c >> 5), rr = r & 15, cc = c & 31, ob = rr * 64 + cc * 2; return st * 1024 + (ob ^ (((ob >> 9) & 1) << 5)); }
__host__ __device__ __forceinline__ void stage_rc(int b, int& R, int& C) { const int st = b / 1024, sb = b % 1024, swz = sb ^ (((sb >> 9) & 1) << 5); R = (st >> 1) * 16 + swz / 64; C = (st & 1) * 32 + (swz % 64) / 2; }
__host__ __device__ __forceinline__ int perm32(int rho) { const int n = rho >> 4, i = rho & 15; return 8 * (i >> 2) + 4 * n + (i & 3); }
struct Unit { int pm, pn, kt0, nkt; };
struct Gemm { const bf16_t* A; const bf16_t* Bt; int M, N, K; };
struct StaticOrder {
    int nM, nN, nwg, G, c, nMf, ns, ktiles, nfull;
    __device__ void init(int M, int N, int K, int G_, int c_, int nMf_ = -1, int ns_ = 1) { nM = M / BM; nN = N / BM; G = G_; c = c_; ktiles = K / BK; nMf = nMf_ < 0 ? nM : nMf_; ns = ns_; nfull = nMf * nN; nwg = nfull + (nM - nMf) * nN * ns; }
    __device__ __forceinline__ bool next(int i, Unit& u) const {
        const long L = (long)i * G + c; if (L >= nwg) return false;
        int pm, pn, kt0 = 0, nkt = ktiles;
        if (L >= nfull) { const int s = (int)L - nfull, tile = s / ns, sl = s - tile * ns; pm = nMf + tile / nN; pn = tile % nN; nkt = ktiles / ns; kt0 = sl * nkt; }
        else {
            int wgid = (int)L; { const int q = nfull / NXCD, r = nfull % NXCD, xcd = wgid % NXCD, off = wgid / NXCD; wgid = (xcd < r ? xcd * (q + 1) : r * (q + 1) + (xcd - r) * q) + off; }
            const int nig = WGM * nN, gid = wgid / nig, fm = gid * WGM, gsz = (nMf - fm) < WGM ? (nMf - fm) : WGM;
            pm = fm + ((wgid % nig) % gsz); pn = (wgid % nig) / gsz;
        }
        u = Unit{pm, pn, kt0, nkt}; return true;
    }
};
template <class Epi, bool ALIGN_EPI, bool SP2>
__device__ __forceinline__ void gemm_phase(LAS unsigned char* lds, const Gemm g, const StaticOrder& S, const Epi& E) {
    const int tid = threadIdx.x, wid = __builtin_amdgcn_readfirstlane(tid >> 6), lane = tid & 63, wr = wid >> 2, wc = wid & 3, fr = lane & 15, fq = lane >> 4;
    const int K = g.K;
    unsigned voffA[2], voffB[2];
#pragma unroll
    for (int i = 0; i < 2; ++i) { int R, C; stage_rc(tid * 16 + i * 8192, R, C); const int Rb = Epi::PERM ? ((R & ~31) + perm32(R & 31)) : R;
        voffA[i] = (unsigned)(R * K + C) * 2u; voffB[i] = (unsigned)(Rb * K + C) * 2u; }
    const size_t kstep = (size_t)(BK * 2);
    const size_t hstep = (size_t)HALF * K * 2;
    const size_t tstep = 2 * hstep;
    const unsigned ldsw = (unsigned)wid * 1024u;
    const int aoff = lds_byte(wr * 64 + fr, fq * 8), boff = lds_byte(wc * 32 + fr, fq * 8);
#define PG8_SA(b, h) (((b) * 2 + (h)) * HTB)
#define PG8_SB(b, h) ((4 + (b) * 2 + (h)) * HTB)
#define PG8_STAGE(bufoff, gbase, voff) do { _Pragma("unroll") for (int _i = 0; _i < 2; ++_i) \
        __builtin_amdgcn_global_load_lds((const unsigned*)((const char*)(gbase) + (voff)[_i]), (LAS unsigned*)(lds + (bufoff) + ldsw + _i * 8192), 16, 0, 0); } while (0)
#define PG8_LDA(dst, b, h) do { _Pragma("unroll") for (int m = 0; m < 4; ++m) _Pragma("unroll") for (int k = 0; k < 2; ++k) dst[m][k] = *(const LAS bf16x8*)(lds + PG8_SA(b, h) + aoff + m * 2048 + k * 1024); } while (0)
#define PG8_LDB(dst, b, h) do { _Pragma("unroll") for (int n = 0; n < 2; ++n) _Pragma("unroll") for (int k = 0; k < 2; ++k) dst[n][k] = *(const LAS bf16x8*)(lds + PG8_SB(b, h) + boff + n * 2048 + k * 1024); } while (0)
#define PG8_MMA(ai, bj, At, Bt) do { __builtin_amdgcn_s_setprio(1); _Pragma("unroll") for (int m = 0; m < 4; ++m) _Pragma("unroll") for (int n = 0; n < 2; ++n) _Pragma("unroll") for (int k = 0; k < 2; ++k) \
        acc[ai][bj][m][n] = __builtin_amdgcn_mfma_f32_16x16x32_bf16(Bt[n][k], At[m][k], acc[ai][bj][m][n], 0, 0, 0); __builtin_amdgcn_s_setprio(0); } while (0)
#define PG8_WAIT_V(n) asm volatile("s_waitcnt vmcnt(" #n ")" ::: "memory")
#define PG8_WAIT_L(n) asm volatile("s_waitcnt lgkmcnt(" #n ")" ::: "memory")
#define PG8_BAR __builtin_amdgcn_s_barrier()
#define PG8_SCHED __builtin_amdgcn_sched_barrier(0)
    Unit cur, nxt; int ui = 0;
    if (!S.next(0, cur)) return;
    f32x4 acc[2][2][4][2];
#pragma unroll
    for (int a = 0; a < 2; ++a)
#pragma unroll
        for (int b = 0; b < 2; ++b)
#pragma unroll
            for (int m = 0; m < 4; ++m)
#pragma unroll
                for (int n = 0; n < 2; ++n) acc[a][b][m][n] = (f32x4){0.f, 0.f, 0.f, 0.f};
    bf16x8 At[4][2], B0[2][2], B1[2][2];
    const char* cA = (const char*)g.A + (size_t)cur.pm * tstep + (size_t)cur.kt0 * kstep; const char* cB = (const char*)g.Bt + (size_t)cur.pn * tstep + (size_t)cur.kt0 * kstep;
    if constexpr (SP2) {
        PG8_STAGE(PG8_SB(0, 0), cB, voffB); PG8_STAGE(PG8_SB(0, 1), cB + hstep, voffB); PG8_STAGE(PG8_SA(0, 0), cA, voffA); PG8_STAGE(PG8_SA(0, 1), cA + hstep, voffA);
        if (wr == 1) PG8_BAR;
        PG8_WAIT_V(2); PG8_BAR;
        PG8_STAGE(PG8_SB(1, 0), cB + kstep, voffB); PG8_STAGE(PG8_SA(1, 0), cA + kstep, voffA); PG8_STAGE(PG8_SB(1, 1), cB + hstep + kstep, voffB);
        PG8_WAIT_V(6); PG8_BAR;
    } else {
        PG8_STAGE(PG8_SB(0, 0), cB, voffB); PG8_STAGE(PG8_SA(0, 0), cA, voffA); PG8_STAGE(PG8_SB(0, 1), cB + hstep, voffB); PG8_STAGE(PG8_SA(0, 1), cA + hstep, voffA);
        if (wr == 1) PG8_BAR;
        PG8_WAIT_V(4); PG8_BAR;
        PG8_STAGE(PG8_SB(1, 0), cB + kstep, voffB); PG8_STAGE(PG8_SA(1, 0), cA + kstep, voffA); PG8_STAGE(PG8_SB(1, 1), cB + hstep + kstep, voffB);
        PG8_WAIT_V(6); PG8_BAR;
    }
    for (;;) {
        const bool has_next = S.next(ui + 1, nxt);
        const char* nA = has_next ? (const char*)g.A + (size_t)nxt.pm * tstep + (size_t)nxt.kt0 * kstep : cA; const char* nB = has_next ? (const char*)g.Bt + (size_t)nxt.pn * tstep + (size_t)nxt.kt0 * kstep : cB;
        const int nt = cur.nkt;
        for (int t = 0; t < nt; t += 2) {
            const bool last = (t == nt - 2);
            const char* a1 = cA + (size_t)(t + 1) * kstep;
            const char* a2 = last ? nA : cA + (size_t)(t + 2) * kstep; const char* b2 = last ? nB : cB + (size_t)(t + 2) * kstep;
            const char* a3 = a2 + kstep; const char* b3 = b2 + kstep;
            if constexpr (SP2) {
            PG8_LDB(B0, 0, 0); PG8_LDB(B1, 0, 1); PG8_SCHED; PG8_LDA(At, 0, 0); PG8_STAGE(PG8_SA(1, 1), a1 + hstep, voffA);
            PG8_WAIT_V(8); PG8_WAIT_L(0); PG8_BAR; PG8_MMA(0, 0, At, B0); PG8_MMA(0, 1, At, B1); PG8_BAR; PG8_SCHED;
            PG8_LDA(At, 0, 1); PG8_STAGE(PG8_SB(0, 0), b2, voffB); PG8_STAGE(PG8_SB(0, 1), b2 + hstep, voffB); PG8_STAGE(PG8_SA(0, 0), a2, voffA);
            PG8_WAIT_V(8); PG8_WAIT_L(0); PG8_BAR; PG8_MMA(1, 0, At, B0); PG8_MMA(1, 1, At, B1); PG8_BAR; PG8_SCHED;
            PG8_LDB(B0, 1, 0); PG8_LDB(B1, 1, 1); PG8_SCHED; PG8_LDA(At, 1, 0); PG8_STAGE(PG8_SA(0, 1), a2 + hstep, voffA);
            PG8_WAIT_V(8); PG8_WAIT_L(0); PG8_BAR; PG8_MMA(0, 0, At, B0); PG8_MMA(0, 1, At, B1); PG8_BAR; PG8_SCHED;
            PG8_LDA(At, 1, 1); PG8_STAGE(PG8_SB(1, 0), b3, voffB); PG8_STAGE(PG8_SB(1, 1), b3 + hstep, voffB); PG8_STAGE(PG8_SA(1, 0), a3, voffA);
            PG8_WAIT_V(8); PG8_WAIT_L(0); PG8_BAR; PG8_MMA(1, 0, At, B0); PG8_MMA(1, 1, At, B1); PG8_BAR; PG8_SCHED;
            } else {
            PG8_LDB(B0, 0, 0); PG8_SCHED; PG8_LDA(At, 0, 0); PG8_STAGE(PG8_SA(1, 1), a1 + hstep, voffA);
            PG8_WAIT_L(8); PG8_BAR; PG8_WAIT_L(0); PG8_MMA(0, 0, At, B0); PG8_BAR; PG8_SCHED;
            PG8_LDB(B1, 0, 1); PG8_STAGE(PG8_SB(0, 0), b2, voffB);
            PG8_BAR; PG8_WAIT_L(0); PG8_MMA(0, 1, At, B1); PG8_BAR;
            PG8_LDA(At, 0, 1); PG8_STAGE(PG8_SA(0, 0), a2, voffA);
            PG8_BAR; PG8_WAIT_L(0); PG8_MMA(1, 0, At, B0); PG8_BAR; PG8_SCHED;
            PG8_STAGE(PG8_SB(0, 1), b2 + hstep, voffB);
            PG8_WAIT_V(6); PG8_BAR; PG8_MMA(1, 1, At, B1); PG8_BAR;
            PG8_LDB(B0, 1, 0); PG8_SCHED; PG8_LDA(At, 1, 0); PG8_STAGE(PG8_SA(0, 1), a2 + hstep, voffA);
            PG8_WAIT_L(8); PG8_BAR; PG8_WAIT_L(0); PG8_MMA(0, 0, At, B0); PG8_BAR; PG8_SCHED;
            PG8_LDB(B1, 1, 1); PG8_STAGE(PG8_SB(1, 0), b3, voffB);
            PG8_BAR; PG8_WAIT_L(0); PG8_MMA(0, 1, At, B1); PG8_BAR;
            PG8_LDA(At, 1, 1); PG8_STAGE(PG8_SA(1, 0), a3, voffA);
            PG8_BAR; PG8_WAIT_L(0); PG8_MMA(1, 0, At, B0); PG8_BAR; PG8_SCHED;
            PG8_STAGE(PG8_SB(1, 1), b3 + hstep, voffB);
            PG8_WAIT_V(6); PG8_BAR; PG8_MMA(1, 1, At, B1); PG8_BAR;
            }
        }
        if constexpr (ALIGN_EPI) { if (wr == 0) PG8_BAR; }
        E(acc, cur, wr, wc, fr, fq);
        if (!has_next) break;
#pragma unroll
        for (int a = 0; a < 2; ++a)
#pragma unroll
            for (int b = 0; b < 2; ++b)
#pragma unroll
                for (int m = 0; m < 4; ++m)
#pragma unroll
                    for (int n = 0; n < 2; ++n) acc[a][b][m][n] = (f32x4){0.f, 0.f, 0.f, 0.f};
        cur = nxt; cA = nA; cB = nB; ++ui;
        if constexpr (ALIGN_EPI) { if (wr == 1) PG8_BAR; }
    }
    PG8_WAIT_V(0);
    if constexpr (!ALIGN_EPI) { if (wr == 0) PG8_BAR; }
    PG8_BAR;
#undef PG8_SA
#undef PG8_SB
#undef PG8_STAGE
#undef PG8_LDA
#undef PG8_LDB
#undef PG8_MMA
#undef PG8_WAIT_V
#undef PG8_WAIT_L
#undef PG8_BAR
#undef PG8_SCHED
}

struct EpiQKV {
    static constexpr bool PERM = true;
    bf16_t* Q; bf16_t* Kb; bf16_t* Vb; const float* bias; const float* rope; float* kp; float* vp; float* ks; float* vs;
    __device__ __forceinline__ void operator()(const f32x4 (&acc)[2][2][4][2], const Unit& u, int wr, int wc, int fr, int fq) const {
        const int kind = u.pn < 4 ? 0 : u.pn - 3;
        const int lc0 = wc * 32 + 8 * fq;
        f32x4 bv[2][2];
#pragma unroll
        for (int bj = 0; bj < 2; ++bj)
#pragma unroll
            for (int n = 0; n < 2; ++n) bv[bj][n] = *(const f32x4*)(bias + u.pn * 256 + bj * 128 + lc0 + 4 * n);
        const bool dorope = (kind < 2) && ((wc & 1) == 0);
        const float sgn = (fq == 0) ? -1.f : 1.f;
#pragma unroll
        for (int ai = 0; ai < 2; ++ai)
#pragma unroll
            for (int m = 0; m < 4; ++m) {
                const int r = u.pm * 256 + ai * 128 + wr * 64 + m * 16 + fr;
                const bool prompt = r < MP;
                const int t = prompt ? (r & 2047) : ((r - MP) & 63), b = prompt ? (r >> 11) : ((r - MP) >> 6);
                const int pos = prompt ? t : 1024 + t;
                f32x4 cs[2], sn[2];
                if (dorope) { cs[0] = *(const f32x4*)(rope + pos * 16); cs[1] = *(const f32x4*)(rope + pos * 16 + 4); sn[0] = *(const f32x4*)(rope + pos * 16 + 8); sn[1] = *(const f32x4*)(rope + pos * 16 + 12); }
#pragma unroll
                for (int bj = 0; bj < 2; ++bj) {
                    f32x4 v[2];
#pragma unroll
                    for (int n = 0; n < 2; ++n) {
                        v[n] = acc[ai][bj][m][n] + bv[bj][n];
                        if (dorope) {
#pragma unroll
                            for (int j = 0; j < 4; ++j) { const float p = __shfl_xor(v[n][j], 16); const float rv = v[n][j] * cs[n][j] + sgn * p * sn[n][j]; v[n][j] = (fq < 2) ? rv : v[n][j]; }
                        }
                    }
                    if (kind == 0) {
                        u32x4 w; w.x = cvt_pk_bf16(v[0][0] * QSCALE, v[0][1] * QSCALE); w.y = cvt_pk_bf16(v[0][2] * QSCALE, v[0][3] * QSCALE); w.z = cvt_pk_bf16(v[1][0] * QSCALE, v[1][1] * QSCALE); w.w = cvt_pk_bf16(v[1][2] * QSCALE, v[1][3] * QSCALE);
                        *(u32x4*)(Q + (size_t)r * DM + u.pn * 256 + bj * 128 + lc0) = w;
                    } else {
                        const int col = bj * 128 + lc0;
                        const size_t krow = prompt ? (size_t)r : (size_t)MP + b * 192 + 128 + t;
                        u32x4 w; w.x = cvt_pk_bf16(v[0][0], v[0][1]); w.y = cvt_pk_bf16(v[0][2], v[0][3]); w.z = cvt_pk_bf16(v[1][0], v[1][1]); w.w = cvt_pk_bf16(v[1][2], v[1][3]);
                        *(u32x4*)((kind == 1 ? Kb : Vb) + krow * 256 + col) = w;
                        float* o = nullptr;
                        if (prompt) { if (t >= SEQ - 128) o = (kind == 1 ? kp : vp) + ((size_t)(b * 128 + t - (SEQ - 128)) * 256 + col); }
                        else o = (kind == 1 ? ks : vs) + ((size_t)(b * 128 + 64 + t) * 256 + col);
                        if (o) { *(f32x4*)o = v[0]; *(f32x4*)(o + 4) = v[1]; }
                    }
                }
            }
    }
};
struct EpiPlainSS {
    static constexpr bool PERM = true;
    bf16_t* O; const float* bias; float* ss; float* sacc; int ktiles;
    __device__ __forceinline__ void operator()(const f32x4 (&acc)[2][2][4][2], const Unit& u, int wr, int wc, int fr, int fq) const {
        const int col0 = u.pn * 256 + wc * 32 + 8 * fq;
        if (u.nkt != ktiles) {
            const int slice = u.kt0 / u.nkt;
#pragma unroll
            for (int ai = 0; ai < 2; ++ai)
#pragma unroll
                for (int m = 0; m < 4; ++m) {
                    const int r = u.pm * 256 + ai * 128 + wr * 64 + m * 16 + fr - MP; float* sp = sacc + ((size_t)slice * MS + r) * DM + col0;
#pragma unroll
                    for (int bj = 0; bj < 2; ++bj) { *(f32x4*)(sp + bj * 128) = acc[ai][bj][m][0]; *(f32x4*)(sp + bj * 128 + 4) = acc[ai][bj][m][1]; }
                }
            return;
        }
        f32x4 bv[2][2];
#pragma unroll
        for (int bj = 0; bj < 2; ++bj)
#pragma unroll
            for (int n = 0; n < 2; ++n) bv[bj][n] = bias ? *(const f32x4*)(bias + col0 + bj * 128 + 4 * n) : (f32x4){0.f, 0.f, 0.f, 0.f};
#pragma unroll
        for (int ai = 0; ai < 2; ++ai)
#pragma unroll
            for (int m = 0; m < 4; ++m) {
                const int r = u.pm * 256 + ai * 128 + wr * 64 + m * 16 + fr; float s = 0.f;
#pragma unroll
                for (int bj = 0; bj < 2; ++bj) {
                    const f32x4 v0 = acc[ai][bj][m][0] + bv[bj][0], v1 = acc[ai][bj][m][1] + bv[bj][1];
                    s += (v0[0] * v0[0] + v0[1] * v0[1]) + (v0[2] * v0[2] + v0[3] * v0[3]) + (v1[0] * v1[0] + v1[1] * v1[1]) + (v1[2] * v1[2] + v1[3] * v1[3]);
                    u32x4 w; w.x = cvt_pk_bf16(v0[0], v0[1]); w.y = cvt_pk_bf16(v0[2], v0[3]); w.z = cvt_pk_bf16(v1[0], v1[1]); w.w = cvt_pk_bf16(v1[2], v1[3]);
                    *(u32x4*)(O + (size_t)r * DM + col0 + bj * 128) = w;
                }
                s += __shfl_xor(s, 16); s += __shfl_xor(s, 32);
                if (fq == 0) ss[(size_t)r * 32 + u.pn * 4 + wc] = s;
            }
    }
};
struct EpiGlu {
    static constexpr bool PERM = true;
    bf16_t* O; const float* bias; float* ss;
    __device__ __forceinline__ void operator()(const f32x4 (&acc)[2][2][4][2], const Unit& u, int wr, int wc, int fr, int fq) const {
        const int oc0 = u.pn * 128 + wc * 32 + 8 * fq;
        f32x4 ba[2], bg[2];
#pragma unroll
        for (int n = 0; n < 2; ++n) { ba[n] = *(const f32x4*)(bias + oc0 + 4 * n); bg[n] = *(const f32x4*)(bias + DM + oc0 + 4 * n); }
#pragma unroll
        for (int ai = 0; ai < 2; ++ai)
#pragma unroll
            for (int m = 0; m < 4; ++m) {
                const int r = u.pm * 256 + ai * 128 + wr * 64 + m * 16 + fr; float s = 0.f; f32x4 o[2];
#pragma unroll
                for (int n = 0; n < 2; ++n) { const f32x4 a = acc[ai][0][m][n] + ba[n], g = acc[ai][1][m][n] + bg[n];
#pragma unroll
                    for (int j = 0; j < 4; ++j) { o[n][j] = a[j] * sigmoid_f(g[j]); s += o[n][j] * o[n][j]; } }
                u32x4 w; w.x = cvt_pk_bf16(o[0][0], o[0][1]); w.y = cvt_pk_bf16(o[0][2], o[0][3]); w.z = cvt_pk_bf16(o[1][0], o[1][1]); w.w = cvt_pk_bf16(o[1][2], o[1][3]);
                *(u32x4*)(O + (size_t)r * DM + oc0) = w;
                s += __shfl_xor(s, 16); s += __shfl_xor(s, 32);
                if (fq == 0) ss[(size_t)r * 32 + u.pn * 4 + wc] = s;
            }
    }
};
struct EpiUp {
    static constexpr bool PERM = true;
    bf16_t* G; float* E; const float* cw; const float* cb;
    __device__ __forceinline__ void operator()(f32x4 (&acc)[2][2][4][2], const Unit& u, int wr, int wc, int fr, int fq) const {
        const int oc0 = u.pn * 128 + wc * 32 + 8 * fq;
        {
            const int e = (fr < 2) ? fr : fr - 12; const int msel = (fr < 2) ? 0 : 3;
            if (fr < 2 || fr >= 14) {
#pragma unroll
                for (int ai = 0; ai < 2; ++ai) {
                    const int seg = u.pm * 4 + ai * 2 + wr; float* eb = E + ((size_t)seg * 4 + e) * FF2 + oc0;
#pragma unroll
                    for (int bj = 0; bj < 2; ++bj)
#pragma unroll
                        for (int n = 0; n < 2; ++n) { const f32x4 v = (msel == 0) ? acc[ai][bj][0][n] : acc[ai][bj][3][n]; *(f32x4*)(eb + bj * FF + 4 * n) = v; }
                }
            }
        }
#pragma unroll
        for (int n = 0; n < 2; ++n) {
#pragma unroll
            for (int bj = 0; bj < 2; ++bj) {
                const float* cwp = cw + bj * FF + oc0 + 4 * n;
                const f32x4 w0 = *(const f32x4*)(cwp), w1 = *(const f32x4*)(cwp + FF2), w2 = *(const f32x4*)(cwp + 2 * FF2), bb = *(const f32x4*)(cb + bj * FF + oc0 + 4 * n);
#pragma unroll
                for (int ai = 0; ai < 2; ++ai)
#pragma unroll
                    for (int m = 3; m >= 0; --m) {
                        const f32x4 v = acc[ai][bj][m][n]; const f32x4 vp = (m > 0) ? acc[ai][bj][m - 1][n] : v;
                        f32x4 c;
#pragma unroll
                        for (int j = 0; j < 4; ++j) {
                            const float p1 = dpp_f<0x121>(fr == 15 ? vp[j] : v[j]);
                            const float p2 = dpp_f<0x122>(fr >= 14 ? vp[j] : v[j]);
                            c[j] = bb[j] + w0[j] * p2 + w1[j] * p1 + w2[j] * v[j];
                        }
                        asm volatile("" : "+v"(c));
                        acc[ai][bj][m][n] = c;
                    }
                asm volatile("" ::: "memory");
            }
        }
#pragma unroll
        for (int ai = 0; ai < 2; ++ai)
#pragma unroll
            for (int m = 0; m < 4; ++m) {
                const int r = u.pm * 256 + ai * 128 + wr * 64 + m * 16 + fr;
                f32x4 o[2];
#pragma unroll
                for (int n = 0; n < 2; ++n)
#pragma unroll
                    for (int j = 0; j < 4; ++j) o[n][j] = gelu_tanh(acc[ai][0][m][n][j]) * acc[ai][1][m][n][j];
                u32x4 w; w.x = cvt_pk_bf16(o[0][0], o[0][1]); w.y = cvt_pk_bf16(o[0][2], o[0][3]); w.z = cvt_pk_bf16(o[1][0], o[1][1]); w.w = cvt_pk_bf16(o[1][2], o[1][3]);
                if (!(m == 0 && fr < 2)) *(u32x4*)(G + (size_t)r * FF + oc0) = w;
            }
    }
};
}

#ifndef PROBE_REPMASK
#define PROBE_REPMASK 0
#endif
struct Args { const float* in[30]; float* out; unsigned char* ws; int ph_lo, ph_hi, coop, repmask; };
constexpr int NPHASE = 16;
constexpr int LDS_BYTES = 147456;

__device__ __forceinline__ unsigned f2bf(float f) { unsigned u = __builtin_bit_cast(unsigned, f); return (u + 0x7fffu + ((u >> 16) & 1u)) >> 16; }
__device__ __forceinline__ unsigned pk2(float lo, float hi) { return f2bf(lo) | (f2bf(hi) << 16); }
__device__ __forceinline__ void transpose_item(const float* W, int K, int N, bf16_t* WT, int pair_half, LAS float* scr, int item, int lane) {
    const int nblk = N / 32, kb = item / nblk, nb = item % nblk, k0 = 64 * kb, n0 = 32 * nb;
#pragma unroll 8
    for (int i = 0; i < 32; ++i) { const int kk = 2 * i + (lane >> 5); scr[kk * 33 + (lane & 31)] = W[(size_t)(k0 + kk) * N + n0 + (lane & 31)]; }
    asm volatile("s_waitcnt lgkmcnt(0)" ::: "memory");
    int r0 = n0;
    if (pair_half > 0) { const int half = n0 / pair_half, c = n0 % pair_half; r0 = 256 * (c / 128) + 128 * half + (c % 128); }
    const int c = lane & 7;
#pragma unroll
    for (int j = 0; j < 4; ++j) { const int n = (lane >> 3) + 8 * j; const LAS float* s = scr + (8 * c) * 33 + n;
        u32x4 o; o.x = pk2(s[0 * 33], s[1 * 33]); o.y = pk2(s[2 * 33], s[3 * 33]); o.z = pk2(s[4 * 33], s[5 * 33]); o.w = pk2(s[6 * 33], s[7 * 33]);
        *(u32x4*)(WT + (size_t)(r0 + n) * K + k0 + 8 * c) = o; }
    asm volatile("s_waitcnt lgkmcnt(0)" ::: "memory");
}

template <bool HAS_M, bool HAS_NEXT, bool XIN_F32, bool XOUT_F32, bool M_F32 = false>
__device__ __forceinline__ void row_pass(const void* xin, void* xout, const bf16_t* mrow, const float* ssrow, int nslots, const float* gpost, const float* gnext, bf16_t* arow, int lane, const float* saccrow = nullptr, const float* mbias = nullptr) {
    f32x4 v[4];
#pragma unroll
    for (int j = 0; j < 4; ++j) {
        if constexpr (XIN_F32) v[j] = *((const f32x4*)xin + lane + 64 * j);
        else { const u32x2 xw = *((const u32x2*)xin + lane + 64 * j); v[j][0] = __uint_as_float(xw.x << 16); v[j][1] = __uint_as_float(xw.x & 0xffff0000u); v[j][2] = __uint_as_float(xw.y << 16); v[j][3] = __uint_as_float(xw.y & 0xffff0000u); }
    }
    if constexpr (HAS_M) {
        f32x4 mv[4]; float s;
        if constexpr (M_F32) {
            s = 0.f;
#pragma unroll
            for (int j = 0; j < 4; ++j) { mv[j] = mbias ? *((const f32x4*)mbias + lane + 64 * j) : (f32x4){0.f, 0.f, 0.f, 0.f};
                for (int sl = 0; sl < nslots; ++sl) mv[j] += *((const f32x4*)(saccrow + (size_t)sl * MS * DM) + lane + 64 * j);
                s += (mv[j][0] * mv[j][0] + mv[j][1] * mv[j][1]) + (mv[j][2] * mv[j][2] + mv[j][3] * mv[j][3]); }
        } else {
            s = (lane < nslots) ? ssrow[lane] : 0.f;
#pragma unroll
            for (int j = 0; j < 4; ++j) { const u32x2 mw = *((const u32x2*)mrow + lane + 64 * j);
                mv[j][0] = __uint_as_float(mw.x << 16); mv[j][1] = __uint_as_float(mw.x & 0xffff0000u); mv[j][2] = __uint_as_float(mw.y << 16); mv[j][3] = __uint_as_float(mw.y & 0xffff0000u); }
        }
        s = wave_sum(s);
        const float rstd = 1.0f / sqrtf(s * (1.0f / DM) + EPS);
#pragma unroll
        for (int j = 0; j < 4; ++j) {
            const f32x4 gp = *((const f32x4*)gpost + lane + 64 * j);
            v[j] += mv[j] * rstd * gp;
            if constexpr (XOUT_F32) *((f32x4*)xout + lane + 64 * j) = v[j];
            else { u32x2 w; w.x = cvt_pk_bf16(v[j][0], v[j][1]); w.y = cvt_pk_bf16(v[j][2], v[j][3]); *((u32x2*)xout + lane + 64 * j) = w; }
        }
    }
    if constexpr (HAS_NEXT) {
        float s2 = 0.f;
#pragma unroll
        for (int j = 0; j < 4; ++j) s2 += (v[j][0] * v[j][0] + v[j][1] * v[j][1]) + (v[j][2] * v[j][2] + v[j][3] * v[j][3]);
        s2 = wave_sum(s2);
        const float rstd2 = 1.0f / sqrtf(s2 * (1.0f / DM) + EPS);
#pragma unroll
        for (int j = 0; j < 4; ++j) { const f32x4 gn = *((const f32x4*)gnext + lane + 64 * j);
            u32x2 w; w.x = cvt_pk_bf16(v[j][0] * rstd2 * gn[0], v[j][1] * rstd2 * gn[1]); w.y = cvt_pk_bf16(v[j][2] * rstd2 * gn[2], v[j][3] * rstd2 * gn[3]);
            *((u32x2*)arow + lane + 64 * j) = w; }
    }
}

__device__ __forceinline__ s16x4 vtr(LAS const unsigned char* p) { return __builtin_bit_cast(s16x4, __builtin_amdgcn_ds_read_tr16_b64_v4i16((LAS s16x4*)p)); }
__device__ __forceinline__ void attn_unit_coords(int u, int& qrow0, int& krow0, int& kb0, int& kvh) {
    if (u < NB * 128) { const int b = u >> 7, rem = u & 127, c = rem >> 2; kvh = rem & 3; qrow0 = b * SEQ + c * 64; krow0 = qrow0 - 128; kb0 = c >= 2 ? 0 : 2 * (2 - c); }
    else { const int u2 = u - NB * 128, b = u2 >> 2; kvh = u2 & 3; qrow0 = MP + b * 64; krow0 = MP + b * 192; kb0 = 0; }
}
__device__ __forceinline__ void attn_phase(LAS unsigned char* lds, const bf16_t* Qb, const bf16_t* Kb, const bf16_t* Vb, bf16_t* Ob, const float* sinks, int G, int blk) {
    const int tid = threadIdx.x, lane = tid & 63, w = __builtin_amdgcn_readfirstlane(tid >> 6), r32 = lane & 31, hi = lane >> 5;
    constexpr int KST = 144, VST = 192, KOFF = 0, VOFF = 192 * KST, OOFF = VOFF + 192 * VST, OST = 136;
    constexpr int NUNITS = NB * 32 * 4 + DB * 4;
    LAS unsigned char* ostage = lds + OOFF + w * (32 * OST);
    u32x4 kreg[3], vreg[3]; bf16x8 qnext[4];
    int qrow0 = 0, krow0 = 0, kb0 = 0, kvh = 0;
#define ATTN_LOAD(UU) do { int q0_, k0_, b0_, h0_; attn_unit_coords((UU), q0_, k0_, b0_, h0_); \
        _Pragma("unroll") for (int i = 0; i < 3; ++i) { const int p_ = tid + 512 * i, row_ = p_ >> 3, ch_ = p_ & 7; \
            if (row_ >= b0_ * 32) { const size_t go_ = (size_t)(k0_ + row_) * 256 + h0_ * 64 + ch_ * 8; kreg[i] = *(const u32x4*)(Kb + go_); vreg[i] = *(const u32x4*)(Vb + go_); } } \
        { const size_t qr_ = (size_t)q0_ + (w & 1) * 32 + r32; const int hq_ = h0_ * 4 + (w >> 1); \
          _Pragma("unroll") for (int dk = 0; dk < 4; ++dk) qnext[dk] = *(const bf16x8*)(Qb + qr_ * DM + hq_ * 64 + dk * 16 + hi * 8); } } while (0)
    if (blk < NUNITS) ATTN_LOAD(blk);
    for (int u = blk; u < NUNITS; u += G) {
        attn_unit_coords(u, qrow0, krow0, kb0, kvh);
        __syncthreads();
#pragma unroll
        for (int i = 0; i < 3; ++i) { const int p = tid + 512 * i, row = p >> 3, ch = p & 7;
            if (row >= kb0 * 32) { *(LAS u32x4*)(lds + KOFF + row * KST + ch * 16) = kreg[i]; *(LAS u32x4*)(lds + VOFF + row * VST + ch * 16) = vreg[i]; } }
        bf16x8 qf[4];
#pragma unroll
        for (int dk = 0; dk < 4; ++dk) qf[dk] = qnext[dk];
        const int hq = kvh * 4 + (w >> 1); const size_t qrowb = (size_t)qrow0 + (w & 1) * 32;
        __syncthreads();
        if (u + G < NUNITS) ATTN_LOAD(u + G);
        f32x16 sc[6];
        float mx = -3.0e38f;
#pragma unroll
        for (int kb = 0; kb < 6; ++kb) {
            if (kb >= kb0) {
                f32x16 a = {};
#pragma unroll
                for (int dk = 0; dk < 4; ++dk) { const bf16x8 kf = *(const LAS bf16x8*)(lds + KOFF + (32 * kb + r32) * KST + (dk * 16 + hi * 8) * 2); a = __builtin_amdgcn_mfma_f32_32x32x16_bf16(kf, qf[dk], a, 0, 0, 0); }
#pragma unroll
                for (int r = 0; r < 16; ++r) mx = fmaxf(mx, a[r]);
                sc[kb] = a;
            }
        }
        mx = fmaxf(mx, __shfl_xor(mx, 32));
        const float sinkl = sinks[hq] * LOG2E; mx = fmaxf(mx, sinkl);
        float ls = 0.f;
#pragma unroll
        for (int kb = 0; kb < 6; ++kb) {
            if (kb >= kb0) {
#pragma unroll
                for (int r = 0; r < 16; ++r) { const float p = __builtin_amdgcn_exp2f(sc[kb][r] - mx); sc[kb][r] = p; ls += p; }
            }
        }
        ls += __shfl_xor(ls, 32);
        const float inv = 1.0f / (ls + __builtin_amdgcn_exp2f(sinkl - mx));
        f32x16 o[2]; o[0] = f32x16{}; o[1] = f32x16{};
        const int vlane = VOFF + (4 * hi + ((lane >> 2) & 3)) * VST + (16 * ((lane >> 4) & 1) + 4 * (lane & 3)) * 2;
#pragma unroll
        for (int kb = 0; kb < 6; ++kb) {
            if (kb >= kb0) {
#pragma unroll
                for (int s = 0; s < 2; ++s) {
                    u32x4 pw; pw.x = cvt_pk_bf16(sc[kb][8 * s + 0], sc[kb][8 * s + 1]); pw.y = cvt_pk_bf16(sc[kb][8 * s + 2], sc[kb][8 * s + 3]); pw.z = cvt_pk_bf16(sc[kb][8 * s + 4], sc[kb][8 * s + 5]); pw.w = cvt_pk_bf16(sc[kb][8 * s + 6], sc[kb][8 * s + 7]);
                    const bf16x8 pf = __builtin_bit_cast(bf16x8, pw);
#pragma unroll
                    for (int db = 0; db < 2; ++db) {
                        LAS const unsigned char* vp = lds + vlane + (32 * kb + 16 * s) * VST + db * 64;
                        const s16x4 lo = vtr(vp), h4 = vtr(vp + 8 * VST);
                        const bf16x8 vf = (bf16x8){lo[0], lo[1], lo[2], lo[3], h4[0], h4[1], h4[2], h4[3]};
                        o[db] = __builtin_amdgcn_mfma_f32_32x32x16_bf16(vf, pf, o[db], 0, 0, 0);
                    }
                }
            }
        }
#pragma unroll
        for (int db = 0; db < 2; ++db)
#pragma unroll
            for (int rq = 0; rq < 4; ++rq) {
                u32x2 wv; wv.x = cvt_pk_bf16(o[db][4 * rq] * inv, o[db][4 * rq + 1] * inv); wv.y = cvt_pk_bf16(o[db][4 * rq + 2] * inv, o[db][4 * rq + 3] * inv);
                *(LAS u32x2*)(ostage + r32 * OST + (32 * db + 8 * rq + 4 * hi) * 2) = wv;
            }
        asm volatile("s_waitcnt lgkmcnt(0)" ::: "memory");
#pragma unroll
        for (int i = 0; i < 4; ++i) { const int row = i * 8 + (lane >> 3), ch = lane & 7;
            const u32x2 a = *(const LAS u32x2*)(ostage + row * OST + ch * 16), b = *(const LAS u32x2*)(ostage + row * OST + ch * 16 + 8);
            u32x4 v; v.x = a.x; v.y = a.y; v.z = b.x; v.w = b.y;
            *(u32x4*)(Ob + (qrowb + row) * DM + hq * 64 + ch * 8) = v; }
        asm volatile("s_waitcnt lgkmcnt(0)" ::: "memory");
    }
#undef ATTN_LOAD
}

struct SsmP { const float *lam_re, *lam_im, *log_dt, *b_re, *b_im, *c_re, *c_im, *dsk, *st_re, *st_im; float *o_rep, *o_imp, *o_res, *o_ims; };
__device__ __forceinline__ void ssm_phase(LAS unsigned char* lds, const bf16_t* A3, bf16_t* Z, const SsmP P, int G, int blk) {
    const int tid = threadIdx.x, lane = tid & 63, w = __builtin_amdgcn_readfirstlane(tid >> 6), p = lane & 31, hi = lane >> 5;
    const int q = w >> 1, role = w & 1;
    constexpr int IST = 72, IMG = 128 * IST;
    LAS unsigned char* img0 = lds + q * (2 * IMG);
    for (int pass = 0; pass < 2; ++pass) {
        const bool samp = (pass == 0);
        const int nunits = samp ? (DB / 2) * 64 : (NB / 2) * 64, T = samp ? DS : SEQ;
        for (int uu = blk * 4 + q; uu < nunits; uu += G * 4) {
            const int bp = uu >> 6, g = uu & 63;
            const int rowbase0 = samp ? MP + (2 * bp) * DS : (2 * bp) * SEQ, bstride = T;
            const float dt = expf(P.log_dt[g]);
            const int ps = g * 64 + p + 32 * role; const float lr = P.lam_re[ps], li = P.lam_im[ps];
            const float mag = expf(lr * dt); const float lbr = mag * cosf(li * dt), lbi = mag * sinf(li * dt);
            const float nr0 = lbr - 1.0f, ni0 = lbi, den = lr * lr + li * li;
            const float zr = (nr0 * lr + ni0 * li) / den, zi = (ni0 * lr - nr0 * li) / den;
            float hr = 0.f, hm = 0.f;
            const int so = ((2 * bp + hi) * 64 + g) * 64 + p + 32 * role;
            if (samp) { hr = P.st_re[so]; hm = P.st_im[so]; }
            bf16x8 bfre, bfim;
            {
                const float* br = P.b_re + ((size_t)ps) * 16 + 8 * hi; const float* bi = P.b_im + ((size_t)ps) * 16 + 8 * hi;
                const f32x4 br0 = *(const f32x4*)br, br1 = *(const f32x4*)(br + 4), bi0 = *(const f32x4*)bi, bi1 = *(const f32x4*)(bi + 4);
                u32x4 wre, wim;
                wre.x = cvt_pk_bf16(zr * br0[0] - zi * bi0[0], zr * br0[1] - zi * bi0[1]); wre.y = cvt_pk_bf16(zr * br0[2] - zi * bi0[2], zr * br0[3] - zi * bi0[3]);
                wre.z = cvt_pk_bf16(zr * br1[0] - zi * bi1[0], zr * br1[1] - zi * bi1[1]); wre.w = cvt_pk_bf16(zr * br1[2] - zi * bi1[2], zr * br1[3] - zi * bi1[3]);
                wim.x = cvt_pk_bf16(zr * bi0[0] + zi * br0[0], zr * bi0[1] + zi * br0[1]); wim.y = cvt_pk_bf16(zr * bi0[2] + zi * br0[2], zr * bi0[3] + zi * br0[3]);
                wim.z = cvt_pk_bf16(zr * bi1[0] + zi * br1[0], zr * bi1[1] + zi * br1[1]); wim.w = cvt_pk_bf16(zr * bi1[2] + zi * br1[2], zr * bi1[3] + zi * br1[3]);
                bfre = __builtin_bit_cast(bf16x8, wre); bfim = __builtin_bit_cast(bf16x8, wim);
            }
            const int ci = lane & 15, kg = lane >> 4;
            bf16x8 cfrag[4];
#pragma unroll
            for (int kb = 0; kb < 4; ++kb) {
                const float* cp = ((kb < 2) ? P.c_re : P.c_im) + ((size_t)(g * 16 + ci)) * 64 + 32 * (kb & 1) + 8 * kg; const float sg = (kb < 2) ? 1.f : -1.f;
                const f32x4 c0 = *(const f32x4*)cp, c1 = *(const f32x4*)(cp + 4);
                u32x4 wc_; wc_.x = cvt_pk_bf16(sg * c0[0], sg * c0[1]); wc_.y = cvt_pk_bf16(sg * c0[2], sg * c0[3]); wc_.z = cvt_pk_bf16(sg * c1[0], sg * c1[1]); wc_.w = cvt_pk_bf16(sg * c1[2], sg * c1[3]);
                cfrag[kb] = __builtin_bit_cast(bf16x8, wc_);
            }
            const f32x4 dsk4 = *(const f32x4*)(P.dsk + g * 16 + 4 * kg);
            const int hip = (p >> 2) & 1, jp = (p & 3) + 4 * (p >> 3);
            const bf16_t* uptr = A3 + ((size_t)(rowbase0 + hip * bstride + jp)) * DM + g * 16 + 8 * hi;
            const size_t yoff = ((size_t)(rowbase0 + role * bstride + ci)) * DM + g * 16 + 4 * kg;
            const int nblk = T / 16;
            bf16x8 ufA = *(const bf16x8*)uptr, ufB = *(const bf16x8*)(uptr + (size_t)16 * DM), ufC = *(const bf16x8*)(uptr + (size_t)32 * DM);
            u32x2 unA = *(const u32x2*)(A3 + yoff), unB = *(const u32x2*)(A3 + yoff + (size_t)16 * DM), unC = *(const u32x2*)(A3 + yoff + (size_t)32 * DM);
            for (int tb = 0; tb < nblk; ++tb) {
                LAS unsigned char* img = img0 + (tb & 1) * IMG;
                const bf16x8 ucur = ufA; const u32x2 uw = unA;
                ufA = ufB; unA = unB; ufB = ufC; unB = unC;
                if (tb + 3 < nblk) { ufC = *(const bf16x8*)(uptr + (size_t)(tb + 3) * 16 * DM); unC = *(const u32x2*)(A3 + yoff + (size_t)(tb + 3) * 16 * DM); }
                f32x16 Xr, Xi;
                { f32x16 z = {}; Xr = __builtin_amdgcn_mfma_f32_32x32x16_bf16(ucur, bfre, z, 0, 0, 0); Xi = __builtin_amdgcn_mfma_f32_32x32x16_bf16(ucur, bfim, z, 0, 0, 0); }
#pragma unroll
                for (int r = 0; r < 16; ++r) {
                    const float nr = lbr * hr - lbi * hm + Xr[r];
                    const float ni = lbr * hm + lbi * hr + Xi[r];
                    hr = nr; hm = ni; Xr[r] = nr; Xi[r] = ni;
                }
#pragma unroll
                for (int q4 = 0; q4 < 4; ++q4) {
                    u32x2 wr_, wi_; wr_.x = cvt_pk_bf16(Xr[4 * q4], Xr[4 * q4 + 1]); wr_.y = cvt_pk_bf16(Xr[4 * q4 + 2], Xr[4 * q4 + 3]); wi_.x = cvt_pk_bf16(Xi[4 * q4], Xi[4 * q4 + 1]); wi_.y = cvt_pk_bf16(Xi[4 * q4 + 2], Xi[4 * q4 + 3]);
                    *(LAS u32x2*)(img + (role * 32 + p) * IST + (16 * hi + 4 * q4) * 2) = wr_;
                    *(LAS u32x2*)(img + ((2 + role) * 32 + p) * IST + (16 * hi + 4 * q4) * 2) = wi_;
                }
                asm volatile("s_waitcnt lgkmcnt(0)\n\ts_barrier" ::: "memory");
                f32x4 y = {0.f, 0.f, 0.f, 0.f};
#pragma unroll
                for (int kb = 0; kb < 4; ++kb) {
                    LAS const unsigned char* ap = img + (32 * kb + 8 * kg + (ci >> 2)) * IST + (16 * role + 4 * (ci & 3)) * 2;
                    const s16x4 lo = vtr(ap), h4 = vtr(ap + 4 * IST);
                    const bf16x8 af = (bf16x8){lo[0], lo[1], lo[2], lo[3], h4[0], h4[1], h4[2], h4[3]};
                    y = __builtin_amdgcn_mfma_f32_16x16x32_bf16(cfrag[kb], af, y, 0, 0, 0);
                }
                const float z0 = gelu_tanh(y[0] + dsk4[0] * __uint_as_float(uw.x << 16)), z1 = gelu_tanh(y[1] + dsk4[1] * __uint_as_float(uw.x & 0xffff0000u));
                const float z2 = gelu_tanh(y[2] + dsk4[2] * __uint_as_float(uw.y << 16)), z3 = gelu_tanh(y[3] + dsk4[3] * __uint_as_float(uw.y & 0xffff0000u));
                u32x2 zw; zw.x = cvt_pk_bf16(z0, z1); zw.y = cvt_pk_bf16(z2, z3);
                *(u32x2*)(Z + yoff + (size_t)tb * 16 * DM) = zw;
                asm volatile("s_waitcnt lgkmcnt(0)" ::: "memory");
            }
            if (samp) { P.o_res[so] = hr; P.o_ims[so] = hm; } else { P.o_rep[so] = hr; P.o_imp[so] = hm; }
        }
        __syncthreads();
    }
}

#define XB_TMO      128
#define XB_XCNT(j)  (256  + 64 * (j))
#define XB_XSUB(j)  (1280 + 64 * (j))
#define XB_XGEN(j)  (2304 + 64 * (j))
#define XB_TOP      3328
#define XB_TOPGEN   3392
#define XCD_BAR_WORDS 3456
#define XB_SPIN_CAP (1u << 18)
__device__ __forceinline__ unsigned xb_ld(unsigned* p)              { return __hip_atomic_load(p, __ATOMIC_RELAXED, __HIP_MEMORY_SCOPE_AGENT); }
__device__ __forceinline__ unsigned xb_add(unsigned* p, unsigned v) { return __hip_atomic_fetch_add(p, v, __ATOMIC_RELAXED, __HIP_MEMORY_SCOPE_AGENT); }
__device__ __forceinline__ unsigned xb_xcc_id() { return (unsigned)__builtin_amdgcn_s_getreg((3 << 11) | 20) & 0xFu; }
#define XB_SPIN(cond, bar) do { unsigned _sp = 0; while (cond) { __builtin_amdgcn_s_sleep(1); \
    if ((++_sp & 255u) == 0u) { if (xb_ld(&(bar)[XB_TMO])) break; if (_sp > XB_SPIN_CAP) { atomicAdd(&(bar)[XB_TMO], 1u); break; } } } } while (0)
struct XcdBarrier { unsigned* bar; unsigned x; volatile LAS unsigned* st; };
__device__ __forceinline__ XcdBarrier xcd_barrier_post(unsigned* bar, volatile LAS unsigned* st) {
    XcdBarrier b; b.bar = bar; b.x = xb_xcc_id(); b.st = st;
    if (threadIdx.x == 0) (void)xb_add(&bar[XB_XCNT(b.x)], 1u);
    return b;
}
__device__ __forceinline__ void xcd_barrier_complete(unsigned* bar, unsigned x, unsigned& nloc, unsigned& nx) {
    const unsigned G = gridDim.x * gridDim.y * gridDim.z;
    unsigned sum, cnt, mine, sp = 0u;
    for (;;) {
        sum = 0u; cnt = 0u; mine = 0u;
#pragma unroll
        for (unsigned j = 0; j < 16; ++j) { const unsigned c = xb_ld(&bar[XB_XCNT(j)]); sum += c; cnt += (c > 0u) ? 1u : 0u; mine = (j == x) ? c : mine; }
        if (sum == G) break;
        __builtin_amdgcn_s_sleep(1);
        if ((++sp & 255u) == 0u) { if (xb_ld(&bar[XB_TMO])) break; if (sp > XB_SPIN_CAP) { atomicAdd(&bar[XB_TMO], 1u); break; } }
    }
    nloc = mine > 0u ? mine : 1u; nx = cnt > 0u ? cnt : 1u;
}
__device__ __forceinline__ void xcd_barrier(const XcdBarrier& b) {
    asm volatile("s_waitcnt vmcnt(0)" ::: "memory");
    __syncthreads();
    if (threadIdx.x == 0) {
        unsigned* bar = b.bar;
        __builtin_amdgcn_s_waitcnt(0);
        unsigned nloc = b.st[0], nx = b.st[1];
        if (nloc == 0u) { xcd_barrier_complete(bar, b.x, nloc, nx); b.st[0] = nloc; b.st[1] = nx; }
        const unsigned old = xb_add(&bar[XB_XSUB(b.x)], 1u);
        const unsigned gen = old / nloc;
        if (old + 1u == (gen + 1u) * nloc) {
            __builtin_amdgcn_fence(__ATOMIC_RELEASE, "agent");
            asm volatile("s_waitcnt vmcnt(0)" ::: "memory");
            const unsigned og = xb_add(&bar[XB_TOP], 1u);
            const unsigned tg = og / nx;
            if (og + 1u == (tg + 1u) * nx) xb_add(&bar[XB_TOPGEN], 1u);
            else XB_SPIN(xb_ld(&bar[XB_TOPGEN]) == tg, bar);
            __builtin_amdgcn_fence(__ATOMIC_ACQUIRE, "agent");
            xb_add(&bar[XB_XGEN(b.x)], 1u);
            asm volatile("s_waitcnt vmcnt(0)" ::: "memory");
        } else {
            XB_SPIN(xb_ld(&bar[XB_XGEN(b.x)]) == gen, bar);
            __builtin_amdgcn_fence(__ATOMIC_ACQUIRE, "agent");
            asm volatile("s_waitcnt vmcnt(0)" ::: "memory");
        }
    }
    __syncthreads();
}

__device__ __forceinline__ void phase_prologue(LAS unsigned char* lds, const Args& args, unsigned char* ws, float* out, int G, int blk, int wave, int lane, int tid) {
    const int gw = blk * 8 + wave, NGW = G * 8;
    bf16_t* Wqkv = (bf16_t*)(ws + WS_WQKV); bf16_t* Wo = (bf16_t*)(ws + WS_WO); bf16_t* Wglu = (bf16_t*)(ws + WS_WGLU); bf16_t* Wup = (bf16_t*)(ws + WS_WUP); bf16_t* Wdn = (bf16_t*)(ws + WS_WDN);
    float* rope = (float*)(ws + WS_ROPE); bf16_t* Abuf = (bf16_t*)(ws + WS_A); bf16_t* Kbuf = (bf16_t*)(ws + WS_K); bf16_t* Vbuf = (bf16_t*)(ws + WS_V);
    LAS float* scr = (LAS float*)(lds + wave * 16384);
    constexpr int I_QKV = 16 * 48, I_O = 16 * 32, I_GLU = 16 * 64, I_UP = 16 * 176, I_DN = 44 * 32;
    constexpr int NITEMS = I_QKV + I_O + I_GLU + 2 * I_UP + 2 * I_DN;
    for (int it = gw; it < NITEMS; it += NGW) {
        int r = it;
        if (r < I_QKV) { transpose_item(args.in[11], DM, QKVD, Wqkv, 0, scr, r, lane); continue; } r -= I_QKV;
        if (r < I_O) { transpose_item(args.in[14], DM, DM, Wo, 0, scr, r, lane); continue; } r -= I_O;
        if (r < I_GLU) { transpose_item(args.in[24], DM, 2 * DM, Wglu, DM, scr, r, lane); continue; } r -= I_GLU;
        if (r < 2 * I_UP) { const int l = r / I_UP; transpose_item(args.in[26] + (size_t)l * DM * FF2, DM, FF2, Wup + (size_t)l * FF2 * DM, FF, scr, r % I_UP, lane); continue; } r -= 2 * I_UP;
        { const int l = r / I_DN; transpose_item(args.in[29] + (size_t)l * FF * DM, FF, DM, Wdn + (size_t)l * DM * FF, 0, scr, r % I_DN, lane); }
    }
    for (int i = blk * 512 + tid; i < SEQ * 8; i += G * 512) { const int pos = i >> 3, f = i & 7; const float inv_freq = powf(500000.0f, -(float)f * 0.125f); const float ang = (float)pos * inv_freq;
        rope[pos * 16 + f] = cosf(ang); rope[pos * 16 + 8 + f] = sinf(ang); }
    for (int i = blk * 512 + tid; i < DB * 128 * 64; i += G * 512) {
        const int b = i / (128 * 64), rem = i % (128 * 64), row = rem >> 6, c4 = (rem & 63) * 4;
        const f32x4 kv = *(const f32x4*)(args.in[2] + ((size_t)(b * 128 + row)) * 256 + c4), vv = *(const f32x4*)(args.in[3] + ((size_t)(b * 128 + row)) * 256 + c4);
        u32x2 kw, vw; kw.x = cvt_pk_bf16(kv[0], kv[1]); kw.y = cvt_pk_bf16(kv[2], kv[3]); vw.x = cvt_pk_bf16(vv[0], vv[1]); vw.y = cvt_pk_bf16(vv[2], vv[3]);
        const size_t krow = (size_t)MP + b * 192 + row;
        *(u32x2*)(Kbuf + krow * 256 + c4) = kw; *(u32x2*)(Vbuf + krow * 256 + c4) = vw;
        if (row >= 64) { *(f32x4*)(out + O_KS + ((size_t)(b * 128 + row - 64)) * 256 + c4) = kv; *(f32x4*)(out + O_VS + ((size_t)(b * 128 + row - 64)) * 256 + c4) = vv; }
    }
    {
        f32x4 gn[4], xa[4], xb_[4];
#pragma unroll
        for (int j = 0; j < 4; ++j) gn[j] = *((const f32x4*)args.in[7] + lane + 64 * j);
#define P0_X(mm) (((mm) < MP) ? args.in[0] + (size_t)(mm) * DM : args.in[1] + (size_t)((mm) - MP) * DM)
        int m = gw;
        if (m < MT) {
#pragma unroll
            for (int j = 0; j < 4; ++j) xa[j] = *((const f32x4*)P0_X(m) + lane + 64 * j);
        }
        for (; m < MT; m += NGW) {
            const int mn = m + NGW;
            if (mn < MT) {
#pragma unroll
                for (int j = 0; j < 4; ++j) xb_[j] = *((const f32x4*)P0_X(mn) + lane + 64 * j);
            }
            float s2 = 0.f;
#pragma unroll
            for (int j = 0; j < 4; ++j) s2 += (xa[j][0] * xa[j][0] + xa[j][1] * xa[j][1]) + (xa[j][2] * xa[j][2] + xa[j][3] * xa[j][3]);
            const float rstd2 = 1.0f / sqrtf(wave_sum(s2) * (1.0f / DM) + EPS);
#pragma unroll
            for (int j = 0; j < 4; ++j) { u32x2 w; w.x = cvt_pk_bf16(xa[j][0] * rstd2 * gn[j][0], xa[j][1] * rstd2 * gn[j][1]); w.y = cvt_pk_bf16(xa[j][2] * rstd2 * gn[j][2], xa[j][3] * rstd2 * gn[j][3]);
                *((u32x2*)(Abuf + (size_t)m * DM) + lane + 64 * j) = w; xa[j] = xb_[j]; }
        }
#undef P0_X
    }
}

template <bool XIN_F32>
__device__ __forceinline__ void rp_load(const void* xrow, const bf16_t* mrow, const float* ssrow, int nslots, int lane, f32x4 (&xf)[4], u32x2 (&xb)[4], u32x2 (&mw)[4], float& ssv) {
#pragma unroll
    for (int j = 0; j < 4; ++j) {
        if constexpr (XIN_F32) xf[j] = *((const f32x4*)xrow + lane + 64 * j); else xb[j] = *((const u32x2*)xrow + lane + 64 * j);
        mw[j] = *((const u32x2*)mrow + lane + 64 * j);
    }
    ssv = (lane < nslots) ? ssrow[lane] : 0.f;
}
template <int MODE>
__device__ __forceinline__ void rp_finish(const f32x4 (&xf)[4], const u32x2 (&xb)[4], const u32x2 (&mw)[4], float ssv, const f32x4 (&gp)[4], const f32x4 (&gn)[4], void* xout, bf16_t* arow, int lane) {
    f32x4 v[4];
    const float rstd = 1.0f / sqrtf(wave_sum(ssv) * (1.0f / DM) + EPS);
    float s2 = 0.f;
#pragma unroll
    for (int j = 0; j < 4; ++j) {
        if constexpr (MODE == 0) v[j] = xf[j];
        else { v[j][0] = __uint_as_float(xb[j].x << 16); v[j][1] = __uint_as_float(xb[j].x & 0xffff0000u); v[j][2] = __uint_as_float(xb[j].y << 16); v[j][3] = __uint_as_float(xb[j].y & 0xffff0000u); }
        f32x4 mv; mv[0] = __uint_as_float(mw[j].x << 16); mv[1] = __uint_as_float(mw[j].x & 0xffff0000u); mv[2] = __uint_as_float(mw[j].y << 16); mv[3] = __uint_as_float(mw[j].y & 0xffff0000u);
        v[j] += mv * rstd * gp[j];
        if constexpr (MODE == 2) *((f32x4*)xout + lane + 64 * j) = v[j];
        else { u32x2 w; w.x = cvt_pk_bf16(v[j][0], v[j][1]); w.y = cvt_pk_bf16(v[j][2], v[j][3]); *((u32x2*)xout + lane + 64 * j) = w; }
        s2 += (v[j][0] * v[j][0] + v[j][1] * v[j][1]) + (v[j][2] * v[j][2] + v[j][3] * v[j][3]);
    }
    if constexpr (MODE != 2) {
        const float rstd2 = 1.0f / sqrtf(wave_sum(s2) * (1.0f / DM) + EPS);
#pragma unroll
        for (int j = 0; j < 4; ++j) { u32x2 w; w.x = cvt_pk_bf16(v[j][0] * rstd2 * gn[j][0], v[j][1] * rstd2 * gn[j][1]); w.y = cvt_pk_bf16(v[j][2] * rstd2 * gn[j][2], v[j][3] * rstd2 * gn[j][3]);
            *((u32x2*)arow + lane + 64 * j) = w; }
    }
}
template <int MODE>
__device__ __forceinline__ void phase_rows(const float* x_prompt, const float* x_sample, bf16_t* X16, float* out, const bf16_t* Mbuf, const float* ss, int nslots, const float* gpost, const float* gnext, bf16_t* Abuf, int gw, int NGW, int lane, const float* sacc, const float* mbias, int ns) {
    int m = gw;
    {
        f32x4 gp[4], gn[4];
#pragma unroll
        for (int j = 0; j < 4; ++j) { gp[j] = *((const f32x4*)gpost + lane + 64 * j); gn[j] = (MODE != 2) ? *((const f32x4*)gnext + lane + 64 * j) : (f32x4){0.f, 0.f, 0.f, 0.f}; }
        f32x4 xfA[4], xfB[4]; u32x2 xbA[4], xbB[4], mwA[4], mwB[4]; float ssA = 0.f, ssB = 0.f;
#define RP_X(mm) ((MODE == 0) ? (const void*)(x_prompt + (size_t)(mm) * DM) : (const void*)(X16 + (size_t)(mm) * DM))
        if (m < MP) rp_load<MODE == 0>(RP_X(m), Mbuf + (size_t)m * DM, ss + (size_t)m * 32, nslots, lane, xfA, xbA, mwA, ssA);
        for (; m < MP; m += NGW) {
            const int mn = m + NGW;
            if (mn < MP) rp_load<MODE == 0>(RP_X(mn), Mbuf + (size_t)mn * DM, ss + (size_t)mn * 32, nslots, lane, xfB, xbB, mwB, ssB);
            rp_finish<MODE>(xfA, xbA, mwA, ssA, gp, gn, (MODE == 2) ? (void*)(out + (size_t)m * DM) : (void*)(X16 + (size_t)m * DM), Abuf + (size_t)m * DM, lane);
#pragma unroll
            for (int j = 0; j < 4; ++j) { xfA[j] = xfB[j]; xbA[j] = xbB[j]; mwA[j] = mwB[j]; }
            ssA = ssB;
        }
#undef RP_X
    }
    for (; m < MT; m += NGW) {
        const bool sp = (sacc != nullptr) && (m >= MP); const float* sr = sp ? sacc + (size_t)(m - MP) * DM : nullptr;
        if constexpr (MODE == 0) { const float* xr = (m < MP) ? x_prompt + (size_t)m * DM : x_sample + (size_t)(m - MP) * DM;
            if (sp) row_pass<true, true, true, false, true>(xr, X16 + (size_t)m * DM, nullptr, nullptr, ns, gpost, gnext, Abuf + (size_t)m * DM, lane, sr, mbias);
            else row_pass<true, true, true, false>(xr, X16 + (size_t)m * DM, Mbuf + (size_t)m * DM, ss + (size_t)m * 32, nslots, gpost, gnext, Abuf + (size_t)m * DM, lane); }
        else if constexpr (MODE == 1) {
            if (sp) row_pass<true, true, false, false, true>(X16 + (size_t)m * DM, X16 + (size_t)m * DM, nullptr, nullptr, ns, gpost, gnext, Abuf + (size_t)m * DM, lane, sr, mbias);
            else row_pass<true, true, false, false>(X16 + (size_t)m * DM, X16 + (size_t)m * DM, Mbuf + (size_t)m * DM, ss + (size_t)m * 32, nslots, gpost, gnext, Abuf + (size_t)m * DM, lane); }
        else {
            if (sp) row_pass<true, false, false, true, true>(X16 + (size_t)m * DM, out + (size_t)m * DM, nullptr, nullptr, ns, gpost, nullptr, nullptr, lane, sr, mbias);
            else row_pass<true, false, false, true>(X16 + (size_t)m * DM, out + (size_t)m * DM, Mbuf + (size_t)m * DM, ss + (size_t)m * 32, nslots, gpost, nullptr, nullptr, lane); }
    }
}
__device__ __forceinline__ void phase_up(LAS unsigned char* lds, const bf16_t* Abuf, const bf16_t* Wup_l, bf16_t* Gbuf, float* Ebuf, const float* cw, const float* cb, int G, int blk) {
    pg8::Gemm g{Abuf, Wup_l, MT, FF2, DM}; pg8::StaticOrder S; S.init(MT, FF2, DM, G, blk);
    pg8::EpiUp E{Gbuf, Ebuf, cw, cb};
    pg8::gemm_phase<pg8::EpiUp, true, true>(lds, g, S, E);
}
__device__ __forceinline__ void phase_down(LAS unsigned char* lds, const bf16_t* Gbuf, const bf16_t* Wdn_l, bf16_t* Mbuf, float* ss, float* sacc, int G, int blk) {
    pg8::Gemm g{Gbuf, Wdn_l, MT, DM, FF}; pg8::StaticOrder S; S.init(MT, DM, FF, G, blk, MP / 256, 11);
    pg8::EpiPlainSS E{Mbuf, nullptr, ss, sacc, FF / 64};
    pg8::gemm_phase<pg8::EpiPlainSS, true, true>(lds, g, S, E);
}
__device__ __forceinline__ void phase_fix(const float* Ebuf, bf16_t* Gbuf, const float* cw, const float* cb, const float* cc, float* out, int l, int G, int blk, int tid) {
    for (int i = blk * 512 + tid; i < NSEG * 2 * (FF / 4); i += G * 512) {
        const int ri = i / (FF / 4), c4 = (i % (FF / 4)) * 4, seg = ri >> 1, j = ri & 1;
        f32x4 o;
        f32x4 cres[2];
#pragma unroll
        for (int hf = 0; hf < 2; ++hf) {
            const int col = hf * FF + c4;
            const f32x4 cur0 = *(const f32x4*)(Ebuf + ((size_t)seg * 4 + 0) * FF2 + col), cur1 = *(const f32x4*)(Ebuf + ((size_t)seg * 4 + 1) * FF2 + col);
            f32x4 p0 = {0.f, 0.f, 0.f, 0.f}, p1 = {0.f, 0.f, 0.f, 0.f};
            if (seg >= MP / 64) { const int b = seg - MP / 64; p0 = *(const f32x4*)(cc + ((size_t)b * 2 + 0) * FF2 + col); p1 = *(const f32x4*)(cc + ((size_t)b * 2 + 1) * FF2 + col); }
            else if ((seg & 31) != 0) { p0 = *(const f32x4*)(Ebuf + ((size_t)(seg - 1) * 4 + 2) * FF2 + col); p1 = *(const f32x4*)(Ebuf + ((size_t)(seg - 1) * 4 + 3) * FF2 + col); }
            const f32x4 w0 = *(const f32x4*)(cw + col), w1 = *(const f32x4*)(cw + FF2 + col), w2 = *(const f32x4*)(cw + 2 * FF2 + col), bb = *(const f32x4*)(cb + col);
            cres[hf] = (j == 0) ? (bb + w0 * p0 + w1 * p1 + w2 * cur0) : (bb + w0 * p1 + w1 * cur0 + w2 * cur1);
        }
#pragma unroll
        for (int q = 0; q < 4; ++q) o[q] = gelu_tanh(cres[0][q]) * cres[1][q];
        u32x2 wv; wv.x = cvt_pk_bf16(o[0], o[1]); wv.y = cvt_pk_bf16(o[2], o[3]);
        *(u32x2*)(Gbuf + ((size_t)seg * 64 + j) * FF + c4) = wv;
    }
    for (int i = blk * 512 + tid; i < (NB + DB) * 2 * (FF2 / 4); i += G * 512) {
        const int ri = i / (FF2 / 4), c4 = (i % (FF2 / 4)) * 4, bb = ri >> 1, e = ri & 1;
        const int seg = (bb < NB) ? bb * 32 + 31 : MP / 64 + (bb - NB);
        const f32x4 v = *(const f32x4*)(Ebuf + ((size_t)seg * 4 + 2 + e) * FF2 + c4);
        float* o = (bb < NB) ? out + O_CP + (((size_t)l * NB + bb) * 2 + e) * FF2 + c4 : out + O_CS + (((size_t)l * DB + (bb - NB)) * 2 + e) * FF2 + c4;
        *(f32x4*)o = v;
    }
}

__global__ void __launch_bounds__(512, 2) fwd_kernel(Args args) {
    extern __shared__ __attribute__((aligned(16))) unsigned char lds_raw[];
    LAS unsigned char* lds = (LAS unsigned char*)lds_raw;
    const int tid = threadIdx.x, lane = tid & 63, wave = __builtin_amdgcn_readfirstlane(tid >> 6);
    const int G = gridDim.x, blk = blockIdx.x;
    const int gw = blk * 8 + wave, NGW = G * 8;
    unsigned char* ws = args.ws; float* out = args.out;
    const float* x_prompt = args.in[0]; const float* x_sample = args.in[1];
    bf16_t* Wqkv = (bf16_t*)(ws + WS_WQKV); bf16_t* Wo = (bf16_t*)(ws + WS_WO); bf16_t* Wglu = (bf16_t*)(ws + WS_WGLU); bf16_t* Wup = (bf16_t*)(ws + WS_WUP); bf16_t* Wdn = (bf16_t*)(ws + WS_WDN);
    float* rope = (float*)(ws + WS_ROPE); float* ss = (float*)(ws + WS_SS);
    bf16_t* Abuf = (bf16_t*)(ws + WS_A); bf16_t* Mbuf = (bf16_t*)(ws + WS_MB); float* Ebuf = (float*)(ws + WS_E); bf16_t* Gbuf = (bf16_t*)(ws + WS_G);
    bf16_t* X16 = (bf16_t*)(ws + WS_X16); float* sacc = (float*)(ws + WS_SACC);
    bf16_t* Qbuf = (bf16_t*)(ws + WS_Q); bf16_t* Kbuf = (bf16_t*)(ws + WS_K); bf16_t* Vbuf = (bf16_t*)(ws + WS_V);


    const int lo = args.ph_lo, hi_ = args.ph_hi;
    volatile LAS unsigned* misc = (volatile LAS unsigned*)(lds + 131072 + 1024);
    if (tid < 2) misc[tid] = 0u;
    __syncthreads();
    XcdBarrier xbar; xbar.bar = (unsigned*)ws; xbar.x = 0; xbar.st = nullptr;
    if (args.coop) xbar = xcd_barrier_post((unsigned*)ws, misc);
    if (args.coop == 2) cg::this_grid().sync();
#define IN(k) (lo <= (k) && (k) < hi_)
#define SEAM(k) do { if (args.coop && (k) + 1 < hi_) xcd_barrier(xbar); } while (0)
#define REP(k) _Pragma("unroll") for (int rep_ = 0; rep_ <= ((PROBE_REPMASK >> (k)) & 1); ++rep_)
    if (IN(0)) { REP(0) { phase_prologue(lds, args, ws, out, G, blk, wave, lane, tid); } SEAM(0); }
    if (IN(1)) { REP(1) {
        pg8::Gemm g{Abuf, Wqkv, MT, QKVD, DM}; pg8::StaticOrder S; S.init(MT, QKVD, DM, G, blk);
        pg8::EpiQKV E{Qbuf, Kbuf, Vbuf, args.in[12], rope, out + O_KP, out + O_VP, out + O_KS, out + O_VS};
        pg8::gemm_phase<pg8::EpiQKV, true, true>(lds, g, S, E); } SEAM(1); }
    if (IN(2)) { REP(2) { attn_phase(lds, Qbuf, Kbuf, Vbuf, Abuf, args.in[13], G, blk); } SEAM(2); }
    if (IN(3)) { REP(3) {
        pg8::Gemm g{Abuf, Wo, MT, DM, DM}; pg8::StaticOrder S; S.init(MT, DM, DM, G, blk, MP / 256, 4);
        pg8::EpiPlainSS E{Mbuf, args.in[15], ss, sacc, DM / 64};
        pg8::gemm_phase<pg8::EpiPlainSS, true, true>(lds, g, S, E); } SEAM(3); }
    if (IN(4)) { REP(4) { phase_rows<0>(x_prompt, x_sample, X16, out, Mbuf, ss, 16, args.in[8], args.in[9], Abuf, gw, NGW, lane, sacc, args.in[15], 4); } SEAM(4); }
    if (IN(5)) { REP(5) { phase_up(lds, Abuf, Wup, Gbuf, Ebuf, args.in[27], args.in[28], G, blk); } SEAM(5); }
    if (IN(6)) { REP(6) { phase_fix(Ebuf, Gbuf, args.in[27], args.in[28], args.in[6], out, 0, G, blk, tid); } SEAM(6); }
    if (IN(7)) { REP(7) { phase_down(lds, Gbuf, Wdn, Mbuf, ss, sacc, G, blk); } SEAM(7); }
    if (IN(8)) { REP(8) { phase_rows<1>(x_prompt, x_sample, X16, out, Mbuf, ss, 16, args.in[10], args.in[7] + DM, Abuf, gw, NGW, lane, sacc, nullptr, 11); } SEAM(8); }
    if (IN(9)) { REP(9) {
        SsmP P{args.in[16], args.in[17], args.in[18], args.in[19], args.in[20], args.in[21], args.in[22], args.in[23], args.in[4], args.in[5], out + O_REP, out + O_IMP, out + O_RES, out + O_IMS};
        ssm_phase(lds, Abuf, Qbuf, P, G, blk); } SEAM(9); }
    if (IN(10)) { REP(10) {
        pg8::Gemm g{Qbuf, Wglu, MT, 2 * DM, DM}; pg8::StaticOrder S; S.init(MT, 2 * DM, DM, G, blk);
        pg8::EpiGlu E{Mbuf, args.in[25], ss};
        pg8::gemm_phase<pg8::EpiGlu, true, true>(lds, g, S, E); } SEAM(10); }
    if (IN(11)) { REP(11) { phase_rows<1>(x_prompt, x_sample, X16, out, Mbuf, ss, 32, args.in[8] + DM, args.in[9] + DM, Abuf, gw, NGW, lane, nullptr, nullptr, 0); } SEAM(11); }
    if (IN(12)) { REP(12) { phase_up(lds, Abuf, Wup + (size_t)FF2 * DM, Gbuf, Ebuf, args.in[27] + (size_t)3 * FF2, args.in[28] + FF2, G, blk); } SEAM(12); }
    if (IN(13)) { REP(13) { phase_fix(Ebuf, Gbuf, args.in[27] + (size_t)3 * FF2, args.in[28] + FF2, args.in[6] + (size_t)DB * 2 * FF2, out, 1, G, blk, tid); } SEAM(13); }
    if (IN(14)) { REP(14) { phase_down(lds, Gbuf, Wdn + (size_t)DM * FF, Mbuf, ss, sacc, G, blk); } SEAM(14); }
    if (IN(15)) { REP(15) { phase_rows<2>(x_prompt, x_sample, X16, out, Mbuf, ss, 16, args.in[10] + DM, nullptr, nullptr, gw, NGW, lane, sacc, nullptr, 11); } }
#undef IN
#undef SEAM
#undef REP
}

extern "C" void kernel_launch(void* const* d_in, const int* in_sizes, int n_in, void* d_out, int out_size, void* d_ws, size_t ws_size, hipStream_t stream) {
    static int grid = 0;
    if (grid == 0) {
        if (n_in != 30 || (size_t)out_size != O_END || ws_size < WS_END) { fprintf(stderr, "kernel_launch: unexpected shapes: n_in %d out %d ws %zu (need out %zu ws %zu)\n", n_in, out_size, ws_size, (size_t)O_END, (size_t)WS_END); grid = -1; return; }
        int dev = 0, cus = 0, per_cu = 0;
        hipGetDevice(&dev); hipDeviceGetAttribute(&cus, hipDeviceAttributeMultiprocessorCount, dev);
        if (hipFuncSetAttribute((const void*)fwd_kernel, hipFuncAttributeMaxDynamicSharedMemorySize, LDS_BYTES) != hipSuccess) { fprintf(stderr, "kernel_launch: hipFuncSetAttribute failed\n"); grid = -1; return; }
        if (hipOccupancyMaxActiveBlocksPerMultiprocessor(&per_cu, (const void*)fwd_kernel, 512, LDS_BYTES) != hipSuccess || per_cu < 1) { fprintf(stderr, "kernel_launch: occupancy query says %d\n", per_cu); per_cu = 1; }
        (void)hipGetLastError();
        grid = cus * 1;
    }
    if (grid < 0) return;
    Args a{};
    for (int i = 0; i < 30; ++i) a.in[i] = (const float*)d_in[i];
    a.out = (float*)d_out; a.ws = (unsigned char*)d_ws;
#ifndef MK_MULTI
    if (hipMemsetAsync(d_ws, 0, 16384, stream) != hipSuccess) { fprintf(stderr, "kernel_launch: memset failed\n"); return; }
    a.ph_lo = 0; a.ph_hi = NPHASE; a.coop = 1;
    void* kargs[] = {&a};
    hipError_t e = hipLaunchCooperativeKernel((const void*)fwd_kernel, dim3(grid), dim3(512), kargs, LDS_BYTES, stream);
    if (e != hipSuccess) fprintf(stderr, "cooperative launch failed: %s (grid %d)\n", hipGetErrorString(e), grid);
#else
    for (int ph = 0; ph < NPHASE; ++ph) { a.ph_lo = ph; a.ph_hi = ph + 1; a.coop = 0; hipLaunchKernelGGL(fwd_kernel, dim3(grid), dim3(512), LDS_BYTES, stream, a); }
#endif
}
```

```cpp
#include <hip/hip_runtime.h>
#include <hip/hip_cooperative_groups.h>
#include <cstdio>
#include <cstdint>
namespace cg = cooperative_groups;

#define LAS __attribute__((address_space(3)))
typedef unsigned short bf16_t;
typedef short bf16x8 __attribute__((ext_vector_type(8)));
typedef short s16x4 __attribute__((ext_vector_type(4)));
typedef float f32x4 __attribute__((ext_vector_type(4)));
typedef float f32x16 __attribute__((ext_vector_type(16)));
typedef unsigned u32x4 __attribute__((ext_vector_type(4)));
typedef unsigned u32x2 __attribute__((ext_vector_type(2)));

constexpr int DM = 1024, NB = 32, SEQ = 2048, MP = NB * SEQ, DB = 16, DS = 64, MS = DB * DS, MT = MP + MS;
constexpr int QKVD = 1536, FF = 2816, FF2 = 5632, NSEG = MT / 64;
constexpr int KVROWS = MP + DB * 192;
constexpr float EPS = 1e-6f, LOG2E = 1.4426950408889634f, QSCALE = 0.125f * 1.4426950408889634f;
constexpr size_t O_Y = 0, O_KP = (size_t)MT * DM, O_VP = O_KP + (size_t)NB * 128 * 256, O_KS = O_VP + (size_t)NB * 128 * 256, O_VS = O_KS + (size_t)DB * 128 * 256,
                 O_REP = O_VS + (size_t)DB * 128 * 256, O_IMP = O_REP + NB * 4096, O_RES = O_IMP + NB * 4096, O_IMS = O_RES + DB * 4096,
                 O_CP = O_IMS + DB * 4096, O_CS = O_CP + (size_t)2 * NB * 2 * FF2, O_END = O_CS + (size_t)2 * DB * 2 * FF2;
constexpr size_t MiB = 1u << 20;
constexpr size_t WS_WQKV = 1 * MiB, WS_WO = 4 * MiB, WS_WGLU = 6 * MiB, WS_WUP = 10 * MiB, WS_WDN = 32 * MiB, WS_ROPE = 43 * MiB, WS_SS = 44 * MiB,
                 WS_A = 54 * MiB, WS_MB = 185 * MiB, WS_E = 316 * MiB, WS_G = 406 * MiB, WS_Q = WS_G, WS_K = WS_G + 132 * MiB, WS_V = WS_K + 34 * MiB, WS_X16 = WS_G + 358 * MiB, WS_SACC = WS_X16 + 131 * MiB, WS_XCH = WS_SACC + 44 * MiB, WS_END = WS_XCH + 13 * MiB;
constexpr size_t WS_CNT = 32768, CTL_ZERO_BYTES = 32768 + 3 * 256 * 256;
static_assert(WS_WUP + (size_t)2 * FF2 * DM * 2 <= WS_WDN && WS_WDN + (size_t)2 * DM * FF * 2 <= WS_ROPE && WS_SS + (size_t)MT * 32 * 4 <= WS_A, "ws map 1");
static_assert(WS_A + (size_t)MT * DM * 2 <= WS_MB && WS_MB + (size_t)MT * DM * 2 <= WS_E && WS_E + (size_t)NSEG * 4 * FF2 * 4 <= WS_G, "ws map 2");
static_assert(WS_X16 + (size_t)MT * DM * 2 <= WS_END, "ws map 4");
static_assert(WS_Q + (size_t)MT * DM * 2 <= WS_K && WS_K + (size_t)KVROWS * 256 * 2 <= WS_V && WS_V + (size_t)KVROWS * 256 * 2 <= WS_END && WS_G + (size_t)MT * FF * 2 <= WS_END, "ws map 3");

__device__ __forceinline__ unsigned cvt_pk_bf16(float lo, float hi) { unsigned r; asm volatile("v_cvt_pk_bf16_f32 %0, %1, %2" : "=v"(r) : "v"(lo), "v"(hi)); return r; }
__device__ __forceinline__ void unpack8(const u32x4 w, f32x4& lo, f32x4& hi) {
    lo[0] = __uint_as_float(w.x << 16); lo[1] = __uint_as_float(w.x & 0xffff0000u); lo[2] = __uint_as_float(w.y << 16); lo[3] = __uint_as_float(w.y & 0xffff0000u);
    hi[0] = __uint_as_float(w.z << 16); hi[1] = __uint_as_float(w.z & 0xffff0000u); hi[2] = __uint_as_float(w.w << 16); hi[3] = __uint_as_float(w.w & 0xffff0000u);
}
__device__ __forceinline__ u32x4 pack8(const f32x4 lo, const f32x4 hi) { u32x4 w; w.x = cvt_pk_bf16(lo[0], lo[1]); w.y = cvt_pk_bf16(lo[2], lo[3]); w.z = cvt_pk_bf16(hi[0], hi[1]); w.w = cvt_pk_bf16(hi[2], hi[3]); return w; }
__device__ __forceinline__ float bf2f(unsigned short b) { return __uint_as_float((unsigned)b << 16); }
__device__ __forceinline__ float gelu_tanh(float x) {
    const float x2 = x * x, u = x * (0.7978845608f + 0.0356774081f * x2);
    const float e = __builtin_amdgcn_exp2f(-2.885390082f * u);
    return x * __builtin_amdgcn_rcpf(1.0f + e);
}
typedef float f32x2 __attribute__((ext_vector_type(2)));
__device__ __forceinline__ f32x2 gelu_gate_pk(f32x2 x, f32x2 cv) {
    const f32x2 x2 = x * x, t = x2 * (-2.885390082f * 0.0356774081f) + (-2.885390082f * 0.7978845608f), a = x * t;
    f32x2 e; e.x = __builtin_amdgcn_exp2f(a.x); e.y = __builtin_amdgcn_exp2f(a.y);
    const f32x2 d = e + 1.0f;
    f32x2 r; r.x = __builtin_amdgcn_rcpf(d.x); r.y = __builtin_amdgcn_rcpf(d.y);
    return (x * cv) * r;
}
__device__ __forceinline__ float sigmoid_f(float v) { return __builtin_amdgcn_rcpf(1.0f + __builtin_amdgcn_exp2f(-LOG2E * v)); }
__device__ __forceinline__ float wave_sum(float v) {
#pragma unroll
    for (int o = 1; o < 64; o <<= 1) v += __shfl_xor(v, o);
    return v;
}
__device__ __forceinline__ float sum_rows4(float v) {
    auto a = __builtin_amdgcn_permlane16_swap(__float_as_uint(v), __float_as_uint(v), false, false);
    const float s = __uint_as_float(a[0]) + __uint_as_float(a[1]);
    auto b = __builtin_amdgcn_permlane32_swap(__float_as_uint(s), __float_as_uint(s), false, false);
    return __uint_as_float(b[0]) + __uint_as_float(b[1]);
}
template <int CTRL> __device__ __forceinline__ float dpp_f(float x) { return __builtin_bit_cast(float, __builtin_amdgcn_update_dpp(0, __builtin_bit_cast(int, x), CTRL, 0xf, 0xf, false)); }

#define FMAC_DPP(c, src, w, CTRL) asm volatile("v_fmac_f32_dpp %0, %1, %2 " CTRL " row_mask:0xf bank_mask:0xf" : "+v"(c) : "v"(src), "v"(w))
namespace pg8 {
constexpr int BM = 256, BK = 64, HALF = 128, HTB = HALF * BK * 2, STAGE_BYTES = 8 * HTB, NXCD = 8, WGM = 8;
__host__ __device__ __forceinline__ int lds_byte(int r, int c) { const int st = (r >> 4) * 2 + (c >> 5), rr = r & 15, cc = c & 31, ob = rr * 64 + cc * 2; return st * 1024 + (ob ^ (((ob >> 9) & 1) << 5)); }
__host__ __device__ __forceinline__ void stage_rc(int b, int& R, int& C) { const int st = b / 1024, sb = b % 1024, swz = sb ^ (((sb >> 9) & 1) << 5); R = (st >> 1) * 16 + swz / 64; C = (st & 1) * 32 + (swz % 64) / 2; }
__host__ __device__ __forceinline__ int perm32(int rho) { const int n = rho >> 4, i = rho & 15; return 8 * (i >> 2) + 4 * n + (i & 3); }
__host__ __device__ __forceinline__ int permrope(int rho) { const int n = rho >> 4, i = rho & 15, fq = i >> 2, j = i & 3; return 16 * (fq >> 1) + 8 * n + 4 * (fq & 1) + j; }
struct Unit { int pm, pn, kt0, nkt; };
struct Gemm { const bf16_t* A; const bf16_t* Bt; int M, N, K; };
struct StaticOrder {
    int nM, nN, nwg, G, c, nMf, ns, ktiles, nfull, wgm = WGM; bool panel = false;
    __device__ void init(int M, int N, int K, int G_, int c_, int nMf_ = -1, int ns_ = 1) { nM = M / BM; nN = N / BM; G = G_; c = c_; ktiles = K / BK; nMf = nMf_ < 0 ? nM : nMf_; ns = ns_; nfull = nMf * nN; nwg = nfull + (nM - nMf) * nN * ns; }
    __device__ __forceinline__ bool next(int i, Unit& u) const {
        const long L = (long)i * G + c; if (L >= nwg) return false;
        int pm, pn, kt0 = 0, nkt = ktiles;
        if (L >= nfull) { const int s = (int)L - nfull, tile = s / ns, sl = s - tile * ns; pm = nMf + tile / nN; pn = tile % nN; nkt = ktiles / ns; kt0 = sl * nkt; }
        else if (panel) { const int x = c & 7, j = c >> 3; pn = j & 3; pm = 64 * i + 8 * (j >> 2) + x; }
        else {
            int wgid = (int)L; { const int q = nfull / NXCD, r = nfull % NXCD, xcd = wgid % NXCD, off = wgid / NXCD; wgid = (xcd < r ? xcd * (q + 1) : r * (q + 1) + (xcd - r) * q) + off; }
            const int nig = wgm * nN, gid = wgid / nig, fm = gid * wgm, gsz = (nMf - fm) < wgm ? (nMf - fm) : wgm;
            pm = fm + ((wgid % nig) % gsz); pn = (wgid % nig) / gsz;
        }
        u = Unit{pm, pn, kt0, nkt}; return true;
    }
};
template <class Epi, bool ALIGN_EPI, bool SP2>
__device__ __forceinline__ void gemm_phase(LAS unsigned char* lds, const Gemm g, const StaticOrder& S, const Epi& E) {
    const int tid = threadIdx.x, wid = __builtin_amdgcn_readfirstlane(tid >> 6), lane = tid & 63, wr = wid >> 2, wc = wid & 3, fr = lane & 15, fq = lane >> 4;
    const int K = g.K;
    unsigned voffA[2], voffB[2];
#pragma unroll
    for (int i = 0; i < 2; ++i) { int R, C; stage_rc(tid * 16 + i * 8192, R, C); const int Rb = (R & ~31) + Epi::perm(R & 31);
        voffA[i] = (unsigned)(R * K + C) * 2u; voffB[i] = (unsigned)(Rb * K + C) * 2u; }
    const size_t kstep = (size_t)(BK * 2);
    const size_t hstep = (size_t)HALF * K * 2;
    const size_t tstep = 2 * hstep;
    const unsigned ldsw = (unsigned)wid * 1024u;
    const int aoff = lds_byte(wr * 64 + fr, fq * 8), boff = lds_byte(wc * 32 + fr, fq * 8);
#define PG8_SA(b, h) (((b) * 2 + (h)) * HTB)
#define PG8_SB(b, h) ((4 + (b) * 2 + (h)) * HTB)
#define PG8_STAGE(bufoff, gbase, voff) do { _Pragma("unroll") for (int _i = 0; _i < 2; ++_i) \
        __builtin_amdgcn_global_load_lds((const unsigned*)((const char*)(gbase) + (voff)[_i]), (LAS unsigned*)(lds + (bufoff) + ldsw + _i * 8192), 16, 0, 0); } while (0)
#define PG8_LDA(dst, b, h) do { _Pragma("unroll") for (int m = 0; m < 4; ++m) _Pragma("unroll") for (int k = 0; k < 2; ++k) dst[m][k] = *(const LAS bf16x8*)(lds + PG8_SA(b, h) + aoff + m * 2048 + k * 1024); } while (0)
#define PG8_LDB(dst, b, h) do { _Pragma("unroll") for (int n = 0; n < 2; ++n) _Pragma("unroll") for (int k = 0; k < 2; ++k) dst[n][k] = *(const LAS bf16x8*)(lds + PG8_SB(b, h) + boff + n * 2048 + k * 1024); } while (0)
#define PG8_MMA(ai, bj, At, Bt) do { __builtin_amdgcn_s_setprio(1); _Pragma("unroll") for (int m = 0; m < 4; ++m) _Pragma("unroll") for (int n = 0; n < 2; ++n) _Pragma("unroll") for (int k = 0; k < 2; ++k) \
        acc[ai][bj][m][n] = __builtin_amdgcn_mfma_f32_16x16x32_bf16(Bt[n][k], At[m][k], acc[ai][bj][m][n], 0, 0, 0); __builtin_amdgcn_s_setprio(0); } while (0)
#define PG8_WAIT_V(n) asm volatile("s_waitcnt vmcnt(" #n ")" ::: "memory")
#define PG8_WAIT_L(n) asm volatile("s_waitcnt lgkmcnt(" #n ")" ::: "memory")
#define PG8_BAR __builtin_amdgcn_s_barrier()
#define PG8_SCHED __builtin_amdgcn_sched_barrier(0)
    Unit cur, nxt; int ui = 0;
    if (!S.next(0, cur)) return;
    f32x4 acc[2][2][4][2];
#pragma unroll
    for (int a = 0; a < 2; ++a)
#pragma unroll
        for (int b = 0; b < 2; ++b)
#pragma unroll
            for (int m = 0; m < 4; ++m)
#pragma unroll
                for (int n = 0; n < 2; ++n) acc[a][b][m][n] = (f32x4){0.f, 0.f, 0.f, 0.f};
    bf16x8 At[4][2], B0[2][2], B1[2][2];
    const char* cA = (const char*)g.A + (size_t)cur.pm * tstep + (size_t)cur.kt0 * kstep; const char* cB = (const char*)g.Bt + (size_t)cur.pn * tstep + (size_t)cur.kt0 * kstep;
    if constexpr (SP2) {
        PG8_STAGE(PG8_SB(0, 0), cB, voffB); PG8_STAGE(PG8_SB(0, 1), cB + hstep, voffB); PG8_STAGE(PG8_SA(0, 0), cA, voffA); PG8_STAGE(PG8_SA(0, 1), cA + hstep, voffA);
        if (wr == 1) PG8_BAR;
        PG8_WAIT_V(2); PG8_BAR;
        PG8_STAGE(PG8_SB(1, 0), cB + kstep, voffB); PG8_STAGE(PG8_SA(1, 0), cA + kstep, voffA); PG8_STAGE(PG8_SB(1, 1), cB + hstep + kstep, voffB);
        PG8_WAIT_V(6); PG8_BAR;
    } else {
        PG8_STAGE(PG8_SB(0, 0), cB, voffB); PG8_STAGE(PG8_SA(0, 0), cA, voffA); PG8_STAGE(PG8_SB(0, 1), cB + hstep, voffB); PG8_STAGE(PG8_SA(0, 1), cA + hstep, voffA);
        if (wr == 1) PG8_BAR;
        PG8_WAIT_V(4); PG8_BAR;
        PG8_STAGE(PG8_SB(1, 0), cB + kstep, voffB); PG8_STAGE(PG8_SA(1, 0), cA + kstep, voffA); PG8_STAGE(PG8_SB(1, 1), cB + hstep + kstep, voffB);
        PG8_WAIT_V(6); PG8_BAR;
    }
    for (;;) {
        const bool has_next = S.next(ui + 1, nxt);
        const char* nA = has_next ? (const char*)g.A + (size_t)nxt.pm * tstep + (size_t)nxt.kt0 * kstep : cA; const char* nB = has_next ? (const char*)g.Bt + (size_t)nxt.pn * tstep + (size_t)nxt.kt0 * kstep : cB;
        const int nt = cur.nkt;
        for (int t = 0; t < nt; t += 2) {
            const bool last = (t == nt - 2);
            const char* a1 = cA + (size_t)(t + 1) * kstep;
            const char* a2 = last ? nA : cA + (size_t)(t + 2) * kstep; const char* b2 = last ? nB : cB + (size_t)(t + 2) * kstep;
            const char* a3 = a2 + kstep; const char* b3 = b2 + kstep;
            if constexpr (SP2) {
            PG8_LDB(B0, 0, 0); PG8_LDB(B1, 0, 1); PG8_SCHED; PG8_LDA(At, 0, 0); PG8_STAGE(PG8_SA(1, 1), a1 + hstep, voffA);
            PG8_WAIT_V(8); PG8_WAIT_L(0); PG8_BAR; PG8_MMA(0, 0, At, B0); PG8_MMA(0, 1, At, B1); PG8_BAR; PG8_SCHED;
            PG8_LDA(At, 0, 1); PG8_STAGE(PG8_SB(0, 0), b2, voffB); PG8_STAGE(PG8_SB(0, 1), b2 + hstep, voffB); PG8_STAGE(PG8_SA(0, 0), a2, voffA);
            PG8_WAIT_V(8); PG8_WAIT_L(0); PG8_BAR; PG8_MMA(1, 0, At, B0); PG8_MMA(1, 1, At, B1); PG8_BAR; PG8_SCHED;
            PG8_LDB(B0, 1, 0); PG8_LDB(B1, 1, 1); PG8_SCHED; PG8_LDA(At, 1, 0); PG8_STAGE(PG8_SA(0, 1), a2 + hstep, voffA);
            PG8_WAIT_V(8); PG8_WAIT_L(0); PG8_BAR; PG8_MMA(0, 0, At, B0); PG8_MMA(0, 1, At, B1); PG8_BAR; PG8_SCHED;
            PG8_LDA(At, 1, 1); PG8_STAGE(PG8_SB(1, 0), b3, voffB); PG8_STAGE(PG8_SB(1, 1), b3 + hstep, voffB); PG8_STAGE(PG8_SA(1, 0), a3, voffA);
            PG8_WAIT_V(8); PG8_WAIT_L(0); PG8_BAR; PG8_MMA(1, 0, At, B0); PG8_MMA(1, 1, At, B1); PG8_BAR; PG8_SCHED;
            } else {
            PG8_LDB(B0, 0, 0); PG8_SCHED; PG8_LDA(At, 0, 0); PG8_STAGE(PG8_SA(1, 1), a1 + hstep, voffA);
            PG8_WAIT_L(8); PG8_BAR; PG8_WAIT_L(0); PG8_MMA(0, 0, At, B0); PG8_BAR; PG8_SCHED;
            PG8_LDB(B1, 0, 1); PG8_STAGE(PG8_SB(0, 0), b2, voffB);
            PG8_BAR; PG8_WAIT_L(0); PG8_MMA(0, 1, At, B1); PG8_BAR;
            PG8_LDA(At, 0, 1); PG8_STAGE(PG8_SA(0, 0), a2, voffA);
            PG8_BAR; PG8_WAIT_L(0); PG8_MMA(1, 0, At, B0); PG8_BAR; PG8_SCHED;
            PG8_STAGE(PG8_SB(0, 1), b2 + hstep, voffB);
            PG8_WAIT_V(6); PG8_BAR; PG8_MMA(1, 1, At, B1); PG8_BAR;
            PG8_LDB(B0, 1, 0); PG8_SCHED; PG8_LDA(At, 1, 0); PG8_STAGE(PG8_SA(0, 1), a2 + hstep, voffA);
            PG8_WAIT_L(8); PG8_BAR; PG8_WAIT_L(0); PG8_MMA(0, 0, At, B0); PG8_BAR; PG8_SCHED;
            PG8_LDB(B1, 1, 1); PG8_STAGE(PG8_SB(1, 0), b3, voffB);
            PG8_BAR; PG8_WAIT_L(0); PG8_MMA(0, 1, At, B1); PG8_BAR;
            PG8_LDA(At, 1, 1); PG8_STAGE(PG8_SA(1, 0), a3, voffA);
            PG8_BAR; PG8_WAIT_L(0); PG8_MMA(1, 0, At, B0); PG8_BAR; PG8_SCHED;
            PG8_STAGE(PG8_SB(1, 1), b3 + hstep, voffB);
            PG8_WAIT_V(6); PG8_BAR; PG8_MMA(1, 1, At, B1); PG8_BAR;
            }
        }
        if constexpr (ALIGN_EPI) { if (wr == 0) PG8_BAR; }
        E(acc, cur, wr, wc, fr, fq);
        if (!has_next) break;
#pragma unroll
        for (int a = 0; a < 2; ++a)
#pragma unroll
            for (int b = 0; b < 2; ++b)
#pragma unroll
                for (int m = 0; m < 4; ++m)
#pragma unroll
                    for (int n = 0; n < 2; ++n) acc[a][b][m][n] = (f32x4){0.f, 0.f, 0.f, 0.f};
        cur = nxt; cA = nA; cB = nB; ++ui;
        if constexpr (ALIGN_EPI) { if (wr == 1) PG8_BAR; }
    }
    PG8_WAIT_V(0);
    if constexpr (!ALIGN_EPI) { if (wr == 0) PG8_BAR; }
    PG8_BAR;
#undef PG8_SA
#undef PG8_SB
#undef PG8_STAGE
#undef PG8_LDA
#undef PG8_LDB
#undef PG8_MMA
#undef PG8_WAIT_V
#undef PG8_WAIT_L
#undef PG8_BAR
#undef PG8_SCHED
}

struct EpiQKV {
    static constexpr bool PERM = true; static __device__ __forceinline__ int perm(int rho) { return permrope(rho); }
    bf16_t* Q; bf16_t* Kb; bf16_t* Vb; const float* bias; const float* rope; float* kp; float* vp; float* ks; float* vs;
    __device__ __forceinline__ void operator()(const f32x4 (&acc)[2][2][4][2], const Unit& u, int wr, int wc, int fr, int fq) const {
        const int kind = u.pn < 4 ? 0 : u.pn - 3;
        const int lc0 = wc * 32 + 16 * (fq >> 1) + 4 * (fq & 1);
        f32x4 bv[2][2];
#pragma unroll
        for (int bj = 0; bj < 2; ++bj)
#pragma unroll
            for (int n = 0; n < 2; ++n) bv[bj][n] = *(const f32x4*)(bias + u.pn * 256 + bj * 128 + lc0 + 8 * n);
        const bool dorope = (kind < 2) && ((wc & 1) == 0) && (fq < 2);
#pragma unroll
        for (int ai = 0; ai < 2; ++ai)
#pragma unroll
            for (int m = 0; m < 4; ++m) {
                const int r = u.pm * 256 + ai * 128 + wr * 64 + m * 16 + fr;
                const bool prompt = r < MP;
                const int t = prompt ? (r & 2047) : ((r - MP) & 63), b = prompt ? (r >> 11) : ((r - MP) >> 6);
                const int pos = prompt ? t : 1024 + t;
                f32x4 cs = {1.f, 1.f, 1.f, 1.f}, sn = {0.f, 0.f, 0.f, 0.f};
                if (dorope) { cs = *(const f32x4*)(rope + pos * 16 + 4 * fq); sn = *(const f32x4*)(rope + pos * 16 + 8 + 4 * fq); }
#pragma unroll
                for (int bj = 0; bj < 2; ++bj) {
                    const f32x4 x1 = acc[ai][bj][m][0] + bv[bj][0], x2 = acc[ai][bj][m][1] + bv[bj][1];
                    f32x4 v[2]; v[0] = x1 * cs - x2 * sn; v[1] = x2 * cs + x1 * sn;
                    if (kind == 0) {
                        u32x2 w0, w1; w0.x = cvt_pk_bf16(v[0][0] * QSCALE, v[0][1] * QSCALE); w0.y = cvt_pk_bf16(v[0][2] * QSCALE, v[0][3] * QSCALE); w1.x = cvt_pk_bf16(v[1][0] * QSCALE, v[1][1] * QSCALE); w1.y = cvt_pk_bf16(v[1][2] * QSCALE, v[1][3] * QSCALE);
                        bf16_t* qp = Q + (size_t)r * DM + u.pn * 256 + bj * 128 + lc0;
                        *(u32x2*)qp = w0; *(u32x2*)(qp + 8) = w1;
                    } else {
                        const int col = bj * 128 + lc0;
                        const size_t krow = prompt ? (size_t)r : (size_t)MP + b * 192 + 128 + t;
                        u32x2 w0, w1; w0.x = cvt_pk_bf16(v[0][0], v[0][1]); w0.y = cvt_pk_bf16(v[0][2], v[0][3]); w1.x = cvt_pk_bf16(v[1][0], v[1][1]); w1.y = cvt_pk_bf16(v[1][2], v[1][3]);
                        bf16_t* kvp = (kind == 1 ? Kb : Vb) + krow * 256 + col;
                        *(u32x2*)kvp = w0; *(u32x2*)(kvp + 8) = w1;
                        float* o = nullptr;
                        if (prompt) { if (t >= SEQ - 128) o = (kind == 1 ? kp : vp) + ((size_t)(b * 128 + t - (SEQ - 128)) * 256 + col); }
                        else o = (kind == 1 ? ks : vs) + ((size_t)(b * 128 + 64 + t) * 256 + col);
                        if (o) { *(f32x4*)o = v[0]; *(f32x4*)(o + 8) = v[1]; }
                    }
                }
            }
    }
};
struct EpiPlainSS {
    static constexpr bool PERM = true; static __device__ __forceinline__ int perm(int rho) { return perm32(rho); }
    bf16_t* O; const float* bias; float* ss; float* sacc; int ktiles;
    __device__ __forceinline__ void operator()(const f32x4 (&acc)[2][2][4][2], const Unit& u, int wr, int wc, int fr, int fq) const {
        const int col0 = u.pn * 256 + wc * 32 + 8 * fq;
        if (u.nkt != ktiles) {
            const int slice = u.kt0 / u.nkt;
#pragma unroll
            for (int ai = 0; ai < 2; ++ai)
#pragma unroll
                for (int m = 0; m < 4; ++m) {
                    const int r = u.pm * 256 + ai * 128 + wr * 64 + m * 16 + fr - MP; float* sp = sacc + ((size_t)slice * MS + r) * DM + col0;
#pragma unroll
                    for (int bj = 0; bj < 2; ++bj) { *(f32x4*)(sp + bj * 128) = acc[ai][bj][m][0]; *(f32x4*)(sp + bj * 128 + 4) = acc[ai][bj][m][1]; }
                }
            return;
        }
        f32x4 bv[2][2];
#pragma unroll
        for (int bj = 0; bj < 2; ++bj)
#pragma unroll
            for (int n = 0; n < 2; ++n) bv[bj][n] = bias ? *(const f32x4*)(bias + col0 + bj * 128 + 4 * n) : (f32x4){0.f, 0.f, 0.f, 0.f};
#pragma unroll
        for (int ai = 0; ai < 2; ++ai)
#pragma unroll
            for (int m = 0; m < 4; ++m) {
                const int r = u.pm * 256 + ai * 128 + wr * 64 + m * 16 + fr; float s = 0.f;
#pragma unroll
                for (int bj = 0; bj < 2; ++bj) {
                    const f32x4 v0 = acc[ai][bj][m][0] + bv[bj][0], v1 = acc[ai][bj][m][1] + bv[bj][1];
                    s += (v0[0] * v0[0] + v0[1] * v0[1]) + (v0[2] * v0[2] + v0[3] * v0[3]) + (v1[0] * v1[0] + v1[1] * v1[1]) + (v1[2] * v1[2] + v1[3] * v1[3]);
                    u32x4 w; w.x = cvt_pk_bf16(v0[0], v0[1]); w.y = cvt_pk_bf16(v0[2], v0[3]); w.z = cvt_pk_bf16(v1[0], v1[1]); w.w = cvt_pk_bf16(v1[2], v1[3]);
                    *(u32x4*)(O + (size_t)r * DM + col0 + bj * 128) = w;
                }
                s += __shfl_xor(s, 16); s += __shfl_xor(s, 32);
                if (fq == 0) ss[(size_t)r * 32 + u.pn * 4 + wc] = s;
            }
    }
};
template <bool XIN_F32, bool LAST>
struct EpiFused {
    static constexpr bool PERM = true; static __device__ __forceinline__ int perm(int rho) { return perm32(rho); }
    const float* bias; const void* xin; bf16_t* xo16; float* xof; bf16_t* aout; const float* gpost; const float* gnext;
    unsigned long long* xch; unsigned* cnt; LAS unsigned char* xl; float* sacc; int ktiles;
    __device__ __forceinline__ void load_x(f32x4 (&x)[2], size_t off) const {
        if constexpr (XIN_F32) { x[0] = *(const f32x4*)((const float*)xin + off); x[1] = *(const f32x4*)((const float*)xin + off + 4); }
        else { const u32x4 w = *(const u32x4*)((const bf16_t*)xin + off);
            x[0][0] = __uint_as_float(w.x << 16); x[0][1] = __uint_as_float(w.x & 0xffff0000u); x[0][2] = __uint_as_float(w.y << 16); x[0][3] = __uint_as_float(w.y & 0xffff0000u);
            x[1][0] = __uint_as_float(w.z << 16); x[1][1] = __uint_as_float(w.z & 0xffff0000u); x[1][2] = __uint_as_float(w.w << 16); x[1][3] = __uint_as_float(w.w & 0xffff0000u); }
    }
    __device__ __forceinline__ void operator()(f32x4 (&acc)[2][2][4][2], const Unit& u, int wr, int wc, int fr, int fq) const {
        asm volatile("" : "+v"(fr), "+v"(fq));
        const int col0 = u.pn * 256 + wc * 32 + 8 * fq;
        if (u.nkt != ktiles) {
            const int slice = u.kt0 / u.nkt;
#pragma unroll
            for (int ai = 0; ai < 2; ++ai)
#pragma unroll
                for (int m = 0; m < 4; ++m) {
                    const int r = u.pm * 256 + ai * 128 + wr * 64 + m * 16 + fr - MP; float* sp = sacc + ((size_t)slice * MS + r) * DM + col0;
#pragma unroll
                    for (int bj = 0; bj < 2; ++bj) { *(f32x4*)(sp + bj * 128) = acc[ai][bj][m][0]; *(f32x4*)(sp + bj * 128 + 4) = acc[ai][bj][m][1]; }
                }
            return;
        }
        int tid = threadIdx.x; asm volatile("" : "+v"(tid)); const int lane = tid & 63, wid = __builtin_amdgcn_readfirstlane(tid >> 6);
        LAS f32x4* P = (LAS f32x4*)xl; LAS f32x2* S2 = (LAS f32x2*)(xl + 16384); volatile LAS unsigned* flag = (volatile LAS unsigned*)(xl + 16384 + 2048);
        f32x4 gp[2][2];
#pragma unroll
        for (int bj = 0; bj < 2; ++bj)
#pragma unroll
            for (int n = 0; n < 2; ++n) { gp[bj][n] = *(const f32x4*)(gpost + col0 + bj * 128 + 4 * n);
                if (bias) { const f32x4 bv = *(const f32x4*)(bias + col0 + bj * 128 + 4 * n);
#pragma unroll
                    for (int ai = 0; ai < 2; ++ai)
#pragma unroll
                        for (int m = 0; m < 4; ++m) acc[ai][bj][m][n] += bv; } }
#pragma unroll
        for (int ai = 0; ai < 2; ++ai)
#pragma unroll
            for (int m = 0; m < 4; ++m) {
                const int rl = ai * 128 + wr * 64 + m * 16 + fr; const size_t roff = (size_t)(u.pm * 256 + rl) * DM + col0;
                float smm = 0.f, sxx = 0.f, sxm = 0.f, sgg = 0.f;
#pragma unroll
                for (int bj = 0; bj < 2; ++bj) { f32x4 x[2]; load_x(x, roff + bj * 128);
#pragma unroll
                    for (int n = 0; n < 2; ++n)
#pragma unroll
                        for (int j = 0; j < 4; ++j) { const float v = acc[ai][bj][m][n][j], mg = v * gp[bj][n][j], xv = x[n][j]; smm += v * v; sxx += xv * xv; sxm += xv * mg; sgg += mg * mg; acc[ai][bj][m][n][j] = mg; } }
                smm = sum_rows4(smm); sxx = sum_rows4(sxx); sxm = sum_rows4(sxm); sgg = sum_rows4(sgg);
                if (fq == 0) P[rl * 4 + wc] = (f32x4){smm, sxx, sxm, sgg};
            }
        asm volatile("s_waitcnt lgkmcnt(0)" ::: "memory"); __builtin_amdgcn_s_barrier(); asm volatile("" ::: "memory");
        if (tid < 256) {
            const f32x4 t = (P[tid * 4 + 0] + P[tid * 4 + 1]) + (P[tid * 4 + 2] + P[tid * 4 + 3]);
            unsigned long long* slot = xch + ((size_t)(u.pm * 256 + tid) * 4 + u.pn) * 2;
            __hip_atomic_store(slot, ((unsigned long long)__float_as_uint(t[1]) << 32) | __float_as_uint(t[0]), __ATOMIC_RELAXED, __HIP_MEMORY_SCOPE_AGENT);
            __hip_atomic_store(slot + 1, ((unsigned long long)__float_as_uint(t[3]) << 32) | __float_as_uint(t[2]), __ATOMIC_RELAXED, __HIP_MEMORY_SCOPE_AGENT);
        }
        asm volatile("s_waitcnt vmcnt(0)" ::: "memory");
        if (wid < 4 && lane == 0) __hip_atomic_fetch_add(cnt + 64 * u.pm, 1u, __ATOMIC_RELAXED, __HIP_MEMORY_SCOPE_AGENT);
        if (wid == 0) {
            unsigned sp = 0u;
            while ((unsigned)__builtin_amdgcn_readfirstlane(__hip_atomic_load(cnt + 64 * u.pm, __ATOMIC_RELAXED, __HIP_MEMORY_SCOPE_AGENT)) < 16u) { __builtin_amdgcn_s_sleep(2); if (++sp > (1u << 21)) break; }
            __builtin_amdgcn_fence(__ATOMIC_ACQUIRE, "agent");
            if (lane == 0) flag[0] = sp;
        }
        asm volatile("s_waitcnt vmcnt(0) lgkmcnt(0)" ::: "memory"); __builtin_amdgcn_s_barrier(); asm volatile("" ::: "memory");
        if (tid < 256) {
            const unsigned long long* slot = xch + (size_t)(u.pm * 256 + tid) * 8; float t0 = 0.f, t1 = 0.f, t2 = 0.f, t3 = 0.f;
#pragma unroll
            for (int q = 0; q < 4; ++q) { const unsigned long long a = __hip_atomic_load(slot + 2 * q, __ATOMIC_RELAXED, __HIP_MEMORY_SCOPE_AGENT), b = __hip_atomic_load(slot + 2 * q + 1, __ATOMIC_RELAXED, __HIP_MEMORY_SCOPE_AGENT);
                t0 += __uint_as_float((unsigned)a); t1 += __uint_as_float((unsigned)(a >> 32)); t2 += __uint_as_float((unsigned)b); t3 += __uint_as_float((unsigned)(b >> 32)); }
            const float s = 1.0f / sqrtf(t0 * (1.0f / DM) + EPS);
            const float q1 = t1 + 2.0f * s * t2 + s * s * t3;
            S2[tid] = (f32x2){s, 1.0f / sqrtf(fmaxf(q1, 0.f) * (1.0f / DM) + EPS)};
        }
        asm volatile("s_waitcnt lgkmcnt(0)" ::: "memory"); __builtin_amdgcn_s_barrier(); asm volatile("" ::: "memory");
#pragma unroll
        for (int ai = 0; ai < 2; ++ai)
#pragma unroll
            for (int m = 0; m < 4; ++m) {
                const int rl = ai * 128 + wr * 64 + m * 16 + fr; const size_t roff = (size_t)(u.pm * 256 + rl) * DM + col0;
                const f32x2 sr = S2[rl];
#pragma unroll
                for (int bj = 0; bj < 2; ++bj) { f32x4 x[2]; load_x(x, roff + bj * 128);
                    f32x4 x1[2];
#pragma unroll
                    for (int n = 0; n < 2; ++n) x1[n] = x[n] + acc[ai][bj][m][n] * sr.x;
                    if constexpr (LAST) { *(f32x4*)(xof + roff + bj * 128) = x1[0]; *(f32x4*)(xof + roff + bj * 128 + 4) = x1[1]; }
                    else {
                        u32x4 w; w.x = cvt_pk_bf16(x1[0][0], x1[0][1]); w.y = cvt_pk_bf16(x1[0][2], x1[0][3]); w.z = cvt_pk_bf16(x1[1][0], x1[1][1]); w.w = cvt_pk_bf16(x1[1][2], x1[1][3]);
                        *(u32x4*)(xo16 + roff + bj * 128) = w;
                        const f32x4 a0 = x1[0] * *(const f32x4*)(gnext + col0 + bj * 128) * sr.y, a1 = x1[1] * *(const f32x4*)(gnext + col0 + bj * 128 + 4) * sr.y;
                        u32x4 wa; wa.x = cvt_pk_bf16(a0[0], a0[1]); wa.y = cvt_pk_bf16(a0[2], a0[3]); wa.z = cvt_pk_bf16(a1[0], a1[1]); wa.w = cvt_pk_bf16(a1[2], a1[3]);
                        *(u32x4*)(aout + roff + bj * 128) = wa;
                    }
                }
            }
        asm volatile("s_waitcnt lgkmcnt(0)" ::: "memory");
    }
};
struct EpiGlu {
    static constexpr bool PERM = true; static __device__ __forceinline__ int perm(int rho) { return perm32(rho); }
    bf16_t* O; const float* bias; float* ss; float* sacc; int ktiles;
    __device__ __forceinline__ void operator()(const f32x4 (&acc)[2][2][4][2], const Unit& u, int wr, int wc, int fr, int fq) const {
        if (u.nkt != ktiles) {
            const int slice = u.kt0 / u.nkt;
#pragma unroll
            for (int ai = 0; ai < 2; ++ai)
#pragma unroll
                for (int m = 0; m < 4; ++m) {
                    const int r = u.pm * 256 + ai * 128 + wr * 64 + m * 16 + fr - MP; float* sp = sacc + ((size_t)slice * MS + r) * (2 * DM) + u.pn * 256 + wc * 32 + 8 * fq;
#pragma unroll
                    for (int bj = 0; bj < 2; ++bj) { *(f32x4*)(sp + bj * 128) = acc[ai][bj][m][0]; *(f32x4*)(sp + bj * 128 + 4) = acc[ai][bj][m][1]; }
                }
            return;
        }
        const int oc0 = u.pn * 128 + wc * 32 + 8 * fq;
        f32x4 ba[2], bg[2];
#pragma unroll
        for (int n = 0; n < 2; ++n) { ba[n] = *(const f32x4*)(bias + oc0 + 4 * n); bg[n] = *(const f32x4*)(bias + DM + oc0 + 4 * n); }
#pragma unroll
        for (int ai = 0; ai < 2; ++ai)
#pragma unroll
            for (int m = 0; m < 4; ++m) {
                const int r = u.pm * 256 + ai * 128 + wr * 64 + m * 16 + fr; float s = 0.f; f32x4 o[2];
#pragma unroll
                for (int n = 0; n < 2; ++n) { const f32x4 a = acc[ai][0][m][n] + ba[n], g = acc[ai][1][m][n] + bg[n];
#pragma unroll
                    for (int j = 0; j < 4; ++j) { o[n][j] = a[j] * sigmoid_f(g[j]); s += o[n][j] * o[n][j]; } }
                u32x4 w; w.x = cvt_pk_bf16(o[0][0], o[0][1]); w.y = cvt_pk_bf16(o[0][2], o[0][3]); w.z = cvt_pk_bf16(o[1][0], o[1][1]); w.w = cvt_pk_bf16(o[1][2], o[1][3]);
                *(u32x4*)(O + (size_t)r * DM + oc0) = w;
                s += __shfl_xor(s, 16); s += __shfl_xor(s, 32);
                if (fq == 0) ss[(size_t)r * 32 + u.pn * 4 + wc] = s;
            }
    }
};
struct EpiUp {
    static constexpr bool PERM = true; static __device__ __forceinline__ int perm(int rho) { return perm32(rho); }
    bf16_t* G; float* E; const float* cw; const float* cb;
    __device__ __forceinline__ void operator()(f32x4 (&acc)[2][2][4][2], const Unit& u, int wr, int wc, int fr, int fq) const {
        const int oc0 = u.pn * 128 + wc * 32 + 8 * fq;
        {
            const int e = (fr < 2) ? fr : fr - 12; const int msel = (fr < 2) ? 0 : 3;
            if (fr < 2 || fr >= 14) {
#pragma unroll
                for (int ai = 0; ai < 2; ++ai) {
                    const int seg = u.pm * 4 + ai * 2 + wr; float* eb = E + ((size_t)seg * 4 + e) * FF2 + oc0;
#pragma unroll
                    for (int bj = 0; bj < 2; ++bj)
#pragma unroll
                        for (int n = 0; n < 2; ++n) { const f32x4 v = (msel == 0) ? acc[ai][bj][0][n] : acc[ai][bj][3][n]; *(f32x4*)(eb + bj * FF + 4 * n) = v; }
                }
            }
        }
        f32x4 pw0[2][2], pw1[2][2], pw2[2][2], pbb[2][2];
#pragma unroll
        for (int n = 0; n < 2; ++n)
#pragma unroll
            for (int bj = 0; bj < 2; ++bj) { const float* cwp = cw + bj * FF + oc0 + 4 * n;
                pw0[n][bj] = *(const f32x4*)(cwp); pw1[n][bj] = *(const f32x4*)(cwp + FF2); pw2[n][bj] = *(const f32x4*)(cwp + 2 * FF2); pbb[n][bj] = *(const f32x4*)(cb + bj * FF + oc0 + 4 * n); }
#pragma unroll
        for (int n = 0; n < 2; ++n) {
#pragma unroll
            for (int bj = 0; bj < 2; ++bj) {
                const f32x4 w0 = pw0[n][bj], w1 = pw1[n][bj], w2 = pw2[n][bj], bb = pbb[n][bj];
                f32x4 w1z, w0z;
#pragma unroll
                for (int j = 0; j < 4; ++j) { w1z[j] = (fr == 0) ? w1[j] : 0.f; w0z[j] = (fr < 2) ? w0[j] : 0.f; }
#pragma unroll
                for (int ai = 0; ai < 2; ++ai)
#pragma unroll
                    for (int m = 3; m >= 0; --m) {
                        const f32x4 v = acc[ai][bj][m][n];
                        f32x4 c = bb + w2 * v;
#pragma unroll
                        for (int j = 0; j < 4; ++j) {
                            FMAC_DPP(c[j], v[j], w1[j], "row_shr:1");
                            FMAC_DPP(c[j], v[j], w0[j], "row_shr:2");
                            if (m > 0) { FMAC_DPP(c[j], acc[ai][bj][m - 1][n][j], w1z[j], "row_ror:1"); FMAC_DPP(c[j], acc[ai][bj][m - 1][n][j], w0z[j], "row_ror:2"); }
                        }
                        acc[ai][bj][m][n] = c;
                    }
            }
        }
#pragma unroll
        for (int ai = 0; ai < 2; ++ai)
#pragma unroll
            for (int m = 0; m < 4; ++m) {
                const int r = u.pm * 256 + ai * 128 + wr * 64 + m * 16 + fr;
                f32x2 o[4];
#pragma unroll
                for (int n = 0; n < 2; ++n)
#pragma unroll
                    for (int h = 0; h < 2; ++h) o[2 * n + h] = gelu_gate_pk((f32x2){acc[ai][0][m][n][2 * h], acc[ai][0][m][n][2 * h + 1]}, (f32x2){acc[ai][1][m][n][2 * h], acc[ai][1][m][n][2 * h + 1]});
                u32x4 w; w.x = cvt_pk_bf16(o[0].x, o[0].y); w.y = cvt_pk_bf16(o[1].x, o[1].y); w.z = cvt_pk_bf16(o[2].x, o[2].y); w.w = cvt_pk_bf16(o[3].x, o[3].y);
                if (!(m == 0 && fr < 2)) *(u32x4*)(G + (size_t)r * FF + oc0) = w;
            }
    }
};
}

#ifndef PROBE_REPMASK
#define PROBE_REPMASK 0
#endif
struct Args { const float* in[30]; float* out; unsigned char* ws; int ph_lo, ph_hi, coop, repmask; };
constexpr int NPHASE = 16;
constexpr int LDS_BYTES = 155648;
constexpr int XL_OFF = 131072, XL_MISC = 131072 + 16384 + 2048 + 128;

__device__ __forceinline__ unsigned f2bf(float f) { unsigned u = __builtin_bit_cast(unsigned, f); return (u + 0x7fffu + ((u >> 16) & 1u)) >> 16; }
__device__ __forceinline__ unsigned pk2(float lo, float hi) { return f2bf(lo) | (f2bf(hi) << 16); }
__device__ __forceinline__ void transpose_item(const float* W, int K, int N, bf16_t* WT, int pair_half, LAS float* scr, int item, int lane) {
    const int nblk = N / 32, kb = item / nblk, nb = item % nblk, k0 = 64 * kb, n0 = 32 * nb;
#pragma unroll 8
    for (int i = 0; i < 32; ++i) { const int kk = 2 * i + (lane >> 5); scr[kk * 33 + (lane & 31)] = W[(size_t)(k0 + kk) * N + n0 + (lane & 31)]; }
    asm volatile("s_waitcnt lgkmcnt(0)" ::: "memory");
    int r0 = n0;
    if (pair_half > 0) { const int half = n0 / pair_half, c = n0 % pair_half; r0 = 256 * (c / 128) + 128 * half + (c % 128); }
    const int c = lane & 7;
#pragma unroll
    for (int j = 0; j < 4; ++j) { const int n = (lane >> 3) + 8 * j; const LAS float* s = scr + (8 * c) * 33 + n;
        u32x4 o; o.x = pk2(s[0 * 33], s[1 * 33]); o.y = pk2(s[2 * 33], s[3 * 33]); o.z = pk2(s[4 * 33], s[5 * 33]); o.w = pk2(s[6 * 33], s[7 * 33]);
        *(u32x4*)(WT + (size_t)(r0 + n) * K + k0 + 8 * c) = o; }
    asm volatile("s_waitcnt lgkmcnt(0)" ::: "memory");
}

template <bool HAS_M, bool HAS_NEXT, bool XIN_F32, bool XOUT_F32, bool M_F32 = false, bool M_GLU = false>
__device__ __forceinline__ void row_pass(const void* xin, void* xout, const bf16_t* mrow, const float* ssrow, int nslots, const float* gpost, const float* gnext, bf16_t* arow, int lane, const float* saccrow = nullptr, const float* mbias = nullptr) {
    f32x4 v[4];
#pragma unroll
    for (int j = 0; j < 4; ++j) {
        if constexpr (XIN_F32) v[j] = *((const f32x4*)xin + lane + 64 * j);
        else { const u32x2 xw = *((const u32x2*)xin + lane + 64 * j); v[j][0] = __uint_as_float(xw.x << 16); v[j][1] = __uint_as_float(xw.x & 0xffff0000u); v[j][2] = __uint_as_float(xw.y << 16); v[j][3] = __uint_as_float(xw.y & 0xffff0000u); }
    }
    if constexpr (HAS_M) {
        f32x4 mv[4]; float s;
        if constexpr (M_GLU) {
            s = 0.f;
#pragma unroll
            for (int j = 0; j < 4; ++j) { const int oc = 4 * (lane + 64 * j), base = 256 * (oc >> 7) + (oc & 127);
                f32x4 a = *(const f32x4*)(mbias + oc), g = *(const f32x4*)(mbias + DM + oc);
                for (int sl = 0; sl < nslots; ++sl) { a += *(const f32x4*)(saccrow + (size_t)sl * MS * 2 * DM + base); g += *(const f32x4*)(saccrow + (size_t)sl * MS * 2 * DM + base + 128); }
#pragma unroll
                for (int q = 0; q < 4; ++q) mv[j][q] = a[q] * sigmoid_f(g[q]);
                s += (mv[j][0] * mv[j][0] + mv[j][1] * mv[j][1]) + (mv[j][2] * mv[j][2] + mv[j][3] * mv[j][3]); }
        } else if constexpr (M_F32) {
            s = 0.f;
#pragma unroll
            for (int j = 0; j < 4; ++j) { mv[j] = mbias ? *((const f32x4*)mbias + lane + 64 * j) : (f32x4){0.f, 0.f, 0.f, 0.f};
                for (int sl = 0; sl < nslots; ++sl) mv[j] += *((const f32x4*)(saccrow + (size_t)sl * MS * DM) + lane + 64 * j);
                s += (mv[j][0] * mv[j][0] + mv[j][1] * mv[j][1]) + (mv[j][2] * mv[j][2] + mv[j][3] * mv[j][3]); }
        } else {
            s = (lane < nslots) ? ssrow[lane] : 0.f;
#pragma unroll
            for (int j = 0; j < 4; ++j) { const u32x2 mw = *((const u32x2*)mrow + lane + 64 * j);
                mv[j][0] = __uint_as_float(mw.x << 16); mv[j][1] = __uint_as_float(mw.x & 0xffff0000u); mv[j][2] = __uint_as_float(mw.y << 16); mv[j][3] = __uint_as_float(mw.y & 0xffff0000u); }
        }
        s = wave_sum(s);
        const float rstd = 1.0f / sqrtf(s * (1.0f / DM) + EPS);
#pragma unroll
        for (int j = 0; j < 4; ++j) {
            const f32x4 gp = *((const f32x4*)gpost + lane + 64 * j);
            v[j] += mv[j] * rstd * gp;
            if constexpr (XOUT_F32) *((f32x4*)xout + lane + 64 * j) = v[j];
            else { u32x2 w; w.x = cvt_pk_bf16(v[j][0], v[j][1]); w.y = cvt_pk_bf16(v[j][2], v[j][3]); *((u32x2*)xout + lane + 64 * j) = w; }
        }
    }
    if constexpr (HAS_NEXT) {
        float s2 = 0.f;
#pragma unroll
        for (int j = 0; j < 4; ++j) s2 += (v[j][0] * v[j][0] + v[j][1] * v[j][1]) + (v[j][2] * v[j][2] + v[j][3] * v[j][3]);
        s2 = wave_sum(s2);
        const float rstd2 = 1.0f / sqrtf(s2 * (1.0f / DM) + EPS);
#pragma unroll
        for (int j = 0; j < 4; ++j) { const f32x4 gn = *((const f32x4*)gnext + lane + 64 * j);
            u32x2 w; w.x = cvt_pk_bf16(v[j][0] * rstd2 * gn[0], v[j][1] * rstd2 * gn[1]); w.y = cvt_pk_bf16(v[j][2] * rstd2 * gn[2], v[j][3] * rstd2 * gn[3]);
            *((u32x2*)arow + lane + 64 * j) = w; }
    }
}

__device__ __forceinline__ s16x4 vtr(LAS const unsigned char* p) { return __builtin_bit_cast(s16x4, __builtin_amdgcn_ds_read_tr16_b64_v4i16((LAS s16x4*)p)); }
__device__ __forceinline__ void attn_unit_coords(int u, int& qrow0, int& krow0, int& kb0, int& kvh) {
    if (u < NB * 128) { const int b = u >> 7, rem = u & 127, c = rem >> 2; kvh = rem & 3; qrow0 = b * SEQ + c * 64; krow0 = qrow0 - 128; kb0 = c >= 2 ? 0 : 2 * (2 - c); }
    else { const int u2 = u - NB * 128, b = u2 >> 2; kvh = u2 & 3; qrow0 = MP + b * 64; krow0 = MP + b * 192; kb0 = 0; }
}
__device__ __forceinline__ void attn_phase(LAS unsigned char* lds, const bf16_t* Qb, const bf16_t* Kb, const bf16_t* Vb, bf16_t* Ob, const float* sinks, int G, int blk) {
    const int tid = threadIdx.x, lane = tid & 63, w = __builtin_amdgcn_readfirstlane(tid >> 6), r32 = lane & 31, hi = lane >> 5;
    constexpr int KST = 144, VST = 192, KOFF = 0, VOFF = 192 * KST, OOFF = VOFF + 192 * VST, OST = 136;
    constexpr int NUNITS = NB * 32 * 4 + DB * 4;
    LAS unsigned char* ostage = lds + OOFF + w * (32 * OST);
    u32x4 kreg[3], vreg[3]; bf16x8 qnext[4];
    int qrow0 = 0, krow0 = 0, kb0 = 0, kvh = 0;
#define ATTN_LOAD(UU) do { int q0_, k0_, b0_, h0_; attn_unit_coords((UU), q0_, k0_, b0_, h0_); \
        _Pragma("unroll") for (int i = 0; i < 3; ++i) { const int p_ = tid + 512 * i, row_ = p_ >> 3, ch_ = p_ & 7; \
            if (row_ >= b0_ * 32) { const size_t go_ = (size_t)(k0_ + row_) * 256 + h0_ * 64 + ch_ * 8; kreg[i] = *(const u32x4*)(Kb + go_); vreg[i] = *(const u32x4*)(Vb + go_); } } \
        { const size_t qr_ = (size_t)q0_ + (w & 1) * 32 + r32; const int hq_ = h0_ * 4 + (w >> 1); \
          _Pragma("unroll") for (int dk = 0; dk < 4; ++dk) qnext[dk] = *(const bf16x8*)(Qb + qr_ * DM + hq_ * 64 + dk * 16 + hi * 8); } } while (0)
    if (blk < NUNITS) ATTN_LOAD(blk);
    for (int u = blk; u < NUNITS; u += G) {
        attn_unit_coords(u, qrow0, krow0, kb0, kvh);
        __syncthreads();
#pragma unroll
        for (int i = 0; i < 3; ++i) { const int p = tid + 512 * i, row = p >> 3, ch = p & 7;
            if (row >= kb0 * 32) { *(LAS u32x4*)(lds + KOFF + row * KST + ch * 16) = kreg[i]; *(LAS u32x4*)(lds + VOFF + row * VST + ch * 16) = vreg[i]; } }
        bf16x8 qf[4];
#pragma unroll
        for (int dk = 0; dk < 4; ++dk) qf[dk] = qnext[dk];
        const int hq = kvh * 4 + (w >> 1); const size_t qrowb = (size_t)qrow0 + (w & 1) * 32;
        __syncthreads();
        if (u + G < NUNITS) ATTN_LOAD(u + G);
        f32x16 sc[6];
        float mx = -3.0e38f;
#pragma unroll
        for (int kb = 0; kb < 6; ++kb) {
            if (kb >= kb0) {
                f32x16 a = {};
#pragma unroll
                for (int dk = 0; dk < 4; ++dk) { const bf16x8 kf = *(const LAS bf16x8*)(lds + KOFF + (32 * kb + r32) * KST + (dk * 16 + hi * 8) * 2); a = __builtin_amdgcn_mfma_f32_32x32x16_bf16(kf, qf[dk], a, 0, 0, 0); }
#pragma unroll
                for (int r = 0; r < 16; ++r) mx = fmaxf(mx, a[r]);
                sc[kb] = a;
            }
        }
        mx = fmaxf(mx, __shfl_xor(mx, 32));
        const float sinkl = sinks[hq] * LOG2E; mx = fmaxf(mx, sinkl);
        float ls = 0.f;
#pragma unroll
        for (int kb = 0; kb < 6; ++kb) {
            if (kb >= kb0) {
#pragma unroll
                for (int r = 0; r < 16; ++r) { const float p = __builtin_amdgcn_exp2f(sc[kb][r] - mx); sc[kb][r] = p; ls += p; }
            }
        }
        ls += __shfl_xor(ls, 32);
        const float inv = 1.0f / (ls + __builtin_amdgcn_exp2f(sinkl - mx));
        f32x16 o[2]; o[0] = f32x16{}; o[1] = f32x16{};
        const int vlane = VOFF + (4 * hi + ((lane >> 2) & 3)) * VST + (16 * ((lane >> 4) & 1) + 4 * (lane & 3)) * 2;
#pragma unroll
        for (int kb = 0; kb < 6; ++kb) {
            if (kb >= kb0) {
#pragma unroll
                for (int s = 0; s < 2; ++s) {
                    u32x4 pw; pw.x = cvt_pk_bf16(sc[kb][8 * s + 0], sc[kb][8 * s + 1]); pw.y = cvt_pk_bf16(sc[kb][8 * s + 2], sc[kb][8 * s + 3]); pw.z = cvt_pk_bf16(sc[kb][8 * s + 4], sc[kb][8 * s + 5]); pw.w = cvt_pk_bf16(sc[kb][8 * s + 6], sc[kb][8 * s + 7]);
                    const bf16x8 pf = __builtin_bit_cast(bf16x8, pw);
#pragma unroll
                    for (int db = 0; db < 2; ++db) {
                        LAS const unsigned char* vp = lds + vlane + (32 * kb + 16 * s) * VST + db * 64;
                        const s16x4 lo = vtr(vp), h4 = vtr(vp + 8 * VST);
                        const bf16x8 vf = (bf16x8){lo[0], lo[1], lo[2], lo[3], h4[0], h4[1], h4[2], h4[3]};
                        o[db] = __builtin_amdgcn_mfma_f32_32x32x16_bf16(vf, pf, o[db], 0, 0, 0);
                    }
                }
            }
        }
#pragma unroll
        for (int db = 0; db < 2; ++db)
#pragma unroll
            for (int rq = 0; rq < 4; ++rq) {
                u32x2 wv; wv.x = cvt_pk_bf16(o[db][4 * rq] * inv, o[db][4 * rq + 1] * inv); wv.y = cvt_pk_bf16(o[db][4 * rq + 2] * inv, o[db][4 * rq + 3] * inv);
                *(LAS u32x2*)(ostage + r32 * OST + (32 * db + 8 * rq + 4 * hi) * 2) = wv;
            }
        asm volatile("s_waitcnt lgkmcnt(0)" ::: "memory");
#pragma unroll
        for (int i = 0; i < 4; ++i) { const int row = i * 8 + (lane >> 3), ch = lane & 7;
            const u32x2 a = *(const LAS u32x2*)(ostage + row * OST + ch * 16), b = *(const LAS u32x2*)(ostage + row * OST + ch * 16 + 8);
            u32x4 v; v.x = a.x; v.y = a.y; v.z = b.x; v.w = b.y;
            *(u32x4*)(Ob + (qrowb + row) * DM + hq * 64 + ch * 8) = v; }
        asm volatile("s_waitcnt lgkmcnt(0)" ::: "memory");
    }
#undef ATTN_LOAD
}

struct SsmP { const float *lam_re, *lam_im, *log_dt, *b_re, *b_im, *c_re, *c_im, *dsk, *st_re, *st_im; float *o_rep, *o_imp, *o_res, *o_ims; };
__device__ __forceinline__ void ssm_phase(LAS unsigned char* lds, const bf16_t* A3, bf16_t* Z, const SsmP P, int G, int blk) {
    const int tid = threadIdx.x, lane = tid & 63, w = __builtin_amdgcn_readfirstlane(tid >> 6), p = lane & 31, hi = lane >> 5;
    const int q = w >> 1, role = w & 1;
    constexpr int IST = 72, IMG = 128 * IST;
    LAS unsigned char* img0 = lds + q * (2 * IMG);
    for (int pass = 0; pass < 2; ++pass) {
        const bool samp = (pass == 0);
        const int nunits = samp ? (DB / 2) * 64 : (NB / 2) * 64, T = samp ? DS : SEQ;
        for (int uu = blk * 4 + q; uu < nunits; uu += G * 4) {
            const int bp = uu >> 6, g = uu & 63;
            const int rowbase0 = samp ? MP + (2 * bp) * DS : (2 * bp) * SEQ, bstride = T;
            const float dt = expf(P.log_dt[g]);
            const int ps = g * 64 + p + 32 * role; const float lr = P.lam_re[ps], li = P.lam_im[ps];
            const float mag = expf(lr * dt); const float lbr = mag * cosf(li * dt), lbi = mag * sinf(li * dt);
            const float nr0 = lbr - 1.0f, ni0 = lbi, den = lr * lr + li * li;
            const float zr = (nr0 * lr + ni0 * li) / den, zi = (ni0 * lr - nr0 * li) / den;
            float hr = 0.f, hm = 0.f;
            const int so = ((2 * bp + hi) * 64 + g) * 64 + p + 32 * role;
            if (samp) { hr = P.st_re[so]; hm = P.st_im[so]; }
            bf16x8 bfre, bfim;
            {
                const float* br = P.b_re + ((size_t)ps) * 16 + 8 * hi; const float* bi = P.b_im + ((size_t)ps) * 16 + 8 * hi;
                const f32x4 br0 = *(const f32x4*)br, br1 = *(const f32x4*)(br + 4), bi0 = *(const f32x4*)bi, bi1 = *(const f32x4*)(bi + 4);
                u32x4 wre, wim;
                wre.x = cvt_pk_bf16(zr * br0[0] - zi * bi0[0], zr * br0[1] - zi * bi0[1]); wre.y = cvt_pk_bf16(zr * br0[2] - zi * bi0[2], zr * br0[3] - zi * bi0[3]);
                wre.z = cvt_pk_bf16(zr * br1[0] - zi * bi1[0], zr * br1[1] - zi * bi1[1]); wre.w = cvt_pk_bf16(zr * br1[2] - zi * bi1[2], zr * br1[3] - zi * bi1[3]);
                wim.x = cvt_pk_bf16(zr * bi0[0] + zi * br0[0], zr * bi0[1] + zi * br0[1]); wim.y = cvt_pk_bf16(zr * bi0[2] + zi * br0[2], zr * bi0[3] + zi * br0[3]);
                wim.z = cvt_pk_bf16(zr * bi1[0] + zi * br1[0], zr * bi1[1] + zi * br1[1]); wim.w = cvt_pk_bf16(zr * bi1[2] + zi * br1[2], zr * bi1[3] + zi * br1[3]);
                bfre = __builtin_bit_cast(bf16x8, wre); bfim = __builtin_bit_cast(bf16x8, wim);
            }
            const int ci = lane & 15, kg = lane >> 4;
            bf16x8 cfrag[4];
#pragma unroll
            for (int kb = 0; kb < 4; ++kb) {
                const float* cp = ((kb < 2) ? P.c_re : P.c_im) + ((size_t)(g * 16 + ci)) * 64 + 32 * (kb & 1) + 8 * kg; const float sg = (kb < 2) ? 1.f : -1.f;
                const f32x4 c0 = *(const f32x4*)cp, c1 = *(const f32x4*)(cp + 4);
                u32x4 wc_; wc_.x = cvt_pk_bf16(sg * c0[0], sg * c0[1]); wc_.y = cvt_pk_bf16(sg * c0[2], sg * c0[3]); wc_.z = cvt_pk_bf16(sg * c1[0], sg * c1[1]); wc_.w = cvt_pk_bf16(sg * c1[2], sg * c1[3]);
                cfrag[kb] = __builtin_bit_cast(bf16x8, wc_);
            }
            const f32x4 dsk4 = *(const f32x4*)(P.dsk + g * 16 + 4 * kg);
            const int hip = (p >> 2) & 1, jp = (p & 3) + 4 * (p >> 3);
            const bf16_t* uptr = A3 + ((size_t)(rowbase0 + hip * bstride + jp)) * DM + g * 16 + 8 * hi;
            const size_t yoff = ((size_t)(rowbase0 + role * bstride + ci)) * DM + g * 16 + 4 * kg;
            const int nblk = T / 16;
            bf16x8 ufA = *(const bf16x8*)uptr, ufB = *(const bf16x8*)(uptr + (size_t)16 * DM), ufC = *(const bf16x8*)(uptr + (size_t)32 * DM);
            u32x2 unA = *(const u32x2*)(A3 + yoff), unB = *(const u32x2*)(A3 + yoff + (size_t)16 * DM), unC = *(const u32x2*)(A3 + yoff + (size_t)32 * DM);
            for (int tb = 0; tb < nblk; ++tb) {
                LAS unsigned char* img = img0 + (tb & 1) * IMG;
                const bf16x8 ucur = ufA; const u32x2 uw = unA;
                ufA = ufB; unA = unB; ufB = ufC; unB = unC;
                if (tb + 3 < nblk) { ufC = *(const bf16x8*)(uptr + (size_t)(tb + 3) * 16 * DM); unC = *(const u32x2*)(A3 + yoff + (size_t)(tb + 3) * 16 * DM); }
                f32x16 Xr, Xi;
                { f32x16 z = {}; Xr = __builtin_amdgcn_mfma_f32_32x32x16_bf16(ucur, bfre, z, 0, 0, 0); Xi = __builtin_amdgcn_mfma_f32_32x32x16_bf16(ucur, bfim, z, 0, 0, 0); }
#pragma unroll
                for (int r = 0; r < 16; ++r) {
                    const float nr = lbr * hr - lbi * hm + Xr[r];
                    const float ni = lbr * hm + lbi * hr + Xi[r];
                    hr = nr; hm = ni; Xr[r] = nr; Xi[r] = ni;
                }
#pragma unroll
                for (int q4 = 0; q4 < 4; ++q4) {
                    u32x2 wr_, wi_; wr_.x = cvt_pk_bf16(Xr[4 * q4], Xr[4 * q4 + 1]); wr_.y = cvt_pk_bf16(Xr[4 * q4 + 2], Xr[4 * q4 + 3]); wi_.x = cvt_pk_bf16(Xi[4 * q4], Xi[4 * q4 + 1]); wi_.y = cvt_pk_bf16(Xi[4 * q4 + 2], Xi[4 * q4 + 3]);
                    *(LAS u32x2*)(img + (role * 32 + p) * IST + (16 * hi + 4 * q4) * 2) = wr_;
                    *(LAS u32x2*)(img + ((2 + role) * 32 + p) * IST + (16 * hi + 4 * q4) * 2) = wi_;
                }
                asm volatile("s_waitcnt lgkmcnt(0)\n\ts_barrier" ::: "memory");
                f32x4 y = {0.f, 0.f, 0.f, 0.f};
#pragma unroll
                for (int kb = 0; kb < 4; ++kb) {
                    LAS const unsigned char* ap = img + (32 * kb + 8 * kg + (ci >> 2)) * IST + (16 * role + 4 * (ci & 3)) * 2;
                    const s16x4 lo = vtr(ap), h4 = vtr(ap + 4 * IST);
                    const bf16x8 af = (bf16x8){lo[0], lo[1], lo[2], lo[3], h4[0], h4[1], h4[2], h4[3]};
                    y = __builtin_amdgcn_mfma_f32_16x16x32_bf16(cfrag[kb], af, y, 0, 0, 0);
                }
                const float z0 = gelu_tanh(y[0] + dsk4[0] * __uint_as_float(uw.x << 16)), z1 = gelu_tanh(y[1] + dsk4[1] * __uint_as_float(uw.x & 0xffff0000u));
                const float z2 = gelu_tanh(y[2] + dsk4[2] * __uint_as_float(uw.y << 16)), z3 = gelu_tanh(y[3] + dsk4[3] * __uint_as_float(uw.y & 0xffff0000u));
                u32x2 zw; zw.x = cvt_pk_bf16(z0, z1); zw.y = cvt_pk_bf16(z2, z3);
                *(u32x2*)(Z + yoff + (size_t)tb * 16 * DM) = zw;
                asm volatile("s_waitcnt lgkmcnt(0)" ::: "memory");
            }
            if (samp) { P.o_res[so] = hr; P.o_ims[so] = hm; } else { P.o_rep[so] = hr; P.o_imp[so] = hm; }
        }
        __syncthreads();
    }
}

#define XB_TMO      128
#define XB_XCNT(j)  (256  + 64 * (j))
#define XB_XSUB(j)  (1280 + 64 * (j))
#define XB_XGEN(j)  (2304 + 64 * (j))
#define XB_TOP      3328
#define XB_TOPGEN   3392
#define XCD_BAR_WORDS 3456
#define XB_SPIN_CAP (1u << 18)
__device__ __forceinline__ unsigned xb_ld(unsigned* p)              { return __hip_atomic_load(p, __ATOMIC_RELAXED, __HIP_MEMORY_SCOPE_AGENT); }
__device__ __forceinline__ unsigned xb_add(unsigned* p, unsigned v) { return __hip_atomic_fetch_add(p, v, __ATOMIC_RELAXED, __HIP_MEMORY_SCOPE_AGENT); }
__device__ __forceinline__ unsigned xb_xcc_id() { return (unsigned)__builtin_amdgcn_s_getreg((3 << 11) | 20) & 0xFu; }
#define XB_SPIN(cond, bar) do { unsigned _sp = 0; while (cond) { __builtin_amdgcn_s_sleep(1); \
    if ((++_sp & 255u) == 0u) { if (xb_ld(&(bar)[XB_TMO])) break; if (_sp > XB_SPIN_CAP) { atomicAdd(&(bar)[XB_TMO], 1u); break; } } } } while (0)
struct XcdBarrier { unsigned* bar; unsigned x; volatile LAS unsigned* st; };
__device__ __forceinline__ XcdBarrier xcd_barrier_post(unsigned* bar, volatile LAS unsigned* st) {
    XcdBarrier b; b.bar = bar; b.x = xb_xcc_id(); b.st = st;
    if (threadIdx.x == 0) (void)xb_add(&bar[XB_XCNT(b.x)], 1u);
    return b;
}
__device__ __forceinline__ void xcd_barrier_complete(unsigned* bar, unsigned x, unsigned& nloc, unsigned& nx) {
    const unsigned G = gridDim.x * gridDim.y * gridDim.z;
    unsigned sum, cnt, mine, sp = 0u;
    for (;;) {
        sum = 0u; cnt = 0u; mine = 0u;
#pragma unroll
        for (unsigned j = 0; j < 16; ++j) { const unsigned c = xb_ld(&bar[XB_XCNT(j)]); sum += c; cnt += (c > 0u) ? 1u : 0u; mine = (j == x) ? c : mine; }
        if (sum == G) break;
        __builtin_amdgcn_s_sleep(1);
        if ((++sp & 255u) == 0u) { if (xb_ld(&bar[XB_TMO])) break; if (sp > XB_SPIN_CAP) { atomicAdd(&bar[XB_TMO], 1u); break; } }
    }
    nloc = mine > 0u ? mine : 1u; nx = cnt > 0u ? cnt : 1u;
}
__device__ __forceinline__ void xcd_barrier(const XcdBarrier& b) {
    asm volatile("s_waitcnt vmcnt(0)" ::: "memory");
    __syncthreads();
    if (threadIdx.x == 0) {
        unsigned* bar = b.bar;
        __builtin_amdgcn_s_waitcnt(0);
        unsigned nloc = b.st[0], nx = b.st[1];
        if (nloc == 0u) { xcd_barrier_complete(bar, b.x, nloc, nx); b.st[0] = nloc; b.st[1] = nx; }
        const unsigned old = xb_add(&bar[XB_XSUB(b.x)], 1u);
        const unsigned gen = old / nloc;
        if (old + 1u == (gen + 1u) * nloc) {
            __builtin_amdgcn_fence(__ATOMIC_RELEASE, "agent");
            asm volatile("s_waitcnt vmcnt(0)" ::: "memory");
            const unsigned og = xb_add(&bar[XB_TOP], 1u);
            const unsigned tg = og / nx;
            if (og + 1u == (tg + 1u) * nx) xb_add(&bar[XB_TOPGEN], 1u);
            else XB_SPIN(xb_ld(&bar[XB_TOPGEN]) == tg, bar);
            __builtin_amdgcn_fence(__ATOMIC_ACQUIRE, "agent");
            xb_add(&bar[XB_XGEN(b.x)], 1u);
            asm volatile("s_waitcnt vmcnt(0)" ::: "memory");
        } else {
            XB_SPIN(xb_ld(&bar[XB_XGEN(b.x)]) == gen, bar);
            __builtin_amdgcn_fence(__ATOMIC_ACQUIRE, "agent");
            asm volatile("s_waitcnt vmcnt(0)" ::: "memory");
        }
    }
    __syncthreads();
}

#ifndef UP_WGM
#define UP_WGM 4
#endif
__device__ __forceinline__ void phase_prologue(LAS unsigned char* lds, const Args& args, unsigned char* ws, float* out, int G, int blk, int wave, int lane, int tid) {
    const int gw = blk * 8 + wave, NGW = G * 8;
    bf16_t* Wqkv = (bf16_t*)(ws + WS_WQKV); bf16_t* Wo = (bf16_t*)(ws + WS_WO); bf16_t* Wglu = (bf16_t*)(ws + WS_WGLU); bf16_t* Wup = (bf16_t*)(ws + WS_WUP); bf16_t* Wdn = (bf16_t*)(ws + WS_WDN);
    float* rope = (float*)(ws + WS_ROPE); bf16_t* Abuf = (bf16_t*)(ws + WS_A); bf16_t* Kbuf = (bf16_t*)(ws + WS_K); bf16_t* Vbuf = (bf16_t*)(ws + WS_V);
    LAS float* scr = (LAS float*)(lds + wave * 16384);
    constexpr int I_QKV = 16 * 48, I_O = 16 * 32, I_GLU = 16 * 64, I_UP = 16 * 176, I_DN = 44 * 32;
    constexpr int NITEMS = I_QKV + I_O + I_GLU + 2 * I_UP + 2 * I_DN;
    for (int it = gw; it < NITEMS; it += NGW) {
        int r = it;
        if (r < I_QKV) { transpose_item(args.in[11], DM, QKVD, Wqkv, 0, scr, r, lane); continue; } r -= I_QKV;
        if (r < I_O) { transpose_item(args.in[14], DM, DM, Wo, 0, scr, r, lane); continue; } r -= I_O;
        if (r < I_GLU) { transpose_item(args.in[24], DM, 2 * DM, Wglu, DM, scr, r, lane); continue; } r -= I_GLU;
        if (r < 2 * I_UP) { const int l = r / I_UP; transpose_item(args.in[26] + (size_t)l * DM * FF2, DM, FF2, Wup + (size_t)l * FF2 * DM, FF, scr, r % I_UP, lane); continue; } r -= 2 * I_UP;
        { const int l = r / I_DN; transpose_item(args.in[29] + (size_t)l * FF * DM, FF, DM, Wdn + (size_t)l * DM * FF, 0, scr, r % I_DN, lane); }
    }
    for (int i = blk * 512 + tid; i < SEQ * 8; i += G * 512) { const int pos = i >> 3, f = i & 7; const float inv_freq = powf(500000.0f, -(float)f * 0.125f); const float ang = (float)pos * inv_freq;
        rope[pos * 16 + f] = cosf(ang); rope[pos * 16 + 8 + f] = sinf(ang); }
    for (int i = blk * 512 + tid; i < DB * 128 * 64; i += G * 512) {
        const int b = i / (128 * 64), rem = i % (128 * 64), row = rem >> 6, c4 = (rem & 63) * 4;
        const f32x4 kv = *(const f32x4*)(args.in[2] + ((size_t)(b * 128 + row)) * 256 + c4), vv = *(const f32x4*)(args.in[3] + ((size_t)(b * 128 + row)) * 256 + c4);
        u32x2 kw, vw; kw.x = cvt_pk_bf16(kv[0], kv[1]); kw.y = cvt_pk_bf16(kv[2], kv[3]); vw.x = cvt_pk_bf16(vv[0], vv[1]); vw.y = cvt_pk_bf16(vv[2], vv[3]);
        const size_t krow = (size_t)MP + b * 192 + row;
        *(u32x2*)(Kbuf + krow * 256 + c4) = kw; *(u32x2*)(Vbuf + krow * 256 + c4) = vw;
        if (row >= 64) { *(f32x4*)(out + O_KS + ((size_t)(b * 128 + row - 64)) * 256 + c4) = kv; *(f32x4*)(out + O_VS + ((size_t)(b * 128 + row - 64)) * 256 + c4) = vv; }
    }
    {
        f32x4 gn[4], xa[4], xb_[4];
#define P0_C(j) (8 * lane + 512 * ((j) >> 1) + 4 * ((j) & 1))
#pragma unroll
        for (int j = 0; j < 4; ++j) gn[j] = *(const f32x4*)(args.in[7] + P0_C(j));
#define P0_X(mm) (((mm) < MP) ? args.in[0] + (size_t)(mm) * DM : args.in[1] + (size_t)((mm) - MP) * DM)
        int m = gw;
        f32x4 xc_[4];
        if (m < MT) {
#pragma unroll
            for (int j = 0; j < 4; ++j) xa[j] = *(const f32x4*)(P0_X(m) + P0_C(j));
        }
        if (m + NGW < MT) {
#pragma unroll
            for (int j = 0; j < 4; ++j) xb_[j] = *(const f32x4*)(P0_X(m + NGW) + P0_C(j));
        }
        for (; m < MT; m += NGW) {
            const int mn = m + 2 * NGW;
            if (mn < MT) {
#pragma unroll
                for (int j = 0; j < 4; ++j) xc_[j] = *(const f32x4*)(P0_X(mn) + P0_C(j));
            }
            float s2 = 0.f;
#pragma unroll
            for (int j = 0; j < 4; ++j) s2 += (xa[j][0] * xa[j][0] + xa[j][1] * xa[j][1]) + (xa[j][2] * xa[j][2] + xa[j][3] * xa[j][3]);
            const float rstd2 = 1.0f / sqrtf(wave_sum(s2) * (1.0f / DM) + EPS);
#pragma unroll
            for (int j = 0; j < 2; ++j) *(u32x4*)(Abuf + (size_t)m * DM + 8 * lane + 512 * j) = pack8(xa[2 * j] * gn[2 * j] * rstd2, xa[2 * j + 1] * gn[2 * j + 1] * rstd2);
#pragma unroll
            for (int j = 0; j < 4; ++j) { xa[j] = xb_[j]; xb_[j] = xc_[j]; }
        }
#undef P0_C
#undef P0_X
    }
}

template <bool XIN_F32>
__device__ __forceinline__ void rp_load(const void* xrow, const bf16_t* mrow, const float* ssrow, int nslots, int lane, f32x4 (&xf)[4], u32x4 (&xb)[2], u32x4 (&mw)[2], float& ssv) {
#pragma unroll
    for (int j = 0; j < 2; ++j) { const int c0 = 8 * lane + 512 * j;
        if constexpr (XIN_F32) { xf[2 * j] = __builtin_nontemporal_load((const f32x4*)((const float*)xrow + c0)); xf[2 * j + 1] = __builtin_nontemporal_load((const f32x4*)((const float*)xrow + c0 + 4)); }
        else xb[j] = *(const u32x4*)((const bf16_t*)xrow + c0);
        mw[j] = __builtin_nontemporal_load((const u32x4*)(mrow + c0));
    }
    ssv = (lane < nslots) ? ssrow[lane] : 0.f;
}
template <int MODE>
__device__ __forceinline__ void rp_finish(const f32x4 (&xf)[4], const u32x4 (&xb)[2], const u32x4 (&mw)[2], float ssv, const f32x4 (&gp)[4], const f32x4 (&gn)[4], void* xout, bf16_t* arow, int lane) {
    f32x4 v[4];
    const float rstd = 1.0f / sqrtf(wave_sum(ssv) * (1.0f / DM) + EPS);
    float s2 = 0.f;
#pragma unroll
    for (int j = 0; j < 2; ++j) { const int c0 = 8 * lane + 512 * j;
        if constexpr (MODE == 0) { v[2 * j] = xf[2 * j]; v[2 * j + 1] = xf[2 * j + 1]; } else unpack8(xb[j], v[2 * j], v[2 * j + 1]);
        f32x4 m0, m1; unpack8(mw[j], m0, m1);
        v[2 * j] += m0 * rstd * gp[2 * j]; v[2 * j + 1] += m1 * rstd * gp[2 * j + 1];
        if constexpr (MODE == 2) { *(f32x4*)((float*)xout + c0) = v[2 * j]; *(f32x4*)((float*)xout + c0 + 4) = v[2 * j + 1]; }
        else *(u32x4*)((bf16_t*)xout + c0) = pack8(v[2 * j], v[2 * j + 1]);
#pragma unroll
        for (int h = 0; h < 2; ++h) s2 += (v[2 * j + h][0] * v[2 * j + h][0] + v[2 * j + h][1] * v[2 * j + h][1]) + (v[2 * j + h][2] * v[2 * j + h][2] + v[2 * j + h][3] * v[2 * j + h][3]);
    }
    if constexpr (MODE != 2) {
        const float rstd2 = 1.0f / sqrtf(wave_sum(s2) * (1.0f / DM) + EPS);
#pragma unroll
        for (int j = 0; j < 2; ++j) *(u32x4*)(arow + 8 * lane + 512 * j) = pack8(v[2 * j] * gn[2 * j] * rstd2, v[2 * j + 1] * gn[2 * j + 1] * rstd2);
    }
}
template <int MODE>
__device__ __forceinline__ void phase_rows(const float* x_prompt, const float* x_sample, bf16_t* X16, float* out, const bf16_t* Mbuf, const float* ss, int nslots, const float* gpost, const float* gnext, bf16_t* Abuf, int gw, int NGW, int lane, const float* sacc, const float* mbias, int ns, bool skip_prompt, bool glu = false) {
    int m = gw;
    if (skip_prompt) m = gw + ((MP - gw + NGW - 1) / NGW) * NGW;
    else {
        f32x4 gp[4], gn[4];
#pragma unroll
        for (int j = 0; j < 4; ++j) { const int cg_ = 8 * lane + 512 * (j >> 1) + 4 * (j & 1); gp[j] = *(const f32x4*)(gpost + cg_); gn[j] = (MODE != 2) ? *(const f32x4*)(gnext + cg_) : (f32x4){0.f, 0.f, 0.f, 0.f}; }
        f32x4 xfA[4], xfB[4], xfC[4]; u32x4 xbA[2], xbB[2], xbC[2], mwA[2], mwB[2], mwC[2]; float ssA = 0.f, ssB = 0.f, ssC = 0.f;
#define RP_X(mm) ((MODE == 0) ? (const void*)(x_prompt + (size_t)(mm) * DM) : (const void*)(X16 + (size_t)(mm) * DM))
        if (m < MP) rp_load<MODE == 0>(RP_X(m), Mbuf + (size_t)m * DM, ss + (size_t)m * 32, nslots, lane, xfA, xbA, mwA, ssA);
        if (m + NGW < MP) rp_load<MODE == 0>(RP_X(m + NGW), Mbuf + (size_t)(m + NGW) * DM, ss + (size_t)(m + NGW) * 32, nslots, lane, xfB, xbB, mwB, ssB);
        for (; m < MP; m += NGW) {
            const int mn = m + 2 * NGW;
            if (mn < MP) rp_load<MODE == 0>(RP_X(mn), Mbuf + (size_t)mn * DM, ss + (size_t)mn * 32, nslots, lane, xfC, xbC, mwC, ssC);
            rp_finish<MODE>(xfA, xbA, mwA, ssA, gp, gn, (MODE == 2) ? (void*)(out + (size_t)m * DM) : (void*)(X16 + (size_t)m * DM), Abuf + (size_t)m * DM, lane);
#pragma unroll
            for (int j = 0; j < 4; ++j) { xfA[j] = xfB[j]; xfB[j] = xfC[j]; }
#pragma unroll
            for (int j = 0; j < 2; ++j) { xbA[j] = xbB[j]; xbB[j] = xbC[j]; mwA[j] = mwB[j]; mwB[j] = mwC[j]; }
            ssA = ssB; ssB = ssC;
        }
#undef RP_X
    }
    for (; m < MT; m += NGW) {
        const bool sp = (sacc != nullptr) && (m >= MP); const float* sr = sp ? sacc + (size_t)(m - MP) * DM : nullptr;
        if constexpr (MODE == 0) { const float* xr = (m < MP) ? x_prompt + (size_t)m * DM : x_sample + (size_t)(m - MP) * DM;
            if (sp) row_pass<true, true, true, false, true>(xr, X16 + (size_t)m * DM, nullptr, nullptr, ns, gpost, gnext, Abuf + (size_t)m * DM, lane, sr, mbias);
            else row_pass<true, true, true, false>(xr, X16 + (size_t)m * DM, Mbuf + (size_t)m * DM, ss + (size_t)m * 32, nslots, gpost, gnext, Abuf + (size_t)m * DM, lane); }
        else if constexpr (MODE == 1) {
            if (sp && glu) row_pass<true, true, false, false, false, true>(X16 + (size_t)m * DM, X16 + (size_t)m * DM, nullptr, nullptr, ns, gpost, gnext, Abuf + (size_t)m * DM, lane, sacc + (size_t)(m - MP) * 2 * DM, mbias);
            else if (sp) row_pass<true, true, false, false, true>(X16 + (size_t)m * DM, X16 + (size_t)m * DM, nullptr, nullptr, ns, gpost, gnext, Abuf + (size_t)m * DM, lane, sr, mbias);
            else row_pass<true, true, false, false>(X16 + (size_t)m * DM, X16 + (size_t)m * DM, Mbuf + (size_t)m * DM, ss + (size_t)m * 32, nslots, gpost, gnext, Abuf + (size_t)m * DM, lane); }
        else {
            if (sp) row_pass<true, false, false, true, true>(X16 + (size_t)m * DM, out + (size_t)m * DM, nullptr, nullptr, ns, gpost, nullptr, nullptr, lane, sr, mbias);
            else row_pass<true, false, false, true>(X16 + (size_t)m * DM, out + (size_t)m * DM, Mbuf + (size_t)m * DM, ss + (size_t)m * 32, nslots, gpost, nullptr, nullptr, lane); }
    }
}
__device__ __forceinline__ void phase_up(LAS unsigned char* lds, const bf16_t* Abuf, const bf16_t* Wup_l, bf16_t* Gbuf, float* Ebuf, const float* cw, const float* cb, int G, int blk) {
    pg8::Gemm g{Abuf, Wup_l, MT, FF2, DM}; pg8::StaticOrder S; S.init(MT, FF2, DM, G, blk); S.wgm = UP_WGM;
    pg8::EpiUp E{Gbuf, Ebuf, cw, cb};
    pg8::gemm_phase<pg8::EpiUp, true, true>(lds, g, S, E);
}
__device__ __forceinline__ void phase_down(LAS unsigned char* lds, const bf16_t* Gbuf, const bf16_t* Wdn_l, bf16_t* Mbuf, float* ss, float* sacc, int G, int blk) {
    pg8::Gemm g{Gbuf, Wdn_l, MT, DM, FF}; pg8::StaticOrder S; S.init(MT, DM, FF, G, blk, MP / 256, 11);
    pg8::EpiPlainSS E{Mbuf, nullptr, ss, sacc, FF / 64};
    pg8::gemm_phase<pg8::EpiPlainSS, true, true>(lds, g, S, E);
}
__device__ __forceinline__ void phase_fix(const float* Ebuf, bf16_t* Gbuf, const float* cw, const float* cb, const float* cc, float* out, int l, int G, int blk, int tid) {
    for (int i = blk * 512 + tid; i < NSEG * 2 * (FF / 4); i += G * 512) {
        const int ri = i / (FF / 4), c4 = (i % (FF / 4)) * 4, seg = ri >> 1, j = ri & 1;
        f32x4 o;
        f32x4 cres[2];
#pragma unroll
        for (int hf = 0; hf < 2; ++hf) {
            const int col = hf * FF + c4;
            const f32x4 cur0 = *(const f32x4*)(Ebuf + ((size_t)seg * 4 + 0) * FF2 + col), cur1 = *(const f32x4*)(Ebuf + ((size_t)seg * 4 + 1) * FF2 + col);
            f32x4 p0 = {0.f, 0.f, 0.f, 0.f}, p1 = {0.f, 0.f, 0.f, 0.f};
            if (seg >= MP / 64) { const int b = seg - MP / 64; p0 = *(const f32x4*)(cc + ((size_t)b * 2 + 0) * FF2 + col); p1 = *(const f32x4*)(cc + ((size_t)b * 2 + 1) * FF2 + col); }
            else if ((seg & 31) != 0) { p0 = *(const f32x4*)(Ebuf + ((size_t)(seg - 1) * 4 + 2) * FF2 + col); p1 = *(const f32x4*)(Ebuf + ((size_t)(seg - 1) * 4 + 3) * FF2 + col); }
            const f32x4 w0 = *(const f32x4*)(cw + col), w1 = *(const f32x4*)(cw + FF2 + col), w2 = *(const f32x4*)(cw + 2 * FF2 + col), bb = *(const f32x4*)(cb + col);
            cres[hf] = (j == 0) ? (bb + w0 * p0 + w1 * p1 + w2 * cur0) : (bb + w0 * p1 + w1 * cur0 + w2 * cur1);
        }
#pragma unroll
        for (int q = 0; q < 4; ++q) o[q] = gelu_tanh(cres[0][q]) * cres[1][q];
        u32x2 wv; wv.x = cvt_pk_bf16(o[0], o[1]); wv.y = cvt_pk_bf16(o[2], o[3]);
        *(u32x2*)(Gbuf + ((size_t)seg * 64 + j) * FF + c4) = wv;
    }
    for (int i = blk * 512 + tid; i < (NB + DB) * 2 * (FF2 / 4); i += G * 512) {
        const int ri = i / (FF2 / 4), c4 = (i % (FF2 / 4)) * 4, bb = ri >> 1, e = ri & 1;
        const int seg = (bb < NB) ? bb * 32 + 31 : MP / 64 + (bb - NB);
        const f32x4 v = *(const f32x4*)(Ebuf + ((size_t)seg * 4 + 2 + e) * FF2 + c4);
        float* o = (bb < NB) ? out + O_CP + (((size_t)l * NB + bb) * 2 + e) * FF2 + c4 : out + O_CS + (((size_t)l * DB + (bb - NB)) * 2 + e) * FF2 + c4;
        *(f32x4*)o = v;
    }
}

__global__ void __launch_bounds__(512, 2) fwd_kernel(Args args) {
    extern __shared__ __attribute__((aligned(16))) unsigned char lds_raw[];
    LAS unsigned char* lds = (LAS unsigned char*)lds_raw;
    const int G = gridDim.x, blk = blockIdx.x, NGW = G * 8;
#define IDS int tid = threadIdx.x; asm volatile("" : "+v"(tid)); const int lane = tid & 63, wave = __builtin_amdgcn_readfirstlane(tid >> 6), gw = blk * 8 + wave; (void)lane; (void)gw
    unsigned char* ws = args.ws; float* out = args.out;
    const float* x_prompt = args.in[0]; const float* x_sample = args.in[1];
    bf16_t* Wqkv = (bf16_t*)(ws + WS_WQKV); bf16_t* Wo = (bf16_t*)(ws + WS_WO); bf16_t* Wglu = (bf16_t*)(ws + WS_WGLU); bf16_t* Wup = (bf16_t*)(ws + WS_WUP); bf16_t* Wdn = (bf16_t*)(ws + WS_WDN);
    float* rope = (float*)(ws + WS_ROPE); float* ss = (float*)(ws + WS_SS);
    bf16_t* Abuf = (bf16_t*)(ws + WS_A); bf16_t* Mbuf = (bf16_t*)(ws + WS_MB); float* Ebuf = (float*)(ws + WS_E); bf16_t* Gbuf = (bf16_t*)(ws + WS_G);
    bf16_t* X16 = (bf16_t*)(ws + WS_X16); float* sacc = (float*)(ws + WS_SACC);
    bf16_t* Qbuf = (bf16_t*)(ws + WS_Q); bf16_t* Kbuf = (bf16_t*)(ws + WS_K); bf16_t* Vbuf = (bf16_t*)(ws + WS_V);


    const int lo = args.ph_lo, hi_ = args.ph_hi;
    volatile LAS unsigned* misc = (volatile LAS unsigned*)(lds + XL_MISC);
    if (threadIdx.x < 2) misc[threadIdx.x] = 0u;
    __syncthreads();
    XcdBarrier xbar; xbar.bar = (unsigned*)ws; xbar.x = 0; xbar.st = nullptr;
    if (args.coop) xbar = xcd_barrier_post((unsigned*)ws, misc);
    if (args.coop == 2) cg::this_grid().sync();
#define IN(k) (lo <= (k) && (k) < hi_)
#define SEAM(k) do { if (args.coop && (k) + 1 < hi_) xcd_barrier(xbar); } while (0)
#define REP(k) _Pragma("unroll") for (int rep_ = 0; rep_ <= ((PROBE_REPMASK >> (k)) & 1); ++rep_)
    if (IN(0)) { IDS; REP(0) { phase_prologue(lds, args, ws, out, G, blk, wave, lane, tid); } SEAM(0); }
    if (IN(1)) { REP(1) {
        pg8::Gemm g{Abuf, Wqkv, MT, QKVD, DM}; pg8::StaticOrder S; S.init(MT, QKVD, DM, G, blk);
        pg8::EpiQKV E{Qbuf, Kbuf, Vbuf, args.in[12], rope, out + O_KP, out + O_VP, out + O_KS, out + O_VS};
        pg8::gemm_phase<pg8::EpiQKV, true, true>(lds, g, S, E); } SEAM(1); }
    if (IN(2)) { REP(2) { attn_phase(lds, Qbuf, Kbuf, Vbuf, Abuf, args.in[13], G, blk); } SEAM(2); }
    const bool fusedp = (G == 256);
    unsigned long long* xch = (unsigned long long*)(ws + WS_XCH); unsigned* pcnt = (unsigned*)(ws + WS_CNT); LAS unsigned char* xl = lds + XL_OFF;
    if (IN(3)) { REP(3) {
        pg8::Gemm g{Abuf, Wo, MT, DM, DM}; pg8::StaticOrder S; S.init(MT, DM, DM, G, blk, MP / 256, 4);
        { pg8::EpiPlainSS E{Mbuf, args.in[15], ss, sacc, DM / 64}; pg8::gemm_phase<pg8::EpiPlainSS, true, true>(lds, g, S, E); } } SEAM(3); }
    bf16_t* Aup0 = Abuf;
    if (IN(4)) { IDS; REP(4) { phase_rows<0>(x_prompt, x_sample, X16, out, Mbuf, ss, 16, args.in[8], args.in[9], Aup0, gw, NGW, lane, sacc, args.in[15], 4, false); } SEAM(4); }
    if (IN(5)) { REP(5) { phase_up(lds, Aup0, Wup, Gbuf, Ebuf, args.in[27], args.in[28], G, blk); } SEAM(5); }
    if (IN(6)) { IDS; REP(6) { phase_fix(Ebuf, Gbuf, args.in[27], args.in[28], args.in[6], out, 0, G, blk, tid); } SEAM(6); }
    if (IN(7)) { REP(7) {
        if (fusedp) { pg8::Gemm g{Gbuf, Wdn, MT, DM, FF}; pg8::StaticOrder S; S.init(MT, DM, FF, G, blk, MP / 256, 11); S.panel = true;
            pg8::EpiFused<false, false> E{nullptr, X16, X16, nullptr, Abuf, args.in[10], args.in[7] + DM, xch + (size_t)MP * 8, pcnt + 256 * 64, xl, sacc, FF / 64};
            pg8::gemm_phase<pg8::EpiFused<false, false>, true, true>(lds, g, S, E); }
        else phase_down(lds, Gbuf, Wdn, Mbuf, ss, sacc, G, blk); } SEAM(7); }
    if (IN(8)) { IDS; REP(8) { phase_rows<1>(x_prompt, x_sample, X16, out, Mbuf, ss, 16, args.in[10], args.in[7] + DM, Abuf, gw, NGW, lane, sacc, nullptr, 11, fusedp); } SEAM(8); }
    if (IN(9)) { REP(9) {
        SsmP P{args.in[16], args.in[17], args.in[18], args.in[19], args.in[20], args.in[21], args.in[22], args.in[23], args.in[4], args.in[5], out + O_REP, out + O_IMP, out + O_RES, out + O_IMS};
        ssm_phase(lds, Abuf, Qbuf, P, G, blk); } SEAM(9); }
    if (IN(10)) { REP(10) {
        pg8::Gemm g{Qbuf, Wglu, MT, 2 * DM, DM}; pg8::StaticOrder S; S.init(MT, 2 * DM, DM, G, blk, MP / 256, 4);
        pg8::EpiGlu E{Mbuf, args.in[25], ss, sacc, DM / 64};
        pg8::gemm_phase<pg8::EpiGlu, true, true>(lds, g, S, E); } SEAM(10); }
    if (IN(11)) { IDS; REP(11) { phase_rows<1>(x_prompt, x_sample, X16, out, Mbuf, ss, 32, args.in[8] + DM, args.in[9] + DM, Abuf, gw, NGW, lane, sacc, args.in[25], 4, false, true); } SEAM(11); }
    if (IN(12)) { REP(12) { phase_up(lds, Abuf, Wup + (size_t)FF2 * DM, Gbuf, Ebuf, args.in[27] + (size_t)3 * FF2, args.in[28] + FF2, G, blk); } SEAM(12); }
    if (IN(13)) { IDS; REP(13) { phase_fix(Ebuf, Gbuf, args.in[27] + (size_t)3 * FF2, args.in[28] + FF2, args.in[6] + (size_t)DB * 2 * FF2, out, 1, G, blk, tid); } SEAM(13); }
    if (IN(14)) { REP(14) {
        if (fusedp) { pg8::Gemm g{Gbuf, Wdn + (size_t)DM * FF, MT, DM, FF}; pg8::StaticOrder S; S.init(MT, DM, FF, G, blk, MP / 256, 11); S.panel = true;
            pg8::EpiFused<false, true> E{nullptr, X16, nullptr, out, nullptr, args.in[10] + DM, nullptr, xch + (size_t)2 * MP * 8, pcnt + 2 * 256 * 64, xl, sacc, FF / 64};
            pg8::gemm_phase<pg8::EpiFused<false, true>, true, true>(lds, g, S, E); }
        else phase_down(lds, Gbuf, Wdn + (size_t)DM * FF, Mbuf, ss, sacc, G, blk); } SEAM(14); }
    if (IN(15)) { IDS; REP(15) { phase_rows<2>(x_prompt, x_sample, X16, out, Mbuf, ss, 16, args.in[10] + DM, nullptr, nullptr, gw, NGW, lane, sacc, nullptr, 11, fusedp); } }
#undef IN
#undef SEAM
#undef REP
}

extern "C" void kernel_launch(void* const* d_in, const int* in_sizes, int n_in, void* d_out, int out_size, void* d_ws, size_t ws_size, hipStream_t stream) {
    static int grid = 0;
    if (grid == 0) {
        if (n_in != 30 || (size_t)out_size != O_END || ws_size < WS_END) { fprintf(stderr, "kernel_launch: unexpected shapes: n_in %d out %d ws %zu (need out %zu ws %zu)\n", n_in, out_size, ws_size, (size_t)O_END, (size_t)WS_END); grid = -1; return; }
        int dev = 0, cus = 0, per_cu = 0;
        hipGetDevice(&dev); hipDeviceGetAttribute(&cus, hipDeviceAttributeMultiprocessorCount, dev);
        if (hipFuncSetAttribute((const void*)fwd_kernel, hipFuncAttributeMaxDynamicSharedMemorySize, LDS_BYTES) != hipSuccess) { fprintf(stderr, "kernel_launch: hipFuncSetAttribute failed\n"); grid = -1; return; }
        if (hipOccupancyMaxActiveBlocksPerMultiprocessor(&per_cu, (const void*)fwd_kernel, 512, LDS_BYTES) != hipSuccess || per_cu < 1) { fprintf(stderr, "kernel_launch: occupancy query says %d\n", per_cu); per_cu = 1; }
        (void)hipGetLastError();
        grid = cus * 1;
    }
    if (grid < 0) return;
    Args a{};
    for (int i = 0; i < 30; ++i) a.in[i] = (const float*)d_in[i];
    a.out = (float*)d_out; a.ws = (unsigned char*)d_ws;
#ifndef MK_MULTI
    if (hipMemsetAsync(d_ws, 0, CTL_ZERO_BYTES, stream) != hipSuccess) { fprintf(stderr, "kernel_launch: memset failed\n"); return; }
    a.ph_lo = 0; a.ph_hi = NPHASE; a.coop = 1;
    void* kargs[] = {&a};
    hipError_t e = hipLaunchCooperativeKernel((const void*)fwd_kernel, dim3(grid), dim3(512), kargs, LDS_BYTES, stream);
    if (e != hipSuccess) fprintf(stderr, "cooperative launch failed: %s (grid %d)\n", hipGetErrorString(e), grid);
#else
    for (int ph = 0; ph < NPHASE; ++ph) { a.ph_lo = ph; a.ph_hi = ph + 1; a.coop = 0; hipLaunchKernelGGL(fwd_kernel, dim3(grid), dim3(512), LDS_BYTES, stream, a); }
#endif
}
```

```cpp
#include <hip/hip_runtime.h>
#include <hip/hip_cooperative_groups.h>
#include <cstdio>
#include <cstdint>
namespace cg = cooperative_groups;

#define LAS __attribute__((address_space(3)))
typedef unsigned short bf16_t;
typedef short bf16x8 __attribute__((ext_vector_type(8)));
typedef short s16x4 __attribute__((ext_vector_type(4)));
typedef float f32x4 __attribute__((ext_vector_type(4)));
typedef float f32x16 __attribute__((ext_vector_type(16)));
typedef unsigned u32x4 __attribute__((ext_vector_type(4)));
typedef unsigned u32x2 __attribute__((ext_vector_type(2)));

constexpr int DM = 1024, NB = 32, SEQ = 2048, MP = NB * SEQ, DB = 16, DS = 64, MS = DB * DS, MT = MP + MS;
constexpr int QKVD = 1536, FF = 2816, FF2 = 5632, NSEG = MT / 64;
constexpr int KVROWS = MP + DB * 192;
constexpr float EPS = 1e-6f, LOG2E = 1.4426950408889634f, QSCALE = 0.125f * 1.4426950408889634f;
constexpr size_t O_Y = 0, O_KP = (size_t)MT * DM, O_VP = O_KP + (size_t)NB * 128 * 256, O_KS = O_VP + (size_t)NB * 128 * 256, O_VS = O_KS + (size_t)DB * 128 * 256,
                 O_REP = O_VS + (size_t)DB * 128 * 256, O_IMP = O_REP + NB * 4096, O_RES = O_IMP + NB * 4096, O_IMS = O_RES + DB * 4096,
                 O_CP = O_IMS + DB * 4096, O_CS = O_CP + (size_t)2 * NB * 2 * FF2, O_END = O_CS + (size_t)2 * DB * 2 * FF2;
constexpr size_t MiB = 1u << 20;
constexpr size_t WS_WQKV = 1 * MiB, WS_WO = 4 * MiB, WS_WGLU = 6 * MiB, WS_WUP = 10 * MiB, WS_WDN = 32 * MiB, WS_ROPE = 43 * MiB, WS_SS = 44 * MiB,
                 WS_A = 54 * MiB, WS_MB = 185 * MiB, WS_E = 316 * MiB, WS_G = 406 * MiB, WS_Q = WS_G, WS_K = WS_G + 132 * MiB, WS_V = WS_K + 34 * MiB, WS_X16 = WS_G + 358 * MiB, WS_SACC = WS_X16 + 131 * MiB, WS_XCH = WS_SACC + 44 * MiB, WS_END = WS_XCH + 13 * MiB;
constexpr size_t WS_CNT = 32768, CTL_ZERO_BYTES = 32768 + 3 * 256 * 256;
static_assert(WS_WUP + (size_t)2 * FF2 * DM * 2 <= WS_WDN && WS_WDN + (size_t)2 * DM * FF * 2 <= WS_ROPE && WS_SS + (size_t)MT * 32 * 4 <= WS_A, "ws map 1");
static_assert(WS_A + (size_t)MT * DM * 2 <= WS_MB && WS_MB + (size_t)MT * DM * 2 <= WS_E && WS_E + (size_t)NSEG * 4 * FF2 * 4 <= WS_G, "ws map 2");
static_assert(WS_X16 + (size_t)MT * DM * 2 <= WS_END, "ws map 4");
static_assert(WS_Q + (size_t)MT * DM * 2 <= WS_K && WS_K + (size_t)KVROWS * 256 * 2 <= WS_V && WS_V + (size_t)KVROWS * 256 * 2 <= WS_END && WS_G + (size_t)MT * FF * 2 <= WS_END, "ws map 3");

__device__ __forceinline__ unsigned cvt_pk_bf16(float lo, float hi) { unsigned r; asm volatile("v_cvt_pk_bf16_f32 %0, %1, %2" : "=v"(r) : "v"(lo), "v"(hi)); return r; }
__device__ __forceinline__ void unpack8(const u32x4 w, f32x4& lo, f32x4& hi) {
    lo[0] = __uint_as_float(w.x << 16); lo[1] = __uint_as_float(w.x & 0xffff0000u); lo[2] = __uint_as_float(w.y << 16); lo[3] = __uint_as_float(w.y & 0xffff0000u);
    hi[0] = __uint_as_float(w.z << 16); hi[1] = __uint_as_float(w.z & 0xffff0000u); hi[2] = __uint_as_float(w.w << 16); hi[3] = __uint_as_float(w.w & 0xffff0000u);
}
__device__ __forceinline__ u32x4 pack8(const f32x4 lo, const f32x4 hi) { u32x4 w; w.x = cvt_pk_bf16(lo[0], lo[1]); w.y = cvt_pk_bf16(lo[2], lo[3]); w.z = cvt_pk_bf16(hi[0], hi[1]); w.w = cvt_pk_bf16(hi[2], hi[3]); return w; }
__device__ __forceinline__ float bf2f(unsigned short b) { return __uint_as_float((unsigned)b << 16); }
__device__ __forceinline__ float gelu_tanh(float x) {
    const float x2 = x * x, u = x * (0.7978845608f + 0.0356774081f * x2);
    const float e = __builtin_amdgcn_exp2f(-2.885390082f * u);
    return x * __builtin_amdgcn_rcpf(1.0f + e);
}
typedef float f32x2 __attribute__((ext_vector_type(2)));
__device__ __forceinline__ f32x2 gelu_gate_pk(f32x2 x, f32x2 cv) {
    const f32x2 x2 = x * x, t = x2 * (-2.885390082f * 0.0356774081f) + (-2.885390082f * 0.7978845608f), a = x * t;
    f32x2 e; e.x = __builtin_amdgcn_exp2f(a.x); e.y = __builtin_amdgcn_exp2f(a.y);
    const f32x2 d = e + 1.0f;
    f32x2 r; r.x = __builtin_amdgcn_rcpf(d.x); r.y = __builtin_amdgcn_rcpf(d.y);
    return (x * cv) * r;
}
__device__ __forceinline__ float sigmoid_f(float v) { return __builtin_amdgcn_rcpf(1.0f + __builtin_amdgcn_exp2f(-LOG2E * v)); }
__device__ __forceinline__ float wave_sum(float v) {
#pragma unroll
    for (int o = 1; o < 64; o <<= 1) v += __shfl_xor(v, o);
    return v;
}
__device__ __forceinline__ float sum_rows4(float v) {
    auto a = __builtin_amdgcn_permlane16_swap(__float_as_uint(v), __float_as_uint(v), false, false);
    const float s = __uint_as_float(a[0]) + __uint_as_float(a[1]);
    auto b = __builtin_amdgcn_permlane32_swap(__float_as_uint(s), __float_as_uint(s), false, false);
    return __uint_as_float(b[0]) + __uint_as_float(b[1]);
}
template <int CTRL> __device__ __forceinline__ float dpp_f(float x) { return __builtin_bit_cast(float, __builtin_amdgcn_update_dpp(0, __builtin_bit_cast(int, x), CTRL, 0xf, 0xf, false)); }

#define FMAC_DPP(c, src, w, CTRL) asm volatile("v_fmac_f32_dpp %0, %1, %2 " CTRL " row_mask:0xf bank_mask:0xf" : "+v"(c) : "v"(src), "v"(w))
namespace pg8 {
constexpr int BM = 256, BK = 64, HALF = 128, HTB = HALF * BK * 2, STAGE_BYTES = 8 * HTB, NXCD = 8, WGM = 8;
__host__ __device__ __forceinline__ int lds_byte(int r, int c) { const int st = (r >> 4) * 2 + (c >> 5), rr = r & 15, cc = c & 31, ob = rr * 64 + cc * 2; return st * 1024 + (ob ^ (((ob >> 9) & 1) << 5)); }
__host__ __device__ __forceinline__ void stage_rc(int b, int& R, int& C) { const int st = b / 1024, sb = b % 1024, swz = sb ^ (((sb >> 9) & 1) << 5); R = (st >> 1) * 16 + swz / 64; C = (st & 1) * 32 + (swz % 64) / 2; }
__host__ __device__ __forceinline__ int perm32(int rho) { const int n = rho >> 4, i = rho & 15; return 8 * (i >> 2) + 4 * n + (i & 3); }
__host__ __device__ __forceinline__ int permrope(int rho) { const int n = rho >> 4, i = rho & 15, fq = i >> 2, j = i & 3; return 16 * (fq >> 1) + 8 * n + 4 * (fq & 1) + j; }
struct Unit { int pm, pn, kt0, nkt; };
struct Gemm { const bf16_t* A; const bf16_t* Bt; int M, N, K; };
struct StaticOrder {
    int nM, nN, nwg, G, c, nMf, ns, ktiles, nfull, wgm = WGM; bool panel = false;
    __device__ void init(int M, int N, int K, int G_, int c_, int nMf_ = -1, int ns_ = 1) { nM = M / BM; nN = N / BM; G = G_; c = c_; ktiles = K / BK; nMf = nMf_ < 0 ? nM : nMf_; ns = ns_; nfull = nMf * nN; nwg = nfull + (nM - nMf) * nN * ns; }
    __device__ __forceinline__ bool next(int i, Unit& u) const {
        const long L = (long)i * G + c; if (L >= nwg) return false;
        int pm, pn, kt0 = 0, nkt = ktiles;
        if (L >= nfull) { const int s = (int)L - nfull, tile = s / ns, sl = s - tile * ns; pm = nMf + tile / nN; pn = tile % nN; nkt = ktiles / ns; kt0 = sl * nkt; }
        else if (panel) { const int x = c & 7, j = c >> 3; pn = j & 3; pm = 64 * i + 8 * (j >> 2) + x; }
        else {
            int wgid = (int)L; { const int q = nfull / NXCD, r = nfull % NXCD, xcd = wgid % NXCD, off = wgid / NXCD; wgid = (xcd < r ? xcd * (q + 1) : r * (q + 1) + (xcd - r) * q) + off; }
            const int nig = wgm * nN, gid = wgid / nig, fm = gid * wgm, gsz = (nMf - fm) < wgm ? (nMf - fm) : wgm;
            pm = fm + ((wgid % nig) % gsz); pn = (wgid % nig) / gsz;
        }
        u = Unit{pm, pn, kt0, nkt}; return true;
    }
};
template <class Epi, bool ALIGN_EPI, bool SP2>
__device__ __forceinline__ void gemm_phase(LAS unsigned char* lds, const Gemm g, const StaticOrder& S, const Epi& E) {
    const int tid = threadIdx.x, wid = __builtin_amdgcn_readfirstlane(tid >> 6), lane = tid & 63, wr = wid >> 2, wc = wid & 3, fr = lane & 15, fq = lane >> 4;
    const int K = g.K;
    unsigned voffA[2], voffB[2];
#pragma unroll
    for (int i = 0; i < 2; ++i) { int R, C; stage_rc(tid * 16 + i * 8192, R, C); const int Rb = (R & ~31) + Epi::perm(R & 31);
        voffA[i] = (unsigned)(R * K + C) * 2u; voffB[i] = (unsigned)(Rb * K + C) * 2u; }
    const size_t kstep = (size_t)(BK * 2);
    const size_t hstep = (size_t)HALF * K * 2;
    const size_t tstep = 2 * hstep;
    const unsigned ldsw = (unsigned)wid * 1024u;
    const int aoff = lds_byte(wr * 64 + fr, fq * 8), boff = lds_byte(wc * 32 + fr, fq * 8);
#define PG8_SA(b, h) (((b) * 2 + (h)) * HTB)
#define PG8_SB(b, h) ((4 + (b) * 2 + (h)) * HTB)
#define PG8_STAGE(bufoff, gbase, voff) do { _Pragma("unroll") for (int _i = 0; _i < 2; ++_i) \
        __builtin_amdgcn_global_load_lds((const unsigned*)((const char*)(gbase) + (voff)[_i]), (LAS unsigned*)(lds + (bufoff) + ldsw + _i * 8192), 16, 0, 0); } while (0)
#define PG8_LDA(dst, b, h) do { _Pragma("unroll") for (int m = 0; m < 4; ++m) _Pragma("unroll") for (int k = 0; k < 2; ++k) dst[m][k] = *(const LAS bf16x8*)(lds + PG8_SA(b, h) + aoff + m * 2048 + k * 1024); } while (0)
#define PG8_LDB(dst, b, h) do { _Pragma("unroll") for (int n = 0; n < 2; ++n) _Pragma("unroll") for (int k = 0; k < 2; ++k) dst[n][k] = *(const LAS bf16x8*)(lds + PG8_SB(b, h) + boff + n * 2048 + k * 1024); } while (0)
#define PG8_MMA(ai, bj, At, Bt) do { __builtin_amdgcn_s_setprio(1); _Pragma("unroll") for (int m = 0; m < 4; ++m) _Pragma("unroll") for (int n = 0; n < 2; ++n) _Pragma("unroll") for (int k = 0; k < 2; ++k) \
        acc[ai][bj][m][n] = __builtin_amdgcn_mfma_f32_16x16x32_bf16(Bt[n][k], At[m][k], acc[ai][bj][m][n], 0, 0, 0); __builtin_amdgcn_s_setprio(0); } while (0)
#define PG8_WAIT_V(n) asm volatile("s_waitcnt vmcnt(" #n ")" ::: "memory")
#define PG8_WAIT_L(n) asm volatile("s_waitcnt lgkmcnt(" #n ")" ::: "memory")
#define PG8_BAR __builtin_amdgcn_s_barrier()
#define PG8_SCHED __builtin_amdgcn_sched_barrier(0)
    Unit cur, nxt; int ui = 0;
    if (!S.next(0, cur)) return;
    f32x4 acc[2][2][4][2];
#pragma unroll
    for (int a = 0; a < 2; ++a)
#pragma unroll
        for (int b = 0; b < 2; ++b)
#pragma unroll
            for (int m = 0; m < 4; ++m)
#pragma unroll
                for (int n = 0; n < 2; ++n) acc[a][b][m][n] = (f32x4){0.f, 0.f, 0.f, 0.f};
    bf16x8 At[4][2], B0[2][2], B1[2][2];
    const char* cA = (const char*)g.A + (size_t)cur.pm * tstep + (size_t)cur.kt0 * kstep; const char* cB = (const char*)g.Bt + (size_t)cur.pn * tstep + (size_t)cur.kt0 * kstep;
    if constexpr (SP2) {
        PG8_STAGE(PG8_SB(0, 0), cB, voffB); PG8_STAGE(PG8_SB(0, 1), cB + hstep, voffB); PG8_STAGE(PG8_SA(0, 0), cA, voffA); PG8_STAGE(PG8_SA(0, 1), cA + hstep, voffA);
        if (wr == 1) PG8_BAR;
        PG8_WAIT_V(2); PG8_BAR;
        PG8_STAGE(PG8_SB(1, 0), cB + kstep, voffB); PG8_STAGE(PG8_SA(1, 0), cA + kstep, voffA); PG8_STAGE(PG8_SB(1, 1), cB + hstep + kstep, voffB);
        PG8_WAIT_V(6); PG8_BAR;
    } else {
        PG8_STAGE(PG8_SB(0, 0), cB, voffB); PG8_STAGE(PG8_SA(0, 0), cA, voffA); PG8_STAGE(PG8_SB(0, 1), cB + hstep, voffB); PG8_STAGE(PG8_SA(0, 1), cA + hstep, voffA);
        if (wr == 1) PG8_BAR;
        PG8_WAIT_V(4); PG8_BAR;
        PG8_STAGE(PG8_SB(1, 0), cB + kstep, voffB); PG8_STAGE(PG8_SA(1, 0), cA + kstep, voffA); PG8_STAGE(PG8_SB(1, 1), cB + hstep + kstep, voffB);
        PG8_WAIT_V(6); PG8_BAR;
    }
    for (;;) {
        const bool has_next = S.next(ui + 1, nxt);
        const char* nA = has_next ? (const char*)g.A + (size_t)nxt.pm * tstep + (size_t)nxt.kt0 * kstep : cA; const char* nB = has_next ? (const char*)g.Bt + (size_t)nxt.pn * tstep + (size_t)nxt.kt0 * kstep : cB;
        const int nt = cur.nkt;
        for (int t = 0; t < nt; t += 2) {
            const bool last = (t == nt - 2);
            const char* a1 = cA + (size_t)(t + 1) * kstep;
            const char* a2 = last ? nA : cA + (size_t)(t + 2) * kstep; const char* b2 = last ? nB : cB + (size_t)(t + 2) * kstep;
            const char* a3 = a2 + kstep; const char* b3 = b2 + kstep;
            if constexpr (SP2) {
            PG8_LDB(B0, 0, 0); PG8_LDB(B1, 0, 1); PG8_SCHED; PG8_LDA(At, 0, 0); PG8_STAGE(PG8_SA(1, 1), a1 + hstep, voffA);
            PG8_WAIT_V(8); PG8_WAIT_L(0); PG8_BAR; PG8_MMA(0, 0, At, B0); PG8_MMA(0, 1, At, B1); PG8_BAR; PG8_SCHED;
            PG8_LDA(At, 0, 1); PG8_STAGE(PG8_SB(0, 0), b2, voffB); PG8_STAGE(PG8_SB(0, 1), b2 + hstep, voffB); PG8_STAGE(PG8_SA(0, 0), a2, voffA);
            PG8_WAIT_V(8); PG8_WAIT_L(0); PG8_BAR; PG8_MMA(1, 0, At, B0); PG8_MMA(1, 1, At, B1); PG8_BAR; PG8_SCHED;
            PG8_LDB(B0, 1, 0); PG8_LDB(B1, 1, 1); PG8_SCHED; PG8_LDA(At, 1, 0); PG8_STAGE(PG8_SA(0, 1), a2 + hstep, voffA);
            PG8_WAIT_V(8); PG8_WAIT_L(0); PG8_BAR; PG8_MMA(0, 0, At, B0); PG8_MMA(0, 1, At, B1); PG8_BAR; PG8_SCHED;
            PG8_LDA(At, 1, 1); PG8_STAGE(PG8_SB(1, 0), b3, voffB); PG8_STAGE(PG8_SB(1, 1), b3 + hstep, voffB); PG8_STAGE(PG8_SA(1, 0), a3, voffA);
            PG8_WAIT_V(8); PG8_WAIT_L(0); PG8_BAR; PG8_MMA(1, 0, At, B0); PG8_MMA(1, 1, At, B1); PG8_BAR; PG8_SCHED;
            } else {
            PG8_LDB(B0, 0, 0); PG8_SCHED; PG8_LDA(At, 0, 0); PG8_STAGE(PG8_SA(1, 1), a1 + hstep, voffA);
            PG8_WAIT_L(8); PG8_BAR; PG8_WAIT_L(0); PG8_MMA(0, 0, At, B0); PG8_BAR; PG8_SCHED;
            PG8_LDB(B1, 0, 1); PG8_STAGE(PG8_SB(0, 0), b2, voffB);
            PG8_BAR; PG8_WAIT_L(0); PG8_MMA(0, 1, At, B1); PG8_BAR;
            PG8_LDA(At, 0, 1); PG8_STAGE(PG8_SA(0, 0), a2, voffA);
            PG8_BAR; PG8_WAIT_L(0); PG8_MMA(1, 0, At, B0); PG8_BAR; PG8_SCHED;
            PG8_STAGE(PG8_SB(0, 1), b2 + hstep, voffB);
            PG8_WAIT_V(6); PG8_BAR; PG8_MMA(1, 1, At, B1); PG8_BAR;
            PG8_LDB(B0, 1, 0); PG8_SCHED; PG8_LDA(At, 1, 0); PG8_STAGE(PG8_SA(0, 1), a2 + hstep, voffA);
            PG8_WAIT_L(8); PG8_BAR; PG8_WAIT_L(0); PG8_MMA(0, 0, At, B0); PG8_BAR; PG8_SCHED;
            PG8_LDB(B1, 1, 1); PG8_STAGE(PG8_SB(1, 0), b3, voffB);
            PG8_BAR; PG8_WAIT_L(0); PG8_MMA(0, 1, At, B1); PG8_BAR;
            PG8_LDA(At, 1, 1); PG8_STAGE(PG8_SA(1, 0), a3, voffA);
            PG8_BAR; PG8_WAIT_L(0); PG8_MMA(1, 0, At, B0); PG8_BAR; PG8_SCHED;
            PG8_STAGE(PG8_SB(1, 1), b3 + hstep, voffB);
            PG8_WAIT_V(6); PG8_BAR; PG8_MMA(1, 1, At, B1); PG8_BAR;
            }
        }
        if constexpr (ALIGN_EPI) { if (wr == 0) PG8_BAR; }
        E(acc, cur, wr, wc, fr, fq);
        if (!has_next) break;
#pragma unroll
        for (int a = 0; a < 2; ++a)
#pragma unroll
            for (int b = 0; b < 2; ++b)
#pragma unroll
                for (int m = 0; m < 4; ++m)
#pragma unroll
                    for (int n = 0; n < 2; ++n) acc[a][b][m][n] = (f32x4){0.f, 0.f, 0.f, 0.f};
        cur = nxt; cA = nA; cB = nB; ++ui;
        if constexpr (ALIGN_EPI) { if (wr == 1) PG8_BAR; }
    }
    PG8_WAIT_V(0);
    if constexpr (!ALIGN_EPI) { if (wr == 0) PG8_BAR; }
    PG8_BAR;
#undef PG8_SA
#undef PG8_SB
#undef PG8_STAGE
#undef PG8_LDA
#undef PG8_LDB
#undef PG8_MMA
#undef PG8_WAIT_V
#undef PG8_WAIT_L
#undef PG8_BAR
#undef PG8_SCHED
}

struct EpiQKV {
    static constexpr bool PERM = true; static __device__ __forceinline__ int perm(int rho) { return permrope(rho); }
    bf16_t* Q; bf16_t* Kb; bf16_t* Vb; const float* bias; const float* rope; float* kp; float* vp; float* ks; float* vs;
    __device__ __forceinline__ void operator()(const f32x4 (&acc)[2][2][4][2], const Unit& u, int wr, int wc, int fr, int fq) const {
        const int kind = u.pn < 4 ? 0 : u.pn - 3;
        const int lc0 = wc * 32 + 16 * (fq >> 1) + 4 * (fq & 1);
        f32x4 bv[2][2];
#pragma unroll
        for (int bj = 0; bj < 2; ++bj)
#pragma unroll
            for (int n = 0; n < 2; ++n) bv[bj][n] = *(const f32x4*)(bias + u.pn * 256 + bj * 128 + lc0 + 8 * n);
        const bool dorope = (kind < 2) && ((wc & 1) == 0) && (fq < 2);
#pragma unroll
        for (int ai = 0; ai < 2; ++ai)
#pragma unroll
            for (int m = 0; m < 4; ++m) {
                const int r = u.pm * 256 + ai * 128 + wr * 64 + m * 16 + fr;
                const bool prompt = r < MP;
                const int t = prompt ? (r & 2047) : ((r - MP) & 63), b = prompt ? (r >> 11) : ((r - MP) >> 6);
                const int pos = prompt ? t : 1024 + t;
                f32x4 cs = {1.f, 1.f, 1.f, 1.f}, sn = {0.f, 0.f, 0.f, 0.f};
                if (dorope) { cs = *(const f32x4*)(rope + pos * 16 + 4 * fq); sn = *(const f32x4*)(rope + pos * 16 + 8 + 4 * fq); }
#pragma unroll
                for (int bj = 0; bj < 2; ++bj) {
                    const f32x4 x1 = acc[ai][bj][m][0] + bv[bj][0], x2 = acc[ai][bj][m][1] + bv[bj][1];
                    f32x4 v[2]; v[0] = x1 * cs - x2 * sn; v[1] = x2 * cs + x1 * sn;
                    if (kind == 0) {
                        u32x2 w0, w1; w0.x = cvt_pk_bf16(v[0][0] * QSCALE, v[0][1] * QSCALE); w0.y = cvt_pk_bf16(v[0][2] * QSCALE, v[0][3] * QSCALE); w1.x = cvt_pk_bf16(v[1][0] * QSCALE, v[1][1] * QSCALE); w1.y = cvt_pk_bf16(v[1][2] * QSCALE, v[1][3] * QSCALE);
                        bf16_t* qp = Q + (size_t)r * DM + u.pn * 256 + bj * 128 + lc0;
                        *(u32x2*)qp = w0; *(u32x2*)(qp + 8) = w1;
                    } else {
                        const int col = bj * 128 + lc0;
                        const size_t krow = prompt ? (size_t)r : (size_t)MP + b * 192 + 128 + t;
                        u32x2 w0, w1; w0.x = cvt_pk_bf16(v[0][0], v[0][1]); w0.y = cvt_pk_bf16(v[0][2], v[0][3]); w1.x = cvt_pk_bf16(v[1][0], v[1][1]); w1.y = cvt_pk_bf16(v[1][2], v[1][3]);
                        bf16_t* kvp = (kind == 1 ? Kb : Vb) + krow * 256 + col;
                        *(u32x2*)kvp = w0; *(u32x2*)(kvp + 8) = w1;
                        float* o = nullptr;
                        if (prompt) { if (t >= SEQ - 128) o = (kind == 1 ? kp : vp) + ((size_t)(b * 128 + t - (SEQ - 128)) * 256 + col); }
                        else o = (kind == 1 ? ks : vs) + ((size_t)(b * 128 + 64 + t) * 256 + col);
                        if (o) { *(f32x4*)o = v[0]; *(f32x4*)(o + 8) = v[1]; }
                    }
                }
            }
    }
};
struct EpiPlainSS {
    static constexpr bool PERM = true; static __device__ __forceinline__ int perm(int rho) { return perm32(rho); }
    bf16_t* O; const float* bias; float* ss; float* sacc; int ktiles;
    __device__ __forceinline__ void operator()(const f32x4 (&acc)[2][2][4][2], const Unit& u, int wr, int wc, int fr, int fq) const {
        const int col0 = u.pn * 256 + wc * 32 + 8 * fq;
        if (u.nkt != ktiles) {
            const int slice = u.kt0 / u.nkt;
#pragma unroll
            for (int ai = 0; ai < 2; ++ai)
#pragma unroll
                for (int m = 0; m < 4; ++m) {
                    const int r = u.pm * 256 + ai * 128 + wr * 64 + m * 16 + fr - MP; float* sp = sacc + ((size_t)slice * MS + r) * DM + col0;
#pragma unroll
                    for (int bj = 0; bj < 2; ++bj) { *(f32x4*)(sp + bj * 128) = acc[ai][bj][m][0]; *(f32x4*)(sp + bj * 128 + 4) = acc[ai][bj][m][1]; }
                }
            return;
        }
        f32x4 bv[2][2];
#pragma unroll
        for (int bj = 0; bj < 2; ++bj)
#pragma unroll
            for (int n = 0; n < 2; ++n) bv[bj][n] = bias ? *(const f32x4*)(bias + col0 + bj * 128 + 4 * n) : (f32x4){0.f, 0.f, 0.f, 0.f};
#pragma unroll
        for (int ai = 0; ai < 2; ++ai)
#pragma unroll
            for (int m = 0; m < 4; ++m) {
                const int r = u.pm * 256 + ai * 128 + wr * 64 + m * 16 + fr; float s = 0.f;
#pragma unroll
                for (int bj = 0; bj < 2; ++bj) {
                    const f32x4 v0 = acc[ai][bj][m][0] + bv[bj][0], v1 = acc[ai][bj][m][1] + bv[bj][1];
                    s += (v0[0] * v0[0] + v0[1] * v0[1]) + (v0[2] * v0[2] + v0[3] * v0[3]) + (v1[0] * v1[0] + v1[1] * v1[1]) + (v1[2] * v1[2] + v1[3] * v1[3]);
                    u32x4 w; w.x = cvt_pk_bf16(v0[0], v0[1]); w.y = cvt_pk_bf16(v0[2], v0[3]); w.z = cvt_pk_bf16(v1[0], v1[1]); w.w = cvt_pk_bf16(v1[2], v1[3]);
                    *(u32x4*)(O + (size_t)r * DM + col0 + bj * 128) = w;
                }
                s += __shfl_xor(s, 16); s += __shfl_xor(s, 32);
                if (fq == 0) ss[(size_t)r * 32 + u.pn * 4 + wc] = s;
            }
    }
};
template <bool XIN_F32, bool LAST>
struct EpiFused {
    static constexpr bool PERM = true; static __device__ __forceinline__ int perm(int rho) { return perm32(rho); }
    const float* bias; const void* xin; bf16_t* xo16; float* xof; bf16_t* aout; const float* gpost; const float* gnext;
    unsigned long long* xch; unsigned* cnt; LAS unsigned char* xl; float* sacc; int ktiles;
    __device__ __forceinline__ void load_x(f32x4 (&x)[2], size_t off) const {
        if constexpr (XIN_F32) { x[0] = *(const f32x4*)((const float*)xin + off); x[1] = *(const f32x4*)((const float*)xin + off + 4); }
        else { const u32x4 w = *(const u32x4*)((const bf16_t*)xin + off);
            x[0][0] = __uint_as_float(w.x << 16); x[0][1] = __uint_as_float(w.x & 0xffff0000u); x[0][2] = __uint_as_float(w.y << 16); x[0][3] = __uint_as_float(w.y & 0xffff0000u);
            x[1][0] = __uint_as_float(w.z << 16); x[1][1] = __uint_as_float(w.z & 0xffff0000u); x[1][2] = __uint_as_float(w.w << 16); x[1][3] = __uint_as_float(w.w & 0xffff0000u); }
    }
    __device__ __forceinline__ void operator()(f32x4 (&acc)[2][2][4][2], const Unit& u, int wr, int wc, int fr, int fq) const {
        asm volatile("" : "+v"(fr), "+v"(fq));
        const int col0 = u.pn * 256 + wc * 32 + 8 * fq;
        if (u.nkt != ktiles) {
            const int slice = u.kt0 / u.nkt;
#pragma unroll
            for (int ai = 0; ai < 2; ++ai)
#pragma unroll
                for (int m = 0; m < 4; ++m) {
                    const int r = u.pm * 256 + ai * 128 + wr * 64 + m * 16 + fr - MP; float* sp = sacc + ((size_t)slice * MS + r) * DM + col0;
#pragma unroll
                    for (int bj = 0; bj < 2; ++bj) { *(f32x4*)(sp + bj * 128) = acc[ai][bj][m][0]; *(f32x4*)(sp + bj * 128 + 4) = acc[ai][bj][m][1]; }
                }
            return;
        }
        int tid = threadIdx.x; asm volatile("" : "+v"(tid)); const int lane = tid & 63, wid = __builtin_amdgcn_readfirstlane(tid >> 6);
        LAS f32x4* P = (LAS f32x4*)xl; LAS f32x2* S2 = (LAS f32x2*)(xl + 16384); volatile LAS unsigned* flag = (volatile LAS unsigned*)(xl + 16384 + 2048);
        f32x4 gp[2][2];
#pragma unroll
        for (int bj = 0; bj < 2; ++bj)
#pragma unroll
            for (int n = 0; n < 2; ++n) { gp[bj][n] = *(const f32x4*)(gpost + col0 + bj * 128 + 4 * n);
                if (bias) { const f32x4 bv = *(const f32x4*)(bias + col0 + bj * 128 + 4 * n);
#pragma unroll
                    for (int ai = 0; ai < 2; ++ai)
#pragma unroll
                        for (int m = 0; m < 4; ++m) acc[ai][bj][m][n] += bv; } }
#pragma unroll
        for (int ai = 0; ai < 2; ++ai)
#pragma unroll
            for (int m = 0; m < 4; ++m) {
                const int rl = ai * 128 + wr * 64 + m * 16 + fr; const size_t roff = (size_t)(u.pm * 256 + rl) * DM + col0;
                float smm = 0.f, sxx = 0.f, sxm = 0.f, sgg = 0.f;
#pragma unroll
                for (int bj = 0; bj < 2; ++bj) { f32x4 x[2]; load_x(x, roff + bj * 128);
#pragma unroll
                    for (int n = 0; n < 2; ++n)
#pragma unroll
                        for (int j = 0; j < 4; ++j) { const float v = acc[ai][bj][m][n][j], mg = v * gp[bj][n][j], xv = x[n][j]; smm += v * v; sxx += xv * xv; sxm += xv * mg; sgg += mg * mg; acc[ai][bj][m][n][j] = mg; } }
                smm = sum_rows4(smm); sxx = sum_rows4(sxx); sxm = sum_rows4(sxm); sgg = sum_rows4(sgg);
                if (fq == 0) P[rl * 4 + wc] = (f32x4){smm, sxx, sxm, sgg};
            }
        asm volatile("s_waitcnt lgkmcnt(0)" ::: "memory"); __builtin_amdgcn_s_barrier(); asm volatile("" ::: "memory");
        if (tid < 256) {
            const f32x4 t = (P[tid * 4 + 0] + P[tid * 4 + 1]) + (P[tid * 4 + 2] + P[tid * 4 + 3]);
            unsigned long long* slot = xch + ((size_t)(u.pm * 256 + tid) * 4 + u.pn) * 2;
            __hip_atomic_store(slot, ((unsigned long long)__float_as_uint(t[1]) << 32) | __float_as_uint(t[0]), __ATOMIC_RELAXED, __HIP_MEMORY_SCOPE_AGENT);
            __hip_atomic_store(slot + 1, ((unsigned long long)__float_as_uint(t[3]) << 32) | __float_as_uint(t[2]), __ATOMIC_RELAXED, __HIP_MEMORY_SCOPE_AGENT);
        }
        asm volatile("s_waitcnt vmcnt(0)" ::: "memory");
        if (wid < 4 && lane == 0) __hip_atomic_fetch_add(cnt + 64 * u.pm, 1u, __ATOMIC_RELAXED, __HIP_MEMORY_SCOPE_AGENT);
        if (wid == 0) {
            unsigned sp = 0u;
            while ((unsigned)__builtin_amdgcn_readfirstlane(__hip_atomic_load(cnt + 64 * u.pm, __ATOMIC_RELAXED, __HIP_MEMORY_SCOPE_AGENT)) < 16u) { __builtin_amdgcn_s_sleep(2); if (++sp > (1u << 21)) break; }
            __builtin_amdgcn_fence(__ATOMIC_ACQUIRE, "agent");
            if (lane == 0) flag[0] = sp;
        }
        asm volatile("s_waitcnt vmcnt(0) lgkmcnt(0)" ::: "memory"); __builtin_amdgcn_s_barrier(); asm volatile("" ::: "memory");
        if (tid < 256) {
            const unsigned long long* slot = xch + (size_t)(u.pm * 256 + tid) * 8; float t0 = 0.f, t1 = 0.f, t2 = 0.f, t3 = 0.f;
#pragma unroll
            for (int q = 0; q < 4; ++q) { const unsigned long long a = __hip_atomic_load(slot + 2 * q, __ATOMIC_RELAXED, __HIP_MEMORY_SCOPE_AGENT), b = __hip_atomic_load(slot + 2 * q + 1, __ATOMIC_RELAXED, __HIP_MEMORY_SCOPE_AGENT);
                t0 += __uint_as_float((unsigned)a); t1 += __uint_as_float((unsigned)(a >> 32)); t2 += __uint_as_float((unsigned)b); t3 += __uint_as_float((unsigned)(b >> 32)); }
            const float s = 1.0f / sqrtf(t0 * (1.0f / DM) + EPS);
            const float q1 = t1 + 2.0f * s * t2 + s * s * t3;
            S2[tid] = (f32x2){s, 1.0f / sqrtf(fmaxf(q1, 0.f) * (1.0f / DM) + EPS)};
        }
        asm volatile("s_waitcnt lgkmcnt(0)" ::: "memory"); __builtin_amdgcn_s_barrier(); asm volatile("" ::: "memory");
#pragma unroll
        for (int ai = 0; ai < 2; ++ai)
#pragma unroll
            for (int m = 0; m < 4; ++m) {
                const int rl = ai * 128 + wr * 64 + m * 16 + fr; const size_t roff = (size_t)(u.pm * 256 + rl) * DM + col0;
                const f32x2 sr = S2[rl];
#pragma unroll
                for (int bj = 0; bj < 2; ++bj) { f32x4 x[2]; load_x(x, roff + bj * 128);
                    f32x4 x1[2];
#pragma unroll
                    for (int n = 0; n < 2; ++n) x1[n] = x[n] + acc[ai][bj][m][n] * sr.x;
                    if constexpr (LAST) { *(f32x4*)(xof + roff + bj * 128) = x1[0]; *(f32x4*)(xof + roff + bj * 128 + 4) = x1[1]; }
                    else {
                        u32x4 w; w.x = cvt_pk_bf16(x1[0][0], x1[0][1]); w.y = cvt_pk_bf16(x1[0][2], x1[0][3]); w.z = cvt_pk_bf16(x1[1][0], x1[1][1]); w.w = cvt_pk_bf16(x1[1][2], x1[1][3]);
                        *(u32x4*)(xo16 + roff + bj * 128) = w;
                        const f32x4 a0 = x1[0] * *(const f32x4*)(gnext + col0 + bj * 128) * sr.y, a1 = x1[1] * *(const f32x4*)(gnext + col0 + bj * 128 + 4) * sr.y;
                        u32x4 wa; wa.x = cvt_pk_bf16(a0[0], a0[1]); wa.y = cvt_pk_bf16(a0[2], a0[3]); wa.z = cvt_pk_bf16(a1[0], a1[1]); wa.w = cvt_pk_bf16(a1[2], a1[3]);
                        *(u32x4*)(aout + roff + bj * 128) = wa;
                    }
                }
            }
        asm volatile("s_waitcnt lgkmcnt(0)" ::: "memory");
    }
};
struct EpiGlu {
    static constexpr bool PERM = true; static __device__ __forceinline__ int perm(int rho) { return perm32(rho); }
    bf16_t* O; const float* bias; float* ss; float* sacc; int ktiles;
    __device__ __forceinline__ void operator()(const f32x4 (&acc)[2][2][4][2], const Unit& u, int wr, int wc, int fr, int fq) const {
        if (u.nkt != ktiles) {
            const int slice = u.kt0 / u.nkt;
#pragma unroll
            for (int ai = 0; ai < 2; ++ai)
#pragma unroll
                for (int m = 0; m < 4; ++m) {
                    const int r = u.pm * 256 + ai * 128 + wr * 64 + m * 16 + fr - MP; float* sp = sacc + ((size_t)slice * MS + r) * (2 * DM) + u.pn * 256 + wc * 32 + 8 * fq;
#pragma unroll
                    for (int bj = 0; bj < 2; ++bj) { *(f32x4*)(sp + bj * 128) = acc[ai][bj][m][0]; *(f32x4*)(sp + bj * 128 + 4) = acc[ai][bj][m][1]; }
                }
            return;
        }
        const int oc0 = u.pn * 128 + wc * 32 + 8 * fq;
        f32x4 ba[2], bg[2];
#pragma unroll
        for (int n = 0; n < 2; ++n) { ba[n] = *(const f32x4*)(bias + oc0 + 4 * n); bg[n] = *(const f32x4*)(bias + DM + oc0 + 4 * n); }
#pragma unroll
        for (int ai = 0; ai < 2; ++ai)
#pragma unroll
            for (int m = 0; m < 4; ++m) {
                const int r = u.pm * 256 + ai * 128 + wr * 64 + m * 16 + fr; float s = 0.f; f32x4 o[2];
#pragma unroll
                for (int n = 0; n < 2; ++n) { const f32x4 a = acc[ai][0][m][n] + ba[n], g = acc[ai][1][m][n] + bg[n];
#pragma unroll
                    for (int j = 0; j < 4; ++j) { o[n][j] = a[j] * sigmoid_f(g[j]); s += o[n][j] * o[n][j]; } }
                u32x4 w; w.x = cvt_pk_bf16(o[0][0], o[0][1]); w.y = cvt_pk_bf16(o[0][2], o[0][3]); w.z = cvt_pk_bf16(o[1][0], o[1][1]); w.w = cvt_pk_bf16(o[1][2], o[1][3]);
                *(u32x4*)(O + (size_t)r * DM + oc0) = w;
                s += __shfl_xor(s, 16); s += __shfl_xor(s, 32);
                if (fq == 0) ss[(size_t)r * 32 + u.pn * 4 + wc] = s;
            }
    }
};
struct EpiUp {
    static constexpr bool PERM = true; static __device__ __forceinline__ int perm(int rho) { return perm32(rho); }
    bf16_t* G; bf16_t* E; const float* cw; const float* cb;
    __device__ __forceinline__ void operator()(f32x4 (&acc)[2][2][4][2], const Unit& u, int wr, int wc, int fr, int fq) const {
        const int oc0 = u.pn * 128 + wc * 32 + 8 * fq;
        {
            const int e = (fr < 2) ? fr : fr - 12; const int msel = (fr < 2) ? 0 : 3;
            if (fr < 2 || fr >= 14) {
#pragma unroll
                for (int ai = 0; ai < 2; ++ai) {
                    const int seg = u.pm * 4 + ai * 2 + wr; bf16_t* eb = E + ((size_t)seg * 4 + e) * FF2 + oc0;
#pragma unroll
                    for (int bj = 0; bj < 2; ++bj)
#pragma unroll
                        for (int n = 0; n < 2; ++n) { const f32x4 v = (msel == 0) ? acc[ai][bj][0][n] : acc[ai][bj][3][n]; u32x2 w; w.x = cvt_pk_bf16(v[0], v[1]); w.y = cvt_pk_bf16(v[2], v[3]); *(u32x2*)(eb + bj * FF + 4 * n) = w; }
                }
            }
        }
        f32x4 pw0[2][2], pw1[2][2], pw2[2][2], pbb[2][2];
#pragma unroll
        for (int n = 0; n < 2; ++n)
#pragma unroll
            for (int bj = 0; bj < 2; ++bj) { const float* cwp = cw + bj * FF + oc0 + 4 * n;
                pw0[n][bj] = *(const f32x4*)(cwp); pw1[n][bj] = *(const f32x4*)(cwp + FF2); pw2[n][bj] = *(const f32x4*)(cwp + 2 * FF2); pbb[n][bj] = *(const f32x4*)(cb + bj * FF + oc0 + 4 * n); }
#pragma unroll
        for (int n = 0; n < 2; ++n) {
#pragma unroll
            for (int bj = 0; bj < 2; ++bj) {
                const f32x4 w0 = pw0[n][bj], w1 = pw1[n][bj], w2 = pw2[n][bj], bb = pbb[n][bj];
                f32x4 w1z, w0z;
#pragma unroll
                for (int j = 0; j < 4; ++j) { w1z[j] = (fr == 0) ? w1[j] : 0.f; w0z[j] = (fr < 2) ? w0[j] : 0.f; }
#pragma unroll
                for (int ai = 0; ai < 2; ++ai)
#pragma unroll
                    for (int m = 3; m >= 0; --m) {
                        const f32x4 v = acc[ai][bj][m][n];
                        f32x4 c = bb + w2 * v;
#pragma unroll
                        for (int j = 0; j < 4; ++j) {
                            FMAC_DPP(c[j], v[j], w1[j], "row_shr:1");
                            FMAC_DPP(c[j], v[j], w0[j], "row_shr:2");
                            if (m > 0) { FMAC_DPP(c[j], acc[ai][bj][m - 1][n][j], w1z[j], "row_ror:1"); FMAC_DPP(c[j], acc[ai][bj][m - 1][n][j], w0z[j], "row_ror:2"); }
                        }
                        acc[ai][bj][m][n] = c;
                    }
            }
        }
#pragma unroll
        for (int ai = 0; ai < 2; ++ai)
#pragma unroll
            for (int m = 0; m < 4; ++m) {
                const int r = u.pm * 256 + ai * 128 + wr * 64 + m * 16 + fr;
                f32x2 o[4];
#pragma unroll
                for (int n = 0; n < 2; ++n)
#pragma unroll
                    for (int h = 0; h < 2; ++h) o[2 * n + h] = gelu_gate_pk((f32x2){acc[ai][0][m][n][2 * h], acc[ai][0][m][n][2 * h + 1]}, (f32x2){acc[ai][1][m][n][2 * h], acc[ai][1][m][n][2 * h + 1]});
                u32x4 w; w.x = cvt_pk_bf16(o[0].x, o[0].y); w.y = cvt_pk_bf16(o[1].x, o[1].y); w.z = cvt_pk_bf16(o[2].x, o[2].y); w.w = cvt_pk_bf16(o[3].x, o[3].y);
                if (!(m == 0 && fr < 2)) *(u32x4*)(G + (size_t)r * FF + oc0) = w;
            }
    }
};
}

#ifndef PROBE_REPMASK
#define PROBE_REPMASK 0
#endif
struct Args { const float* in[30]; float* out; unsigned char* ws; int ph_lo, ph_hi, coop, repmask; };
constexpr int NPHASE = 16;
constexpr int LDS_BYTES = 155648;
constexpr int XL_OFF = 131072, XL_MISC = 131072 + 16384 + 2048 + 128;

__device__ __forceinline__ unsigned f2bf(float f) { unsigned u = __builtin_bit_cast(unsigned, f); return (u + 0x7fffu + ((u >> 16) & 1u)) >> 16; }
__device__ __forceinline__ unsigned pk2(float lo, float hi) { return f2bf(lo) | (f2bf(hi) << 16); }
__device__ __forceinline__ void transpose_item(const float* W, int K, int N, bf16_t* WT, int pair_half, LAS float* scr, int item, int lane) {
    const int nblk = N / 32, kb = item / nblk, nb = item % nblk, k0 = 64 * kb, n0 = 32 * nb;
#pragma unroll 8
    for (int i = 0; i < 32; ++i) { const int kk = 2 * i + (lane >> 5); scr[kk * 33 + (lane & 31)] = W[(size_t)(k0 + kk) * N + n0 + (lane & 31)]; }
    asm volatile("s_waitcnt lgkmcnt(0)" ::: "memory");
    int r0 = n0;
    if (pair_half > 0) { const int half = n0 / pair_half, c = n0 % pair_half; r0 = 256 * (c / 128) + 128 * half + (c % 128); }
    const int c = lane & 7;
#pragma unroll
    for (int j = 0; j < 4; ++j) { const int n = (lane >> 3) + 8 * j; const LAS float* s = scr + (8 * c) * 33 + n;
        u32x4 o; o.x = pk2(s[0 * 33], s[1 * 33]); o.y = pk2(s[2 * 33], s[3 * 33]); o.z = pk2(s[4 * 33], s[5 * 33]); o.w = pk2(s[6 * 33], s[7 * 33]);
        *(u32x4*)(WT + (size_t)(r0 + n) * K + k0 + 8 * c) = o; }
    asm volatile("s_waitcnt lgkmcnt(0)" ::: "memory");
}

template <bool HAS_M, bool HAS_NEXT, bool XIN_F32, bool XOUT_F32, bool M_F32 = false, bool M_GLU = false>
__device__ __forceinline__ void row_pass(const void* xin, void* xout, const bf16_t* mrow, const float* ssrow, int nslots, const float* gpost, const float* gnext, bf16_t* arow, int lane, const float* saccrow = nullptr, const float* mbias = nullptr) {
    f32x4 v[4];
#pragma unroll
    for (int j = 0; j < 4; ++j) {
        if constexpr (XIN_F32) v[j] = *((const f32x4*)xin + lane + 64 * j);
        else { const u32x2 xw = *((const u32x2*)xin + lane + 64 * j); v[j][0] = __uint_as_float(xw.x << 16); v[j][1] = __uint_as_float(xw.x & 0xffff0000u); v[j][2] = __uint_as_float(xw.y << 16); v[j][3] = __uint_as_float(xw.y & 0xffff0000u); }
    }
    if constexpr (HAS_M) {
        f32x4 mv[4]; float s;
        if constexpr (M_GLU) {
            s = 0.f;
#pragma unroll
            for (int j = 0; j < 4; ++j) { const int oc = 4 * (lane + 64 * j), base = 256 * (oc >> 7) + (oc & 127);
                f32x4 a = *(const f32x4*)(mbias + oc), g = *(const f32x4*)(mbias + DM + oc);
                for (int sl = 0; sl < nslots; ++sl) { a += *(const f32x4*)(saccrow + (size_t)sl * MS * 2 * DM + base); g += *(const f32x4*)(saccrow + (size_t)sl * MS * 2 * DM + base + 128); }
#pragma unroll
                for (int q = 0; q < 4; ++q) mv[j][q] = a[q] * sigmoid_f(g[q]);
                s += (mv[j][0] * mv[j][0] + mv[j][1] * mv[j][1]) + (mv[j][2] * mv[j][2] + mv[j][3] * mv[j][3]); }
        } else if constexpr (M_F32) {
            s = 0.f;
#pragma unroll
            for (int j = 0; j < 4; ++j) { mv[j] = mbias ? *((const f32x4*)mbias + lane + 64 * j) : (f32x4){0.f, 0.f, 0.f, 0.f};
                for (int sl = 0; sl < nslots; ++sl) mv[j] += *((const f32x4*)(saccrow + (size_t)sl * MS * DM) + lane + 64 * j);
                s += (mv[j][0] * mv[j][0] + mv[j][1] * mv[j][1]) + (mv[j][2] * mv[j][2] + mv[j][3] * mv[j][3]); }
        } else {
            s = (lane < nslots) ? ssrow[lane] : 0.f;
#pragma unroll
            for (int j = 0; j < 4; ++j) { const u32x2 mw = *((const u32x2*)mrow + lane + 64 * j);
                mv[j][0] = __uint_as_float(mw.x << 16); mv[j][1] = __uint_as_float(mw.x & 0xffff0000u); mv[j][2] = __uint_as_float(mw.y << 16); mv[j][3] = __uint_as_float(mw.y & 0xffff0000u); }
        }
        s = wave_sum(s);
        const float rstd = 1.0f / sqrtf(s * (1.0f / DM) + EPS);
#pragma unroll
        for (int j = 0; j < 4; ++j) {
            const f32x4 gp = *((const f32x4*)gpost + lane + 64 * j);
            v[j] += mv[j] * rstd * gp;
            if constexpr (XOUT_F32) *((f32x4*)xout + lane + 64 * j) = v[j];
            else { u32x2 w; w.x = cvt_pk_bf16(v[j][0], v[j][1]); w.y = cvt_pk_bf16(v[j][2], v[j][3]); *((u32x2*)xout + lane + 64 * j) = w; }
        }
    }
    if constexpr (HAS_NEXT) {
        float s2 = 0.f;
#pragma unroll
        for (int j = 0; j < 4; ++j) s2 += (v[j][0] * v[j][0] + v[j][1] * v[j][1]) + (v[j][2] * v[j][2] + v[j][3] * v[j][3]);
        s2 = wave_sum(s2);
        const float rstd2 = 1.0f / sqrtf(s2 * (1.0f / DM) + EPS);
#pragma unroll
        for (int j = 0; j < 4; ++j) { const f32x4 gn = *((const f32x4*)gnext + lane + 64 * j);
            u32x2 w; w.x = cvt_pk_bf16(v[j][0] * rstd2 * gn[0], v[j][1] * rstd2 * gn[1]); w.y = cvt_pk_bf16(v[j][2] * rstd2 * gn[2], v[j][3] * rstd2 * gn[3]);
            *((u32x2*)arow + lane + 64 * j) = w; }
    }
}

__device__ __forceinline__ s16x4 vtr(LAS const unsigned char* p) { return __builtin_bit_cast(s16x4, __builtin_amdgcn_ds_read_tr16_b64_v4i16((LAS s16x4*)p)); }
__device__ __forceinline__ void attn_unit_coords(int u, int& qrow0, int& krow0, int& kb0, int& kvh) {
    if (u < NB * 128) { const int b = u >> 7, rem = u & 127, c = rem >> 2; kvh = rem & 3; qrow0 = b * SEQ + c * 64; krow0 = qrow0 - 128; kb0 = c >= 2 ? 0 : 2 * (2 - c); }
    else { const int u2 = u - NB * 128, b = u2 >> 2; kvh = u2 & 3; qrow0 = MP + b * 64; krow0 = MP + b * 192; kb0 = 0; }
}
__device__ __forceinline__ void attn_phase(LAS unsigned char* lds, const bf16_t* Qb, const bf16_t* Kb, const bf16_t* Vb, bf16_t* Ob, const float* sinks, int G, int blk) {
    const int tid = threadIdx.x, lane = tid & 63, w = __builtin_amdgcn_readfirstlane(tid >> 6), r32 = lane & 31, hi = lane >> 5;
    constexpr int KST = 144, VST = 192, KOFF = 0, VOFF = 192 * KST, OOFF = VOFF + 192 * VST, OST = 136;
    constexpr int NUNITS = NB * 32 * 4 + DB * 4;
    LAS unsigned char* ostage = lds + OOFF + w * (32 * OST);
    u32x4 kreg[3], vreg[3]; bf16x8 qnext[4];
    int qrow0 = 0, krow0 = 0, kb0 = 0, kvh = 0;
#define ATTN_LOAD(UU) do { int q0_, k0_, b0_, h0_; attn_unit_coords((UU), q0_, k0_, b0_, h0_); \
        _Pragma("unroll") for (int i = 0; i < 3; ++i) { const int p_ = tid + 512 * i, row_ = p_ >> 3, ch_ = p_ & 7; \
            if (row_ >= b0_ * 32) { const size_t go_ = (size_t)(k0_ + row_) * 256 + h0_ * 64 + ch_ * 8; kreg[i] = *(const u32x4*)(Kb + go_); vreg[i] = *(const u32x4*)(Vb + go_); } } \
        { const size_t qr_ = (size_t)q0_ + (w & 1) * 32 + r32; const int hq_ = h0_ * 4 + (w >> 1); \
          _Pragma("unroll") for (int dk = 0; dk < 4; ++dk) qnext[dk] = *(const bf16x8*)(Qb + qr_ * DM + hq_ * 64 + dk * 16 + hi * 8); } } while (0)
    if (blk < NUNITS) ATTN_LOAD(blk);
    for (int u = blk; u < NUNITS; u += G) {
        attn_unit_coords(u, qrow0, krow0, kb0, kvh);
        __syncthreads();
#pragma unroll
        for (int i = 0; i < 3; ++i) { const int p = tid + 512 * i, row = p >> 3, ch = p & 7;
            if (row >= kb0 * 32) { *(LAS u32x4*)(lds + KOFF + row * KST + ch * 16) = kreg[i]; *(LAS u32x4*)(lds + VOFF + row * VST + ch * 16) = vreg[i]; } }
        bf16x8 qf[4];
#pragma unroll
        for (int dk = 0; dk < 4; ++dk) qf[dk] = qnext[dk];
        const int hq = kvh * 4 + (w >> 1); const size_t qrowb = (size_t)qrow0 + (w & 1) * 32;
        __syncthreads();
        if (u + G < NUNITS) ATTN_LOAD(u + G);
        f32x16 sc[6];
        float mx = -3.0e38f;
#pragma unroll
        for (int kb = 0; kb < 6; ++kb) {
            if (kb >= kb0) {
                f32x16 a = {};
#pragma unroll
                for (int dk = 0; dk < 4; ++dk) { const bf16x8 kf = *(const LAS bf16x8*)(lds + KOFF + (32 * kb + r32) * KST + (dk * 16 + hi * 8) * 2); a = __builtin_amdgcn_mfma_f32_32x32x16_bf16(kf, qf[dk], a, 0, 0, 0); }
#pragma unroll
                for (int r = 0; r < 16; ++r) mx = fmaxf(mx, a[r]);
                sc[kb] = a;
            }
        }
        mx = fmaxf(mx, __shfl_xor(mx, 32));
        const float sinkl = sinks[hq] * LOG2E; mx = fmaxf(mx, sinkl);
        float ls = 0.f;
#pragma unroll
        for (int kb = 0; kb < 6; ++kb) {
            if (kb >= kb0) {
#pragma unroll
                for (int r = 0; r < 16; ++r) { const float p = __builtin_amdgcn_exp2f(sc[kb][r] - mx); sc[kb][r] = p; ls += p; }
            }
        }
        ls += __shfl_xor(ls, 32);
        const float inv = 1.0f / (ls + __builtin_amdgcn_exp2f(sinkl - mx));
        f32x16 o[2]; o[0] = f32x16{}; o[1] = f32x16{};
        const int vlane = VOFF + (4 * hi + ((lane >> 2) & 3)) * VST + (16 * ((lane >> 4) & 1) + 4 * (lane & 3)) * 2;
#pragma unroll
        for (int kb = 0; kb < 6; ++kb) {
            if (kb >= kb0) {
#pragma unroll
                for (int s = 0; s < 2; ++s) {
                    u32x4 pw; pw.x = cvt_pk_bf16(sc[kb][8 * s + 0], sc[kb][8 * s + 1]); pw.y = cvt_pk_bf16(sc[kb][8 * s + 2], sc[kb][8 * s + 3]); pw.z = cvt_pk_bf16(sc[kb][8 * s + 4], sc[kb][8 * s + 5]); pw.w = cvt_pk_bf16(sc[kb][8 * s + 6], sc[kb][8 * s + 7]);
                    const bf16x8 pf = __builtin_bit_cast(bf16x8, pw);
#pragma unroll
                    for (int db = 0; db < 2; ++db) {
                        LAS const unsigned char* vp = lds + vlane + (32 * kb + 16 * s) * VST + db * 64;
                        const s16x4 lo = vtr(vp), h4 = vtr(vp + 8 * VST);
                        const bf16x8 vf = (bf16x8){lo[0], lo[1], lo[2], lo[3], h4[0], h4[1], h4[2], h4[3]};
                        o[db] = __builtin_amdgcn_mfma_f32_32x32x16_bf16(vf, pf, o[db], 0, 0, 0);
                    }
                }
            }
        }
#pragma unroll
        for (int db = 0; db < 2; ++db)
#pragma unroll
            for (int rq = 0; rq < 4; ++rq) {
                u32x2 wv; wv.x = cvt_pk_bf16(o[db][4 * rq] * inv, o[db][4 * rq + 1] * inv); wv.y = cvt_pk_bf16(o[db][4 * rq + 2] * inv, o[db][4 * rq + 3] * inv);
                *(LAS u32x2*)(ostage + r32 * OST + (32 * db + 8 * rq + 4 * hi) * 2) = wv;
            }
        asm volatile("s_waitcnt lgkmcnt(0)" ::: "memory");
#pragma unroll
        for (int i = 0; i < 4; ++i) { const int row = i * 8 + (lane >> 3), ch = lane & 7;
            const u32x2 a = *(const LAS u32x2*)(ostage + row * OST + ch * 16), b = *(const LAS u32x2*)(ostage + row * OST + ch * 16 + 8);
            u32x4 v; v.x = a.x; v.y = a.y; v.z = b.x; v.w = b.y;
            *(u32x4*)(Ob + (qrowb + row) * DM + hq * 64 + ch * 8) = v; }
        asm volatile("s_waitcnt lgkmcnt(0)" ::: "memory");
    }
#undef ATTN_LOAD
}

struct SsmP { const float *lam_re, *lam_im, *log_dt, *b_re, *b_im, *c_re, *c_im, *dsk, *st_re, *st_im; float *o_rep, *o_imp, *o_res, *o_ims; };
__device__ __forceinline__ void ssm_phase(LAS unsigned char* lds, const bf16_t* A3, bf16_t* Z, const SsmP P, int G, int blk) {
    const int tid = threadIdx.x, lane = tid & 63, w = __builtin_amdgcn_readfirstlane(tid >> 6), p = lane & 31, hi = lane >> 5;
    const int q = w >> 1, role = w & 1;
    constexpr int IST = 72, IMG = 128 * IST;
    LAS unsigned char* img0 = lds + q * (2 * IMG);
    for (int pass = 0; pass < 2; ++pass) {
        const bool samp = (pass == 0);
        const int nunits = samp ? (DB / 2) * 64 : (NB / 2) * 64, T = samp ? DS : SEQ;
        for (int uu = blk * 4 + q; uu < nunits; uu += G * 4) {
            const int bp = uu >> 6, g = uu & 63;
            const int rowbase0 = samp ? MP + (2 * bp) * DS : (2 * bp) * SEQ, bstride = T;
            const float dt = expf(P.log_dt[g]);
            const int ps = g * 64 + p + 32 * role; const float lr = P.lam_re[ps], li = P.lam_im[ps];
            const float mag = expf(lr * dt); const float lbr = mag * cosf(li * dt), lbi = mag * sinf(li * dt);
            const float nr0 = lbr - 1.0f, ni0 = lbi, den = lr * lr + li * li;
            const float zr = (nr0 * lr + ni0 * li) / den, zi = (ni0 * lr - nr0 * li) / den;
            float hr = 0.f, hm = 0.f;
            const int so = ((2 * bp + hi) * 64 + g) * 64 + p + 32 * role;
            if (samp) { hr = P.st_re[so]; hm = P.st_im[so]; }
            bf16x8 bfre, bfim;
            {
                const float* br = P.b_re + ((size_t)ps) * 16 + 8 * hi; const float* bi = P.b_im + ((size_t)ps) * 16 + 8 * hi;
                const f32x4 br0 = *(const f32x4*)br, br1 = *(const f32x4*)(br + 4), bi0 = *(const f32x4*)bi, bi1 = *(const f32x4*)(bi + 4);
                u32x4 wre, wim;
                wre.x = cvt_pk_bf16(zr * br0[0] - zi * bi0[0], zr * br0[1] - zi * bi0[1]); wre.y = cvt_pk_bf16(zr * br0[2] - zi * bi0[2], zr * br0[3] - zi * bi0[3]);
                wre.z = cvt_pk_bf16(zr * br1[0] - zi * bi1[0], zr * br1[1] - zi * bi1[1]); wre.w = cvt_pk_bf16(zr * br1[2] - zi * bi1[2], zr * br1[3] - zi * bi1[3]);
                wim.x = cvt_pk_bf16(zr * bi0[0] + zi * br0[0], zr * bi0[1] + zi * br0[1]); wim.y = cvt_pk_bf16(zr * bi0[2] + zi * br0[2], zr * bi0[3] + zi * br0[3]);
                wim.z = cvt_pk_bf16(zr * bi1[0] + zi * br1[0], zr * bi1[1] + zi * br1[1]); wim.w = cvt_pk_bf16(zr * bi1[2] + zi * br1[2], zr * bi1[3] + zi * br1[3]);
                bfre = __builtin_bit_cast(bf16x8, wre); bfim = __builtin_bit_cast(bf16x8, wim);
            }
            const int ci = lane & 15, kg = lane >> 4;
            bf16x8 cfrag[4];
#pragma unroll
            for (int kb = 0; kb < 4; ++kb) {
                const float* cp = ((kb < 2) ? P.c_re : P.c_im) + ((size_t)(g * 16 + ci)) * 64 + 32 * (kb & 1) + 8 * kg; const float sg = (kb < 2) ? 1.f : -1.f;
                const f32x4 c0 = *(const f32x4*)cp, c1 = *(const f32x4*)(cp + 4);
                u32x4 wc_; wc_.x = cvt_pk_bf16(sg * c0[0], sg * c0[1]); wc_.y = cvt_pk_bf16(sg * c0[2], sg * c0[3]); wc_.z = cvt_pk_bf16(sg * c1[0], sg * c1[1]); wc_.w = cvt_pk_bf16(sg * c1[2], sg * c1[3]);
                cfrag[kb] = __builtin_bit_cast(bf16x8, wc_);
            }
            const f32x4 dsk4 = *(const f32x4*)(P.dsk + g * 16 + 4 * kg);
            const int hip = (p >> 2) & 1, jp = (p & 3) + 4 * (p >> 3);
            const bf16_t* uptr = A3 + ((size_t)(rowbase0 + hip * bstride + jp)) * DM + g * 16 + 8 * hi;
            const size_t yoff = ((size_t)(rowbase0 + role * bstride + ci)) * DM + g * 16 + 4 * kg;
            const int nblk = T / 16;
            bf16x8 ufA = *(const bf16x8*)uptr, ufB = *(const bf16x8*)(uptr + (size_t)16 * DM), ufC = *(const bf16x8*)(uptr + (size_t)32 * DM);
            u32x2 unA = *(const u32x2*)(A3 + yoff), unB = *(const u32x2*)(A3 + yoff + (size_t)16 * DM), unC = *(const u32x2*)(A3 + yoff + (size_t)32 * DM);
            for (int tb = 0; tb < nblk; ++tb) {
                LAS unsigned char* img = img0 + (tb & 1) * IMG;
                const bf16x8 ucur = ufA; const u32x2 uw = unA;
                ufA = ufB; unA = unB; ufB = ufC; unB = unC;
                if (tb + 3 < nblk) { ufC = *(const bf16x8*)(uptr + (size_t)(tb + 3) * 16 * DM); unC = *(const u32x2*)(A3 + yoff + (size_t)(tb + 3) * 16 * DM); }
                f32x16 Xr, Xi;
                { f32x16 z = {}; Xr = __builtin_amdgcn_mfma_f32_32x32x16_bf16(ucur, bfre, z, 0, 0, 0); Xi = __builtin_amdgcn_mfma_f32_32x32x16_bf16(ucur, bfim, z, 0, 0, 0); }
#pragma unroll
                for (int r = 0; r < 16; ++r) {
                    const float nr = lbr * hr - lbi * hm + Xr[r];
                    const float ni = lbr * hm + lbi * hr + Xi[r];
                    hr = nr; hm = ni; Xr[r] = nr; Xi[r] = ni;
                }
#pragma unroll
                for (int q4 = 0; q4 < 4; ++q4) {
                    u32x2 wr_, wi_; wr_.x = cvt_pk_bf16(Xr[4 * q4], Xr[4 * q4 + 1]); wr_.y = cvt_pk_bf16(Xr[4 * q4 + 2], Xr[4 * q4 + 3]); wi_.x = cvt_pk_bf16(Xi[4 * q4], Xi[4 * q4 + 1]); wi_.y = cvt_pk_bf16(Xi[4 * q4 + 2], Xi[4 * q4 + 3]);
                    *(LAS u32x2*)(img + (role * 32 + p) * IST + (16 * hi + 4 * q4) * 2) = wr_;
                    *(LAS u32x2*)(img + ((2 + role) * 32 + p) * IST + (16 * hi + 4 * q4) * 2) = wi_;
                }
                asm volatile("s_waitcnt lgkmcnt(0)\n\ts_barrier" ::: "memory");
                f32x4 y = {0.f, 0.f, 0.f, 0.f};
#pragma unroll
                for (int kb = 0; kb < 4; ++kb) {
                    LAS const unsigned char* ap = img + (32 * kb + 8 * kg + (ci >> 2)) * IST + (16 * role + 4 * (ci & 3)) * 2;
                    const s16x4 lo = vtr(ap), h4 = vtr(ap + 4 * IST);
                    const bf16x8 af = (bf16x8){lo[0], lo[1], lo[2], lo[3], h4[0], h4[1], h4[2], h4[3]};
                    y = __builtin_amdgcn_mfma_f32_16x16x32_bf16(cfrag[kb], af, y, 0, 0, 0);
                }
                const float z0 = gelu_tanh(y[0] + dsk4[0] * __uint_as_float(uw.x << 16)), z1 = gelu_tanh(y[1] + dsk4[1] * __uint_as_float(uw.x & 0xffff0000u));
                const float z2 = gelu_tanh(y[2] + dsk4[2] * __uint_as_float(uw.y << 16)), z3 = gelu_tanh(y[3] + dsk4[3] * __uint_as_float(uw.y & 0xffff0000u));
                u32x2 zw; zw.x = cvt_pk_bf16(z0, z1); zw.y = cvt_pk_bf16(z2, z3);
                *(u32x2*)(Z + yoff + (size_t)tb * 16 * DM) = zw;
                asm volatile("s_waitcnt lgkmcnt(0)" ::: "memory");
            }
            if (samp) { P.o_res[so] = hr; P.o_ims[so] = hm; } else { P.o_rep[so] = hr; P.o_imp[so] = hm; }
        }
        __syncthreads();
    }
}

#define XB_TMO      128
#define XB_XCNT(j)  (256  + 64 * (j))
#define XB_XSUB(j)  (1280 + 64 * (j))
#define XB_XGEN(j)  (2304 + 64 * (j))
#define XB_TOP      3328
#define XB_TOPGEN   3392
#define XCD_BAR_WORDS 3456
#define XB_SPIN_CAP (1u << 18)
__device__ __forceinline__ unsigned xb_ld(unsigned* p)              { return __hip_atomic_load(p, __ATOMIC_RELAXED, __HIP_MEMORY_SCOPE_AGENT); }
__device__ __forceinline__ unsigned xb_add(unsigned* p, unsigned v) { return __hip_atomic_fetch_add(p, v, __ATOMIC_RELAXED, __HIP_MEMORY_SCOPE_AGENT); }
__device__ __forceinline__ unsigned xb_xcc_id() { return (unsigned)__builtin_amdgcn_s_getreg((3 << 11) | 20) & 0xFu; }
#define XB_SPIN(cond, bar) do { unsigned _sp = 0; while (cond) { __builtin_amdgcn_s_sleep(1); \
    if ((++_sp & 255u) == 0u) { if (xb_ld(&(bar)[XB_TMO])) break; if (_sp > XB_SPIN_CAP) { atomicAdd(&(bar)[XB_TMO], 1u); break; } } } } while (0)
struct XcdBarrier { unsigned* bar; unsigned x; volatile LAS unsigned* st; };
__device__ __forceinline__ XcdBarrier xcd_barrier_post(unsigned* bar, volatile LAS unsigned* st) {
    XcdBarrier b; b.bar = bar; b.x = xb_xcc_id(); b.st = st;
    if (threadIdx.x == 0) (void)xb_add(&bar[XB_XCNT(b.x)], 1u);
    return b;
}
__device__ __forceinline__ void xcd_barrier_complete(unsigned* bar, unsigned x, unsigned& nloc, unsigned& nx) {
    const unsigned G = gridDim.x * gridDim.y * gridDim.z;
    unsigned sum, cnt, mine, sp = 0u;
    for (;;) {
        sum = 0u; cnt = 0u; mine = 0u;
#pragma unroll
        for (unsigned j = 0; j < 16; ++j) { const unsigned c = xb_ld(&bar[XB_XCNT(j)]); sum += c; cnt += (c > 0u) ? 1u : 0u; mine = (j == x) ? c : mine; }
        if (sum == G) break;
        __builtin_amdgcn_s_sleep(1);
        if ((++sp & 255u) == 0u) { if (xb_ld(&bar[XB_TMO])) break; if (sp > XB_SPIN_CAP) { atomicAdd(&bar[XB_TMO], 1u); break; } }
    }
    nloc = mine > 0u ? mine : 1u; nx = cnt > 0u ? cnt : 1u;
}
__device__ __forceinline__ void xcd_barrier(const XcdBarrier& b) {
    asm volatile("s_waitcnt vmcnt(0)" ::: "memory");
    __syncthreads();
    if (threadIdx.x == 0) {
        unsigned* bar = b.bar;
        __builtin_amdgcn_s_waitcnt(0);
        unsigned nloc = b.st[0], nx = b.st[1];
        if (nloc == 0u) { xcd_barrier_complete(bar, b.x, nloc, nx); b.st[0] = nloc; b.st[1] = nx; }
        const unsigned old = xb_add(&bar[XB_XSUB(b.x)], 1u);
        const unsigned gen = old / nloc;
        if (old + 1u == (gen + 1u) * nloc) {
            __builtin_amdgcn_fence(__ATOMIC_RELEASE, "agent");
            asm volatile("s_waitcnt vmcnt(0)" ::: "memory");
            const unsigned og = xb_add(&bar[XB_TOP], 1u);
            const unsigned tg = og / nx;
            if (og + 1u == (tg + 1u) * nx) xb_add(&bar[XB_TOPGEN], 1u);
            else XB_SPIN(xb_ld(&bar[XB_TOPGEN]) == tg, bar);
            __builtin_amdgcn_fence(__ATOMIC_ACQUIRE, "agent");
            xb_add(&bar[XB_XGEN(b.x)], 1u);
            asm volatile("s_waitcnt vmcnt(0)" ::: "memory");
        } else {
            XB_SPIN(xb_ld(&bar[XB_XGEN(b.x)]) == gen, bar);
            __builtin_amdgcn_fence(__ATOMIC_ACQUIRE, "agent");
            asm volatile("s_waitcnt vmcnt(0)" ::: "memory");
        }
    }
    __syncthreads();
}

#ifndef UP_WGM
#define UP_WGM 4
#endif
__device__ __forceinline__ void phase_prologue(LAS unsigned char* lds, const Args& args, unsigned char* ws, float* out, int G, int blk, int wave, int lane, int tid) {
    const int gw = blk * 8 + wave, NGW = G * 8;
    bf16_t* Wqkv = (bf16_t*)(ws + WS_WQKV); bf16_t* Wo = (bf16_t*)(ws + WS_WO); bf16_t* Wglu = (bf16_t*)(ws + WS_WGLU); bf16_t* Wup = (bf16_t*)(ws + WS_WUP); bf16_t* Wdn = (bf16_t*)(ws + WS_WDN);
    float* rope = (float*)(ws + WS_ROPE); bf16_t* Abuf = (bf16_t*)(ws + WS_A); bf16_t* Kbuf = (bf16_t*)(ws + WS_K); bf16_t* Vbuf = (bf16_t*)(ws + WS_V);
    LAS float* scr = (LAS float*)(lds + wave * 16384);
    constexpr int I_QKV = 16 * 48, I_O = 16 * 32, I_GLU = 16 * 64, I_UP = 16 * 176, I_DN = 44 * 32;
    constexpr int NITEMS = I_QKV + I_O + I_GLU + 2 * I_UP + 2 * I_DN;
    for (int it = gw; it < NITEMS; it += NGW) {
        int r = it;
        if (r < I_QKV) { transpose_item(args.in[11], DM, QKVD, Wqkv, 0, scr, r, lane); continue; } r -= I_QKV;
        if (r < I_O) { transpose_item(args.in[14], DM, DM, Wo, 0, scr, r, lane); continue; } r -= I_O;
        if (r < I_GLU) { transpose_item(args.in[24], DM, 2 * DM, Wglu, DM, scr, r, lane); continue; } r -= I_GLU;
        if (r < 2 * I_UP) { const int l = r / I_UP; transpose_item(args.in[26] + (size_t)l * DM * FF2, DM, FF2, Wup + (size_t)l * FF2 * DM, FF, scr, r % I_UP, lane); continue; } r -= 2 * I_UP;
        { const int l = r / I_DN; transpose_item(args.in[29] + (size_t)l * FF * DM, FF, DM, Wdn + (size_t)l * DM * FF, 0, scr, r % I_DN, lane); }
    }
    for (int i = blk * 512 + tid; i < SEQ * 8; i += G * 512) { const int pos = i >> 3, f = i & 7; const float inv_freq = powf(500000.0f, -(float)f * 0.125f); const float ang = (float)pos * inv_freq;
        rope[pos * 16 + f] = cosf(ang); rope[pos * 16 + 8 + f] = sinf(ang); }
    for (int i = blk * 512 + tid; i < DB * 128 * 64; i += G * 512) {
        const int b = i / (128 * 64), rem = i % (128 * 64), row = rem >> 6, c4 = (rem & 63) * 4;
        const f32x4 kv = *(const f32x4*)(args.in[2] + ((size_t)(b * 128 + row)) * 256 + c4), vv = *(const f32x4*)(args.in[3] + ((size_t)(b * 128 + row)) * 256 + c4);
        u32x2 kw, vw; kw.x = cvt_pk_bf16(kv[0], kv[1]); kw.y = cvt_pk_bf16(kv[2], kv[3]); vw.x = cvt_pk_bf16(vv[0], vv[1]); vw.y = cvt_pk_bf16(vv[2], vv[3]);
        const size_t krow = (size_t)MP + b * 192 + row;
        *(u32x2*)(Kbuf + krow * 256 + c4) = kw; *(u32x2*)(Vbuf + krow * 256 + c4) = vw;
        if (row >= 64) { *(f32x4*)(out + O_KS + ((size_t)(b * 128 + row - 64)) * 256 + c4) = kv; *(f32x4*)(out + O_VS + ((size_t)(b * 128 + row - 64)) * 256 + c4) = vv; }
    }
    {
        f32x4 gn[4], xa[4], xb_[4];
#define P0_C(j) (8 * lane + 512 * ((j) >> 1) + 4 * ((j) & 1))
#pragma unroll
        for (int j = 0; j < 4; ++j) gn[j] = *(const f32x4*)(args.in[7] + P0_C(j));
#define P0_X(mm) (((mm) < MP) ? args.in[0] + (size_t)(mm) * DM : args.in[1] + (size_t)((mm) - MP) * DM)
        int m = gw;
        if (m < MT) {
#pragma unroll
            for (int j = 0; j < 4; ++j) xa[j] = *(const f32x4*)(P0_X(m) + P0_C(j));
        }
        for (; m < MT; m += NGW) {
            const int mn = m + NGW;
            if (mn < MT) {
#pragma unroll
                for (int j = 0; j < 4; ++j) xb_[j] = *(const f32x4*)(P0_X(mn) + P0_C(j));
            }
            float s2 = 0.f;
#pragma unroll
            for (int j = 0; j < 4; ++j) s2 += (xa[j][0] * xa[j][0] + xa[j][1] * xa[j][1]) + (xa[j][2] * xa[j][2] + xa[j][3] * xa[j][3]);
            const float rstd2 = 1.0f / sqrtf(wave_sum(s2) * (1.0f / DM) + EPS);
#pragma unroll
            for (int j = 0; j < 2; ++j) *(u32x4*)(Abuf + (size_t)m * DM + 8 * lane + 512 * j) = pack8(xa[2 * j] * gn[2 * j] * rstd2, xa[2 * j + 1] * gn[2 * j + 1] * rstd2);
#pragma unroll
            for (int j = 0; j < 4; ++j) xa[j] = xb_[j];
        }
#undef P0_C
#undef P0_X
    }
}

template <bool XIN_F32>
__device__ __forceinline__ void rp_load(const void* xrow, const bf16_t* mrow, const float* ssrow, int nslots, int lane, f32x4 (&xf)[4], u32x4 (&xb)[2], u32x4 (&mw)[2], float& ssv) {
#pragma unroll
    for (int j = 0; j < 2; ++j) { const int c0 = 8 * lane + 512 * j;
        if constexpr (XIN_F32) { xf[2 * j] = __builtin_nontemporal_load((const f32x4*)((const float*)xrow + c0)); xf[2 * j + 1] = __builtin_nontemporal_load((const f32x4*)((const float*)xrow + c0 + 4)); }
        else xb[j] = *(const u32x4*)((const bf16_t*)xrow + c0);
        mw[j] = __builtin_nontemporal_load((const u32x4*)(mrow + c0));
    }
    ssv = (lane < nslots) ? ssrow[lane] : 0.f;
}
template <int MODE>
__device__ __forceinline__ void rp_finish(const f32x4 (&xf)[4], const u32x4 (&xb)[2], const u32x4 (&mw)[2], float ssv, const f32x4 (&gp)[4], const f32x4 (&gn)[4], void* xout, bf16_t* arow, int lane) {
    f32x4 v[4];
    const float rstd = 1.0f / sqrtf(wave_sum(ssv) * (1.0f / DM) + EPS);
    float s2 = 0.f;
#pragma unroll
    for (int j = 0; j < 2; ++j) { const int c0 = 8 * lane + 512 * j;
        if constexpr (MODE == 0) { v[2 * j] = xf[2 * j]; v[2 * j + 1] = xf[2 * j + 1]; } else unpack8(xb[j], v[2 * j], v[2 * j + 1]);
        f32x4 m0, m1; unpack8(mw[j], m0, m1);
        v[2 * j] += m0 * rstd * gp[2 * j]; v[2 * j + 1] += m1 * rstd * gp[2 * j + 1];
        if constexpr (MODE == 2) { *(f32x4*)((float*)xout + c0) = v[2 * j]; *(f32x4*)((float*)xout + c0 + 4) = v[2 * j + 1]; }
        else *(u32x4*)((bf16_t*)xout + c0) = pack8(v[2 * j], v[2 * j + 1]);
#pragma unroll
        for (int h = 0; h < 2; ++h) s2 += (v[2 * j + h][0] * v[2 * j + h][0] + v[2 * j + h][1] * v[2 * j + h][1]) + (v[2 * j + h][2] * v[2 * j + h][2] + v[2 * j + h][3] * v[2 * j + h][3]);
    }
    if constexpr (MODE != 2) {
        const float rstd2 = 1.0f / sqrtf(wave_sum(s2) * (1.0f / DM) + EPS);
#pragma unroll
        for (int j = 0; j < 2; ++j) *(u32x4*)(arow + 8 * lane + 512 * j) = pack8(v[2 * j] * gn[2 * j] * rstd2, v[2 * j + 1] * gn[2 * j + 1] * rstd2);
    }
}
template <int MODE>
__device__ __forceinline__ void phase_rows(const float* x_prompt, const float* x_sample, bf16_t* X16, float* out, const bf16_t* Mbuf, const float* ss, int nslots, const float* gpost, const float* gnext, bf16_t* Abuf, int gw, int NGW, int lane, const float* sacc, const float* mbias, int ns, bool skip_prompt, bool glu = false) {
    int m = gw;
    if (skip_prompt) m = gw + ((MP - gw + NGW - 1) / NGW) * NGW;
    else {
        f32x4 gp[4], gn[4];
#pragma unroll
        for (int j = 0; j < 4; ++j) { const int cg_ = 8 * lane + 512 * (j >> 1) + 4 * (j & 1); gp[j] = *(const f32x4*)(gpost + cg_); gn[j] = (MODE != 2) ? *(const f32x4*)(gnext + cg_) : (f32x4){0.f, 0.f, 0.f, 0.f}; }
        f32x4 xfA[4], xfB[4]; u32x4 xbA[2], xbB[2], mwA[2], mwB[2]; float ssA = 0.f, ssB = 0.f;
#define RP_X(mm) ((MODE == 0) ? (const void*)(x_prompt + (size_t)(mm) * DM) : (const void*)(X16 + (size_t)(mm) * DM))
        if (m < MP) rp_load<MODE == 0>(RP_X(m), Mbuf + (size_t)m * DM, ss + (size_t)m * 32, nslots, lane, xfA, xbA, mwA, ssA);
        for (; m < MP; m += NGW) {
            const int mn = m + NGW;
            if (mn < MP) rp_load<MODE == 0>(RP_X(mn), Mbuf + (size_t)mn * DM, ss + (size_t)mn * 32, nslots, lane, xfB, xbB, mwB, ssB);
            rp_finish<MODE>(xfA, xbA, mwA, ssA, gp, gn, (MODE == 2) ? (void*)(out + (size_t)m * DM) : (void*)(X16 + (size_t)m * DM), Abuf + (size_t)m * DM, lane);
#pragma unroll
            for (int j = 0; j < 4; ++j) xfA[j] = xfB[j];
#pragma unroll
            for (int j = 0; j < 2; ++j) { xbA[j] = xbB[j]; mwA[j] = mwB[j]; }
            ssA = ssB;
        }
#undef RP_X
    }
    for (; m < MT; m += NGW) {
        const bool sp = (sacc != nullptr) && (m >= MP); const float* sr = sp ? sacc + (size_t)(m - MP) * DM : nullptr;
        if constexpr (MODE == 0) { const float* xr = (m < MP) ? x_prompt + (size_t)m * DM : x_sample + (size_t)(m - MP) * DM;
            if (sp) row_pass<true, true, true, false, true>(xr, X16 + (size_t)m * DM, nullptr, nullptr, ns, gpost, gnext, Abuf + (size_t)m * DM, lane, sr, mbias);
            else row_pass<true, true, true, false>(xr, X16 + (size_t)m * DM, Mbuf + (size_t)m * DM, ss + (size_t)m * 32, nslots, gpost, gnext, Abuf + (size_t)m * DM, lane); }
        else if constexpr (MODE == 1) {
            if (sp && glu) row_pass<true, true, false, false, false, true>(X16 + (size_t)m * DM, X16 + (size_t)m * DM, nullptr, nullptr, ns, gpost, gnext, Abuf + (size_t)m * DM, lane, sacc + (size_t)(m - MP) * 2 * DM, mbias);
            else if (sp) row_pass<true, true, false, false, true>(X16 + (size_t)m * DM, X16 + (size_t)m * DM, nullptr, nullptr, ns, gpost, gnext, Abuf + (size_t)m * DM, lane, sr, mbias);
            else row_pass<true, true, false, false>(X16 + (size_t)m * DM, X16 + (size_t)m * DM, Mbuf + (size_t)m * DM, ss + (size_t)m * 32, nslots, gpost, gnext, Abuf + (size_t)m * DM, lane); }
        else {
            if (sp) row_pass<true, false, false, true, true>(X16 + (size_t)m * DM, out + (size_t)m * DM, nullptr, nullptr, ns, gpost, nullptr, nullptr, lane, sr, mbias);
            else row_pass<true, false, false, true>(X16 + (size_t)m * DM, out + (size_t)m * DM, Mbuf + (size_t)m * DM, ss + (size_t)m * 32, nslots, gpost, nullptr, nullptr, lane); }
    }
}
__device__ __forceinline__ void phase_up(LAS unsigned char* lds, const bf16_t* Abuf, const bf16_t* Wup_l, bf16_t* Gbuf, bf16_t* Ebuf, const float* cw, const float* cb, int G, int blk) {
    pg8::Gemm g{Abuf, Wup_l, MT, FF2, DM}; pg8::StaticOrder S; S.init(MT, FF2, DM, G, blk); S.wgm = UP_WGM;
    pg8::EpiUp E{Gbuf, Ebuf, cw, cb};
    pg8::gemm_phase<pg8::EpiUp, true, true>(lds, g, S, E);
}
__device__ __forceinline__ void phase_down(LAS unsigned char* lds, const bf16_t* Gbuf, const bf16_t* Wdn_l, bf16_t* Mbuf, float* ss, float* sacc, int G, int blk) {
    pg8::Gemm g{Gbuf, Wdn_l, MT, DM, FF}; pg8::StaticOrder S; S.init(MT, DM, FF, G, blk, MP / 256, 11);
    pg8::EpiPlainSS E{Mbuf, nullptr, ss, sacc, FF / 64};
    pg8::gemm_phase<pg8::EpiPlainSS, true, true>(lds, g, S, E);
}
__device__ __forceinline__ f32x4 ld_bf4(const bf16_t* p) { const u32x2 w = *(const u32x2*)p; return (f32x4){__uint_as_float(w.x << 16), __uint_as_float(w.x & 0xffff0000u), __uint_as_float(w.y << 16), __uint_as_float(w.y & 0xffff0000u)}; }
__device__ __forceinline__ void phase_fix(const bf16_t* Ebuf, bf16_t* Gbuf, const float* cw, const float* cb, const float* cc, float* out, int l, int G, int blk, int tid) {
    for (int i = blk * 512 + tid; i < NSEG * 2 * (FF / 4); i += G * 512) {
        const int ri = i / (FF / 4), c4 = (i % (FF / 4)) * 4, seg = ri >> 1, j = ri & 1;
        f32x4 o;
        f32x4 cres[2];
#pragma unroll
        for (int hf = 0; hf < 2; ++hf) {
            const int col = hf * FF + c4;
            const f32x4 cur0 = ld_bf4(Ebuf + ((size_t)seg * 4 + 0) * FF2 + col), cur1 = ld_bf4(Ebuf + ((size_t)seg * 4 + 1) * FF2 + col);
            f32x4 p0 = {0.f, 0.f, 0.f, 0.f}, p1 = {0.f, 0.f, 0.f, 0.f};
            if (seg >= MP / 64) { const int b = seg - MP / 64; p0 = *(const f32x4*)(cc + ((size_t)b * 2 + 0) * FF2 + col); p1 = *(const f32x4*)(cc + ((size_t)b * 2 + 1) * FF2 + col); }
            else if ((seg & 31) != 0) { p0 = ld_bf4(Ebuf + ((size_t)(seg - 1) * 4 + 2) * FF2 + col); p1 = ld_bf4(Ebuf + ((size_t)(seg - 1) * 4 + 3) * FF2 + col); }
            const f32x4 w0 = *(const f32x4*)(cw + col), w1 = *(const f32x4*)(cw + FF2 + col), w2 = *(const f32x4*)(cw + 2 * FF2 + col), bb = *(const f32x4*)(cb + col);
            cres[hf] = (j == 0) ? (bb + w0 * p0 + w1 * p1 + w2 * cur0) : (bb + w0 * p1 + w1 * cur0 + w2 * cur1);
        }
#pragma unroll
        for (int q = 0; q < 4; ++q) o[q] = gelu_tanh(cres[0][q]) * cres[1][q];
        u32x2 wv; wv.x = cvt_pk_bf16(o[0], o[1]); wv.y = cvt_pk_bf16(o[2], o[3]);
        *(u32x2*)(Gbuf + ((size_t)seg * 64 + j) * FF + c4) = wv;
    }
    for (int i = blk * 512 + tid; i < (NB + DB) * 2 * (FF2 / 4); i += G * 512) {
        const int ri = i / (FF2 / 4), c4 = (i % (FF2 / 4)) * 4, bb = ri >> 1, e = ri & 1;
        const int seg = (bb < NB) ? bb * 32 + 31 : MP / 64 + (bb - NB);
        const f32x4 v = ld_bf4(Ebuf + ((size_t)seg * 4 + 2 + e) * FF2 + c4);
        float* o = (bb < NB) ? out + O_CP + (((size_t)l * NB + bb) * 2 + e) * FF2 + c4 : out + O_CS + (((size_t)l * DB + (bb - NB)) * 2 + e) * FF2 + c4;
        *(f32x4*)o = v;
    }
}

__global__ void __launch_bounds__(512, 2) fwd_kernel(Args args) {
    extern __shared__ __attribute__((aligned(16))) unsigned char lds_raw[];
    LAS unsigned char* lds = (LAS unsigned char*)lds_raw;
    const int G = gridDim.x, blk = blockIdx.x, NGW = G * 8;
#define IDS int tid = threadIdx.x; asm volatile("" : "+v"(tid)); const int lane = tid & 63, wave = __builtin_amdgcn_readfirstlane(tid >> 6), gw = blk * 8 + wave; (void)lane; (void)gw
    unsigned char* ws = args.ws; float* out = args.out;
    const float* x_prompt = args.in[0]; const float* x_sample = args.in[1];
    bf16_t* Wqkv = (bf16_t*)(ws + WS_WQKV); bf16_t* Wo = (bf16_t*)(ws + WS_WO); bf16_t* Wglu = (bf16_t*)(ws + WS_WGLU); bf16_t* Wup = (bf16_t*)(ws + WS_WUP); bf16_t* Wdn = (bf16_t*)(ws + WS_WDN);
    float* rope = (float*)(ws + WS_ROPE); float* ss = (float*)(ws + WS_SS);
    bf16_t* Abuf = (bf16_t*)(ws + WS_A); bf16_t* Mbuf = (bf16_t*)(ws + WS_MB); bf16_t* Ebuf = (bf16_t*)(ws + WS_E); bf16_t* Gbuf = (bf16_t*)(ws + WS_G);
    bf16_t* X16 = (bf16_t*)(ws + WS_X16); float* sacc = (float*)(ws + WS_SACC);
    bf16_t* Qbuf = (bf16_t*)(ws + WS_Q); bf16_t* Kbuf = (bf16_t*)(ws + WS_K); bf16_t* Vbuf = (bf16_t*)(ws + WS_V);


    const int lo = args.ph_lo, hi_ = args.ph_hi;
    volatile LAS unsigned* misc = (volatile LAS unsigned*)(lds + XL_MISC);
    if (threadIdx.x < 2) misc[threadIdx.x] = 0u;
    __syncthreads();
    XcdBarrier xbar; xbar.bar = (unsigned*)ws; xbar.x = 0; xbar.st = nullptr;
    if (args.coop) xbar = xcd_barrier_post((unsigned*)ws, misc);
    if (args.coop == 2) cg::this_grid().sync();
#define IN(k) (lo <= (k) && (k) < hi_)
#define SEAM(k) do { if (args.coop && (k) + 1 < hi_) xcd_barrier(xbar); } while (0)
#define REP(k) _Pragma("unroll") for (int rep_ = 0; rep_ <= ((PROBE_REPMASK >> (k)) & 1); ++rep_)
    if (IN(0)) { IDS; REP(0) { phase_prologue(lds, args, ws, out, G, blk, wave, lane, tid); } SEAM(0); }
    if (IN(1)) { REP(1) {
        pg8::Gemm g{Abuf, Wqkv, MT, QKVD, DM}; pg8::StaticOrder S; S.init(MT, QKVD, DM, G, blk);
        pg8::EpiQKV E{Qbuf, Kbuf, Vbuf, args.in[12], rope, out + O_KP, out + O_VP, out + O_KS, out + O_VS};
        pg8::gemm_phase<pg8::EpiQKV, true, true>(lds, g, S, E); } SEAM(1); }
    if (IN(2)) { REP(2) { attn_phase(lds, Qbuf, Kbuf, Vbuf, Abuf, args.in[13], G, blk); } SEAM(2); }
    const bool fusedp = (G == 256);
    unsigned long long* xch = (unsigned long long*)(ws + WS_XCH); unsigned* pcnt = (unsigned*)(ws + WS_CNT); LAS unsigned char* xl = lds + XL_OFF;
    if (IN(3)) { REP(3) {
        pg8::Gemm g{Abuf, Wo, MT, DM, DM}; pg8::StaticOrder S; S.init(MT, DM, DM, G, blk, MP / 256, 4);
        { pg8::EpiPlainSS E{Mbuf, args.in[15], ss, sacc, DM / 64}; pg8::gemm_phase<pg8::EpiPlainSS, true, true>(lds, g, S, E); } } SEAM(3); }
    bf16_t* Aup0 = Abuf;
    if (IN(4)) { IDS; REP(4) { phase_rows<0>(x_prompt, x_sample, X16, out, Mbuf, ss, 16, args.in[8], args.in[9], Aup0, gw, NGW, lane, sacc, args.in[15], 4, false); } SEAM(4); }
    if (IN(5)) { REP(5) { phase_up(lds, Aup0, Wup, Gbuf, Ebuf, args.in[27], args.in[28], G, blk); } SEAM(5); }
    if (IN(6)) { IDS; REP(6) { phase_fix(Ebuf, Gbuf, args.in[27], args.in[28], args.in[6], out, 0, G, blk, tid); } SEAM(6); }
    if (IN(7)) { REP(7) {
        if (fusedp) { pg8::Gemm g{Gbuf, Wdn, MT, DM, FF}; pg8::StaticOrder S; S.init(MT, DM, FF, G, blk, MP / 256, 11); S.panel = true;
            pg8::EpiFused<false, false> E{nullptr, X16, X16, nullptr, Abuf, args.in[10], args.in[7] + DM, xch + (size_t)MP * 8, pcnt + 256 * 64, xl, sacc, FF / 64};
            pg8::gemm_phase<pg8::EpiFused<false, false>, true, true>(lds, g, S, E); }
        else phase_down(lds, Gbuf, Wdn, Mbuf, ss, sacc, G, blk); } SEAM(7); }
    if (IN(8)) { IDS; REP(8) { phase_rows<1>(x_prompt, x_sample, X16, out, Mbuf, ss, 16, args.in[10], args.in[7] + DM, Abuf, gw, NGW, lane, sacc, nullptr, 11, fusedp); } SEAM(8); }
    if (IN(9)) { REP(9) {
        SsmP P{args.in[16], args.in[17], args.in[18], args.in[19], args.in[20], args.in[21], args.in[22], args.in[23], args.in[4], args.in[5], out + O_REP, out + O_IMP, out + O_RES, out + O_IMS};
        ssm_phase(lds, Abuf, Qbuf, P, G, blk); } SEAM(9); }
    if (IN(10)) { REP(10) {
        pg8::Gemm g{Qbuf, Wglu, MT, 2 * DM, DM}; pg8::StaticOrder S; S.init(MT, 2 * DM, DM, G, blk, MP / 256, 4);
        pg8::EpiGlu E{Mbuf, args.in[25], ss, sacc, DM / 64};
        pg8::gemm_phase<pg8::EpiGlu, true, true>(lds, g, S, E); } SEAM(10); }
    if (IN(11)) { IDS; REP(11) { phase_rows<1>(x_prompt, x_sample, X16, out, Mbuf, ss, 32, args.in[8] + DM, args.in[9] + DM, Abuf, gw, NGW, lane, sacc, args.in[25], 4, false, true); } SEAM(11); }
    if (IN(12)) { REP(12) { phase_up(lds, Abuf, Wup + (size_t)FF2 * DM, Gbuf, Ebuf, args.in[27] + (size_t)3 * FF2, args.in[28] + FF2, G, blk); } SEAM(12); }
    if (IN(13)) { IDS; REP(13) { phase_fix(Ebuf, Gbuf, args.in[27] + (size_t)3 * FF2, args.in[28] + FF2, args.in[6] + (size_t)DB * 2 * FF2, out, 1, G, blk, tid); } SEAM(13); }
    if (IN(14)) { REP(14) {
        if (fusedp) { pg8::Gemm g{Gbuf, Wdn + (size_t)DM * FF, MT, DM, FF}; pg8::StaticOrder S; S.init(MT, DM, FF, G, blk, MP / 256, 11); S.panel = true;
            pg8::EpiFused<false, true> E{nullptr, X16, nullptr, out, nullptr, args.in[10] + DM, nullptr, xch + (size_t)2 * MP * 8, pcnt + 2 * 256 * 64, xl, sacc, FF / 64};
            pg8::gemm_phase<pg8::EpiFused<false, true>, true, true>(lds, g, S, E); }
        else phase_down(lds, Gbuf, Wdn + (size_t)DM * FF, Mbuf, ss, sacc, G, blk); } SEAM(14); }
    if (IN(15)) { IDS; REP(15) { phase_rows<2>(x_prompt, x_sample, X16, out, Mbuf, ss, 16, args.in[10] + DM, nullptr, nullptr, gw, NGW, lane, sacc, nullptr, 11, fusedp); } }
#undef IN
#undef SEAM
#undef REP
}

extern "C" void kernel_launch(void* const* d_in, const int* in_sizes, int n_in, void* d_out, int out_size, void* d_ws, size_t ws_size, hipStream_t stream) {
    static int grid = 0;
    if (grid == 0) {
        if (n_in != 30 || (size_t)out_size != O_END || ws_size < WS_END) { fprintf(stderr, "kernel_launch: unexpected shapes: n_in %d out %d ws %zu (need out %zu ws %zu)\n", n_in, out_size, ws_size, (size_t)O_END, (size_t)WS_END); grid = -1; return; }
        int dev = 0, cus = 0, per_cu = 0;
        hipGetDevice(&dev); hipDeviceGetAttribute(&cus, hipDeviceAttributeMultiprocessorCount, dev);
        if (hipFuncSetAttribute((const void*)fwd_kernel, hipFuncAttributeMaxDynamicSharedMemorySize, LDS_BYTES) != hipSuccess) { fprintf(stderr, "kernel_launch: hipFuncSetAttribute failed\n"); grid = -1; return; }
        if (hipOccupancyMaxActiveBlocksPerMultiprocessor(&per_cu, (const void*)fwd_kernel, 512, LDS_BYTES) != hipSuccess || per_cu < 1) { fprintf(stderr, "kernel_launch: occupancy query says %d\n", per_cu); per_cu = 1; }
        (void)hipGetLastError();
        grid = cus * 1;
    }
    if (grid < 0) return;
    Args a{};
    for (int i = 0; i < 30; ++i) a.in[i] = (const float*)d_in[i];
    a.out = (float*)d_out; a.ws = (unsigned char*)d_ws;
#ifndef MK_MULTI
    if (hipMemsetAsync(d_ws, 0, CTL_ZERO_BYTES, stream) != hipSuccess) { fprintf(stderr, "kernel_launch: memset failed\n"); return; }
    a.ph_lo = 0; a.ph_hi = NPHASE; a.coop = 1;
    void* kargs[] = {&a};
    hipError_t e = hipLaunchCooperativeKernel((const void*)fwd_kernel, dim3(grid), dim3(512), kargs, LDS_BYTES, stream);
    if (e != hipSuccess) fprintf(stderr, "cooperative launch failed: %s (grid %d)\n", hipGetErrorString(e), grid);
#else
    for (int ph = 0; ph < NPHASE; ++ph) { a.ph_lo = ph; a.ph_hi = ph + 1; a.coop = 0; hipLaunchKernelGGL(fwd_kernel, dim3(grid), dim3(512), LDS_BYTES, stream, a); }
#endif
}
```

```cpp
#include <hip/hip_runtime.h>
#include <hip/hip_cooperative_groups.h>
#include <cstdio>
#include <cstdint>
namespace cg = cooperative_groups;

#define LAS __attribute__((address_space(3)))
typedef unsigned short bf16_t;
typedef short bf16x8 __attribute__((ext_vector_type(8)));
typedef short s16x4 __attribute__((ext_vector_type(4)));
typedef float f32x4 __attribute__((ext_vector_type(4)));
typedef float f32x16 __attribute__((ext_vector_type(16)));
typedef unsigned u32x4 __attribute__((ext_vector_type(4)));
typedef unsigned u32x2 __attribute__((ext_vector_type(2)));

constexpr int DM = 1024, NB = 32, SEQ = 2048, MP = NB * SEQ, DB = 16, DS = 64, MS = DB * DS, MT = MP + MS;
constexpr int QKVD = 1536, FF = 2816, FF2 = 5632, NSEG = MT / 64;
constexpr int KVROWS = MP + DB * 192;
constexpr float EPS = 1e-6f, LOG2E = 1.4426950408889634f, QSCALE = 0.125f * 1.4426950408889634f;
constexpr size_t O_Y = 0, O_KP = (size_t)MT * DM, O_VP = O_KP + (size_t)NB * 128 * 256, O_KS = O_VP + (size_t)NB * 128 * 256, O_VS = O_KS + (size_t)DB * 128 * 256,
                 O_REP = O_VS + (size_t)DB * 128 * 256, O_IMP = O_REP + NB * 4096, O_RES = O_IMP + NB * 4096, O_IMS = O_RES + DB * 4096,
                 O_CP = O_IMS + DB * 4096, O_CS = O_CP + (size_t)2 * NB * 2 * FF2, O_END = O_CS + (size_t)2 * DB * 2 * FF2;
constexpr size_t MiB = 1u << 20;
constexpr size_t WS_WQKV = 1 * MiB, WS_WO = 4 * MiB, WS_WGLU = 6 * MiB, WS_WUP = 10 * MiB, WS_WDN = 32 * MiB, WS_ROPE = 43 * MiB, WS_SS = 44 * MiB,
                 WS_A = 54 * MiB, WS_MB = 185 * MiB, WS_E = 316 * MiB, WS_G = 406 * MiB, WS_Q = WS_G, WS_K = WS_G + 132 * MiB, WS_V = WS_K + 34 * MiB, WS_X16 = WS_G + 358 * MiB, WS_SACC = WS_X16 + 131 * MiB, WS_XCH = WS_SACC + 44 * MiB, WS_END = WS_XCH + 13 * MiB;
constexpr size_t WS_CNT = 32768, CTL_ZERO_BYTES = 32768 + 3 * 256 * 256;
static_assert(WS_WUP + (size_t)2 * FF2 * DM * 2 <= WS_WDN && WS_WDN + (size_t)2 * DM * FF * 2 <= WS_ROPE && WS_SS + (size_t)MT * 32 * 4 <= WS_A, "ws map 1");
static_assert(WS_A + (size_t)MT * DM * 2 <= WS_MB && WS_MB + (size_t)MT * DM * 2 <= WS_E && WS_E + (size_t)NSEG * 4 * FF2 * 4 <= WS_G, "ws map 2");
static_assert(WS_X16 + (size_t)MT * DM * 2 <= WS_END, "ws map 4");
static_assert(WS_Q + (size_t)MT * DM * 2 <= WS_K && WS_K + (size_t)KVROWS * 256 * 2 <= WS_V && WS_V + (size_t)KVROWS * 256 * 2 <= WS_END && WS_G + (size_t)MT * FF * 2 <= WS_END, "ws map 3");

__device__ __forceinline__ unsigned cvt_pk_bf16(float lo, float hi) { unsigned r; asm volatile("v_cvt_pk_bf16_f32 %0, %1, %2" : "=v"(r) : "v"(lo), "v"(hi)); return r; }
__device__ __forceinline__ void unpack8(const u32x4 w, f32x4& lo, f32x4& hi) {
    lo[0] = __uint_as_float(w.x << 16); lo[1] = __uint_as_float(w.x & 0xffff0000u); lo[2] = __uint_as_float(w.y << 16); lo[3] = __uint_as_float(w.y & 0xffff0000u);
    hi[0] = __uint_as_float(w.z << 16); hi[1] = __uint_as_float(w.z & 0xffff0000u); hi[2] = __uint_as_float(w.w << 16); hi[3] = __uint_as_float(w.w & 0xffff0000u);
}
__device__ __forceinline__ u32x4 pack8(const f32x4 lo, const f32x4 hi) { u32x4 w; w.x = cvt_pk_bf16(lo[0], lo[1]); w.y = cvt_pk_bf16(lo[2], lo[3]); w.z = cvt_pk_bf16(hi[0], hi[1]); w.w = cvt_pk_bf16(hi[2], hi[3]); return w; }
__device__ __forceinline__ float bf2f(unsigned short b) { return __uint_as_float((unsigned)b << 16); }
__device__ __forceinline__ float gelu_tanh(float x) {
    const float x2 = x * x, u = x * (0.7978845608f + 0.0356774081f * x2);
    const float e = __builtin_amdgcn_exp2f(-2.885390082f * u);
    return x * __builtin_amdgcn_rcpf(1.0f + e);
}
typedef float f32x2 __attribute__((ext_vector_type(2)));
__device__ __forceinline__ f32x2 gelu_gate_pk(f32x2 x, f32x2 cv) {
    const f32x2 x2 = x * x, t = x2 * (-2.885390082f * 0.0356774081f) + (-2.885390082f * 0.7978845608f), a = x * t;
    f32x2 e; e.x = __builtin_amdgcn_exp2f(a.x); e.y = __builtin_amdgcn_exp2f(a.y);
    const f32x2 d = e + 1.0f;
    f32x2 r; r.x = __builtin_amdgcn_rcpf(d.x); r.y = __builtin_amdgcn_rcpf(d.y);
    return (x * cv) * r;
}
__device__ __forceinline__ float sigmoid_f(float v) { return __builtin_amdgcn_rcpf(1.0f + __builtin_amdgcn_exp2f(-LOG2E * v)); }
__device__ __forceinline__ float wave_sum(float v) {
#pragma unroll
    for (int o = 1; o < 64; o <<= 1) v += __shfl_xor(v, o);
    return v;
}
__device__ __forceinline__ float sum_rows4(float v) {
    auto a = __builtin_amdgcn_permlane16_swap(__float_as_uint(v), __float_as_uint(v), false, false);
    const float s = __uint_as_float(a[0]) + __uint_as_float(a[1]);
    auto b = __builtin_amdgcn_permlane32_swap(__float_as_uint(s), __float_as_uint(s), false, false);
    return __uint_as_float(b[0]) + __uint_as_float(b[1]);
}
template <int CTRL> __device__ __forceinline__ float dpp_f(float x) { return __builtin_bit_cast(float, __builtin_amdgcn_update_dpp(0, __builtin_bit_cast(int, x), CTRL, 0xf, 0xf, false)); }

#define FMAC_DPP(c, src, w, CTRL) asm volatile("v_fmac_f32_dpp %0, %1, %2 " CTRL " row_mask:0xf bank_mask:0xf" : "+v"(c) : "v"(src), "v"(w))
namespace pg8 {
constexpr int BM = 256, BK = 64, HALF = 128, HTB = HALF * BK * 2, STAGE_BYTES = 8 * HTB, NXCD = 8, WGM = 8;
__host__ __device__ __forceinline__ int lds_byte(int r, int c) { const int st = (r >> 4) * 2 + (c >> 5), rr = r & 15, cc = c & 31, ob = rr * 64 + cc * 2; return st * 1024 + (ob ^ (((ob >> 9) & 1) << 5)); }
__host__ __device__ __forceinline__ void stage_rc(int b, int& R, int& C) { const int st = b / 1024, sb = b % 1024, swz = sb ^ (((sb >> 9) & 1) << 5); R = (st >> 1) * 16 + swz / 64; C = (st & 1) * 32 + (swz % 64) / 2; }
__host__ __device__ __forceinline__ int perm32(int rho) { const int n = rho >> 4, i = rho & 15; return 8 * (i >> 2) + 4 * n + (i & 3); }
__host__ __device__ __forceinline__ int permrope(int rho) { const int n = rho >> 4, i = rho & 15, fq = i >> 2, j = i & 3; return 16 * (fq >> 1) + 8 * n + 4 * (fq & 1) + j; }
struct Unit { int pm, pn, kt0, nkt; };
struct Gemm { const bf16_t* A; const bf16_t* Bt; int M, N, K; };
struct StaticOrder {
    int nM, nN, nwg, G, c, nMf, ns, ktiles, nfull, wgm = WGM; bool panel = false;
    __device__ void init(int M, int N, int K, int G_, int c_, int nMf_ = -1, int ns_ = 1) { nM = M / BM; nN = N / BM; G = G_; c = c_; ktiles = K / BK; nMf = nMf_ < 0 ? nM : nMf_; ns = ns_; nfull = nMf * nN; nwg = nfull + (nM - nMf) * nN * ns; }
    __device__ __forceinline__ bool next(int i, Unit& u) const {
        const long L = (long)i * G + c; if (L >= nwg) return false;
        int pm, pn, kt0 = 0, nkt = ktiles;
        if (L >= nfull) { const int s = (int)L - nfull, tile = s / ns, sl = s - tile * ns; pm = nMf + tile / nN; pn = tile % nN; nkt = ktiles / ns; kt0 = sl * nkt; }
        else if (panel) { const int x = c & 7, j = c >> 3; pn = j & 3; pm = 64 * i + 8 * (j >> 2) + x; }
        else {
            int wgid = (int)L; { const int q = nfull / NXCD, r = nfull % NXCD, xcd = wgid % NXCD, off = wgid / NXCD; wgid = (xcd < r ? xcd * (q + 1) : r * (q + 1) + (xcd - r) * q) + off; }
            const int nig = wgm * nN, gid = wgid / nig, fm = gid * wgm, gsz = (nMf - fm) < wgm ? (nMf - fm) : wgm;
            pm = fm + ((wgid % nig) % gsz); pn = (wgid % nig) / gsz;
        }
        u = Unit{pm, pn, kt0, nkt}; return true;
    }
};
template <class Epi, bool ALIGN_EPI, bool SP2>
__device__ __forceinline__ void gemm_phase(LAS unsigned char* lds, const Gemm g, const StaticOrder& S, const Epi& E) {
    const int tid = threadIdx.x, wid = __builtin_amdgcn_readfirstlane(tid >> 6), lane = tid & 63, wr = wid >> 2, wc = wid & 3, fr = lane & 15, fq = lane >> 4;
    const int K = g.K;
    unsigned voffA[2], voffB[2];
#pragma unroll
    for (int i = 0; i < 2; ++i) { int R, C; stage_rc(tid * 16 + i * 8192, R, C); const int Rb = (R & ~31) + Epi::perm(R & 31);
        voffA[i] = (unsigned)(R * K + C) * 2u; voffB[i] = (unsigned)(Rb * K + C) * 2u; }
    const size_t kstep = (size_t)(BK * 2);
    const size_t hstep = (size_t)HALF * K * 2;
    const size_t tstep = 2 * hstep;
    const unsigned ldsw = (unsigned)wid * 1024u;
    const int aoff = lds_byte(wr * 64 + fr, fq * 8), boff = lds_byte(wc * 32 + fr, fq * 8);
#define PG8_SA(b, h) (((b) * 2 + (h)) * HTB)
#define PG8_SB(b, h) ((4 + (b) * 2 + (h)) * HTB)
#define PG8_STAGE(bufoff, gbase, voff) do { _Pragma("unroll") for (int _i = 0; _i < 2; ++_i) \
        __builtin_amdgcn_global_load_lds((const unsigned*)((const char*)(gbase) + (voff)[_i]), (LAS unsigned*)(lds + (bufoff) + ldsw + _i * 8192), 16, 0, 0); } while (0)
#define PG8_LDA(dst, b, h) do { _Pragma("unroll") for (int m = 0; m < 4; ++m) _Pragma("unroll") for (int k = 0; k < 2; ++k) dst[m][k] = *(const LAS bf16x8*)(lds + PG8_SA(b, h) + aoff + m * 2048 + k * 1024); } while (0)
#define PG8_LDB(dst, b, h) do { _Pragma("unroll") for (int n = 0; n < 2; ++n) _Pragma("unroll") for (int k = 0; k < 2; ++k) dst[n][k] = *(const LAS bf16x8*)(lds + PG8_SB(b, h) + boff + n * 2048 + k * 1024); } while (0)
#define PG8_MMA(ai, bj, At, Bt) do { __builtin_amdgcn_s_setprio(1); _Pragma("unroll") for (int m = 0; m < 4; ++m) _Pragma("unroll") for (int n = 0; n < 2; ++n) _Pragma("unroll") for (int k = 0; k < 2; ++k) \
        acc[ai][bj][m][n] = __builtin_amdgcn_mfma_f32_16x16x32_bf16(Bt[n][k], At[m][k], acc[ai][bj][m][n], 0, 0, 0); __builtin_amdgcn_s_setprio(0); } while (0)
#define PG8_WAIT_V(n) asm volatile("s_waitcnt vmcnt(" #n ")" ::: "memory")
#define PG8_WAIT_L(n) asm volatile("s_waitcnt lgkmcnt(" #n ")" ::: "memory")
#define PG8_BAR __builtin_amdgcn_s_barrier()
#define PG8_SCHED __builtin_amdgcn_sched_barrier(0)
    Unit cur, nxt; int ui = 0;
    if (!S.next(0, cur)) return;
    f32x4 acc[2][2][4][2];
#pragma unroll
    for (int a = 0; a < 2; ++a)
#pragma unroll
        for (int b = 0; b < 2; ++b)
#pragma unroll
            for (int m = 0; m < 4; ++m)
#pragma unroll
                for (int n = 0; n < 2; ++n) acc[a][b][m][n] = (f32x4){0.f, 0.f, 0.f, 0.f};
    bf16x8 At[4][2], B0[2][2], B1[2][2];
    const char* cA = (const char*)g.A + (size_t)cur.pm * tstep + (size_t)cur.kt0 * kstep; const char* cB = (const char*)g.Bt + (size_t)cur.pn * tstep + (size_t)cur.kt0 * kstep;
    if constexpr (SP2) {
        PG8_STAGE(PG8_SB(0, 0), cB, voffB); PG8_STAGE(PG8_SB(0, 1), cB + hstep, voffB); PG8_STAGE(PG8_SA(0, 0), cA, voffA); PG8_STAGE(PG8_SA(0, 1), cA + hstep, voffA);
        if (wr == 1) PG8_BAR;
        PG8_WAIT_V(2); PG8_BAR;
        PG8_STAGE(PG8_SB(1, 0), cB + kstep, voffB); PG8_STAGE(PG8_SA(1, 0), cA + kstep, voffA); PG8_STAGE(PG8_SB(1, 1), cB + hstep + kstep, voffB);
        PG8_WAIT_V(6); PG8_BAR;
    } else {
        PG8_STAGE(PG8_SB(0, 0), cB, voffB); PG8_STAGE(PG8_SA(0, 0), cA, voffA); PG8_STAGE(PG8_SB(0, 1), cB + hstep, voffB); PG8_STAGE(PG8_SA(0, 1), cA + hstep, voffA);
        if (wr == 1) PG8_BAR;
        PG8_WAIT_V(4); PG8_BAR;
        PG8_STAGE(PG8_SB(1, 0), cB + kstep, voffB); PG8_STAGE(PG8_SA(1, 0), cA + kstep, voffA); PG8_STAGE(PG8_SB(1, 1), cB + hstep + kstep, voffB);
        PG8_WAIT_V(6); PG8_BAR;
    }
    for (;;) {
        const bool has_next = S.next(ui + 1, nxt);
        const char* nA = has_next ? (const char*)g.A + (size_t)nxt.pm * tstep + (size_t)nxt.kt0 * kstep : cA; const char* nB = has_next ? (const char*)g.Bt + (size_t)nxt.pn * tstep + (size_t)nxt.kt0 * kstep : cB;
        const int nt = cur.nkt;
        for (int t = 0; t < nt; t += 2) {
            const bool last = (t == nt - 2);
            const char* a1 = cA + (size_t)(t + 1) * kstep;
            const char* a2 = last ? nA : cA + (size_t)(t + 2) * kstep; const char* b2 = last ? nB : cB + (size_t)(t + 2) * kstep;
            const char* a3 = a2 + kstep; const char* b3 = b2 + kstep;
            if constexpr (SP2) {
            PG8_LDB(B0, 0, 0); PG8_LDB(B1, 0, 1); PG8_SCHED; PG8_LDA(At, 0, 0); PG8_STAGE(PG8_SA(1, 1), a1 + hstep, voffA);
            PG8_WAIT_V(8); PG8_WAIT_L(0); PG8_BAR; PG8_MMA(0, 0, At, B0); PG8_MMA(0, 1, At, B1); PG8_BAR; PG8_SCHED;
            PG8_LDA(At, 0, 1); PG8_STAGE(PG8_SB(0, 0), b2, voffB); PG8_STAGE(PG8_SB(0, 1), b2 + hstep, voffB); PG8_STAGE(PG8_SA(0, 0), a2, voffA);
            PG8_WAIT_V(8); PG8_WAIT_L(0); PG8_BAR; PG8_MMA(1, 0, At, B0); PG8_MMA(1, 1, At, B1); PG8_BAR; PG8_SCHED;
            PG8_LDB(B0, 1, 0); PG8_LDB(B1, 1, 1); PG8_SCHED; PG8_LDA(At, 1, 0); PG8_STAGE(PG8_SA(0, 1), a2 + hstep, voffA);
            PG8_WAIT_V(8); PG8_WAIT_L(0); PG8_BAR; PG8_MMA(0, 0, At, B0); PG8_MMA(0, 1, At, B1); PG8_BAR; PG8_SCHED;
            PG8_LDA(At, 1, 1); PG8_STAGE(PG8_SB(1, 0), b3, voffB); PG8_STAGE(PG8_SB(1, 1), b3 + hstep, voffB); PG8_STAGE(PG8_SA(1, 0), a3, voffA);
            PG8_WAIT_V(8); PG8_WAIT_L(0); PG8_BAR; PG8_MMA(1, 0, At, B0); PG8_MMA(1, 1, At, B1); PG8_BAR; PG8_SCHED;
            } else {
            PG8_LDB(B0, 0, 0); PG8_SCHED; PG8_LDA(At, 0, 0); PG8_STAGE(PG8_SA(1, 1), a1 + hstep, voffA);
            PG8_WAIT_L(8); PG8_BAR; PG8_WAIT_L(0); PG8_MMA(0, 0, At, B0); PG8_BAR; PG8_SCHED;
            PG8_LDB(B1, 0, 1); PG8_STAGE(PG8_SB(0, 0), b2, voffB);
            PG8_BAR; PG8_WAIT_L(0); PG8_MMA(0, 1, At, B1); PG8_BAR;
            PG8_LDA(At, 0, 1); PG8_STAGE(PG8_SA(0, 0), a2, voffA);
            PG8_BAR; PG8_WAIT_L(0); PG8_MMA(1, 0, At, B0); PG8_BAR; PG8_SCHED;
            PG8_STAGE(PG8_SB(0, 1), b2 + hstep, voffB);
            PG8_WAIT_V(6); PG8_BAR; PG8_MMA(1, 1, At, B1); PG8_BAR;
            PG8_LDB(B0, 1, 0); PG8_SCHED; PG8_LDA(At, 1, 0); PG8_STAGE(PG8_SA(0, 1), a2 + hstep, voffA);
            PG8_WAIT_L(8); PG8_BAR; PG8_WAIT_L(0); PG8_MMA(0, 0, At, B0); PG8_BAR; PG8_SCHED;
            PG8_LDB(B1, 1, 1); PG8_STAGE(PG8_SB(1, 0), b3, voffB);
            PG8_BAR; PG8_WAIT_L(0); PG8_MMA(0, 1, At, B1); PG8_BAR;
            PG8_LDA(At, 1, 1); PG8_STAGE(PG8_SA(1, 0), a3, voffA);
            PG8_BAR; PG8_WAIT_L(0); PG8_MMA(1, 0, At, B0); PG8_BAR; PG8_SCHED;
            PG8_STAGE(PG8_SB(1, 1), b3 + hstep, voffB);
            PG8_WAIT_V(6); PG8_BAR; PG8_MMA(1, 1, At, B1); PG8_BAR;
            }
        }
        if constexpr (ALIGN_EPI) { if (wr == 0) PG8_BAR; }
        E(acc, cur, wr, wc, fr, fq);
        if (!has_next) break;
#pragma unroll
        for (int a = 0; a < 2; ++a)
#pragma unroll
            for (int b = 0; b < 2; ++b)
#pragma unroll
                for (int m = 0; m < 4; ++m)
#pragma unroll
                    for (int n = 0; n < 2; ++n) acc[a][b][m][n] = (f32x4){0.f, 0.f, 0.f, 0.f};
        cur = nxt; cA = nA; cB = nB; ++ui;
        if constexpr (ALIGN_EPI) { if (wr == 1) PG8_BAR; }
    }
    PG8_WAIT_V(0);
    if constexpr (!ALIGN_EPI) { if (wr == 0) PG8_BAR; }
    PG8_BAR;
#undef PG8_SA
#undef PG8_SB
#undef PG8_STAGE
#undef PG8_LDA
#undef PG8_LDB
#undef PG8_MMA
#undef PG8_WAIT_V
#undef PG8_WAIT_L
#undef PG8_BAR
#undef PG8_SCHED
}

struct EpiQKV {
    static constexpr bool PERM = true; static __device__ __forceinline__ int perm(int rho) { return permrope(rho); }
    bf16_t* Q; bf16_t* Kb; bf16_t* Vb; const float* bias; const float* rope; float* kp; float* vp; float* ks; float* vs;
    __device__ __forceinline__ void operator()(const f32x4 (&acc)[2][2][4][2], const Unit& u, int wr, int wc, int fr, int fq) const {
        const int kind = u.pn < 4 ? 0 : u.pn - 3;
        const int lc0 = wc * 32 + 16 * (fq >> 1) + 4 * (fq & 1);
        f32x4 bv[2][2];
#pragma unroll
        for (int bj = 0; bj < 2; ++bj)
#pragma unroll
            for (int n = 0; n < 2; ++n) bv[bj][n] = *(const f32x4*)(bias + u.pn * 256 + bj * 128 + lc0 + 8 * n);
        const bool dorope = (kind < 2) && ((wc & 1) == 0) && (fq < 2);
#pragma unroll
        for (int ai = 0; ai < 2; ++ai)
#pragma unroll
            for (int m = 0; m < 4; ++m) {
                const int r = u.pm * 256 + ai * 128 + wr * 64 + m * 16 + fr;
                const bool prompt = r < MP;
                const int t = prompt ? (r & 2047) : ((r - MP) & 63), b = prompt ? (r >> 11) : ((r - MP) >> 6);
                const int pos = prompt ? t : 1024 + t;
                f32x4 cs = {1.f, 1.f, 1.f, 1.f}, sn = {0.f, 0.f, 0.f, 0.f};
                if (dorope) { cs = *(const f32x4*)(rope + pos * 16 + 4 * fq); sn = *(const f32x4*)(rope + pos * 16 + 8 + 4 * fq); }
#pragma unroll
                for (int bj = 0; bj < 2; ++bj) {
                    const f32x4 x1 = acc[ai][bj][m][0] + bv[bj][0], x2 = acc[ai][bj][m][1] + bv[bj][1];
                    f32x4 v[2]; v[0] = x1 * cs - x2 * sn; v[1] = x2 * cs + x1 * sn;
                    if (kind == 0) {
                        u32x2 w0, w1; w0.x = cvt_pk_bf16(v[0][0] * QSCALE, v[0][1] * QSCALE); w0.y = cvt_pk_bf16(v[0][2] * QSCALE, v[0][3] * QSCALE); w1.x = cvt_pk_bf16(v[1][0] * QSCALE, v[1][1] * QSCALE); w1.y = cvt_pk_bf16(v[1][2] * QSCALE, v[1][3] * QSCALE);
                        bf16_t* qp = Q + (size_t)r * DM + u.pn * 256 + bj * 128 + lc0;
                        *(u32x2*)qp = w0; *(u32x2*)(qp + 8) = w1;
                    } else {
                        const int col = bj * 128 + lc0;
                        const size_t krow = prompt ? (size_t)r : (size_t)MP + b * 192 + 128 + t;
                        u32x2 w0, w1; w0.x = cvt_pk_bf16(v[0][0], v[0][1]); w0.y = cvt_pk_bf16(v[0][2], v[0][3]); w1.x = cvt_pk_bf16(v[1][0], v[1][1]); w1.y = cvt_pk_bf16(v[1][2], v[1][3]);
                        bf16_t* kvp = (kind == 1 ? Kb : Vb) + krow * 256 + col;
                        *(u32x2*)kvp = w0; *(u32x2*)(kvp + 8) = w1;
                        float* o = nullptr;
                        if (prompt) { if (t >= SEQ - 128) o = (kind == 1 ? kp : vp) + ((size_t)(b * 128 + t - (SEQ - 128)) * 256 + col); }
                        else o = (kind == 1 ? ks : vs) + ((size_t)(b * 128 + 64 + t) * 256 + col);
                        if (o) { *(f32x4*)o = v[0]; *(f32x4*)(o + 8) = v[1]; }
                    }
                }
            }
    }
};
struct EpiPlainSS {
    static constexpr bool PERM = true; static __device__ __forceinline__ int perm(int rho) { return perm32(rho); }
    bf16_t* O; const float* bias; float* ss; float* sacc; int ktiles;
    __device__ __forceinline__ void operator()(const f32x4 (&acc)[2][2][4][2], const Unit& u, int wr, int wc, int fr, int fq) const {
        const int col0 = u.pn * 256 + wc * 32 + 8 * fq;
        if (u.nkt != ktiles) {
            const int slice = u.kt0 / u.nkt;
#pragma unroll
            for (int ai = 0; ai < 2; ++ai)
#pragma unroll
                for (int m = 0; m < 4; ++m) {
                    const int r = u.pm * 256 + ai * 128 + wr * 64 + m * 16 + fr - MP; float* sp = sacc + ((size_t)slice * MS + r) * DM + col0;
#pragma unroll
                    for (int bj = 0; bj < 2; ++bj) { *(f32x4*)(sp + bj * 128) = acc[ai][bj][m][0]; *(f32x4*)(sp + bj * 128 + 4) = acc[ai][bj][m][1]; }
                }
            return;
        }
        f32x4 bv[2][2];
#pragma unroll
        for (int bj = 0; bj < 2; ++bj)
#pragma unroll
            for (int n = 0; n < 2; ++n) bv[bj][n] = bias ? *(const f32x4*)(bias + col0 + bj * 128 + 4 * n) : (f32x4){0.f, 0.f, 0.f, 0.f};
#pragma unroll
        for (int ai = 0; ai < 2; ++ai)
#pragma unroll
            for (int m = 0; m < 4; ++m) {
                const int r = u.pm * 256 + ai * 128 + wr * 64 + m * 16 + fr; float s = 0.f;
#pragma unroll
                for (int bj = 0; bj < 2; ++bj) {
                    const f32x4 v0 = acc[ai][bj][m][0] + bv[bj][0], v1 = acc[ai][bj][m][1] + bv[bj][1];
                    s += (v0[0] * v0[0] + v0[1] * v0[1]) + (v0[2] * v0[2] + v0[3] * v0[3]) + (v1[0] * v1[0] + v1[1] * v1[1]) + (v1[2] * v1[2] + v1[3] * v1[3]);
                    u32x4 w; w.x = cvt_pk_bf16(v0[0], v0[1]); w.y = cvt_pk_bf16(v0[2], v0[3]); w.z = cvt_pk_bf16(v1[0], v1[1]); w.w = cvt_pk_bf16(v1[2], v1[3]);
                    *(u32x4*)(O + (size_t)r * DM + col0 + bj * 128) = w;
                }
                s += __shfl_xor(s, 16); s += __shfl_xor(s, 32);
                if (fq == 0) ss[(size_t)r * 32 + u.pn * 4 + wc] = s;
            }
    }
};
template <bool XIN_F32, bool LAST>
struct EpiFused {
    static constexpr bool PERM = true; static __device__ __forceinline__ int perm(int rho) { return perm32(rho); }
    const float* bias; const void* xin; bf16_t* xo16; float* xof; bf16_t* aout; const float* gpost; const float* gnext;
    unsigned long long* xch; unsigned* cnt; LAS unsigned char* xl; float* sacc; int ktiles;
    __device__ __forceinline__ void load_x(f32x4 (&x)[2], size_t off) const {
        if constexpr (XIN_F32) { x[0] = *(const f32x4*)((const float*)xin + off); x[1] = *(const f32x4*)((const float*)xin + off + 4); }
        else { const u32x4 w = *(const u32x4*)((const bf16_t*)xin + off);
            x[0][0] = __uint_as_float(w.x << 16); x[0][1] = __uint_as_float(w.x & 0xffff0000u); x[0][2] = __uint_as_float(w.y << 16); x[0][3] = __uint_as_float(w.y & 0xffff0000u);
            x[1][0] = __uint_as_float(w.z << 16); x[1][1] = __uint_as_float(w.z & 0xffff0000u); x[1][2] = __uint_as_float(w.w << 16); x[1][3] = __uint_as_float(w.w & 0xffff0000u); }
    }
    __device__ __forceinline__ void operator()(f32x4 (&acc)[2][2][4][2], const Unit& u, int wr, int wc, int fr, int fq) const {
        asm volatile("" : "+v"(fr), "+v"(fq));
        const int col0 = u.pn * 256 + wc * 32 + 8 * fq;
        if (u.nkt != ktiles) {
            const int slice = u.kt0 / u.nkt;
#pragma unroll
            for (int ai = 0; ai < 2; ++ai)
#pragma unroll
                for (int m = 0; m < 4; ++m) {
                    const int r = u.pm * 256 + ai * 128 + wr * 64 + m * 16 + fr - MP; float* sp = sacc + ((size_t)slice * MS + r) * DM + col0;
#pragma unroll
                    for (int bj = 0; bj < 2; ++bj) { *(f32x4*)(sp + bj * 128) = acc[ai][bj][m][0]; *(f32x4*)(sp + bj * 128 + 4) = acc[ai][bj][m][1]; }
                }
            return;
        }
        int tid = threadIdx.x; asm volatile("" : "+v"(tid)); const int lane = tid & 63, wid = __builtin_amdgcn_readfirstlane(tid >> 6);
        LAS f32x4* P = (LAS f32x4*)xl; LAS f32x2* S2 = (LAS f32x2*)(xl + 16384); volatile LAS unsigned* flag = (volatile LAS unsigned*)(xl + 16384 + 2048);
        f32x4 gp[2][2];
#pragma unroll
        for (int bj = 0; bj < 2; ++bj)
#pragma unroll
            for (int n = 0; n < 2; ++n) { gp[bj][n] = *(const f32x4*)(gpost + col0 + bj * 128 + 4 * n);
                if (bias) { const f32x4 bv = *(const f32x4*)(bias + col0 + bj * 128 + 4 * n);
#pragma unroll
                    for (int ai = 0; ai < 2; ++ai)
#pragma unroll
                        for (int m = 0; m < 4; ++m) acc[ai][bj][m][n] += bv; } }
#pragma unroll
        for (int ai = 0; ai < 2; ++ai)
#pragma unroll
            for (int m = 0; m < 4; ++m) {
                const int rl = ai * 128 + wr * 64 + m * 16 + fr; const size_t roff = (size_t)(u.pm * 256 + rl) * DM + col0;
                float smm = 0.f, sxx = 0.f, sxm = 0.f, sgg = 0.f;
#pragma unroll
                for (int bj = 0; bj < 2; ++bj) { f32x4 x[2]; load_x(x, roff + bj * 128);
#pragma unroll
                    for (int n = 0; n < 2; ++n)
#pragma unroll
                        for (int j = 0; j < 4; ++j) { const float v = acc[ai][bj][m][n][j], mg = v * gp[bj][n][j], xv = x[n][j]; smm += v * v; sxx += xv * xv; sxm += xv * mg; sgg += mg * mg; acc[ai][bj][m][n][j] = mg; } }
                smm = sum_rows4(smm); sxx = sum_rows4(sxx); sxm = sum_rows4(sxm); sgg = sum_rows4(sgg);
                if (fq == 0) P[rl * 4 + wc] = (f32x4){smm, sxx, sxm, sgg};
            }
        asm volatile("s_waitcnt lgkmcnt(0)" ::: "memory"); __builtin_amdgcn_s_barrier(); asm volatile("" ::: "memory");
        if (tid < 256) {
            const f32x4 t = (P[tid * 4 + 0] + P[tid * 4 + 1]) + (P[tid * 4 + 2] + P[tid * 4 + 3]);
            unsigned long long* slot = xch + ((size_t)(u.pm * 256 + tid) * 4 + u.pn) * 2;
            __hip_atomic_store(slot, ((unsigned long long)__float_as_uint(t[1]) << 32) | __float_as_uint(t[0]), __ATOMIC_RELAXED, __HIP_MEMORY_SCOPE_AGENT);
            __hip_atomic_store(slot + 1, ((unsigned long long)__float_as_uint(t[3]) << 32) | __float_as_uint(t[2]), __ATOMIC_RELAXED, __HIP_MEMORY_SCOPE_AGENT);
        }
        asm volatile("s_waitcnt vmcnt(0)" ::: "memory");
        if (wid < 4 && lane == 0) __hip_atomic_fetch_add(cnt + 64 * u.pm, 1u, __ATOMIC_RELAXED, __HIP_MEMORY_SCOPE_AGENT);
        if (wid == 0) {
            unsigned sp = 0u;
            while ((unsigned)__builtin_amdgcn_readfirstlane(__hip_atomic_load(cnt + 64 * u.pm, __ATOMIC_RELAXED, __HIP_MEMORY_SCOPE_AGENT)) < 16u) { __builtin_amdgcn_s_sleep(2); if (++sp > (1u << 21)) break; }
            __builtin_amdgcn_fence(__ATOMIC_ACQUIRE, "agent");
            if (lane == 0) flag[0] = sp;
        }
        asm volatile("s_waitcnt vmcnt(0) lgkmcnt(0)" ::: "memory"); __builtin_amdgcn_s_barrier(); asm volatile("" ::: "memory");
        if (tid < 256) {
            const unsigned long long* slot = xch + (size_t)(u.pm * 256 + tid) * 8; float t0 = 0.f, t1 = 0.f, t2 = 0.f, t3 = 0.f;
#pragma unroll
            for (int q = 0; q < 4; ++q) { const unsigned long long a = __hip_atomic_load(slot + 2 * q, __ATOMIC_RELAXED, __HIP_MEMORY_SCOPE_AGENT), b = __hip_atomic_load(slot + 2 * q + 1, __ATOMIC_RELAXED, __HIP_MEMORY_SCOPE_AGENT);
                t0 += __uint_as_float((unsigned)a); t1 += __uint_as_float((unsigned)(a >> 32)); t2 += __uint_as_float((unsigned)b); t3 += __uint_as_float((unsigned)(b >> 32)); }
            const float s = 1.0f / sqrtf(t0 * (1.0f / DM) + EPS);
            const float q1 = t1 + 2.0f * s * t2 + s * s * t3;
            S2[tid] = (f32x2){s, 1.0f / sqrtf(fmaxf(q1, 0.f) * (1.0f / DM) + EPS)};
        }
        asm volatile("s_waitcnt lgkmcnt(0)" ::: "memory"); __builtin_amdgcn_s_barrier(); asm volatile("" ::: "memory");
#pragma unroll
        for (int ai = 0; ai < 2; ++ai)
#pragma unroll
            for (int m = 0; m < 4; ++m) {
                const int rl = ai * 128 + wr * 64 + m * 16 + fr; const size_t roff = (size_t)(u.pm * 256 + rl) * DM + col0;
                const f32x2 sr = S2[rl];
#pragma unroll
                for (int bj = 0; bj < 2; ++bj) { f32x4 x[2]; load_x(x, roff + bj * 128);
                    f32x4 x1[2];
#pragma unroll
                    for (int n = 0; n < 2; ++n) x1[n] = x[n] + acc[ai][bj][m][n] * sr.x;
                    if constexpr (LAST) { *(f32x4*)(xof + roff + bj * 128) = x1[0]; *(f32x4*)(xof + roff + bj * 128 + 4) = x1[1]; }
                    else {
                        u32x4 w; w.x = cvt_pk_bf16(x1[0][0], x1[0][1]); w.y = cvt_pk_bf16(x1[0][2], x1[0][3]); w.z = cvt_pk_bf16(x1[1][0], x1[1][1]); w.w = cvt_pk_bf16(x1[1][2], x1[1][3]);
                        *(u32x4*)(xo16 + roff + bj * 128) = w;
                        const f32x4 a0 = x1[0] * *(const f32x4*)(gnext + col0 + bj * 128) * sr.y, a1 = x1[1] * *(const f32x4*)(gnext + col0 + bj * 128 + 4) * sr.y;
                        u32x4 wa; wa.x = cvt_pk_bf16(a0[0], a0[1]); wa.y = cvt_pk_bf16(a0[2], a0[3]); wa.z = cvt_pk_bf16(a1[0], a1[1]); wa.w = cvt_pk_bf16(a1[2], a1[3]);
                        *(u32x4*)(aout + roff + bj * 128) = wa;
                    }
                }
            }
        asm volatile("s_waitcnt lgkmcnt(0)" ::: "memory");
    }
};
struct EpiGlu {
    static constexpr bool PERM = true; static __device__ __forceinline__ int perm(int rho) { return perm32(rho); }
    bf16_t* O; const float* bias; float* ss; float* sacc; int ktiles;
    __device__ __forceinline__ void operator()(const f32x4 (&acc)[2][2][4][2], const Unit& u, int wr, int wc, int fr, int fq) const {
        if (u.nkt != ktiles) {
            const int slice = u.kt0 / u.nkt;
#pragma unroll
            for (int ai = 0; ai < 2; ++ai)
#pragma unroll
                for (int m = 0; m < 4; ++m) {
                    const int r = u.pm * 256 + ai * 128 + wr * 64 + m * 16 + fr - MP; float* sp = sacc + ((size_t)slice * MS + r) * (2 * DM) + u.pn * 256 + wc * 32 + 8 * fq;
#pragma unroll
                    for (int bj = 0; bj < 2; ++bj) { *(f32x4*)(sp + bj * 128) = acc[ai][bj][m][0]; *(f32x4*)(sp + bj * 128 + 4) = acc[ai][bj][m][1]; }
                }
            return;
        }
        const int oc0 = u.pn * 128 + wc * 32 + 8 * fq;
        f32x4 ba[2], bg[2];
#pragma unroll
        for (int n = 0; n < 2; ++n) { ba[n] = *(const f32x4*)(bias + oc0 + 4 * n); bg[n] = *(const f32x4*)(bias + DM + oc0 + 4 * n); }
#pragma unroll
        for (int ai = 0; ai < 2; ++ai)
#pragma unroll
            for (int m = 0; m < 4; ++m) {
                const int r = u.pm * 256 + ai * 128 + wr * 64 + m * 16 + fr; float s = 0.f; f32x4 o[2];
#pragma unroll
                for (int n = 0; n < 2; ++n) { const f32x4 a = acc[ai][0][m][n] + ba[n], g = acc[ai][1][m][n] + bg[n];
#pragma unroll
                    for (int j = 0; j < 4; ++j) { o[n][j] = a[j] * sigmoid_f(g[j]); s += o[n][j] * o[n][j]; } }
                u32x4 w; w.x = cvt_pk_bf16(o[0][0], o[0][1]); w.y = cvt_pk_bf16(o[0][2], o[0][3]); w.z = cvt_pk_bf16(o[1][0], o[1][1]); w.w = cvt_pk_bf16(o[1][2], o[1][3]);
                *(u32x4*)(O + (size_t)r * DM + oc0) = w;
                s += __shfl_xor(s, 16); s += __shfl_xor(s, 32);
                if (fq == 0) ss[(size_t)r * 32 + u.pn * 4 + wc] = s;
            }
    }
};
struct EpiUp {
    static constexpr bool PERM = true; static __device__ __forceinline__ int perm(int rho) { return perm32(rho); }
    bf16_t* G; bf16_t* E; const float* cw; const float* cb;
    __device__ __forceinline__ void operator()(f32x4 (&acc)[2][2][4][2], const Unit& u, int wr, int wc, int fr, int fq) const {
        const int oc0 = u.pn * 128 + wc * 32 + 8 * fq;
        {
            const int e = (fr < 2) ? fr : fr - 12; const int msel = (fr < 2) ? 0 : 3;
            if (fr < 2 || fr >= 14) {
#pragma unroll
                for (int ai = 0; ai < 2; ++ai) {
                    const int seg = u.pm * 4 + ai * 2 + wr; bf16_t* eb = E + ((size_t)seg * 4 + e) * FF2 + oc0;
#pragma unroll
                    for (int bj = 0; bj < 2; ++bj)
#pragma unroll
                        for (int n = 0; n < 2; ++n) { const f32x4 v = (msel == 0) ? acc[ai][bj][0][n] : acc[ai][bj][3][n]; u32x2 w; w.x = cvt_pk_bf16(v[0], v[1]); w.y = cvt_pk_bf16(v[2], v[3]); *(u32x2*)(eb + bj * FF + 4 * n) = w; }
                }
            }
        }
        f32x4 pw0[2][2], pw1[2][2], pw2[2][2], pbb[2][2];
#pragma unroll
        for (int n = 0; n < 2; ++n)
#pragma unroll
            for (int bj = 0; bj < 2; ++bj) { const float* cwp = cw + bj * FF + oc0 + 4 * n;
                pw0[n][bj] = *(const f32x4*)(cwp); pw1[n][bj] = *(const f32x4*)(cwp + FF2); pw2[n][bj] = *(const f32x4*)(cwp + 2 * FF2); pbb[n][bj] = *(const f32x4*)(cb + bj * FF + oc0 + 4 * n); }
#pragma unroll
        for (int n = 0; n < 2; ++n) {
#pragma unroll
            for (int bj = 0; bj < 2; ++bj) {
                const f32x4 w0 = pw0[n][bj], w1 = pw1[n][bj], w2 = pw2[n][bj], bb = pbb[n][bj];
                f32x4 w1z, w0z;
#pragma unroll
                for (int j = 0; j < 4; ++j) { w1z[j] = (fr == 0) ? w1[j] : 0.f; w0z[j] = (fr < 2) ? w0[j] : 0.f; }
#pragma unroll
                for (int ai = 0; ai < 2; ++ai)
#pragma unroll
                    for (int m = 3; m >= 0; --m) {
                        const f32x4 v = acc[ai][bj][m][n];
                        f32x4 c = bb + w2 * v;
#pragma unroll
                        for (int j = 0; j < 4; ++j) {
                            FMAC_DPP(c[j], v[j], w1[j], "row_shr:1");
                            FMAC_DPP(c[j], v[j], w0[j], "row_shr:2");
                            if (m > 0) { FMAC_DPP(c[j], acc[ai][bj][m - 1][n][j], w1z[j], "row_ror:1"); FMAC_DPP(c[j], acc[ai][bj][m - 1][n][j], w0z[j], "row_ror:2"); }
                        }
                        acc[ai][bj][m][n] = c;
                    }
            }
        }
#pragma unroll
        for (int ai = 0; ai < 2; ++ai)
#pragma unroll
            for (int m = 0; m < 4; ++m) {
                const int r = u.pm * 256 + ai * 128 + wr * 64 + m * 16 + fr;
                f32x2 o[4];
#pragma unroll
                for (int n = 0; n < 2; ++n)
#pragma unroll
                    for (int h = 0; h < 2; ++h) o[2 * n + h] = gelu_gate_pk((f32x2){acc[ai][0][m][n][2 * h], acc[ai][0][m][n][2 * h + 1]}, (f32x2){acc[ai][1][m][n][2 * h], acc[ai][1][m][n][2 * h + 1]});
                u32x4 w; w.x = cvt_pk_bf16(o[0].x, o[0].y); w.y = cvt_pk_bf16(o[1].x, o[1].y); w.z = cvt_pk_bf16(o[2].x, o[2].y); w.w = cvt_pk_bf16(o[3].x, o[3].y);
                if (!(m == 0 && fr < 2)) *(u32x4*)(G + (size_t)r * FF + oc0) = w;
            }
    }
};
}

#ifndef PROBE_REPMASK
#define PROBE_REPMASK 0
#endif
struct Args { const float* in[30]; float* out; unsigned char* ws; int ph_lo, ph_hi, coop, repmask; };
constexpr int NPHASE = 16;
constexpr int LDS_BYTES = 155648;
constexpr int XL_OFF = 131072, XL_MISC = 131072 + 16384 + 2048 + 128;

__device__ __forceinline__ unsigned f2bf(float f) { unsigned u = __builtin_bit_cast(unsigned, f); return (u + 0x7fffu + ((u >> 16) & 1u)) >> 16; }
__device__ __forceinline__ unsigned pk2(float lo, float hi) { return f2bf(lo) | (f2bf(hi) << 16); }
__device__ __forceinline__ void transpose_item(const float* W, int K, int N, bf16_t* WT, int pair_half, LAS float* scr, int item, int lane) {
    const int nblk = N / 32, kb = item / nblk, nb = item % nblk, k0 = 64 * kb, n0 = 32 * nb;
#pragma unroll 8
    for (int i = 0; i < 32; ++i) { const int kk = 2 * i + (lane >> 5); scr[kk * 33 + (lane & 31)] = W[(size_t)(k0 + kk) * N + n0 + (lane & 31)]; }
    asm volatile("s_waitcnt lgkmcnt(0)" ::: "memory");
    int r0 = n0;
    if (pair_half > 0) { const int half = n0 / pair_half, c = n0 % pair_half; r0 = 256 * (c / 128) + 128 * half + (c % 128); }
    const int c = lane & 7;
#pragma unroll
    for (int j = 0; j < 4; ++j) { const int n = (lane >> 3) + 8 * j; const LAS float* s = scr + (8 * c) * 33 + n;
        u32x4 o; o.x = pk2(s[0 * 33], s[1 * 33]); o.y = pk2(s[2 * 33], s[3 * 33]); o.z = pk2(s[4 * 33], s[5 * 33]); o.w = pk2(s[6 * 33], s[7 * 33]);
        *(u32x4*)(WT + (size_t)(r0 + n) * K + k0 + 8 * c) = o; }
    asm volatile("s_waitcnt lgkmcnt(0)" ::: "memory");
}

template <bool HAS_M, bool HAS_NEXT, bool XIN_F32, bool XOUT_F32, bool M_F32 = false, bool M_GLU = false>
__device__ __forceinline__ void row_pass(const void* xin, void* xout, const bf16_t* mrow, const float* ssrow, int nslots, const float* gpost, const float* gnext, bf16_t* arow, int lane, const float* saccrow = nullptr, const float* mbias = nullptr) {
    f32x4 v[4];
#pragma unroll
    for (int j = 0; j < 4; ++j) {
        if constexpr (XIN_F32) v[j] = *((const f32x4*)xin + lane + 64 * j);
        else { const u32x2 xw = *((const u32x2*)xin + lane + 64 * j); v[j][0] = __uint_as_float(xw.x << 16); v[j][1] = __uint_as_float(xw.x & 0xffff0000u); v[j][2] = __uint_as_float(xw.y << 16); v[j][3] = __uint_as_float(xw.y & 0xffff0000u); }
    }
    if constexpr (HAS_M) {
        f32x4 mv[4]; float s;
        if constexpr (M_GLU) {
            s = 0.f;
#pragma unroll
            for (int j = 0; j < 4; ++j) { const int oc = 4 * (lane + 64 * j), base = 256 * (oc >> 7) + (oc & 127);
                f32x4 a = *(const f32x4*)(mbias + oc), g = *(const f32x4*)(mbias + DM + oc);
                for (int sl = 0; sl < nslots; ++sl) { a += *(const f32x4*)(saccrow + (size_t)sl * MS * 2 * DM + base); g += *(const f32x4*)(saccrow + (size_t)sl * MS * 2 * DM + base + 128); }
#pragma unroll
                for (int q = 0; q < 4; ++q) mv[j][q] = a[q] * sigmoid_f(g[q]);
                s += (mv[j][0] * mv[j][0] + mv[j][1] * mv[j][1]) + (mv[j][2] * mv[j][2] + mv[j][3] * mv[j][3]); }
        } else if constexpr (M_F32) {
            s = 0.f;
#pragma unroll
            for (int j = 0; j < 4; ++j) { mv[j] = mbias ? *((const f32x4*)mbias + lane + 64 * j) : (f32x4){0.f, 0.f, 0.f, 0.f};
                for (int sl = 0; sl < nslots; ++sl) mv[j] += *((const f32x4*)(saccrow + (size_t)sl * MS * DM) + lane + 64 * j);
                s += (mv[j][0] * mv[j][0] + mv[j][1] * mv[j][1]) + (mv[j][2] * mv[j][2] + mv[j][3] * mv[j][3]); }
        } else {
            s = (lane < nslots) ? ssrow[lane] : 0.f;
#pragma unroll
            for (int j = 0; j < 4; ++j) { const u32x2 mw = *((const u32x2*)mrow + lane + 64 * j);
                mv[j][0] = __uint_as_float(mw.x << 16); mv[j][1] = __uint_as_float(mw.x & 0xffff0000u); mv[j][2] = __uint_as_float(mw.y << 16); mv[j][3] = __uint_as_float(mw.y & 0xffff0000u); }
        }
        s = wave_sum(s);
        const float rstd = 1.0f / sqrtf(s * (1.0f / DM) + EPS);
#pragma unroll
        for (int j = 0; j < 4; ++j) {
            const f32x4 gp = *((const f32x4*)gpost + lane + 64 * j);
            v[j] += mv[j] * rstd * gp;
            if constexpr (XOUT_F32) *((f32x4*)xout + lane + 64 * j) = v[j];
            else { u32x2 w; w.x = cvt_pk_bf16(v[j][0], v[j][1]); w.y = cvt_pk_bf16(v[j][2], v[j][3]); *((u32x2*)xout + lane + 64 * j) = w; }
        }
    }
    if constexpr (HAS_NEXT) {
        float s2 = 0.f;
#pragma unroll
        for (int j = 0; j < 4; ++j) s2 += (v[j][0] * v[j][0] + v[j][1] * v[j][1]) + (v[j][2] * v[j][2] + v[j][3] * v[j][3]);
        s2 = wave_sum(s2);
        const float rstd2 = 1.0f / sqrtf(s2 * (1.0f / DM) + EPS);
#pragma unroll
        for (int j = 0; j < 4; ++j) { const f32x4 gn = *((const f32x4*)gnext + lane + 64 * j);
            u32x2 w; w.x = cvt_pk_bf16(v[j][0] * rstd2 * gn[0], v[j][1] * rstd2 * gn[1]); w.y = cvt_pk_bf16(v[j][2] * rstd2 * gn[2], v[j][3] * rstd2 * gn[3]);
            *((u32x2*)arow + lane + 64 * j) = w; }
    }
}

__device__ __forceinline__ s16x4 vtr(LAS const unsigned char* p) { return __builtin_bit_cast(s16x4, __builtin_amdgcn_ds_read_tr16_b64_v4i16((LAS s16x4*)p)); }
__device__ __forceinline__ void attn_unit_coords(int u, int& qrow0, int& krow0, int& kb0, int& kvh) {
    if (u < NB * 128) { const int b = u >> 7, rem = u & 127, c = rem >> 2; kvh = rem & 3; qrow0 = b * SEQ + c * 64; krow0 = qrow0 - 128; kb0 = c >= 2 ? 0 : 2 * (2 - c); }
    else { const int u2 = u - NB * 128, b = u2 >> 2; kvh = u2 & 3; qrow0 = MP + b * 64; krow0 = MP + b * 192; kb0 = 0; }
}
__device__ __forceinline__ void attn_phase(LAS unsigned char* lds, const bf16_t* Qb, const bf16_t* Kb, const bf16_t* Vb, bf16_t* Ob, const float* sinks, int G, int blk) {
    const int tid = threadIdx.x, lane = tid & 63, w = __builtin_amdgcn_readfirstlane(tid >> 6), r32 = lane & 31, hi = lane >> 5;
    constexpr int KST = 144, VST = 192, KOFF = 0, VOFF = 192 * KST, OOFF = VOFF + 192 * VST, OST = 136;
    constexpr int NUNITS = NB * 32 * 4 + DB * 4;
    LAS unsigned char* ostage = lds + OOFF + w * (32 * OST);
    u32x4 kreg[3], vreg[3]; bf16x8 qnext[4];
    int qrow0 = 0, krow0 = 0, kb0 = 0, kvh = 0;
#define ATTN_LOAD(UU) do { int q0_, k0_, b0_, h0_; attn_unit_coords((UU), q0_, k0_, b0_, h0_); \
        _Pragma("unroll") for (int i = 0; i < 3; ++i) { const int p_ = tid + 512 * i, row_ = p_ >> 3, ch_ = p_ & 7; \
            if (row_ >= b0_ * 32) { const size_t go_ = (size_t)(k0_ + row_) * 256 + h0_ * 64 + ch_ * 8; kreg[i] = *(const u32x4*)(Kb + go_); vreg[i] = *(const u32x4*)(Vb + go_); } } \
        { const size_t qr_ = (size_t)q0_ + (w & 1) * 32 + r32; const int hq_ = h0_ * 4 + (w >> 1); \
          _Pragma("unroll") for (int dk = 0; dk < 4; ++dk) qnext[dk] = *(const bf16x8*)(Qb + qr_ * DM + hq_ * 64 + dk * 16 + hi * 8); } } while (0)
    if (blk < NUNITS) ATTN_LOAD(blk);
    for (int u = blk; u < NUNITS; u += G) {
        attn_unit_coords(u, qrow0, krow0, kb0, kvh);
        __syncthreads();
#pragma unroll
        for (int i = 0; i < 3; ++i) { const int p = tid + 512 * i, row = p >> 3, ch = p & 7;
            if (row >= kb0 * 32) { *(LAS u32x4*)(lds + KOFF + row * KST + ch * 16) = kreg[i]; *(LAS u32x4*)(lds + VOFF + row * VST + ch * 16) = vreg[i]; } }
        bf16x8 qf[4];
#pragma unroll
        for (int dk = 0; dk < 4; ++dk) qf[dk] = qnext[dk];
        const int hq = kvh * 4 + (w >> 1); const size_t qrowb = (size_t)qrow0 + (w & 1) * 32;
        __syncthreads();
        if (u + G < NUNITS) ATTN_LOAD(u + G);
        f32x16 sc[6];
        float mx = -3.0e38f;
#pragma unroll
        for (int kb = 0; kb < 6; ++kb) {
            if (kb >= kb0) {
                f32x16 a = {};
#pragma unroll
                for (int dk = 0; dk < 4; ++dk) { const bf16x8 kf = *(const LAS bf16x8*)(lds + KOFF + (32 * kb + r32) * KST + (dk * 16 + hi * 8) * 2); a = __builtin_amdgcn_mfma_f32_32x32x16_bf16(kf, qf[dk], a, 0, 0, 0); }
#pragma unroll
                for (int r = 0; r < 16; ++r) mx = fmaxf(mx, a[r]);
                sc[kb] = a;
            }
        }
        mx = fmaxf(mx, __shfl_xor(mx, 32));
        const float sinkl = sinks[hq] * LOG2E; mx = fmaxf(mx, sinkl);
        float ls = 0.f;
#pragma unroll
        for (int kb = 0; kb < 6; ++kb) {
            if (kb >= kb0) {
#pragma unroll
                for (int r = 0; r < 16; ++r) { const float p = __builtin_amdgcn_exp2f(sc[kb][r] - mx); sc[kb][r] = p; ls += p; }
            }
        }
        ls += __shfl_xor(ls, 32);
        const float inv = 1.0f / (ls + __builtin_amdgcn_exp2f(sinkl - mx));
        f32x16 o[2]; o[0] = f32x16{}; o[1] = f32x16{};
        const int vlane = VOFF + (4 * hi + ((lane >> 2) & 3)) * VST + (16 * ((lane >> 4) & 1) + 4 * (lane & 3)) * 2;
#pragma unroll
        for (int kb = 0; kb < 6; ++kb) {
            if (kb >= kb0) {
#pragma unroll
                for (int s = 0; s < 2; ++s) {
                    u32x4 pw; pw.x = cvt_pk_bf16(sc[kb][8 * s + 0], sc[kb][8 * s + 1]); pw.y = cvt_pk_bf16(sc[kb][8 * s + 2], sc[kb][8 * s + 3]); pw.z = cvt_pk_bf16(sc[kb][8 * s + 4], sc[kb][8 * s + 5]); pw.w = cvt_pk_bf16(sc[kb][8 * s + 6], sc[kb][8 * s + 7]);
                    const bf16x8 pf = __builtin_bit_cast(bf16x8, pw);
#pragma unroll
                    for (int db = 0; db < 2; ++db) {
                        LAS const unsigned char* vp = lds + vlane + (32 * kb + 16 * s) * VST + db * 64;
                        const s16x4 lo = vtr(vp), h4 = vtr(vp + 8 * VST);
                        const bf16x8 vf = (bf16x8){lo[0], lo[1], lo[2], lo[3], h4[0], h4[1], h4[2], h4[3]};
                        o[db] = __builtin_amdgcn_mfma_f32_32x32x16_bf16(vf, pf, o[db], 0, 0, 0);
                    }
                }
            }
        }
#pragma unroll
        for (int db = 0; db < 2; ++db)
#pragma unroll
            for (int rq = 0; rq < 4; ++rq) {
                u32x2 wv; wv.x = cvt_pk_bf16(o[db][4 * rq] * inv, o[db][4 * rq + 1] * inv); wv.y = cvt_pk_bf16(o[db][4 * rq + 2] * inv, o[db][4 * rq + 3] * inv);
                *(LAS u32x2*)(ostage + r32 * OST + (32 * db + 8 * rq + 4 * hi) * 2) = wv;
            }
        asm volatile("s_waitcnt lgkmcnt(0)" ::: "memory");
#pragma unroll
        for (int i = 0; i < 4; ++i) { const int row = i * 8 + (lane >> 3), ch = lane & 7;
            const u32x2 a = *(const LAS u32x2*)(ostage + row * OST + ch * 16), b = *(const LAS u32x2*)(ostage + row * OST + ch * 16 + 8);
            u32x4 v; v.x = a.x; v.y = a.y; v.z = b.x; v.w = b.y;
            *(u32x4*)(Ob + (qrowb + row) * DM + hq * 64 + ch * 8) = v; }
        asm volatile("s_waitcnt lgkmcnt(0)" ::: "memory");
    }
#undef ATTN_LOAD
}

struct SsmP { const float *lam_re, *lam_im, *log_dt, *b_re, *b_im, *c_re, *c_im, *dsk, *st_re, *st_im; float *o_rep, *o_imp, *o_res, *o_ims; };
__device__ __forceinline__ void ssm_phase(LAS unsigned char* lds, const bf16_t* A3, bf16_t* Z, const SsmP P, int G, int blk) {
    const int tid = threadIdx.x, lane = tid & 63, w = __builtin_amdgcn_readfirstlane(tid >> 6), p = lane & 31, hi = lane >> 5;
    const int q = w >> 1, role = w & 1;
    constexpr int IST = 72, IMG = 128 * IST;
    LAS unsigned char* img0 = lds + q * (2 * IMG);
    for (int pass = 0; pass < 2; ++pass) {
        const bool samp = (pass == 0);
        const int nunits = samp ? (DB / 2) * 64 : (NB / 2) * 64, T = samp ? DS : SEQ;
        for (int uu = blk * 4 + q; uu < nunits; uu += G * 4) {
            const int bp = uu >> 6, g = uu & 63;
            const int rowbase0 = samp ? MP + (2 * bp) * DS : (2 * bp) * SEQ, bstride = T;
            const float dt = expf(P.log_dt[g]);
            const int ps = g * 64 + p + 32 * role; const float lr = P.lam_re[ps], li = P.lam_im[ps];
            const float mag = expf(lr * dt); const float lbr = mag * cosf(li * dt), lbi = mag * sinf(li * dt);
            const float nr0 = lbr - 1.0f, ni0 = lbi, den = lr * lr + li * li;
            const float zr = (nr0 * lr + ni0 * li) / den, zi = (ni0 * lr - nr0 * li) / den;
            float hr = 0.f, hm = 0.f;
            const int so = ((2 * bp + hi) * 64 + g) * 64 + p + 32 * role;
            if (samp) { hr = P.st_re[so]; hm = P.st_im[so]; }
            bf16x8 bfre, bfim;
            {
                const float* br = P.b_re + ((size_t)ps) * 16 + 8 * hi; const float* bi = P.b_im + ((size_t)ps) * 16 + 8 * hi;
                const f32x4 br0 = *(const f32x4*)br, br1 = *(const f32x4*)(br + 4), bi0 = *(const f32x4*)bi, bi1 = *(const f32x4*)(bi + 4);
                u32x4 wre, wim;
                wre.x = cvt_pk_bf16(zr * br0[0] - zi * bi0[0], zr * br0[1] - zi * bi0[1]); wre.y = cvt_pk_bf16(zr * br0[2] - zi * bi0[2], zr * br0[3] - zi * bi0[3]);
                wre.z = cvt_pk_bf16(zr * br1[0] - zi * bi1[0], zr * br1[1] - zi * bi1[1]); wre.w = cvt_pk_bf16(zr * br1[2] - zi * bi1[2], zr * br1[3] - zi * bi1[3]);
                wim.x = cvt_pk_bf16(zr * bi0[0] + zi * br0[0], zr * bi0[1] + zi * br0[1]); wim.y = cvt_pk_bf16(zr * bi0[2] + zi * br0[2], zr * bi0[3] + zi * br0[3]);
                wim.z = cvt_pk_bf16(zr * bi1[0] + zi * br1[0], zr * bi1[1] + zi * br1[1]); wim.w = cvt_pk_bf16(zr * bi1[2] + zi * br1[2], zr * bi1[3] + zi * br1[3]);
                bfre = __builtin_bit_cast(bf16x8, wre); bfim = __builtin_bit_cast(bf16x8, wim);
            }
            const int ci = lane & 15, kg = lane >> 4;
            bf16x8 cfrag[4];
#pragma unroll
            for (int kb = 0; kb < 4; ++kb) {
                const float* cp = ((kb < 2) ? P.c_re : P.c_im) + ((size_t)(g * 16 + ci)) * 64 + 32 * (kb & 1) + 8 * kg; const float sg = (kb < 2) ? 1.f : -1.f;
                const f32x4 c0 = *(const f32x4*)cp, c1 = *(const f32x4*)(cp + 4);
                u32x4 wc_; wc_.x = cvt_pk_bf16(sg * c0[0], sg * c0[1]); wc_.y = cvt_pk_bf16(sg * c0[2], sg * c0[3]); wc_.z = cvt_pk_bf16(sg * c1[0], sg * c1[1]); wc_.w = cvt_pk_bf16(sg * c1[2], sg * c1[3]);
                cfrag[kb] = __builtin_bit_cast(bf16x8, wc_);
            }
            const f32x4 dsk4 = *(const f32x4*)(P.dsk + g * 16 + 4 * kg);
            const int hip = (p >> 2) & 1, jp = (p & 3) + 4 * (p >> 3);
            const bf16_t* uptr = A3 + ((size_t)(rowbase0 + hip * bstride + jp)) * DM + g * 16 + 8 * hi;
            const size_t yoff = ((size_t)(rowbase0 + role * bstride + ci)) * DM + g * 16 + 4 * kg;
            const int nblk = T / 16;
            bf16x8 ufA = *(const bf16x8*)uptr, ufB = *(const bf16x8*)(uptr + (size_t)16 * DM), ufC = *(const bf16x8*)(uptr + (size_t)32 * DM);
            u32x2 unA = *(const u32x2*)(A3 + yoff), unB = *(const u32x2*)(A3 + yoff + (size_t)16 * DM), unC = *(const u32x2*)(A3 + yoff + (size_t)32 * DM);
            for (int tb = 0; tb < nblk; ++tb) {
                LAS unsigned char* img = img0 + (tb & 1) * IMG;
                const bf16x8 ucur = ufA; const u32x2 uw = unA;
                ufA = ufB; unA = unB; ufB = ufC; unB = unC;
                if (tb + 3 < nblk) { ufC = *(const bf16x8*)(uptr + (size_t)(tb + 3) * 16 * DM); unC = *(const u32x2*)(A3 + yoff + (size_t)(tb + 3) * 16 * DM); }
                f32x16 Xr, Xi;
                { f32x16 z = {}; Xr = __builtin_amdgcn_mfma_f32_32x32x16_bf16(ucur, bfre, z, 0, 0, 0); Xi = __builtin_amdgcn_mfma_f32_32x32x16_bf16(ucur, bfim, z, 0, 0, 0); }
#pragma unroll
                for (int r = 0; r < 16; ++r) {
                    const float nr = lbr * hr - lbi * hm + Xr[r];
                    const float ni = lbr * hm + lbi * hr + Xi[r];
                    hr = nr; hm = ni; Xr[r] = nr; Xi[r] = ni;
                }
#pragma unroll
                for (int q4 = 0; q4 < 4; ++q4) {
                    u32x2 wr_, wi_; wr_.x = cvt_pk_bf16(Xr[4 * q4], Xr[4 * q4 + 1]); wr_.y = cvt_pk_bf16(Xr[4 * q4 + 2], Xr[4 * q4 + 3]); wi_.x = cvt_pk_bf16(Xi[4 * q4], Xi[4 * q4 + 1]); wi_.y = cvt_pk_bf16(Xi[4 * q4 + 2], Xi[4 * q4 + 3]);
                    *(LAS u32x2*)(img + (role * 32 + p) * IST + (16 * hi + 4 * q4) * 2) = wr_;
                    *(LAS u32x2*)(img + ((2 + role) * 32 + p) * IST + (16 * hi + 4 * q4) * 2) = wi_;
                }
                asm volatile("s_waitcnt lgkmcnt(0)\n\ts_barrier" ::: "memory");
                f32x4 y = {0.f, 0.f, 0.f, 0.f};
#pragma unroll
                for (int kb = 0; kb < 4; ++kb) {
                    LAS const unsigned char* ap = img + (32 * kb + 8 * kg + (ci >> 2)) * IST + (16 * role + 4 * (ci & 3)) * 2;
                    const s16x4 lo = vtr(ap), h4 = vtr(ap + 4 * IST);
                    const bf16x8 af = (bf16x8){lo[0], lo[1], lo[2], lo[3], h4[0], h4[1], h4[2], h4[3]};
                    y = __builtin_amdgcn_mfma_f32_16x16x32_bf16(cfrag[kb], af, y, 0, 0, 0);
                }
                const float z0 = gelu_tanh(y[0] + dsk4[0] * __uint_as_float(uw.x << 16)), z1 = gelu_tanh(y[1] + dsk4[1] * __uint_as_float(uw.x & 0xffff0000u));
                const float z2 = gelu_tanh(y[2] + dsk4[2] * __uint_as_float(uw.y << 16)), z3 = gelu_tanh(y[3] + dsk4[3] * __uint_as_float(uw.y & 0xffff0000u));
                u32x2 zw; zw.x = cvt_pk_bf16(z0, z1); zw.y = cvt_pk_bf16(z2, z3);
                *(u32x2*)(Z + yoff + (size_t)tb * 16 * DM) = zw;
                asm volatile("s_waitcnt lgkmcnt(0)" ::: "memory");
            }
            if (samp) { P.o_res[so] = hr; P.o_ims[so] = hm; } else { P.o_rep[so] = hr; P.o_imp[so] = hm; }
        }
        __syncthreads();
    }
}

#define XB_TMO      128
#define XB_XCNT(j)  (256  + 64 * (j))
#define XB_XSUB(j)  (1280 + 64 * (j))
#define XB_XGEN(j)  (2304 + 64 * (j))
#define XB_TOP      3328
#define XB_TOPGEN   3392
#define XCD_BAR_WORDS 3456
#define XB_SPIN_CAP (1u << 18)
__device__ __forceinline__ unsigned xb_ld(unsigned* p)              { return __hip_atomic_load(p, __ATOMIC_RELAXED, __HIP_MEMORY_SCOPE_AGENT); }
__device__ __forceinline__ unsigned xb_add(unsigned* p, unsigned v) { return __hip_atomic_fetch_add(p, v, __ATOMIC_RELAXED, __HIP_MEMORY_SCOPE_AGENT); }
__device__ __forceinline__ unsigned xb_xcc_id() { return (unsigned)__builtin_amdgcn_s_getreg((3 << 11) | 20) & 0xFu; }
#define XB_SPIN(cond, bar) do { unsigned _sp = 0; while (cond) { __builtin_amdgcn_s_sleep(1); \
    if ((++_sp & 255u) == 0u) { if (xb_ld(&(bar)[XB_TMO])) break; if (_sp > XB_SPIN_CAP) { atomicAdd(&(bar)[XB_TMO], 1u); break; } } } } while (0)
struct XcdBarrier { unsigned* bar; unsigned x; volatile LAS unsigned* st; };
__device__ __forceinline__ XcdBarrier xcd_barrier_post(unsigned* bar, volatile LAS unsigned* st) {
    XcdBarrier b; b.bar = bar; b.x = xb_xcc_id(); b.st = st;
    if (threadIdx.x == 0) (void)xb_add(&bar[XB_XCNT(b.x)], 1u);
    return b;
}
__device__ __forceinline__ void xcd_barrier_complete(unsigned* bar, unsigned x, unsigned& nloc, unsigned& nx) {
    const unsigned G = gridDim.x * gridDim.y * gridDim.z;
    unsigned sum, cnt, mine, sp = 0u;
    for (;;) {
        sum = 0u; cnt = 0u; mine = 0u;
#pragma unroll
        for (unsigned j = 0; j < 16; ++j) { const unsigned c = xb_ld(&bar[XB_XCNT(j)]); sum += c; cnt += (c > 0u) ? 1u : 0u; mine = (j == x) ? c : mine; }
        if (sum == G) break;
        __builtin_amdgcn_s_sleep(1);
        if ((++sp & 255u) == 0u) { if (xb_ld(&bar[XB_TMO])) break; if (sp > XB_SPIN_CAP) { atomicAdd(&bar[XB_TMO], 1u); break; } }
    }
    nloc = mine > 0u ? mine : 1u; nx = cnt > 0u ? cnt : 1u;
}
__device__ __forceinline__ void xcd_barrier(const XcdBarrier& b) {
    asm volatile("s_waitcnt vmcnt(0)" ::: "memory");
    __syncthreads();
    if (threadIdx.x == 0) {
        unsigned* bar = b.bar;
        __builtin_amdgcn_s_waitcnt(0);
        unsigned nloc = b.st[0], nx = b.st[1];
        if (nloc == 0u) { xcd_barrier_complete(bar, b.x, nloc, nx); b.st[0] = nloc; b.st[1] = nx; }
        const unsigned old = xb_add(&bar[XB_XSUB(b.x)], 1u);
        const unsigned gen = old / nloc;
        if (old + 1u == (gen + 1u) * nloc) {
            __builtin_amdgcn_fence(__ATOMIC_RELEASE, "agent");
            asm volatile("s_waitcnt vmcnt(0)" ::: "memory");
            const unsigned og = xb_add(&bar[XB_TOP], 1u);
            const unsigned tg = og / nx;
            if (og + 1u == (tg + 1u) * nx) xb_add(&bar[XB_TOPGEN], 1u);
            else XB_SPIN(xb_ld(&bar[XB_TOPGEN]) == tg, bar);
            __builtin_amdgcn_fence(__ATOMIC_ACQUIRE, "agent");
            xb_add(&bar[XB_XGEN(b.x)], 1u);
            asm volatile("s_waitcnt vmcnt(0)" ::: "memory");
        } else {
            XB_SPIN(xb_ld(&bar[XB_XGEN(b.x)]) == gen, bar);
            __builtin_amdgcn_fence(__ATOMIC_ACQUIRE, "agent");
            asm volatile("s_waitcnt vmcnt(0)" ::: "memory");
        }
    }
    __syncthreads();
}

#ifndef UP_WGM
#define UP_WGM 4
#endif
__device__ __forceinline__ void phase_prologue(LAS unsigned char* lds, const Args& args, unsigned char* ws, float* out, int G, int blk, int wave, int lane, int tid) {
    const int gw = blk * 8 + wave, NGW = G * 8;
    bf16_t* Wqkv = (bf16_t*)(ws + WS_WQKV); bf16_t* Wo = (bf16_t*)(ws + WS_WO); bf16_t* Wglu = (bf16_t*)(ws + WS_WGLU); bf16_t* Wup = (bf16_t*)(ws + WS_WUP); bf16_t* Wdn = (bf16_t*)(ws + WS_WDN);
    float* rope = (float*)(ws + WS_ROPE); bf16_t* Abuf = (bf16_t*)(ws + WS_A); bf16_t* Kbuf = (bf16_t*)(ws + WS_K); bf16_t* Vbuf = (bf16_t*)(ws + WS_V);
    LAS float* scr = (LAS float*)(lds + wave * 16384);
    constexpr int I_QKV = 16 * 48, I_O = 16 * 32, I_GLU = 16 * 64, I_UP = 16 * 176, I_DN = 44 * 32;
    constexpr int NITEMS = I_QKV + I_O + I_GLU + 2 * I_UP + 2 * I_DN;
    for (int it = gw; it < NITEMS; it += NGW) {
        int r = it;
        if (r < I_QKV) { transpose_item(args.in[11], DM, QKVD, Wqkv, 0, scr, r, lane); continue; } r -= I_QKV;
        if (r < I_O) { transpose_item(args.in[14], DM, DM, Wo, 0, scr, r, lane); continue; } r -= I_O;
        if (r < I_GLU) { transpose_item(args.in[24], DM, 2 * DM, Wglu, DM, scr, r, lane); continue; } r -= I_GLU;
        if (r < 2 * I_UP) { const int l = r / I_UP; transpose_item(args.in[26] + (size_t)l * DM * FF2, DM, FF2, Wup + (size_t)l * FF2 * DM, FF, scr, r % I_UP, lane); continue; } r -= 2 * I_UP;
        { const int l = r / I_DN; transpose_item(args.in[29] + (size_t)l * FF * DM, FF, DM, Wdn + (size_t)l * DM * FF, 0, scr, r % I_DN, lane); }
    }
    for (int i = blk * 512 + tid; i < SEQ * 8; i += G * 512) { const int pos = i >> 3, f = i & 7; const float inv_freq = powf(500000.0f, -(float)f * 0.125f); const float ang = (float)pos * inv_freq;
        rope[pos * 16 + f] = cosf(ang); rope[pos * 16 + 8 + f] = sinf(ang); }
    for (int i = blk * 512 + tid; i < DB * 128 * 64; i += G * 512) {
        const int b = i / (128 * 64), rem = i % (128 * 64), row = rem >> 6, c4 = (rem & 63) * 4;
        const f32x4 kv = *(const f32x4*)(args.in[2] + ((size_t)(b * 128 + row)) * 256 + c4), vv = *(const f32x4*)(args.in[3] + ((size_t)(b * 128 + row)) * 256 + c4);
        u32x2 kw, vw; kw.x = cvt_pk_bf16(kv[0], kv[1]); kw.y = cvt_pk_bf16(kv[2], kv[3]); vw.x = cvt_pk_bf16(vv[0], vv[1]); vw.y = cvt_pk_bf16(vv[2], vv[3]);
        const size_t krow = (size_t)MP + b * 192 + row;
        *(u32x2*)(Kbuf + krow * 256 + c4) = kw; *(u32x2*)(Vbuf + krow * 256 + c4) = vw;
        if (row >= 64) { *(f32x4*)(out + O_KS + ((size_t)(b * 128 + row - 64)) * 256 + c4) = kv; *(f32x4*)(out + O_VS + ((size_t)(b * 128 + row - 64)) * 256 + c4) = vv; }
    }
    {
        f32x4 gn[4], xa[4], xb_[4];
#define P0_C(j) (8 * lane + 512 * ((j) >> 1) + 4 * ((j) & 1))
#pragma unroll
        for (int j = 0; j < 4; ++j) gn[j] = *(const f32x4*)(args.in[7] + P0_C(j));
#define P0_X(mm) (((mm) < MP) ? args.in[0] + (size_t)(mm) * DM : args.in[1] + (size_t)((mm) - MP) * DM)
        int m = gw;
        if (m < MT) {
#pragma unroll
            for (int j = 0; j < 4; ++j) xa[j] = *(const f32x4*)(P0_X(m) + P0_C(j));
        }
        for (; m < MT; m += NGW) {
            const int mn = m + NGW;
            if (mn < MT) {
#pragma unroll
                for (int j = 0; j < 4; ++j) xb_[j] = *(const f32x4*)(P0_X(mn) + P0_C(j));
            }
            float s2 = 0.f;
#pragma unroll
            for (int j = 0; j < 4; ++j) s2 += (xa[j][0] * xa[j][0] + xa[j][1] * xa[j][1]) + (xa[j][2] * xa[j][2] + xa[j][3] * xa[j][3]);
            const float rstd2 = 1.0f / sqrtf(wave_sum(s2) * (1.0f / DM) + EPS);
#pragma unroll
            for (int j = 0; j < 2; ++j) *(u32x4*)(Abuf + (size_t)m * DM + 8 * lane + 512 * j) = pack8(xa[2 * j] * gn[2 * j] * rstd2, xa[2 * j + 1] * gn[2 * j + 1] * rstd2);
#pragma unroll
            for (int j = 0; j < 4; ++j) xa[j] = xb_[j];
        }
#undef P0_C
#undef P0_X
    }
}

template <bool XIN_F32>
__device__ __forceinline__ void rp_load(const void* xrow, const bf16_t* mrow, const float* ssrow, int nslots, int lane, f32x4 (&xf)[4], u32x4 (&xb)[2], u32x4 (&mw)[2], float& ssv) {
#pragma unroll
    for (int j = 0; j < 2; ++j) { const int c0 = 8 * lane + 512 * j;
        if constexpr (XIN_F32) { xf[2 * j] = __builtin_nontemporal_load((const f32x4*)((const float*)xrow + c0)); xf[2 * j + 1] = __builtin_nontemporal_load((const f32x4*)((const float*)xrow + c0 + 4)); }
        else xb[j] = *(const u32x4*)((const bf16_t*)xrow + c0);
        mw[j] = __builtin_nontemporal_load((const u32x4*)(mrow + c0));
    }
    ssv = (lane < nslots) ? ssrow[lane] : 0.f;
}
template <int MODE>
__device__ __forceinline__ void rp_finish(const f32x4 (&xf)[4], const u32x4 (&xb)[2], const u32x4 (&mw)[2], float ssv, const f32x4 (&gp)[4], const f32x4 (&gn)[4], void* xout, bf16_t* arow, int lane) {
    f32x4 v[4];
    const float rstd = 1.0f / sqrtf(wave_sum(ssv) * (1.0f / DM) + EPS);
    float s2 = 0.f;
#pragma unroll
    for (int j = 0; j < 2; ++j) { const int c0 = 8 * lane + 512 * j;
        if constexpr (MODE == 0) { v[2 * j] = xf[2 * j]; v[2 * j + 1] = xf[2 * j + 1]; } else unpack8(xb[j], v[2 * j], v[2 * j + 1]);
        f32x4 m0, m1; unpack8(mw[j], m0, m1);
        v[2 * j] += m0 * rstd * gp[2 * j]; v[2 * j + 1] += m1 * rstd * gp[2 * j + 1];
        if constexpr (MODE == 2) { *(f32x4*)((float*)xout + c0) = v[2 * j]; *(f32x4*)((float*)xout + c0 + 4) = v[2 * j + 1]; }
        else *(u32x4*)((bf16_t*)xout + c0) = pack8(v[2 * j], v[2 * j + 1]);
#pragma unroll
        for (int h = 0; h < 2; ++h) s2 += (v[2 * j + h][0] * v[2 * j + h][0] + v[2 * j + h][1] * v[2 * j + h][1]) + (v[2 * j + h][2] * v[2 * j + h][2] + v[2 * j + h][3] * v[2 * j + h][3]);
    }
    if constexpr (MODE != 2) {
        const float rstd2 = 1.0f / sqrtf(wave_sum(s2) * (1.0f / DM) + EPS);
#pragma unroll
        for (int j = 0; j < 2; ++j) *(u32x4*)(arow + 8 * lane + 512 * j) = pack8(v[2 * j] * gn[2 * j] * rstd2, v[2 * j + 1] * gn[2 * j + 1] * rstd2);
    }
}
template <int MODE>
__device__ __forceinline__ void phase_rows(const float* x_prompt, const float* x_sample, bf16_t* X16, float* out, const bf16_t* Mbuf, const float* ss, int nslots, const float* gpost, const float* gnext, bf16_t* Abuf, int gw, int NGW, int lane, const float* sacc, const float* mbias, int ns, bool skip_prompt, bool glu = false) {
    int m = gw;
    if (skip_prompt) m = gw + ((MP - gw + NGW - 1) / NGW) * NGW;
    else {
        f32x4 gp[4], gn[4];
#pragma unroll
        for (int j = 0; j < 4; ++j) { const int cg_ = 8 * lane + 512 * (j >> 1) + 4 * (j & 1); gp[j] = *(const f32x4*)(gpost + cg_); gn[j] = (MODE != 2) ? *(const f32x4*)(gnext + cg_) : (f32x4){0.f, 0.f, 0.f, 0.f}; }
        f32x4 xfA[4], xfB[4]; u32x4 xbA[2], xbB[2], mwA[2], mwB[2]; float ssA = 0.f, ssB = 0.f;
#define RP_X(mm) ((MODE == 0) ? (const void*)(x_prompt + (size_t)(mm) * DM) : (const void*)(X16 + (size_t)(mm) * DM))
        if (m < MP) rp_load<MODE == 0>(RP_X(m), Mbuf + (size_t)m * DM, ss + (size_t)m * 32, nslots, lane, xfA, xbA, mwA, ssA);
        for (; m < MP; m += NGW) {
            const int mn = m + NGW;
            if (mn < MP) rp_load<MODE == 0>(RP_X(mn), Mbuf + (size_t)mn * DM, ss + (size_t)mn * 32, nslots, lane, xfB, xbB, mwB, ssB);
            rp_finish<MODE>(xfA, xbA, mwA, ssA, gp, gn, (MODE == 2) ? (void*)(out + (size_t)m * DM) : (void*)(X16 + (size_t)m * DM), Abuf + (size_t)m * DM, lane);
#pragma unroll
            for (int j = 0; j < 4; ++j) xfA[j] = xfB[j];
#pragma unroll
            for (int j = 0; j < 2; ++j) { xbA[j] = xbB[j]; mwA[j] = mwB[j]; }
            ssA = ssB;
        }
#undef RP_X
    }
    for (; m < MT; m += NGW) {
        const bool sp = (sacc != nullptr) && (m >= MP); const float* sr = sp ? sacc + (size_t)(m - MP) * DM : nullptr;
        if constexpr (MODE == 0) { const float* xr = (m < MP) ? x_prompt + (size_t)m * DM : x_sample + (size_t)(m - MP) * DM;
            if (sp) row_pass<true, true, true, false, true>(xr, X16 + (size_t)m * DM, nullptr, nullptr, ns, gpost, gnext, Abuf + (size_t)m * DM, lane, sr, mbias);
            else row_pass<true, true, true, false>(xr, X16 + (size_t)m * DM, Mbuf + (size_t)m * DM, ss + (size_t)m * 32, nslots, gpost, gnext, Abuf + (size_t)m * DM, lane); }
        else if constexpr (MODE == 1) {
            if (sp && glu) row_pass<true, true, false, false, false, true>(X16 + (size_t)m * DM, X16 + (size_t)m * DM, nullptr, nullptr, ns, gpost, gnext, Abuf + (size_t)m * DM, lane, sacc + (size_t)(m - MP) * 2 * DM, mbias);
            else if (sp) row_pass<true, true, false, false, true>(X16 + (size_t)m * DM, X16 + (size_t)m * DM, nullptr, nullptr, ns, gpost, gnext, Abuf + (size_t)m * DM, lane, sr, mbias);
            else row_pass<true, true, false, false>(X16 + (size_t)m * DM, X16 + (size_t)m * DM, Mbuf + (size_t)m * DM, ss + (size_t)m * 32, nslots, gpost, gnext, Abuf + (size_t)m * DM, lane); }
        else {
            if (sp) row_pass<true, false, false, true, true>(X16 + (size_t)m * DM, out + (size_t)m * DM, nullptr, nullptr, ns, gpost, nullptr, nullptr, lane, sr, mbias);
            else row_pass<true, false, false, true>(X16 + (size_t)m * DM, out + (size_t)m * DM, Mbuf + (size_t)m * DM, ss + (size_t)m * 32, nslots, gpost, nullptr, nullptr, lane); }
    }
}
__device__ __forceinline__ void phase_up(LAS unsigned char* lds, const bf16_t* Abuf, const bf16_t* Wup_l, bf16_t* Gbuf, bf16_t* Ebuf, const float* cw, const float* cb, int G, int blk) {
    pg8::Gemm g{Abuf, Wup_l, MT, FF2, DM}; pg8::StaticOrder S; S.init(MT, FF2, DM, G, blk); S.wgm = UP_WGM;
    pg8::EpiUp E{Gbuf, Ebuf, cw, cb};
    pg8::gemm_phase<pg8::EpiUp, true, true>(lds, g, S, E);
}
__device__ __forceinline__ void phase_down(LAS unsigned char* lds, const bf16_t* Gbuf, const bf16_t* Wdn_l, bf16_t* Mbuf, float* ss, float* sacc, int G, int blk) {
    pg8::Gemm g{Gbuf, Wdn_l, MT, DM, FF}; pg8::StaticOrder S; S.init(MT, DM, FF, G, blk, MP / 256, 11);
    pg8::EpiPlainSS E{Mbuf, nullptr, ss, sacc, FF / 64};
    pg8::gemm_phase<pg8::EpiPlainSS, true, true>(lds, g, S, E);
}
__device__ __forceinline__ f32x4 ld_bf4(const bf16_t* p) { const u32x2 w = *(const u32x2*)p; return (f32x4){__uint_as_float(w.x << 16), __uint_as_float(w.x & 0xffff0000u), __uint_as_float(w.y << 16), __uint_as_float(w.y & 0xffff0000u)}; }
__device__ __forceinline__ void phase_fix(const bf16_t* Ebuf, bf16_t* Gbuf, const float* cw, const float* cb, const float* cc, float* out, int l, int G, int blk, int tid) {
    for (int i = blk * 512 + tid; i < NSEG * (FF / 4); i += G * 512) {
        const int seg = i / (FF / 4), c4 = (i % (FF / 4)) * 4;
        f32x4 c0r[2], c1r[2];
#pragma unroll
        for (int hf = 0; hf < 2; ++hf) {
            const int col = hf * FF + c4;
            const f32x4 cur0 = ld_bf4(Ebuf + ((size_t)seg * 4 + 0) * FF2 + col), cur1 = ld_bf4(Ebuf + ((size_t)seg * 4 + 1) * FF2 + col);
            f32x4 p0 = {0.f, 0.f, 0.f, 0.f}, p1 = {0.f, 0.f, 0.f, 0.f};
            if (seg >= MP / 64) { const int b = seg - MP / 64; p0 = *(const f32x4*)(cc + ((size_t)b * 2 + 0) * FF2 + col); p1 = *(const f32x4*)(cc + ((size_t)b * 2 + 1) * FF2 + col); }
            else if ((seg & 31) != 0) { p0 = ld_bf4(Ebuf + ((size_t)(seg - 1) * 4 + 2) * FF2 + col); p1 = ld_bf4(Ebuf + ((size_t)(seg - 1) * 4 + 3) * FF2 + col); }
            const f32x4 w0 = *(const f32x4*)(cw + col), w1 = *(const f32x4*)(cw + FF2 + col), w2 = *(const f32x4*)(cw + 2 * FF2 + col), bb = *(const f32x4*)(cb + col);
            c0r[hf] = bb + w0 * p0 + w1 * p1 + w2 * cur0;
            c1r[hf] = bb + w0 * p1 + w1 * cur0 + w2 * cur1;
        }
        f32x4 o0, o1;
#pragma unroll
        for (int q = 0; q < 4; ++q) { o0[q] = gelu_tanh(c0r[0][q]) * c0r[1][q]; o1[q] = gelu_tanh(c1r[0][q]) * c1r[1][q]; }
        u32x2 wv; wv.x = cvt_pk_bf16(o0[0], o0[1]); wv.y = cvt_pk_bf16(o0[2], o0[3]);
        *(u32x2*)(Gbuf + ((size_t)seg * 64 + 0) * FF + c4) = wv;
        wv.x = cvt_pk_bf16(o1[0], o1[1]); wv.y = cvt_pk_bf16(o1[2], o1[3]);
        *(u32x2*)(Gbuf + ((size_t)seg * 64 + 1) * FF + c4) = wv;
    }
    for (int i = blk * 512 + tid; i < (NB + DB) * 2 * (FF2 / 4); i += G * 512) {
        const int ri = i / (FF2 / 4), c4 = (i % (FF2 / 4)) * 4, bb = ri >> 1, e = ri & 1;
        const int seg = (bb < NB) ? bb * 32 + 31 : MP / 64 + (bb - NB);
        const f32x4 v = ld_bf4(Ebuf + ((size_t)seg * 4 + 2 + e) * FF2 + c4);
        float* o = (bb < NB) ? out + O_CP + (((size_t)l * NB + bb) * 2 + e) * FF2 + c4 : out + O_CS + (((size_t)l * DB + (bb - NB)) * 2 + e) * FF2 + c4;
        *(f32x4*)o = v;
    }
}

__global__ void __launch_bounds__(512, 2) fwd_kernel(Args args) {
    extern __shared__ __attribute__((aligned(16))) unsigned char lds_raw[];
    LAS unsigned char* lds = (LAS unsigned char*)lds_raw;
    const int G = gridDim.x, blk = blockIdx.x, NGW = G * 8;
#define IDS int tid = threadIdx.x; asm volatile("" : "+v"(tid)); const int lane = tid & 63, wave = __builtin_amdgcn_readfirstlane(tid >> 6), gw = blk * 8 + wave; (void)lane; (void)gw
    unsigned char* ws = args.ws; float* out = args.out;
    const float* x_prompt = args.in[0]; const float* x_sample = args.in[1];
    bf16_t* Wqkv = (bf16_t*)(ws + WS_WQKV); bf16_t* Wo = (bf16_t*)(ws + WS_WO); bf16_t* Wglu = (bf16_t*)(ws + WS_WGLU); bf16_t* Wup = (bf16_t*)(ws + WS_WUP); bf16_t* Wdn = (bf16_t*)(ws + WS_WDN);
    float* rope = (float*)(ws + WS_ROPE); float* ss = (float*)(ws + WS_SS);
    bf16_t* Abuf = (bf16_t*)(ws + WS_A); bf16_t* Mbuf = (bf16_t*)(ws + WS_MB); bf16_t* Ebuf = (bf16_t*)(ws + WS_E); bf16_t* Gbuf = (bf16_t*)(ws + WS_G);
    bf16_t* X16 = (bf16_t*)(ws + WS_X16); float* sacc = (float*)(ws + WS_SACC);
    bf16_t* Qbuf = (bf16_t*)(ws + WS_Q); bf16_t* Kbuf = (bf16_t*)(ws + WS_K); bf16_t* Vbuf = (bf16_t*)(ws + WS_V);


    const int lo = args.ph_lo, hi_ = args.ph_hi;
    volatile LAS unsigned* misc = (volatile LAS unsigned*)(lds + XL_MISC);
    if (threadIdx.x < 2) misc[threadIdx.x] = 0u;
    __syncthreads();
    XcdBarrier xbar; xbar.bar = (unsigned*)ws; xbar.x = 0; xbar.st = nullptr;
    if (args.coop) xbar = xcd_barrier_post((unsigned*)ws, misc);
    if (args.coop == 2) cg::this_grid().sync();
#define IN(k) (lo <= (k) && (k) < hi_)
#define SEAM(k) do { if (args.coop && (k) + 1 < hi_) xcd_barrier(xbar); } while (0)
#define REP(k) _Pragma("unroll") for (int rep_ = 0; rep_ <= ((PROBE_REPMASK >> (k)) & 1); ++rep_)
    if (IN(0)) { IDS; REP(0) { phase_prologue(lds, args, ws, out, G, blk, wave, lane, tid); } SEAM(0); }
    if (IN(1)) { REP(1) {
        pg8::Gemm g{Abuf, Wqkv, MT, QKVD, DM}; pg8::StaticOrder S; S.init(MT, QKVD, DM, G, blk);
        pg8::EpiQKV E{Qbuf, Kbuf, Vbuf, args.in[12], rope, out + O_KP, out + O_VP, out + O_KS, out + O_VS};
        pg8::gemm_phase<pg8::EpiQKV, true, true>(lds, g, S, E); } SEAM(1); }
    if (IN(2)) { REP(2) { attn_phase(lds, Qbuf, Kbuf, Vbuf, Abuf, args.in[13], G, blk); } SEAM(2); }
    const bool fusedp = (G == 256);
    unsigned long long* xch = (unsigned long long*)(ws + WS_XCH); unsigned* pcnt = (unsigned*)(ws + WS_CNT); LAS unsigned char* xl = lds + XL_OFF;
    if (IN(3)) { REP(3) {
        pg8::Gemm g{Abuf, Wo, MT, DM, DM}; pg8::StaticOrder S; S.init(MT, DM, DM, G, blk, MP / 256, 4);
        { pg8::EpiPlainSS E{Mbuf, args.in[15], ss, sacc, DM / 64}; pg8::gemm_phase<pg8::EpiPlainSS, true, true>(lds, g, S, E); } } SEAM(3); }
    bf16_t* Aup0 = Abuf;
    if (IN(4)) { IDS; REP(4) { phase_rows<0>(x_prompt, x_sample, X16, out, Mbuf, ss, 16, args.in[8], args.in[9], Aup0, gw, NGW, lane, sacc, args.in[15], 4, false); } SEAM(4); }
    if (IN(5)) { REP(5) { phase_up(lds, Aup0, Wup, Gbuf, Ebuf, args.in[27], args.in[28], G, blk); } SEAM(5); }
    if (IN(6)) { IDS; REP(6) { phase_fix(Ebuf, Gbuf, args.in[27], args.in[28], args.in[6], out, 0, G, blk, tid); } SEAM(6); }
    if (IN(7)) { REP(7) {
        if (fusedp) { pg8::Gemm g{Gbuf, Wdn, MT, DM, FF}; pg8::StaticOrder S; S.init(MT, DM, FF, G, blk, MP / 256, 11); S.panel = true;
            pg8::EpiFused<false, false> E{nullptr, X16, X16, nullptr, Abuf, args.in[10], args.in[7] + DM, xch + (size_t)MP * 8, pcnt + 256 * 64, xl, sacc, FF / 64};
            pg8::gemm_phase<pg8::EpiFused<false, false>, true, true>(lds, g, S, E); }
        else phase_down(lds, Gbuf, Wdn, Mbuf, ss, sacc, G, blk); } SEAM(7); }
    if (IN(8)) { IDS; REP(8) { phase_rows<1>(x_prompt, x_sample, X16, out, Mbuf, ss, 16, args.in[10], args.in[7] + DM, Abuf, gw, NGW, lane, sacc, nullptr, 11, fusedp); } SEAM(8); }
    if (IN(9)) { REP(9) {
        SsmP P{args.in[16], args.in[17], args.in[18], args.in[19], args.in[20], args.in[21], args.in[22], args.in[23], args.in[4], args.in[5], out + O_REP, out + O_IMP, out + O_RES, out + O_IMS};
        ssm_phase(lds, Abuf, Qbuf, P, G, blk); } SEAM(9); }
    if (IN(10)) { REP(10) {
        pg8::Gemm g{Qbuf, Wglu, MT, 2 * DM, DM}; pg8::StaticOrder S; S.init(MT, 2 * DM, DM, G, blk, MP / 256, 4);
        pg8::EpiGlu E{Mbuf, args.in[25], ss, sacc, DM / 64};
        pg8::gemm_phase<pg8::EpiGlu, true, true>(lds, g, S, E); } SEAM(10); }
    if (IN(11)) { IDS; REP(11) { phase_rows<1>(x_prompt, x_sample, X16, out, Mbuf, ss, 32, args.in[8] + DM, args.in[9] + DM, Abuf, gw, NGW, lane, sacc, args.in[25], 4, false, true); } SEAM(11); }
    if (IN(12)) { REP(12) { phase_up(lds, Abuf, Wup + (size_t)FF2 * DM, Gbuf, Ebuf, args.in[27] + (size_t)3 * FF2, args.in[28] + FF2, G, blk); } SEAM(12); }
    if (IN(13)) { IDS; REP(13) { phase_fix(Ebuf, Gbuf, args.in[27] + (size_t)3 * FF2, args.in[28] + FF2, args.in[6] + (size_t)DB * 2 * FF2, out, 1, G, blk, tid); } SEAM(13); }
    if (IN(14)) { REP(14) {
        if (fusedp) { pg8::Gemm g{Gbuf, Wdn + (size_t)DM * FF, MT, DM, FF}; pg8::StaticOrder S; S.init(MT, DM, FF, G, blk, MP / 256, 11); S.panel = true;
            pg8::EpiFused<false, true> E{nullptr, X16, nullptr, out, nullptr, args.in[10] + DM, nullptr, xch + (size_t)2 * MP * 8, pcnt + 2 * 256 * 64, xl, sacc, FF / 64};
            pg8::gemm_phase<pg8::EpiFused<false, true>, true, true>(lds, g, S, E); }
        else phase_down(lds, Gbuf, Wdn + (size_t)DM * FF, Mbuf, ss, sacc, G, blk); } SEAM(14); }
    if (IN(15)) { IDS; REP(15) { phase_rows<2>(x_prompt, x_sample, X16, out, Mbuf, ss, 16, args.in[10] + DM, nullptr, nullptr, gw, NGW, lane, sacc, nullptr, 11, fusedp); } }
#undef IN
#undef SEAM
#undef REP
}

extern "C" void kernel_launch(void* const* d_in, const int* in_sizes, int n_in, void* d_out, int out_size, void* d_ws, size_t ws_size, hipStream_t stream) {
    static int grid = 0;
    if (grid == 0) {
        if (n_in != 30 || (size_t)out_size != O_END || ws_size < WS_END) { fprintf(stderr, "kernel_launch: unexpected shapes: n_in %d out %d ws %zu (need out %zu ws %zu)\n", n_in, out_size, ws_size, (size_t)O_END, (size_t)WS_END); grid = -1; return; }
        int dev = 0, cus = 0, per_cu = 0;
        hipGetDevice(&dev); hipDeviceGetAttribute(&cus, hipDeviceAttributeMultiprocessorCount, dev);
        if (hipFuncSetAttribute((const void*)fwd_kernel, hipFuncAttributeMaxDynamicSharedMemorySize, LDS_BYTES) != hipSuccess) { fprintf(stderr, "kernel_launch: hipFuncSetAttribute failed\n"); grid = -1; return; }
        if (hipOccupancyMaxActiveBlocksPerMultiprocessor(&per_cu, (const void*)fwd_kernel, 512, LDS_BYTES) != hipSuccess || per_cu < 1) { fprintf(stderr, "kernel_launch: occupancy query says %d\n", per_cu); per_cu = 1; }
        (void)hipGetLastError();
        grid = cus * 1;
    }
    if (grid < 0) return;
    Args a{};
    for (int i = 0; i < 30; ++i) a.in[i] = (const float*)d_in[i];
    a.out = (float*)d_out; a.ws = (unsigned char*)d_ws;
#ifndef MK_MULTI
    if (hipMemsetAsync(d_ws, 0, CTL_ZERO_BYTES, stream) != hipSuccess) { fprintf(stderr, "kernel_launch: memset failed\n"); return; }
    a.ph_lo = 0; a.ph_hi = NPHASE; a.coop = 1;
    void* kargs[] = {&a};
    hipError_t e = hipLaunchCooperativeKernel((const void*)fwd_kernel, dim3(grid), dim3(512), kargs, LDS_BYTES, stream);
    if (e != hipSuccess) fprintf(stderr, "cooperative launch failed: %s (grid %d)\n", hipGetErrorString(e), grid);
#else
    for (int ph = 0; ph < NPHASE; ++ph) { a.ph_lo = ph; a.ph_hi = ph + 1; a.coop = 0; hipLaunchKernelGGL(fwd_kernel, dim3(grid), dim3(512), LDS_BYTES, stream, a); }
#endif
}
```

```cpp
#include <hip/hip_runtime.h>
#include <hip/hip_cooperative_groups.h>
#include <cstdio>
#include <cstdint>
namespace cg = cooperative_groups;

#define LAS __attribute__((address_space(3)))
typedef unsigned short bf16_t;
typedef short bf16x8 __attribute__((ext_vector_type(8)));
typedef short s16x4 __attribute__((ext_vector_type(4)));
typedef float f32x4 __attribute__((ext_vector_type(4)));
typedef float f32x16 __attribute__((ext_vector_type(16)));
typedef unsigned u32x4 __attribute__((ext_vector_type(4)));
typedef unsigned u32x2 __attribute__((ext_vector_type(2)));

constexpr int DM = 1024, NB = 32, SEQ = 2048, MP = NB * SEQ, DB = 16, DS = 64, MS = DB * DS, MT = MP + MS;
constexpr int QKVD = 1536, FF = 2816, FF2 = 5632, NSEG = MT / 64;
constexpr int KVROWS = MP + DB * 192;
constexpr float EPS = 1e-6f, LOG2E = 1.4426950408889634f, QSCALE = 0.125f * 1.4426950408889634f;
constexpr size_t O_Y = 0, O_KP = (size_t)MT * DM, O_VP = O_KP + (size_t)NB * 128 * 256, O_KS = O_VP + (size_t)NB * 128 * 256, O_VS = O_KS + (size_t)DB * 128 * 256,
                 O_REP = O_VS + (size_t)DB * 128 * 256, O_IMP = O_REP + NB * 4096, O_RES = O_IMP + NB * 4096, O_IMS = O_RES + DB * 4096,
                 O_CP = O_IMS + DB * 4096, O_CS = O_CP + (size_t)2 * NB * 2 * FF2, O_END = O_CS + (size_t)2 * DB * 2 * FF2;
constexpr size_t MiB = 1u << 20;
constexpr size_t WS_WQKV = 1 * MiB, WS_WO = 4 * MiB, WS_WGLU = 6 * MiB, WS_WUP = 10 * MiB, WS_WDN = 32 * MiB, WS_ROPE = 43 * MiB, WS_SS = 44 * MiB,
                 WS_A = 54 * MiB, WS_MB = 185 * MiB, WS_E = 316 * MiB, WS_G = 406 * MiB, WS_Q = WS_G, WS_K = WS_G + 132 * MiB, WS_V = WS_K + 34 * MiB, WS_X16 = WS_G + 358 * MiB, WS_SACC = WS_X16 + 131 * MiB, WS_XCH = WS_SACC + 44 * MiB, WS_END = WS_XCH + 13 * MiB;
constexpr size_t WS_CNT = 32768, CTL_ZERO_BYTES = 32768 + 3 * 256 * 256;
static_assert(WS_WUP + (size_t)2 * FF2 * DM * 2 <= WS_WDN && WS_WDN + (size_t)2 * DM * FF * 2 <= WS_ROPE && WS_SS + (size_t)MT * 32 * 4 <= WS_A, "ws map 1");
static_assert(WS_A + (size_t)MT * DM * 2 <= WS_MB && WS_MB + (size_t)MT * DM * 2 <= WS_E && WS_E + (size_t)NSEG * 4 * FF2 * 4 <= WS_G, "ws map 2");
static_assert(WS_X16 + (size_t)MT * DM * 2 <= WS_END, "ws map 4");
static_assert(WS_Q + (size_t)MT * DM * 2 <= WS_K && WS_K + (size_t)KVROWS * 256 * 2 <= WS_V && WS_V + (size_t)KVROWS * 256 * 2 <= WS_END && WS_G + (size_t)MT * FF * 2 <= WS_END, "ws map 3");

__device__ __forceinline__ unsigned cvt_pk_bf16(float lo, float hi) { unsigned r; asm volatile("v_cvt_pk_bf16_f32 %0, %1, %2" : "=v"(r) : "v"(lo), "v"(hi)); return r; }
__device__ __forceinline__ void unpack8(const u32x4 w, f32x4& lo, f32x4& hi) {
    lo[0] = __uint_as_float(w.x << 16); lo[1] = __uint_as_float(w.x & 0xffff0000u); lo[2] = __uint_as_float(w.y << 16); lo[3] = __uint_as_float(w.y & 0xffff0000u);
    hi[0] = __uint_as_float(w.z << 16); hi[1] = __uint_as_float(w.z & 0xffff0000u); hi[2] = __uint_as_float(w.w << 16); hi[3] = __uint_as_float(w.w & 0xffff0000u);
}
__device__ __forceinline__ u32x4 pack8(const f32x4 lo, const f32x4 hi) { u32x4 w; w.x = cvt_pk_bf16(lo[0], lo[1]); w.y = cvt_pk_bf16(lo[2], lo[3]); w.z = cvt_pk_bf16(hi[0], hi[1]); w.w = cvt_pk_bf16(hi[2], hi[3]); return w; }
__device__ __forceinline__ float bf2f(unsigned short b) { return __uint_as_float((unsigned)b << 16); }
__device__ __forceinline__ float gelu_tanh(float x) {
    const float x2 = x * x, u = x * (0.7978845608f + 0.0356774081f * x2);
    const float e = __builtin_amdgcn_exp2f(-2.885390082f * u);
    return x * __builtin_amdgcn_rcpf(1.0f + e);
}
typedef float f32x2 __attribute__((ext_vector_type(2)));
__device__ __forceinline__ f32x2 gelu_gate_pk(f32x2 x, f32x2 cv) {
    const f32x2 x2 = x * x, t = x2 * (-2.885390082f * 0.0356774081f) + (-2.885390082f * 0.7978845608f), a = x * t;
    f32x2 e; e.x = __builtin_amdgcn_exp2f(a.x); e.y = __builtin_amdgcn_exp2f(a.y);
    const f32x2 d = e + 1.0f;
    f32x2 r; r.x = __builtin_amdgcn_rcpf(d.x); r.y = __builtin_amdgcn_rcpf(d.y);
    return (x * cv) * r;
}
__device__ __forceinline__ float sigmoid_f(float v) { return __builtin_amdgcn_rcpf(1.0f + __builtin_amdgcn_exp2f(-LOG2E * v)); }
__device__ __forceinline__ float wave_sum(float v) {
#pragma unroll
    for (int o = 1; o < 64; o <<= 1) v += __shfl_xor(v, o);
    return v;
}
__device__ __forceinline__ float sum_rows4(float v) {
    auto a = __builtin_amdgcn_permlane16_swap(__float_as_uint(v), __float_as_uint(v), false, false);
    const float s = __uint_as_float(a[0]) + __uint_as_float(a[1]);
    auto b = __builtin_amdgcn_permlane32_swap(__float_as_uint(s), __float_as_uint(s), false, false);
    return __uint_as_float(b[0]) + __uint_as_float(b[1]);
}
template <int CTRL> __device__ __forceinline__ float dpp_f(float x) { return __builtin_bit_cast(float, __builtin_amdgcn_update_dpp(0, __builtin_bit_cast(int, x), CTRL, 0xf, 0xf, false)); }

#define FMAC_DPP(c, src, w, CTRL) asm volatile("v_fmac_f32_dpp %0, %1, %2 " CTRL " row_mask:0xf bank_mask:0xf" : "+v"(c) : "v"(src), "v"(w))
namespace pg8 {
constexpr int BM = 256, BK = 64, HALF = 128, HTB = HALF * BK * 2, STAGE_BYTES = 8 * HTB, NXCD = 8, WGM = 8;
__host__ __device__ __forceinline__ int lds_byte(int r, int c) { const int st = (r >> 4) * 2 + (c >> 5), rr = r & 15, cc = c & 31, ob = rr * 64 + cc * 2; return st * 1024 + (ob ^ (((ob >> 9) & 1) << 5)); }
__host__ __device__ __forceinline__ void stage_rc(int b, int& R, int& C) { const int st = b / 1024, sb = b % 1024, swz = sb ^ (((sb >> 9) & 1) << 5); R = (st >> 1) * 16 + swz / 64; C = (st & 1) * 32 + (swz % 64) / 2; }
__host__ __device__ __forceinline__ int perm32(int rho) { const int n = rho >> 4, i = rho & 15; return 8 * (i >> 2) + 4 * n + (i & 3); }
__host__ __device__ __forceinline__ int permrope(int rho) { const int n = rho >> 4, i = rho & 15, fq = i >> 2, j = i & 3; return 16 * (fq >> 1) + 8 * n + 4 * (fq & 1) + j; }
struct Unit { int pm, pn, kt0, nkt; };
struct Gemm { const bf16_t* A; const bf16_t* Bt; int M, N, K; };
struct StaticOrder {
    int nM, nN, nwg, G, c, nMf, ns, ktiles, nfull, wgm = WGM; bool panel = false;
    __device__ void init(int M, int N, int K, int G_, int c_, int nMf_ = -1, int ns_ = 1) { nM = M / BM; nN = N / BM; G = G_; c = c_; ktiles = K / BK; nMf = nMf_ < 0 ? nM : nMf_; ns = ns_; nfull = nMf * nN; nwg = nfull + (nM - nMf) * nN * ns; }
    __device__ __forceinline__ bool next(int i, Unit& u) const {
        const long L = (long)i * G + c; if (L >= nwg) return false;
        int pm, pn, kt0 = 0, nkt = ktiles;
        if (L >= nfull) { const int s = (int)L - nfull, tile = s / ns, sl = s - tile * ns; pm = nMf + tile / nN; pn = tile % nN; nkt = ktiles / ns; kt0 = sl * nkt; }
        else if (panel) { const int x = c & 7, j = c >> 3; pn = j & 3; pm = 64 * i + 8 * (j >> 2) + x; }
        else {
            int wgid = (int)L; { const int q = nfull / NXCD, r = nfull % NXCD, xcd = wgid % NXCD, off = wgid / NXCD; wgid = (xcd < r ? xcd * (q + 1) : r * (q + 1) + (xcd - r) * q) + off; }
            const int nig = wgm * nN, gid = wgid / nig, fm = gid * wgm, gsz = (nMf - fm) < wgm ? (nMf - fm) : wgm;
            pm = fm + ((wgid % nig) % gsz); pn = (wgid % nig) / gsz;
        }
        u = Unit{pm, pn, kt0, nkt}; return true;
    }
};
template <class Epi, bool ALIGN_EPI, bool SP2>
__device__ __forceinline__ void gemm_phase(LAS unsigned char* lds, const Gemm g, const StaticOrder& S, const Epi& E) {
    const int tid = threadIdx.x, wid = __builtin_amdgcn_readfirstlane(tid >> 6), lane = tid & 63, wr = wid >> 2, wc = wid & 3, fr = lane & 15, fq = lane >> 4;
    const int K = g.K;
    unsigned voffA[2], voffB[2];
#pragma unroll
    for (int i = 0; i < 2; ++i) { int R, C; stage_rc(tid * 16 + i * 8192, R, C); const int Rb = (R & ~31) + Epi::perm(R & 31);
        voffA[i] = (unsigned)(R * K + C) * 2u; voffB[i] = (unsigned)(Rb * K + C) * 2u; }
    const size_t kstep = (size_t)(BK * 2);
    const size_t hstep = (size_t)HALF * K * 2;
    const size_t tstep = 2 * hstep;
    const unsigned ldsw = (unsigned)wid * 1024u;
    const int aoff = lds_byte(wr * 64 + fr, fq * 8), boff = lds_byte(wc * 32 + fr, fq * 8);
#define PG8_SA(b, h) (((b) * 2 + (h)) * HTB)
#define PG8_SB(b, h) ((4 + (b) * 2 + (h)) * HTB)
#define PG8_STAGE(bufoff, gbase, voff) do { _Pragma("unroll") for (int _i = 0; _i < 2; ++_i) \
        __builtin_amdgcn_global_load_lds((const unsigned*)((const char*)(gbase) + (voff)[_i]), (LAS unsigned*)(lds + (bufoff) + ldsw + _i * 8192), 16, 0, 0); } while (0)
#define PG8_LDA(dst, b, h) do { _Pragma("unroll") for (int m = 0; m < 4; ++m) _Pragma("unroll") for (int k = 0; k < 2; ++k) dst[m][k] = *(const LAS bf16x8*)(lds + PG8_SA(b, h) + aoff + m * 2048 + k * 1024); } while (0)
#define PG8_LDB(dst, b, h) do { _Pragma("unroll") for (int n = 0; n < 2; ++n) _Pragma("unroll") for (int k = 0; k < 2; ++k) dst[n][k] = *(const LAS bf16x8*)(lds + PG8_SB(b, h) + boff + n * 2048 + k * 1024); } while (0)
#define PG8_MMA(ai, bj, At, Bt) do { __builtin_amdgcn_s_setprio(1); _Pragma("unroll") for (int m = 0; m < 4; ++m) _Pragma("unroll") for (int n = 0; n < 2; ++n) _Pragma("unroll") for (int k = 0; k < 2; ++k) \
        acc[ai][bj][m][n] = __builtin_amdgcn_mfma_f32_16x16x32_bf16(Bt[n][k], At[m][k], acc[ai][bj][m][n], 0, 0, 0); __builtin_amdgcn_s_setprio(0); } while (0)
#define PG8_WAIT_V(n) asm volatile("s_waitcnt vmcnt(" #n ")" ::: "memory")
#define PG8_WAIT_L(n) asm volatile("s_waitcnt lgkmcnt(" #n ")" ::: "memory")
#define PG8_BAR __builtin_amdgcn_s_barrier()
#define PG8_SCHED __builtin_amdgcn_sched_barrier(0)
    Unit cur, nxt; int ui = 0;
    if (!S.next(0, cur)) return;
    f32x4 acc[2][2][4][2];
#pragma unroll
    for (int a = 0; a < 2; ++a)
#pragma unroll
        for (int b = 0; b < 2; ++b)
#pragma unroll
            for (int m = 0; m < 4; ++m)
#pragma unroll
                for (int n = 0; n < 2; ++n) acc[a][b][m][n] = (f32x4){0.f, 0.f, 0.f, 0.f};
    bf16x8 At[4][2], B0[2][2], B1[2][2];
    const char* cA = (const char*)g.A + (size_t)cur.pm * tstep + (size_t)cur.kt0 * kstep; const char* cB = (const char*)g.Bt + (size_t)cur.pn * tstep + (size_t)cur.kt0 * kstep;
    if constexpr (SP2) {
        PG8_STAGE(PG8_SB(0, 0), cB, voffB); PG8_STAGE(PG8_SB(0, 1), cB + hstep, voffB); PG8_STAGE(PG8_SA(0, 0), cA, voffA); PG8_STAGE(PG8_SA(0, 1), cA + hstep, voffA);
        if (wr == 1) PG8_BAR;
        PG8_WAIT_V(2); PG8_BAR;
        PG8_STAGE(PG8_SB(1, 0), cB + kstep, voffB); PG8_STAGE(PG8_SA(1, 0), cA + kstep, voffA); PG8_STAGE(PG8_SB(1, 1), cB + hstep + kstep, voffB);
        PG8_WAIT_V(6); PG8_BAR;
    } else {
        PG8_STAGE(PG8_SB(0, 0), cB, voffB); PG8_STAGE(PG8_SA(0, 0), cA, voffA); PG8_STAGE(PG8_SB(0, 1), cB + hstep, voffB); PG8_STAGE(PG8_SA(0, 1), cA + hstep, voffA);
        if (wr == 1) PG8_BAR;
        PG8_WAIT_V(4); PG8_BAR;
        PG8_STAGE(PG8_SB(1, 0), cB + kstep, voffB); PG8_STAGE(PG8_SA(1, 0), cA + kstep, voffA); PG8_STAGE(PG8_SB(1, 1), cB + hstep + kstep, voffB);
        PG8_WAIT_V(6); PG8_BAR;
    }
    for (;;) {
        const bool has_next = S.next(ui + 1, nxt);
        const char* nA = has_next ? (const char*)g.A + (size_t)nxt.pm * tstep + (size_t)nxt.kt0 * kstep : cA; const char* nB = has_next ? (const char*)g.Bt + (size_t)nxt.pn * tstep + (size_t)nxt.kt0 * kstep : cB;
        const int nt = cur.nkt;
        for (int t = 0; t < nt; t += 2) {
            const bool last = (t == nt - 2);
            const char* a1 = cA + (size_t)(t + 1) * kstep;
            const char* a2 = last ? nA : cA + (size_t)(t + 2) * kstep; const char* b2 = last ? nB : cB + (size_t)(t + 2) * kstep;
            const char* a3 = a2 + kstep; const char* b3 = b2 + kstep;
            if constexpr (SP2) {
            PG8_LDB(B0, 0, 0); PG8_LDB(B1, 0, 1); PG8_SCHED; PG8_LDA(At, 0, 0); PG8_STAGE(PG8_SA(1, 1), a1 + hstep, voffA);
            PG8_WAIT_V(8); PG8_WAIT_L(0); PG8_BAR; PG8_MMA(0, 0, At, B0); PG8_MMA(0, 1, At, B1); PG8_BAR; PG8_SCHED;
            PG8_LDA(At, 0, 1); PG8_STAGE(PG8_SB(0, 0), b2, voffB); PG8_STAGE(PG8_SB(0, 1), b2 + hstep, voffB); PG8_STAGE(PG8_SA(0, 0), a2, voffA);
            PG8_WAIT_V(8); PG8_WAIT_L(0); PG8_BAR; PG8_MMA(1, 0, At, B0); PG8_MMA(1, 1, At, B1); PG8_BAR; PG8_SCHED;
            PG8_LDB(B0, 1, 0); PG8_LDB(B1, 1, 1); PG8_SCHED; PG8_LDA(At, 1, 0); PG8_STAGE(PG8_SA(0, 1), a2 + hstep, voffA);
            PG8_WAIT_V(8); PG8_WAIT_L(0); PG8_BAR; PG8_MMA(0, 0, At, B0); PG8_MMA(0, 1, At, B1); PG8_BAR; PG8_SCHED;
            PG8_LDA(At, 1, 1); PG8_STAGE(PG8_SB(1, 0), b3, voffB); PG8_STAGE(PG8_SB(1, 1), b3 + hstep, voffB); PG8_STAGE(PG8_SA(1, 0), a3, voffA);
            PG8_WAIT_V(8); PG8_WAIT_L(0); PG8_BAR; PG8_MMA(1, 0, At, B0); PG8_MMA(1, 1, At, B1); PG8_BAR; PG8_SCHED;
            } else {
            PG8_LDB(B0, 0, 0); PG8_SCHED; PG8_LDA(At, 0, 0); PG8_STAGE(PG8_SA(1, 1), a1 + hstep, voffA);
            PG8_WAIT_L(8); PG8_BAR; PG8_WAIT_L(0); PG8_MMA(0, 0, At, B0); PG8_BAR; PG8_SCHED;
            PG8_LDB(B1, 0, 1); PG8_STAGE(PG8_SB(0, 0), b2, voffB);
            PG8_BAR; PG8_WAIT_L(0); PG8_MMA(0, 1, At, B1); PG8_BAR;
            PG8_LDA(At, 0, 1); PG8_STAGE(PG8_SA(0, 0), a2, voffA);
            PG8_BAR; PG8_WAIT_L(0); PG8_MMA(1, 0, At, B0); PG8_BAR; PG8_SCHED;
            PG8_STAGE(PG8_SB(0, 1), b2 + hstep, voffB);
            PG8_WAIT_V(6); PG8_BAR; PG8_MMA(1, 1, At, B1); PG8_BAR;
            PG8_LDB(B0, 1, 0); PG8_SCHED; PG8_LDA(At, 1, 0); PG8_STAGE(PG8_SA(0, 1), a2 + hstep, voffA);
            PG8_WAIT_L(8); PG8_BAR; PG8_WAIT_L(0); PG8_MMA(0, 0, At, B0); PG8_BAR; PG8_SCHED;
            PG8_LDB(B1, 1, 1); PG8_STAGE(PG8_SB(1, 0), b3, voffB);
            PG8_BAR; PG8_WAIT_L(0); PG8_MMA(0, 1, At, B1); PG8_BAR;
            PG8_LDA(At, 1, 1); PG8_STAGE(PG8_SA(1, 0), a3, voffA);
            PG8_BAR; PG8_WAIT_L(0); PG8_MMA(1, 0, At, B0); PG8_BAR; PG8_SCHED;
            PG8_STAGE(PG8_SB(1, 1), b3 + hstep, voffB);
            PG8_WAIT_V(6); PG8_BAR; PG8_MMA(1, 1, At, B1); PG8_BAR;
            }
        }
        if constexpr (ALIGN_EPI) { if (wr == 0) PG8_BAR; }
        E(acc, cur, wr, wc, fr, fq);
        if (!has_next) break;
#pragma unroll
        for (int a = 0; a < 2; ++a)
#pragma unroll
            for (int b = 0; b < 2; ++b)
#pragma unroll
                for (int m = 0; m < 4; ++m)
#pragma unroll
                    for (int n = 0; n < 2; ++n) acc[a][b][m][n] = (f32x4){0.f, 0.f, 0.f, 0.f};
        cur = nxt; cA = nA; cB = nB; ++ui;
        if constexpr (ALIGN_EPI) { if (wr == 1) PG8_BAR; }
    }
    PG8_WAIT_V(0);
    if constexpr (!ALIGN_EPI) { if (wr == 0) PG8_BAR; }
    PG8_BAR;
#undef PG8_SA
#undef PG8_SB
#undef PG8_STAGE
#undef PG8_LDA
#undef PG8_LDB
#undef PG8_MMA
#undef PG8_WAIT_V
#undef PG8_WAIT_L
#undef PG8_BAR
#undef PG8_SCHED
}

struct EpiQKV {
    static constexpr bool PERM = true; static __device__ __forceinline__ int perm(int rho) { return permrope(rho); }
    bf16_t* Q; bf16_t* Kb; bf16_t* Vb; const float* bias; const float* rope; float* kp; float* vp; float* ks; float* vs;
    __device__ __forceinline__ void operator()(const f32x4 (&acc)[2][2][4][2], const Unit& u, int wr, int wc, int fr, int fq) const {
        const int kind = u.pn < 4 ? 0 : u.pn - 3;
        const int lc0 = wc * 32 + 16 * (fq >> 1) + 4 * (fq & 1);
        f32x4 bv[2][2];
#pragma unroll
        for (int bj = 0; bj < 2; ++bj)
#pragma unroll
            for (int n = 0; n < 2; ++n) bv[bj][n] = *(const f32x4*)(bias + u.pn * 256 + bj * 128 + lc0 + 8 * n);
        const bool dorope = (kind < 2) && ((wc & 1) == 0) && (fq < 2);
#pragma unroll
        for (int ai = 0; ai < 2; ++ai)
#pragma unroll
            for (int m = 0; m < 4; ++m) {
                const int r = u.pm * 256 + ai * 128 + wr * 64 + m * 16 + fr;
                const bool prompt = r < MP;
                const int t = prompt ? (r & 2047) : ((r - MP) & 63), b = prompt ? (r >> 11) : ((r - MP) >> 6);
                const int pos = prompt ? t : 1024 + t;
                f32x4 cs = {1.f, 1.f, 1.f, 1.f}, sn = {0.f, 0.f, 0.f, 0.f};
                if (dorope) { cs = *(const f32x4*)(rope + pos * 16 + 4 * fq); sn = *(const f32x4*)(rope + pos * 16 + 8 + 4 * fq); }
#pragma unroll
                for (int bj = 0; bj < 2; ++bj) {
                    const f32x4 x1 = acc[ai][bj][m][0] + bv[bj][0], x2 = acc[ai][bj][m][1] + bv[bj][1];
                    f32x4 v[2]; v[0] = x1 * cs - x2 * sn; v[1] = x2 * cs + x1 * sn;
                    if (kind == 0) {
                        u32x2 w0, w1; w0.x = cvt_pk_bf16(v[0][0] * QSCALE, v[0][1] * QSCALE); w0.y = cvt_pk_bf16(v[0][2] * QSCALE, v[0][3] * QSCALE); w1.x = cvt_pk_bf16(v[1][0] * QSCALE, v[1][1] * QSCALE); w1.y = cvt_pk_bf16(v[1][2] * QSCALE, v[1][3] * QSCALE);
                        bf16_t* qp = Q + (size_t)r * DM + u.pn * 256 + bj * 128 + lc0;
                        *(u32x2*)qp = w0; *(u32x2*)(qp + 8) = w1;
                    } else {
                        const int col = bj * 128 + lc0;
                        const size_t krow = prompt ? (size_t)r : (size_t)MP + b * 192 + 128 + t;
                        u32x2 w0, w1; w0.x = cvt_pk_bf16(v[0][0], v[0][1]); w0.y = cvt_pk_bf16(v[0][2], v[0][3]); w1.x = cvt_pk_bf16(v[1][0], v[1][1]); w1.y = cvt_pk_bf16(v[1][2], v[1][3]);
                        bf16_t* kvp = (kind == 1 ? Kb : Vb) + krow * 256 + col;
                        *(u32x2*)kvp = w0; *(u32x2*)(kvp + 8) = w1;
                        float* o = nullptr;
                        if (prompt) { if (t >= SEQ - 128) o = (kind == 1 ? kp : vp) + ((size_t)(b * 128 + t - (SEQ - 128)) * 256 + col); }
                        else o = (kind == 1 ? ks : vs) + ((size_t)(b * 128 + 64 + t) * 256 + col);
                        if (o) { *(f32x4*)o = v[0]; *(f32x4*)(o + 8) = v[1]; }
                    }
                }
            }
    }
};
struct EpiPlainSS {
    static constexpr bool PERM = true; static __device__ __forceinline__ int perm(int rho) { return perm32(rho); }
    bf16_t* O; const float* bias; float* ss; float* sacc; int ktiles;
    __device__ __forceinline__ void operator()(const f32x4 (&acc)[2][2][4][2], const Unit& u, int wr, int wc, int fr, int fq) const {
        const int col0 = u.pn * 256 + wc * 32 + 8 * fq;
        if (u.nkt != ktiles) {
            const int slice = u.kt0 / u.nkt;
#pragma unroll
            for (int ai = 0; ai < 2; ++ai)
#pragma unroll
                for (int m = 0; m < 4; ++m) {
                    const int r = u.pm * 256 + ai * 128 + wr * 64 + m * 16 + fr - MP; float* sp = sacc + ((size_t)slice * MS + r) * DM + col0;
#pragma unroll
                    for (int bj = 0; bj < 2; ++bj) { *(f32x4*)(sp + bj * 128) = acc[ai][bj][m][0]; *(f32x4*)(sp + bj * 128 + 4) = acc[ai][bj][m][1]; }
                }
            return;
        }
        f32x4 bv[2][2];
#pragma unroll
        for (int bj = 0; bj < 2; ++bj)
#pragma unroll
            for (int n = 0; n < 2; ++n) bv[bj][n] = bias ? *(const f32x4*)(bias + col0 + bj * 128 + 4 * n) : (f32x4){0.f, 0.f, 0.f, 0.f};
#pragma unroll
        for (int ai = 0; ai < 2; ++ai)
#pragma unroll
            for (int m = 0; m < 4; ++m) {
                const int r = u.pm * 256 + ai * 128 + wr * 64 + m * 16 + fr; float s = 0.f;
#pragma unroll
                for (int bj = 0; bj < 2; ++bj) {
                    const f32x4 v0 = acc[ai][bj][m][0] + bv[bj][0], v1 = acc[ai][bj][m][1] + bv[bj][1];
                    s += (v0[0] * v0[0] + v0[1] * v0[1]) + (v0[2] * v0[2] + v0[3] * v0[3]) + (v1[0] * v1[0] + v1[1] * v1[1]) + (v1[2] * v1[2] + v1[3] * v1[3]);
                    u32x4 w; w.x = cvt_pk_bf16(v0[0], v0[1]); w.y = cvt_pk_bf16(v0[2], v0[3]); w.z = cvt_pk_bf16(v1[0], v1[1]); w.w = cvt_pk_bf16(v1[2], v1[3]);
                    *(u32x4*)(O + (size_t)r * DM + col0 + bj * 128) = w;
                }
                s += __shfl_xor(s, 16); s += __shfl_xor(s, 32);
                if (fq == 0) ss[(size_t)r * 32 + u.pn * 4 + wc] = s;
            }
    }
};
template <bool XIN_F32, bool LAST>
struct EpiFused {
    static constexpr bool PERM = true; static __device__ __forceinline__ int perm(int rho) { return perm32(rho); }
    const float* bias; const void* xin; bf16_t* xo16; float* xof; bf16_t* aout; const float* gpost; const float* gnext;
    unsigned long long* xch; unsigned* cnt; LAS unsigned char* xl; float* sacc; int ktiles;
    __device__ __forceinline__ void load_x(f32x4 (&x)[2], size_t off) const {
        if constexpr (XIN_F32) { x[0] = *(const f32x4*)((const float*)xin + off); x[1] = *(const f32x4*)((const float*)xin + off + 4); }
        else { const u32x4 w = *(const u32x4*)((const bf16_t*)xin + off);
            x[0][0] = __uint_as_float(w.x << 16); x[0][1] = __uint_as_float(w.x & 0xffff0000u); x[0][2] = __uint_as_float(w.y << 16); x[0][3] = __uint_as_float(w.y & 0xffff0000u);
            x[1][0] = __uint_as_float(w.z << 16); x[1][1] = __uint_as_float(w.z & 0xffff0000u); x[1][2] = __uint_as_float(w.w << 16); x[1][3] = __uint_as_float(w.w & 0xffff0000u); }
    }
    __device__ __forceinline__ void operator()(f32x4 (&acc)[2][2][4][2], const Unit& u, int wr, int wc, int fr, int fq) const {
        asm volatile("" : "+v"(fr), "+v"(fq));
        const int col0 = u.pn * 256 + wc * 32 + 8 * fq;
        if (u.nkt != ktiles) {
            const int slice = u.kt0 / u.nkt;
#pragma unroll
            for (int ai = 0; ai < 2; ++ai)
#pragma unroll
                for (int m = 0; m < 4; ++m) {
                    const int r = u.pm * 256 + ai * 128 + wr * 64 + m * 16 + fr - MP; float* sp = sacc + ((size_t)slice * MS + r) * DM + col0;
#pragma unroll
                    for (int bj = 0; bj < 2; ++bj) { *(f32x4*)(sp + bj * 128) = acc[ai][bj][m][0]; *(f32x4*)(sp + bj * 128 + 4) = acc[ai][bj][m][1]; }
                }
            return;
        }
        int tid = threadIdx.x; asm volatile("" : "+v"(tid)); const int lane = tid & 63, wid = __builtin_amdgcn_readfirstlane(tid >> 6);
        LAS f32x4* P = (LAS f32x4*)xl; LAS f32x2* S2 = (LAS f32x2*)(xl + 16384); volatile LAS unsigned* flag = (volatile LAS unsigned*)(xl + 16384 + 2048);
        f32x4 gp[2][2];
#pragma unroll
        for (int bj = 0; bj < 2; ++bj)
#pragma unroll
            for (int n = 0; n < 2; ++n) { gp[bj][n] = *(const f32x4*)(gpost + col0 + bj * 128 + 4 * n);
                if (bias) { const f32x4 bv = *(const f32x4*)(bias + col0 + bj * 128 + 4 * n);
#pragma unroll
                    for (int ai = 0; ai < 2; ++ai)
#pragma unroll
                        for (int m = 0; m < 4; ++m) acc[ai][bj][m][n] += bv; } }
#pragma unroll
        for (int ai = 0; ai < 2; ++ai)
#pragma unroll
            for (int m = 0; m < 4; ++m) {
                const int rl = ai * 128 + wr * 64 + m * 16 + fr; const size_t roff = (size_t)(u.pm * 256 + rl) * DM + col0;
                float smm = 0.f, sxx = 0.f, sxm = 0.f, sgg = 0.f;
#pragma unroll
                for (int bj = 0; bj < 2; ++bj) { f32x4 x[2]; load_x(x, roff + bj * 128);
#pragma unroll
                    for (int n = 0; n < 2; ++n)
#pragma unroll
                        for (int j = 0; j < 4; ++j) { const float v = acc[ai][bj][m][n][j], mg = v * gp[bj][n][j], xv = x[n][j]; smm += v * v; sxx += xv * xv; sxm += xv * mg; sgg += mg * mg; acc[ai][bj][m][n][j] = mg; } }
                smm = sum_rows4(smm); sxx = sum_rows4(sxx); sxm = sum_rows4(sxm); sgg = sum_rows4(sgg);
                if (fq == 0) P[rl * 4 + wc] = (f32x4){smm, sxx, sxm, sgg};
            }
        asm volatile("s_waitcnt lgkmcnt(0)" ::: "memory"); __builtin_amdgcn_s_barrier(); asm volatile("" ::: "memory");
        if (tid < 256) {
            const f32x4 t = (P[tid * 4 + 0] + P[tid * 4 + 1]) + (P[tid * 4 + 2] + P[tid * 4 + 3]);
            unsigned long long* slot = xch + ((size_t)(u.pm * 256 + tid) * 4 + u.pn) * 2;
            __hip_atomic_store(slot, ((unsigned long long)__float_as_uint(t[1]) << 32) | __float_as_uint(t[0]), __ATOMIC_RELAXED, __HIP_MEMORY_SCOPE_AGENT);
            __hip_atomic_store(slot + 1, ((unsigned long long)__float_as_uint(t[3]) << 32) | __float_as_uint(t[2]), __ATOMIC_RELAXED, __HIP_MEMORY_SCOPE_AGENT);
        }
        asm volatile("s_waitcnt vmcnt(0)" ::: "memory");
        if (wid < 4 && lane == 0) __hip_atomic_fetch_add(cnt + 64 * u.pm, 1u, __ATOMIC_RELAXED, __HIP_MEMORY_SCOPE_AGENT);
        if (wid == 0) {
            unsigned sp = 0u;
            while ((unsigned)__builtin_amdgcn_readfirstlane(__hip_atomic_load(cnt + 64 * u.pm, __ATOMIC_RELAXED, __HIP_MEMORY_SCOPE_AGENT)) < 16u) { __builtin_amdgcn_s_sleep(2); if (++sp > (1u << 21)) break; }
            __builtin_amdgcn_fence(__ATOMIC_ACQUIRE, "agent");
            if (lane == 0) flag[0] = sp;
        }
        asm volatile("s_waitcnt vmcnt(0) lgkmcnt(0)" ::: "memory"); __builtin_amdgcn_s_barrier(); asm volatile("" ::: "memory");
        if (tid < 256) {
            const unsigned long long* slot = xch + (size_t)(u.pm * 256 + tid) * 8; float t0 = 0.f, t1 = 0.f, t2 = 0.f, t3 = 0.f;
#pragma unroll
            for (int q = 0; q < 4; ++q) { const unsigned long long a = __hip_atomic_load(slot + 2 * q, __ATOMIC_RELAXED, __HIP_MEMORY_SCOPE_AGENT), b = __hip_atomic_load(slot + 2 * q + 1, __ATOMIC_RELAXED, __HIP_MEMORY_SCOPE_AGENT);
                t0 += __uint_as_float((unsigned)a); t1 += __uint_as_float((unsigned)(a >> 32)); t2 += __uint_as_float((unsigned)b); t3 += __uint_as_float((unsigned)(b >> 32)); }
            const float s = 1.0f / sqrtf(t0 * (1.0f / DM) + EPS);
            const float q1 = t1 + 2.0f * s * t2 + s * s * t3;
            S2[tid] = (f32x2){s, 1.0f / sqrtf(fmaxf(q1, 0.f) * (1.0f / DM) + EPS)};
        }
        asm volatile("s_waitcnt lgkmcnt(0)" ::: "memory"); __builtin_amdgcn_s_barrier(); asm volatile("" ::: "memory");
#pragma unroll
        for (int ai = 0; ai < 2; ++ai)
#pragma unroll
            for (int m = 0; m < 4; ++m) {
                const int rl = ai * 128 + wr * 64 + m * 16 + fr; const size_t roff = (size_t)(u.pm * 256 + rl) * DM + col0;
                const f32x2 sr = S2[rl];
#pragma unroll
                for (int bj = 0; bj < 2; ++bj) { f32x4 x[2]; load_x(x, roff + bj * 128);
                    f32x4 x1[2];
#pragma unroll
                    for (int n = 0; n < 2; ++n) x1[n] = x[n] + acc[ai][bj][m][n] * sr.x;
                    if constexpr (LAST) { *(f32x4*)(xof + roff + bj * 128) = x1[0]; *(f32x4*)(xof + roff + bj * 128 + 4) = x1[1]; }
                    else {
                        u32x4 w; w.x = cvt_pk_bf16(x1[0][0], x1[0][1]); w.y = cvt_pk_bf16(x1[0][2], x1[0][3]); w.z = cvt_pk_bf16(x1[1][0], x1[1][1]); w.w = cvt_pk_bf16(x1[1][2], x1[1][3]);
                        *(u32x4*)(xo16 + roff + bj * 128) = w;
                        const f32x4 a0 = x1[0] * *(const f32x4*)(gnext + col0 + bj * 128) * sr.y, a1 = x1[1] * *(const f32x4*)(gnext + col0 + bj * 128 + 4) * sr.y;
                        u32x4 wa; wa.x = cvt_pk_bf16(a0[0], a0[1]); wa.y = cvt_pk_bf16(a0[2], a0[3]); wa.z = cvt_pk_bf16(a1[0], a1[1]); wa.w = cvt_pk_bf16(a1[2], a1[3]);
                        *(u32x4*)(aout + roff + bj * 128) = wa;
                    }
                }
            }
        asm volatile("s_waitcnt lgkmcnt(0)" ::: "memory");
    }
};
struct EpiGlu {
    static constexpr bool PERM = true; static __device__ __forceinline__ int perm(int rho) { return perm32(rho); }
    bf16_t* O; const float* bias; float* ss; float* sacc; int ktiles;
    __device__ __forceinline__ void operator()(const f32x4 (&acc)[2][2][4][2], const Unit& u, int wr, int wc, int fr, int fq) const {
        if (u.nkt != ktiles) {
            const int slice = u.kt0 / u.nkt;
#pragma unroll
            for (int ai = 0; ai < 2; ++ai)
#pragma unroll
                for (int m = 0; m < 4; ++m) {
                    const int r = u.pm * 256 + ai * 128 + wr * 64 + m * 16 + fr - MP; float* sp = sacc + ((size_t)slice * MS + r) * (2 * DM) + u.pn * 256 + wc * 32 + 8 * fq;
#pragma unroll
                    for (int bj = 0; bj < 2; ++bj) { *(f32x4*)(sp + bj * 128) = acc[ai][bj][m][0]; *(f32x4*)(sp + bj * 128 + 4) = acc[ai][bj][m][1]; }
                }
            return;
        }
        const int oc0 = u.pn * 128 + wc * 32 + 8 * fq;
        f32x4 ba[2], bg[2];
#pragma unroll
        for (int n = 0; n < 2; ++n) { ba[n] = *(const f32x4*)(bias + oc0 + 4 * n); bg[n] = *(const f32x4*)(bias + DM + oc0 + 4 * n); }
#pragma unroll
        for (int ai = 0; ai < 2; ++ai)
#pragma unroll
            for (int m = 0; m < 4; ++m) {
                const int r = u.pm * 256 + ai * 128 + wr * 64 + m * 16 + fr; float s = 0.f; f32x4 o[2];
#pragma unroll
                for (int n = 0; n < 2; ++n) { const f32x4 a = acc[ai][0][m][n] + ba[n], g = acc[ai][1][m][n] + bg[n];
#pragma unroll
                    for (int j = 0; j < 4; ++j) { o[n][j] = a[j] * sigmoid_f(g[j]); s += o[n][j] * o[n][j]; } }
                u32x4 w; w.x = cvt_pk_bf16(o[0][0], o[0][1]); w.y = cvt_pk_bf16(o[0][2], o[0][3]); w.z = cvt_pk_bf16(o[1][0], o[1][1]); w.w = cvt_pk_bf16(o[1][2], o[1][3]);
                *(u32x4*)(O + (size_t)r * DM + oc0) = w;
                s += __shfl_xor(s, 16); s += __shfl_xor(s, 32);
                if (fq == 0) ss[(size_t)r * 32 + u.pn * 4 + wc] = s;
            }
    }
};
struct EpiUp {
    static constexpr bool PERM = true; static __device__ __forceinline__ int perm(int rho) { return perm32(rho); }
    bf16_t* G; bf16_t* E; const float* cw; const float* cb;
    __device__ __forceinline__ void operator()(f32x4 (&acc)[2][2][4][2], const Unit& u, int wr, int wc, int fr, int fq) const {
        const int oc0 = u.pn * 128 + wc * 32 + 8 * fq;
        {
            const int e = (fr < 2) ? fr : fr - 12; const int msel = (fr < 2) ? 0 : 3;
            if (fr < 2 || fr >= 14) {
#pragma unroll
                for (int ai = 0; ai < 2; ++ai) {
                    const int seg = u.pm * 4 + ai * 2 + wr; bf16_t* eb = E + ((size_t)seg * 4 + e) * FF2 + oc0;
#pragma unroll
                    for (int bj = 0; bj < 2; ++bj)
#pragma unroll
                        for (int n = 0; n < 2; ++n) { const f32x4 v = (msel == 0) ? acc[ai][bj][0][n] : acc[ai][bj][3][n]; u32x2 w; w.x = cvt_pk_bf16(v[0], v[1]); w.y = cvt_pk_bf16(v[2], v[3]); *(u32x2*)(eb + bj * FF + 4 * n) = w; }
                }
            }
        }
        f32x4 pw0[2][2], pw1[2][2], pw2[2][2], pbb[2][2];
#pragma unroll
        for (int n = 0; n < 2; ++n)
#pragma unroll
            for (int bj = 0; bj < 2; ++bj) { const float* cwp = cw + bj * FF + oc0 + 4 * n;
                pw0[n][bj] = *(const f32x4*)(cwp); pw1[n][bj] = *(const f32x4*)(cwp + FF2); pw2[n][bj] = *(const f32x4*)(cwp + 2 * FF2); pbb[n][bj] = *(const f32x4*)(cb + bj * FF + oc0 + 4 * n); }
#pragma unroll
        for (int n = 0; n < 2; ++n) {
#pragma unroll
            for (int bj = 0; bj < 2; ++bj) {
                const f32x4 w0 = pw0[n][bj], w1 = pw1[n][bj], w2 = pw2[n][bj], bb = pbb[n][bj];
                f32x4 w1z, w0z;
#pragma unroll
                for (int j = 0; j < 4; ++j) { w1z[j] = (fr == 0) ? w1[j] : 0.f; w0z[j] = (fr < 2) ? w0[j] : 0.f; }
#pragma unroll
                for (int ai = 0; ai < 2; ++ai)
#pragma unroll
                    for (int m = 3; m >= 0; --m) {
                        const f32x4 v = acc[ai][bj][m][n];
                        f32x4 c = bb + w2 * v;
#pragma unroll
                        for (int j = 0; j < 4; ++j) FMAC_DPP(c[j], v[j], w1[j], "row_shr:1");
#pragma unroll
                        for (int j = 0; j < 4; ++j) FMAC_DPP(c[j], v[j], w0[j], "row_shr:2");
                        if (m > 0) {
#pragma unroll
                            for (int j = 0; j < 4; ++j) FMAC_DPP(c[j], acc[ai][bj][m - 1][n][j], w1z[j], "row_ror:1");
#pragma unroll
                            for (int j = 0; j < 4; ++j) FMAC_DPP(c[j], acc[ai][bj][m - 1][n][j], w0z[j], "row_ror:2");
                        }
                        acc[ai][bj][m][n] = c;
                    }
            }
        }
#pragma unroll
        for (int ai = 0; ai < 2; ++ai)
#pragma unroll
            for (int m = 0; m < 4; ++m) {
                const int r = u.pm * 256 + ai * 128 + wr * 64 + m * 16 + fr;
                f32x2 o[4];
#pragma unroll
                for (int n = 0; n < 2; ++n)
#pragma unroll
                    for (int h = 0; h < 2; ++h) o[2 * n + h] = gelu_gate_pk((f32x2){acc[ai][0][m][n][2 * h], acc[ai][0][m][n][2 * h + 1]}, (f32x2){acc[ai][1][m][n][2 * h], acc[ai][1][m][n][2 * h + 1]});
                u32x4 w; w.x = cvt_pk_bf16(o[0].x, o[0].y); w.y = cvt_pk_bf16(o[1].x, o[1].y); w.z = cvt_pk_bf16(o[2].x, o[2].y); w.w = cvt_pk_bf16(o[3].x, o[3].y);
                if (!(m == 0 && fr < 2)) *(u32x4*)(G + (size_t)r * FF + oc0) = w;
            }
    }
};
}

#ifndef PROBE_REPMASK
#define PROBE_REPMASK 0
#endif
struct Args { const float* in[30]; float* out; unsigned char* ws; int ph_lo, ph_hi, coop, repmask; };
constexpr int NPHASE = 16;
constexpr int LDS_BYTES = 155648;
constexpr int XL_OFF = 131072, XL_MISC = 131072 + 16384 + 2048 + 128;

__device__ __forceinline__ unsigned f2bf(float f) { unsigned u = __builtin_bit_cast(unsigned, f); return (u + 0x7fffu + ((u >> 16) & 1u)) >> 16; }
__device__ __forceinline__ unsigned pk2(float lo, float hi) { return f2bf(lo) | (f2bf(hi) << 16); }
__device__ __forceinline__ void transpose_item(const float* W, int K, int N, bf16_t* WT, int pair_half, LAS float* scr, int item, int lane) {
    const int nblk = N / 32, kb = item / nblk, nb = item % nblk, k0 = 64 * kb, n0 = 32 * nb;
#pragma unroll 8
    for (int i = 0; i < 32; ++i) { const int kk = 2 * i + (lane >> 5); scr[kk * 33 + (lane & 31)] = W[(size_t)(k0 + kk) * N + n0 + (lane & 31)]; }
    asm volatile("s_waitcnt lgkmcnt(0)" ::: "memory");
    int r0 = n0;
    if (pair_half > 0) { const int half = n0 / pair_half, c = n0 % pair_half; r0 = 256 * (c / 128) + 128 * half + (c % 128); }
    const int c = lane & 7;
#pragma unroll
    for (int j = 0; j < 4; ++j) { const int n = (lane >> 3) + 8 * j; const LAS float* s = scr + (8 * c) * 33 + n;
        u32x4 o; o.x = pk2(s[0 * 33], s[1 * 33]); o.y = pk2(s[2 * 33], s[3 * 33]); o.z = pk2(s[4 * 33], s[5 * 33]); o.w = pk2(s[6 * 33], s[7 * 33]);
        *(u32x4*)(WT + (size_t)(r0 + n) * K + k0 + 8 * c) = o; }
    asm volatile("s_waitcnt lgkmcnt(0)" ::: "memory");
}

template <bool HAS_M, bool HAS_NEXT, bool XIN_F32, bool XOUT_F32, bool M_F32 = false, bool M_GLU = false>
__device__ __forceinline__ void row_pass(const void* xin, void* xout, const bf16_t* mrow, const float* ssrow, int nslots, const float* gpost, const float* gnext, bf16_t* arow, int lane, const float* saccrow = nullptr, const float* mbias = nullptr) {
    f32x4 v[4];
#pragma unroll
    for (int j = 0; j < 4; ++j) {
        if constexpr (XIN_F32) v[j] = *((const f32x4*)xin + lane + 64 * j);
        else { const u32x2 xw = *((const u32x2*)xin + lane + 64 * j); v[j][0] = __uint_as_float(xw.x << 16); v[j][1] = __uint_as_float(xw.x & 0xffff0000u); v[j][2] = __uint_as_float(xw.y << 16); v[j][3] = __uint_as_float(xw.y & 0xffff0000u); }
    }
    if constexpr (HAS_M) {
        f32x4 mv[4]; float s;
        if constexpr (M_GLU) {
            s = 0.f;
#pragma unroll
            for (int j = 0; j < 4; ++j) { const int oc = 4 * (lane + 64 * j), base = 256 * (oc >> 7) + (oc & 127);
                f32x4 a = *(const f32x4*)(mbias + oc), g = *(const f32x4*)(mbias + DM + oc);
                for (int sl = 0; sl < nslots; ++sl) { a += *(const f32x4*)(saccrow + (size_t)sl * MS * 2 * DM + base); g += *(const f32x4*)(saccrow + (size_t)sl * MS * 2 * DM + base + 128); }
#pragma unroll
                for (int q = 0; q < 4; ++q) mv[j][q] = a[q] * sigmoid_f(g[q]);
                s += (mv[j][0] * mv[j][0] + mv[j][1] * mv[j][1]) + (mv[j][2] * mv[j][2] + mv[j][3] * mv[j][3]); }
        } else if constexpr (M_F32) {
            s = 0.f;
#pragma unroll
            for (int j = 0; j < 4; ++j) { mv[j] = mbias ? *((const f32x4*)mbias + lane + 64 * j) : (f32x4){0.f, 0.f, 0.f, 0.f};
                for (int sl = 0; sl < nslots; ++sl) mv[j] += *((const f32x4*)(saccrow + (size_t)sl * MS * DM) + lane + 64 * j);
                s += (mv[j][0] * mv[j][0] + mv[j][1] * mv[j][1]) + (mv[j][2] * mv[j][2] + mv[j][3] * mv[j][3]); }
        } else {
            s = (lane < nslots) ? ssrow[lane] : 0.f;
#pragma unroll
            for (int j = 0; j < 4; ++j) { const u32x2 mw = *((const u32x2*)mrow + lane + 64 * j);
                mv[j][0] = __uint_as_float(mw.x << 16); mv[j][1] = __uint_as_float(mw.x & 0xffff0000u); mv[j][2] = __uint_as_float(mw.y << 16); mv[j][3] = __uint_as_float(mw.y & 0xffff0000u); }
        }
        s = wave_sum(s);
        const float rstd = 1.0f / sqrtf(s * (1.0f / DM) + EPS);
#pragma unroll
        for (int j = 0; j < 4; ++j) {
            const f32x4 gp = *((const f32x4*)gpost + lane + 64 * j);
            v[j] += mv[j] * rstd * gp;
            if constexpr (XOUT_F32) *((f32x4*)xout + lane + 64 * j) = v[j];
            else { u32x2 w; w.x = cvt_pk_bf16(v[j][0], v[j][1]); w.y = cvt_pk_bf16(v[j][2], v[j][3]); *((u32x2*)xout + lane + 64 * j) = w; }
        }
    }
    if constexpr (HAS_NEXT) {
        float s2 = 0.f;
#pragma unroll
        for (int j = 0; j < 4; ++j) s2 += (v[j][0] * v[j][0] + v[j][1] * v[j][1]) + (v[j][2] * v[j][2] + v[j][3] * v[j][3]);
        s2 = wave_sum(s2);
        const float rstd2 = 1.0f / sqrtf(s2 * (1.0f / DM) + EPS);
#pragma unroll
        for (int j = 0; j < 4; ++j) { const f32x4 gn = *((const f32x4*)gnext + lane + 64 * j);
            u32x2 w; w.x = cvt_pk_bf16(v[j][0] * rstd2 * gn[0], v[j][1] * rstd2 * gn[1]); w.y = cvt_pk_bf16(v[j][2] * rstd2 * gn[2], v[j][3] * rstd2 * gn[3]);
            *((u32x2*)arow + lane + 64 * j) = w; }
    }
}

__device__ __forceinline__ s16x4 vtr(LAS const unsigned char* p) { return __builtin_bit_cast(s16x4, __builtin_amdgcn_ds_read_tr16_b64_v4i16((LAS s16x4*)p)); }
__device__ __forceinline__ void attn_unit_coords(int u, int& qrow0, int& krow0, int& kb0, int& kvh) {
    if (u < NB * 128) { const int b = u >> 7, rem = u & 127, c = rem >> 2; kvh = rem & 3; qrow0 = b * SEQ + c * 64; krow0 = qrow0 - 128; kb0 = c >= 2 ? 0 : 2 * (2 - c); }
    else { const int u2 = u - NB * 128, b = u2 >> 2; kvh = u2 & 3; qrow0 = MP + b * 64; krow0 = MP + b * 192; kb0 = 0; }
}
__device__ __forceinline__ void attn_phase(LAS unsigned char* lds, const bf16_t* Qb, const bf16_t* Kb, const bf16_t* Vb, bf16_t* Ob, const float* sinks, int G, int blk) {
    const int tid = threadIdx.x, lane = tid & 63, w = __builtin_amdgcn_readfirstlane(tid >> 6), r32 = lane & 31, hi = lane >> 5;
    constexpr int KST = 144, VST = 192, KOFF = 0, VOFF = 192 * KST, OOFF = VOFF + 192 * VST, OST = 136;
    constexpr int NUNITS = NB * 32 * 4 + DB * 4;
    LAS unsigned char* ostage = lds + OOFF + w * (32 * OST);
    u32x4 kreg[3], vreg[3]; bf16x8 qnext[4];
    int qrow0 = 0, krow0 = 0, kb0 = 0, kvh = 0;
#define ATTN_LOAD(UU) do { int q0_, k0_, b0_, h0_; attn_unit_coords((UU), q0_, k0_, b0_, h0_); \
        _Pragma("unroll") for (int i = 0; i < 3; ++i) { const int p_ = tid + 512 * i, row_ = p_ >> 3, ch_ = p_ & 7; \
            if (row_ >= b0_ * 32) { const size_t go_ = (size_t)(k0_ + row_) * 256 + h0_ * 64 + ch_ * 8; kreg[i] = *(const u32x4*)(Kb + go_); vreg[i] = *(const u32x4*)(Vb + go_); } } \
        { const size_t qr_ = (size_t)q0_ + (w & 1) * 32 + r32; const int hq_ = h0_ * 4 + (w >> 1); \
          _Pragma("unroll") for (int dk = 0; dk < 4; ++dk) qnext[dk] = *(const bf16x8*)(Qb + qr_ * DM + hq_ * 64 + dk * 16 + hi * 8); } } while (0)
    if (blk < NUNITS) ATTN_LOAD(blk);
    for (int u = blk; u < NUNITS; u += G) {
        attn_unit_coords(u, qrow0, krow0, kb0, kvh);
        __syncthreads();
#pragma unroll
        for (int i = 0; i < 3; ++i) { const int p = tid + 512 * i, row = p >> 3, ch = p & 7;
            if (row >= kb0 * 32) { *(LAS u32x4*)(lds + KOFF + row * KST + ch * 16) = kreg[i]; *(LAS u32x4*)(lds + VOFF + row * VST + ch * 16) = vreg[i]; } }
        bf16x8 qf[4];
#pragma unroll
        for (int dk = 0; dk < 4; ++dk) qf[dk] = qnext[dk];
        const int hq = kvh * 4 + (w >> 1); const size_t qrowb = (size_t)qrow0 + (w & 1) * 32;
        __syncthreads();
        if (u + G < NUNITS) ATTN_LOAD(u + G);
        f32x16 sc[6];
        float mx = -3.0e38f;
#pragma unroll
        for (int kb = 0; kb < 6; ++kb) {
            if (kb >= kb0) {
                f32x16 a = {};
#pragma unroll
                for (int dk = 0; dk < 4; ++dk) { const bf16x8 kf = *(const LAS bf16x8*)(lds + KOFF + (32 * kb + r32) * KST + (dk * 16 + hi * 8) * 2); a = __builtin_amdgcn_mfma_f32_32x32x16_bf16(kf, qf[dk], a, 0, 0, 0); }
#pragma unroll
                for (int r = 0; r < 16; ++r) mx = fmaxf(mx, a[r]);
                sc[kb] = a;
            }
        }
        mx = fmaxf(mx, __shfl_xor(mx, 32));
        const float sinkl = sinks[hq] * LOG2E; mx = fmaxf(mx, sinkl);
        float ls = 0.f;
#pragma unroll
        for (int kb = 0; kb < 6; ++kb) {
            if (kb >= kb0) {
#pragma unroll
                for (int r = 0; r < 16; ++r) { const float p = __builtin_amdgcn_exp2f(sc[kb][r] - mx); sc[kb][r] = p; ls += p; }
            }
        }
        ls += __shfl_xor(ls, 32);
        const float inv = 1.0f / (ls + __builtin_amdgcn_exp2f(sinkl - mx));
        f32x16 o[2]; o[0] = f32x16{}; o[1] = f32x16{};
        const int vlane = VOFF + (4 * hi + ((lane >> 2) & 3)) * VST + (16 * ((lane >> 4) & 1) + 4 * (lane & 3)) * 2;
#pragma unroll
        for (int kb = 0; kb < 6; ++kb) {
            if (kb >= kb0) {
#pragma unroll
                for (int s = 0; s < 2; ++s) {
                    u32x4 pw; pw.x = cvt_pk_bf16(sc[kb][8 * s + 0], sc[kb][8 * s + 1]); pw.y = cvt_pk_bf16(sc[kb][8 * s + 2], sc[kb][8 * s + 3]); pw.z = cvt_pk_bf16(sc[kb][8 * s + 4], sc[kb][8 * s + 5]); pw.w = cvt_pk_bf16(sc[kb][8 * s + 6], sc[kb][8 * s + 7]);
                    const bf16x8 pf = __builtin_bit_cast(bf16x8, pw);
#pragma unroll
                    for (int db = 0; db < 2; ++db) {
                        LAS const unsigned char* vp = lds + vlane + (32 * kb + 16 * s) * VST + db * 64;
                        const s16x4 lo = vtr(vp), h4 = vtr(vp + 8 * VST);
                        const bf16x8 vf = (bf16x8){lo[0], lo[1], lo[2], lo[3], h4[0], h4[1], h4[2], h4[3]};
                        o[db] = __builtin_amdgcn_mfma_f32_32x32x16_bf16(vf, pf, o[db], 0, 0, 0);
                    }
                }
            }
        }
#pragma unroll
        for (int db = 0; db < 2; ++db)
#pragma unroll
            for (int rq = 0; rq < 4; ++rq) {
                u32x2 wv; wv.x = cvt_pk_bf16(o[db][4 * rq] * inv, o[db][4 * rq + 1] * inv); wv.y = cvt_pk_bf16(o[db][4 * rq + 2] * inv, o[db][4 * rq + 3] * inv);
                *(LAS u32x2*)(ostage + r32 * OST + (32 * db + 8 * rq + 4 * hi) * 2) = wv;
            }
        asm volatile("s_waitcnt lgkmcnt(0)" ::: "memory");
#pragma unroll
        for (int i = 0; i < 4; ++i) { const int row = i * 8 + (lane >> 3), ch = lane & 7;
            const u32x2 a = *(const LAS u32x2*)(ostage + row * OST + ch * 16), b = *(const LAS u32x2*)(ostage + row * OST + ch * 16 + 8);
            u32x4 v; v.x = a.x; v.y = a.y; v.z = b.x; v.w = b.y;
            *(u32x4*)(Ob + (qrowb + row) * DM + hq * 64 + ch * 8) = v; }
        asm volatile("s_waitcnt lgkmcnt(0)" ::: "memory");
    }
#undef ATTN_LOAD
}

struct SsmP { const float *lam_re, *lam_im, *log_dt, *b_re, *b_im, *c_re, *c_im, *dsk, *st_re, *st_im; float *o_rep, *o_imp, *o_res, *o_ims; };
__device__ __forceinline__ void ssm_phase(LAS unsigned char* lds, const bf16_t* A3, bf16_t* Z, const SsmP P, int G, int blk) {
    const int tid = threadIdx.x, lane = tid & 63, w = __builtin_amdgcn_readfirstlane(tid >> 6), p = lane & 31, hi = lane >> 5;
    const int q = w >> 1, role = w & 1;
    constexpr int IST = 72, IMG = 128 * IST;
    LAS unsigned char* img0 = lds + q * (2 * IMG);
    for (int pass = 0; pass < 2; ++pass) {
        const bool samp = (pass == 0);
        const int nunits = samp ? (DB / 2) * 64 : (NB / 2) * 64, T = samp ? DS : SEQ;
        for (int uu = blk * 4 + q; uu < nunits; uu += G * 4) {
            const int bp = uu >> 6, g = uu & 63;
            const int rowbase0 = samp ? MP + (2 * bp) * DS : (2 * bp) * SEQ, bstride = T;
            const float dt = expf(P.log_dt[g]);
            const int ps = g * 64 + p + 32 * role; const float lr = P.lam_re[ps], li = P.lam_im[ps];
            const float mag = expf(lr * dt); const float lbr = mag * cosf(li * dt), lbi = mag * sinf(li * dt);
            const float nr0 = lbr - 1.0f, ni0 = lbi, den = lr * lr + li * li;
            const float zr = (nr0 * lr + ni0 * li) / den, zi = (ni0 * lr - nr0 * li) / den;
            float hr = 0.f, hm = 0.f;
            const int so = ((2 * bp + hi) * 64 + g) * 64 + p + 32 * role;
            if (samp) { hr = P.st_re[so]; hm = P.st_im[so]; }
            bf16x8 bfre, bfim;
            {
                const float* br = P.b_re + ((size_t)ps) * 16 + 8 * hi; const float* bi = P.b_im + ((size_t)ps) * 16 + 8 * hi;
                const f32x4 br0 = *(const f32x4*)br, br1 = *(const f32x4*)(br + 4), bi0 = *(const f32x4*)bi, bi1 = *(const f32x4*)(bi + 4);
                u32x4 wre, wim;
                wre.x = cvt_pk_bf16(zr * br0[0] - zi * bi0[0], zr * br0[1] - zi * bi0[1]); wre.y = cvt_pk_bf16(zr * br0[2] - zi * bi0[2], zr * br0[3] - zi * bi0[3]);
                wre.z = cvt_pk_bf16(zr * br1[0] - zi * bi1[0], zr * br1[1] - zi * bi1[1]); wre.w = cvt_pk_bf16(zr * br1[2] - zi * bi1[2], zr * br1[3] - zi * bi1[3]);
                wim.x = cvt_pk_bf16(zr * bi0[0] + zi * br0[0], zr * bi0[1] + zi * br0[1]); wim.y = cvt_pk_bf16(zr * bi0[2] + zi * br0[2], zr * bi0[3] + zi * br0[3]);
                wim.z = cvt_pk_bf16(zr * bi1[0] + zi * br1[0], zr * bi1[1] + zi * br1[1]); wim.w = cvt_pk_bf16(zr * bi1[2] + zi * br1[2], zr * bi1[3] + zi * br1[3]);
                bfre = __builtin_bit_cast(bf16x8, wre); bfim = __builtin_bit_cast(bf16x8, wim);
            }
            const int ci = lane & 15, kg = lane >> 4;
            bf16x8 cfrag[4];
#pragma unroll
            for (int kb = 0; kb < 4; ++kb) {
                const float* cp = ((kb < 2) ? P.c_re : P.c_im) + ((size_t)(g * 16 + ci)) * 64 + 32 * (kb & 1) + 8 * kg; const float sg = (kb < 2) ? 1.f : -1.f;
                const f32x4 c0 = *(const f32x4*)cp, c1 = *(const f32x4*)(cp + 4);
                u32x4 wc_; wc_.x = cvt_pk_bf16(sg * c0[0], sg * c0[1]); wc_.y = cvt_pk_bf16(sg * c0[2], sg * c0[3]); wc_.z = cvt_pk_bf16(sg * c1[0], sg * c1[1]); wc_.w = cvt_pk_bf16(sg * c1[2], sg * c1[3]);
                cfrag[kb] = __builtin_bit_cast(bf16x8, wc_);
            }
            const f32x4 dsk4 = *(const f32x4*)(P.dsk + g * 16 + 4 * kg);
            const int hip = (p >> 2) & 1, jp = (p & 3) + 4 * (p >> 3);
            const bf16_t* uptr = A3 + ((size_t)(rowbase0 + hip * bstride + jp)) * DM + g * 16 + 8 * hi;
            const size_t yoff = ((size_t)(rowbase0 + role * bstride + ci)) * DM + g * 16 + 4 * kg;
            const int nblk = T / 16;
            bf16x8 ufA = *(const bf16x8*)uptr, ufB = *(const bf16x8*)(uptr + (size_t)16 * DM), ufC = *(const bf16x8*)(uptr + (size_t)32 * DM);
            u32x2 unA = *(const u32x2*)(A3 + yoff), unB = *(const u32x2*)(A3 + yoff + (size_t)16 * DM), unC = *(const u32x2*)(A3 + yoff + (size_t)32 * DM);
            for (int tb = 0; tb < nblk; ++tb) {
                LAS unsigned char* img = img0 + (tb & 1) * IMG;
                const bf16x8 ucur = ufA; const u32x2 uw = unA;
                ufA = ufB; unA = unB; ufB = ufC; unB = unC;
                if (tb + 3 < nblk) { ufC = *(const bf16x8*)(uptr + (size_t)(tb + 3) * 16 * DM); unC = *(const u32x2*)(A3 + yoff + (size_t)(tb + 3) * 16 * DM); }
                f32x16 Xr, Xi;
                { f32x16 z = {}; Xr = __builtin_amdgcn_mfma_f32_32x32x16_bf16(ucur, bfre, z, 0, 0, 0); Xi = __builtin_amdgcn_mfma_f32_32x32x16_bf16(ucur, bfim, z, 0, 0, 0); }
#pragma unroll
                for (int r = 0; r < 16; ++r) {
                    const float nr = lbr * hr - lbi * hm + Xr[r];
                    const float ni = lbr * hm + lbi * hr + Xi[r];
                    hr = nr; hm = ni; Xr[r] = nr; Xi[r] = ni;
                }
#pragma unroll
                for (int q4 = 0; q4 < 4; ++q4) {
                    u32x2 wr_, wi_; wr_.x = cvt_pk_bf16(Xr[4 * q4], Xr[4 * q4 + 1]); wr_.y = cvt_pk_bf16(Xr[4 * q4 + 2], Xr[4 * q4 + 3]); wi_.x = cvt_pk_bf16(Xi[4 * q4], Xi[4 * q4 + 1]); wi_.y = cvt_pk_bf16(Xi[4 * q4 + 2], Xi[4 * q4 + 3]);
                    *(LAS u32x2*)(img + (role * 32 + p) * IST + (16 * hi + 4 * q4) * 2) = wr_;
                    *(LAS u32x2*)(img + ((2 + role) * 32 + p) * IST + (16 * hi + 4 * q4) * 2) = wi_;
                }
                asm volatile("s_waitcnt lgkmcnt(0)\n\ts_barrier" ::: "memory");
                f32x4 y = {0.f, 0.f, 0.f, 0.f};
#pragma unroll
                for (int kb = 0; kb < 4; ++kb) {
                    LAS const unsigned char* ap = img + (32 * kb + 8 * kg + (ci >> 2)) * IST + (16 * role + 4 * (ci & 3)) * 2;
                    const s16x4 lo = vtr(ap), h4 = vtr(ap + 4 * IST);
                    const bf16x8 af = (bf16x8){lo[0], lo[1], lo[2], lo[3], h4[0], h4[1], h4[2], h4[3]};
                    y = __builtin_amdgcn_mfma_f32_16x16x32_bf16(cfrag[kb], af, y, 0, 0, 0);
                }
                const float z0 = gelu_tanh(y[0] + dsk4[0] * __uint_as_float(uw.x << 16)), z1 = gelu_tanh(y[1] + dsk4[1] * __uint_as_float(uw.x & 0xffff0000u));
                const float z2 = gelu_tanh(y[2] + dsk4[2] * __uint_as_float(uw.y << 16)), z3 = gelu_tanh(y[3] + dsk4[3] * __uint_as_float(uw.y & 0xffff0000u));
                u32x2 zw; zw.x = cvt_pk_bf16(z0, z1); zw.y = cvt_pk_bf16(z2, z3);
                *(u32x2*)(Z + yoff + (size_t)tb * 16 * DM) = zw;
                asm volatile("s_waitcnt lgkmcnt(0)" ::: "memory");
            }
            if (samp) { P.o_res[so] = hr; P.o_ims[so] = hm; } else { P.o_rep[so] = hr; P.o_imp[so] = hm; }
        }
        __syncthreads();
    }
}

#define XB_TMO      128
#define XB_XCNT(j)  (256  + 64 * (j))
#define XB_XSUB(j)  (1280 + 64 * (j))
#define XB_XGEN(j)  (2304 + 64 * (j))
#define XB_TOP      3328
#define XB_TOPGEN   3392
#define XCD_BAR_WORDS 3456
#define XB_SPIN_CAP (1u << 18)
__device__ __forceinline__ unsigned xb_ld(unsigned* p)              { return __hip_atomic_load(p, __ATOMIC_RELAXED, __HIP_MEMORY_SCOPE_AGENT); }
__device__ __forceinline__ unsigned xb_add(unsigned* p, unsigned v) { return __hip_atomic_fetch_add(p, v, __ATOMIC_RELAXED, __HIP_MEMORY_SCOPE_AGENT); }
__device__ __forceinline__ unsigned xb_xcc_id() { return (unsigned)__builtin_amdgcn_s_getreg((3 << 11) | 20) & 0xFu; }
#define XB_SPIN(cond, bar) do { unsigned _sp = 0; while (cond) { __builtin_amdgcn_s_sleep(1); \
    if ((++_sp & 255u) == 0u) { if (xb_ld(&(bar)[XB_TMO])) break; if (_sp > XB_SPIN_CAP) { atomicAdd(&(bar)[XB_TMO], 1u); break; } } } } while (0)
struct XcdBarrier { unsigned* bar; unsigned x; volatile LAS unsigned* st; };
__device__ __forceinline__ XcdBarrier xcd_barrier_post(unsigned* bar, volatile LAS unsigned* st) {
    XcdBarrier b; b.bar = bar; b.x = xb_xcc_id(); b.st = st;
    if (threadIdx.x == 0) (void)xb_add(&bar[XB_XCNT(b.x)], 1u);
    return b;
}
__device__ __forceinline__ void xcd_barrier_complete(unsigned* bar, unsigned x, unsigned& nloc, unsigned& nx) {
    const unsigned G = gridDim.x * gridDim.y * gridDim.z;
    unsigned sum, cnt, mine, sp = 0u;
    for (;;) {
        sum = 0u; cnt = 0u; mine = 0u;
#pragma unroll
        for (unsigned j = 0; j < 16; ++j) { const unsigned c = xb_ld(&bar[XB_XCNT(j)]); sum += c; cnt += (c > 0u) ? 1u : 0u; mine = (j == x) ? c : mine; }
        if (sum == G) break;
        __builtin_amdgcn_s_sleep(1);
        if ((++sp & 255u) == 0u) { if (xb_ld(&bar[XB_TMO])) break; if (sp > XB_SPIN_CAP) { atomicAdd(&bar[XB_TMO], 1u); break; } }
    }
    nloc = mine > 0u ? mine : 1u; nx = cnt > 0u ? cnt : 1u;
}
__device__ __forceinline__ void xcd_barrier(const XcdBarrier& b) {
    asm volatile("s_waitcnt vmcnt(0)" ::: "memory");
    __syncthreads();
    if (threadIdx.x == 0) {
        unsigned* bar = b.bar;
        __builtin_amdgcn_s_waitcnt(0);
        unsigned nloc = b.st[0], nx = b.st[1];
        if (nloc == 0u) { xcd_barrier_complete(bar, b.x, nloc, nx); b.st[0] = nloc; b.st[1] = nx; }
        const unsigned old = xb_add(&bar[XB_XSUB(b.x)], 1u);
        const unsigned gen = old / nloc;
        if (old + 1u == (gen + 1u) * nloc) {
            __builtin_amdgcn_fence(__ATOMIC_RELEASE, "agent");
            asm volatile("s_waitcnt vmcnt(0)" ::: "memory");
            const unsigned og = xb_add(&bar[XB_TOP], 1u);
            const unsigned tg = og / nx;
            if (og + 1u == (tg + 1u) * nx) xb_add(&bar[XB_TOPGEN], 1u);
            else XB_SPIN(xb_ld(&bar[XB_TOPGEN]) == tg, bar);
            __builtin_amdgcn_fence(__ATOMIC_ACQUIRE, "agent");
            xb_add(&bar[XB_XGEN(b.x)], 1u);
            asm volatile("s_waitcnt vmcnt(0)" ::: "memory");
        } else {
            XB_SPIN(xb_ld(&bar[XB_XGEN(b.x)]) == gen, bar);
            __builtin_amdgcn_fence(__ATOMIC_ACQUIRE, "agent");
            asm volatile("s_waitcnt vmcnt(0)" ::: "memory");
        }
    }
    __syncthreads();
}

#ifndef UP_WGM
#define UP_WGM 4
#endif
__device__ __forceinline__ void phase_prologue(LAS unsigned char* lds, const Args& args, unsigned char* ws, float* out, int G, int blk, int wave, int lane, int tid) {
    const int gw = blk * 8 + wave, NGW = G * 8;
    bf16_t* Wqkv = (bf16_t*)(ws + WS_WQKV); bf16_t* Wo = (bf16_t*)(ws + WS_WO); bf16_t* Wglu = (bf16_t*)(ws + WS_WGLU); bf16_t* Wup = (bf16_t*)(ws + WS_WUP); bf16_t* Wdn = (bf16_t*)(ws + WS_WDN);
    float* rope = (float*)(ws + WS_ROPE); bf16_t* Abuf = (bf16_t*)(ws + WS_A); bf16_t* Kbuf = (bf16_t*)(ws + WS_K); bf16_t* Vbuf = (bf16_t*)(ws + WS_V);
    LAS float* scr = (LAS float*)(lds + wave * 16384);
    constexpr int I_QKV = 16 * 48, I_O = 16 * 32, I_GLU = 16 * 64, I_UP = 16 * 176, I_DN = 44 * 32;
    constexpr int NITEMS = I_QKV + I_O + I_GLU + 2 * I_UP + 2 * I_DN;
    for (int it = gw; it < NITEMS; it += NGW) {
        int r = it;
        if (r < I_QKV) { transpose_item(args.in[11], DM, QKVD, Wqkv, 0, scr, r, lane); continue; } r -= I_QKV;
        if (r < I_O) { transpose_item(args.in[14], DM, DM, Wo, 0, scr, r, lane); continue; } r -= I_O;
        if (r < I_GLU) { transpose_item(args.in[24], DM, 2 * DM, Wglu, DM, scr, r, lane); continue; } r -= I_GLU;
        if (r < 2 * I_UP) { const int l = r / I_UP; transpose_item(args.in[26] + (size_t)l * DM * FF2, DM, FF2, Wup + (size_t)l * FF2 * DM, FF, scr, r % I_UP, lane); continue; } r -= 2 * I_UP;
        { const int l = r / I_DN; transpose_item(args.in[29] + (size_t)l * FF * DM, FF, DM, Wdn + (size_t)l * DM * FF, 0, scr, r % I_DN, lane); }
    }
    for (int i = blk * 512 + tid; i < SEQ * 8; i += G * 512) { const int pos = i >> 3, f = i & 7; const float inv_freq = powf(500000.0f, -(float)f * 0.125f); const float ang = (float)pos * inv_freq;
        rope[pos * 16 + f] = cosf(ang); rope[pos * 16 + 8 + f] = sinf(ang); }
    for (int i = blk * 512 + tid; i < DB * 128 * 64; i += G * 512) {
        const int b = i / (128 * 64), rem = i % (128 * 64), row = rem >> 6, c4 = (rem & 63) * 4;
        const f32x4 kv = *(const f32x4*)(args.in[2] + ((size_t)(b * 128 + row)) * 256 + c4), vv = *(const f32x4*)(args.in[3] + ((size_t)(b * 128 + row)) * 256 + c4);
        u32x2 kw, vw; kw.x = cvt_pk_bf16(kv[0], kv[1]); kw.y = cvt_pk_bf16(kv[2], kv[3]); vw.x = cvt_pk_bf16(vv[0], vv[1]); vw.y = cvt_pk_bf16(vv[2], vv[3]);
        const size_t krow = (size_t)MP + b * 192 + row;
        *(u32x2*)(Kbuf + krow * 256 + c4) = kw; *(u32x2*)(Vbuf + krow * 256 + c4) = vw;
        if (row >= 64) { *(f32x4*)(out + O_KS + ((size_t)(b * 128 + row - 64)) * 256 + c4) = kv; *(f32x4*)(out + O_VS + ((size_t)(b * 128 + row - 64)) * 256 + c4) = vv; }
    }
    {
        f32x4 gn[4], xa[4], xb_[4];
#define P0_C(j) (8 * lane + 512 * ((j) >> 1) + 4 * ((j) & 1))
#pragma unroll
        for (int j = 0; j < 4; ++j) gn[j] = *(const f32x4*)(args.in[7] + P0_C(j));
#define P0_X(mm) (((mm) < MP) ? args.in[0] + (size_t)(mm) * DM : args.in[1] + (size_t)((mm) - MP) * DM)
        int m = gw;
        if (m < MT) {
#pragma unroll
            for (int j = 0; j < 4; ++j) xa[j] = *(const f32x4*)(P0_X(m) + P0_C(j));
        }
        for (; m < MT; m += NGW) {
            const int mn = m + NGW;
            if (mn < MT) {
#pragma unroll
                for (int j = 0; j < 4; ++j) xb_[j] = *(const f32x4*)(P0_X(mn) + P0_C(j));
            }
            float s2 = 0.f;
#pragma unroll
            for (int j = 0; j < 4; ++j) s2 += (xa[j][0] * xa[j][0] + xa[j][1] * xa[j][1]) + (xa[j][2] * xa[j][2] + xa[j][3] * xa[j][3]);
            const float rstd2 = 1.0f / sqrtf(wave_sum(s2) * (1.0f / DM) + EPS);
#pragma unroll
            for (int j = 0; j < 2; ++j) *(u32x4*)(Abuf + (size_t)m * DM + 8 * lane + 512 * j) = pack8(xa[2 * j] * gn[2 * j] * rstd2, xa[2 * j + 1] * gn[2 * j + 1] * rstd2);
#pragma unroll
            for (int j = 0; j < 4; ++j) xa[j] = xb_[j];
        }
#undef P0_C
#undef P0_X
    }
}

template <bool XIN_F32>
__device__ __forceinline__ void rp_load(const void* xrow, const bf16_t* mrow, const float* ssrow, int nslots, int lane, f32x4 (&xf)[4], u32x4 (&xb)[2], u32x4 (&mw)[2], float& ssv) {
#pragma unroll
    for (int j = 0; j < 2; ++j) { const int c0 = 8 * lane + 512 * j;
        if constexpr (XIN_F32) { xf[2 * j] = __builtin_nontemporal_load((const f32x4*)((const float*)xrow + c0)); xf[2 * j + 1] = __builtin_nontemporal_load((const f32x4*)((const float*)xrow + c0 + 4)); }
        else xb[j] = *(const u32x4*)((const bf16_t*)xrow + c0);
        mw[j] = __builtin_nontemporal_load((const u32x4*)(mrow + c0));
    }
    ssv = (lane < nslots) ? ssrow[lane] : 0.f;
}
template <int MODE>
__device__ __forceinline__ void rp_finish(const f32x4 (&xf)[4], const u32x4 (&xb)[2], const u32x4 (&mw)[2], float ssv, const f32x4 (&gp)[4], const f32x4 (&gn)[4], void* xout, bf16_t* arow, int lane) {
    f32x4 v[4];
    const float rstd = 1.0f / sqrtf(wave_sum(ssv) * (1.0f / DM) + EPS);
    float s2 = 0.f;
#pragma unroll
    for (int j = 0; j < 2; ++j) { const int c0 = 8 * lane + 512 * j;
        if constexpr (MODE == 0) { v[2 * j] = xf[2 * j]; v[2 * j + 1] = xf[2 * j + 1]; } else unpack8(xb[j], v[2 * j], v[2 * j + 1]);
        f32x4 m0, m1; unpack8(mw[j], m0, m1);
        v[2 * j] += m0 * rstd * gp[2 * j]; v[2 * j + 1] += m1 * rstd * gp[2 * j + 1];
        if constexpr (MODE == 2) { *(f32x4*)((float*)xout + c0) = v[2 * j]; *(f32x4*)((float*)xout + c0 + 4) = v[2 * j + 1]; }
        else *(u32x4*)((bf16_t*)xout + c0) = pack8(v[2 * j], v[2 * j + 1]);
#pragma unroll
        for (int h = 0; h < 2; ++h) s2 += (v[2 * j + h][0] * v[2 * j + h][0] + v[2 * j + h][1] * v[2 * j + h][1]) + (v[2 * j + h][2] * v[2 * j + h][2] + v[2 * j + h][3] * v[2 * j + h][3]);
    }
    if constexpr (MODE != 2) {
        const float rstd2 = 1.0f / sqrtf(wave_sum(s2) * (1.0f / DM) + EPS);
#pragma unroll
        for (int j = 0; j < 2; ++j) *(u32x4*)(arow + 8 * lane + 512 * j) = pack8(v[2 * j] * gn[2 * j] * rstd2, v[2 * j + 1] * gn[2 * j + 1] * rstd2);
    }
}
template <int MODE>
__device__ __forceinline__ void phase_rows(const float* x_prompt, const float* x_sample, bf16_t* X16, float* out, const bf16_t* Mbuf, const float* ss, int nslots, const float* gpost, const float* gnext, bf16_t* Abuf, int gw, int NGW, int lane, const float* sacc, const float* mbias, int ns, bool skip_prompt, bool glu = false) {
    int m = gw;
    if (skip_prompt) m = gw + ((MP - gw + NGW - 1) / NGW) * NGW;
    else {
        f32x4 gp[4], gn[4];
#pragma unroll
        for (int j = 0; j < 4; ++j) { const int cg_ = 8 * lane + 512 * (j >> 1) + 4 * (j & 1); gp[j] = *(const f32x4*)(gpost + cg_); gn[j] = (MODE != 2) ? *(const f32x4*)(gnext + cg_) : (f32x4){0.f, 0.f, 0.f, 0.f}; }
        f32x4 xfA[4], xfB[4]; u32x4 xbA[2], xbB[2], mwA[2], mwB[2]; float ssA = 0.f, ssB = 0.f;
#define RP_X(mm) ((MODE == 0) ? (const void*)(x_prompt + (size_t)(mm) * DM) : (const void*)(X16 + (size_t)(mm) * DM))
        if (m < MP) rp_load<MODE == 0>(RP_X(m), Mbuf + (size_t)m * DM, ss + (size_t)m * 32, nslots, lane, xfA, xbA, mwA, ssA);
        for (; m < MP; m += NGW) {
            const int mn = m + NGW;
            if (mn < MP) rp_load<MODE == 0>(RP_X(mn), Mbuf + (size_t)mn * DM, ss + (size_t)mn * 32, nslots, lane, xfB, xbB, mwB, ssB);
            rp_finish<MODE>(xfA, xbA, mwA, ssA, gp, gn, (MODE == 2) ? (void*)(out + (size_t)m * DM) : (void*)(X16 + (size_t)m * DM), Abuf + (size_t)m * DM, lane);
#pragma unroll
            for (int j = 0; j < 4; ++j) xfA[j] = xfB[j];
#pragma unroll
            for (int j = 0; j < 2; ++j) { xbA[j] = xbB[j]; mwA[j] = mwB[j]; }
            ssA = ssB;
        }
#undef RP_X
    }
    for (; m < MT; m += NGW) {
        const bool sp = (sacc != nullptr) && (m >= MP); const float* sr = sp ? sacc + (size_t)(m - MP) * DM : nullptr;
        if constexpr (MODE == 0) { const float* xr = (m < MP) ? x_prompt + (size_t)m * DM : x_sample + (size_t)(m - MP) * DM;
            if (sp) row_pass<true, true, true, false, true>(xr, X16 + (size_t)m * DM, nullptr, nullptr, ns, gpost, gnext, Abuf + (size_t)m * DM, lane, sr, mbias);
            else row_pass<true, true, true, false>(xr, X16 + (size_t)m * DM, Mbuf + (size_t)m * DM, ss + (size_t)m * 32, nslots, gpost, gnext, Abuf + (size_t)m * DM, lane); }
        else if constexpr (MODE == 1) {
            if (sp && glu) row_pass<true, true, false, false, false, true>(X16 + (size_t)m * DM, X16 + (size_t)m * DM, nullptr, nullptr, ns, gpost, gnext, Abuf + (size_t)m * DM, lane, sacc + (size_t)(m - MP) * 2 * DM, mbias);
            else if (sp) row_pass<true, true, false, false, true>(X16 + (size_t)m * DM, X16 + (size_t)m * DM, nullptr, nullptr, ns, gpost, gnext, Abuf + (size_t)m * DM, lane, sr, mbias);
            else row_pass<true, true, false, false>(X16 + (size_t)m * DM, X16 + (size_t)m * DM, Mbuf + (size_t)m * DM, ss + (size_t)m * 32, nslots, gpost, gnext, Abuf + (size_t)m * DM, lane); }
        else {
            if (sp) row_pass<true, false, false, true, true>(X16 + (size_t)m * DM, out + (size_t)m * DM, nullptr, nullptr, ns, gpost, nullptr, nullptr, lane, sr, mbias);
            else row_pass<true, false, false, true>(X16 + (size_t)m * DM, out + (size_t)m * DM, Mbuf + (size_t)m * DM, ss + (size_t)m * 32, nslots, gpost, nullptr, nullptr, lane); }
    }
}
__device__ __forceinline__ void phase_up(LAS unsigned char* lds, const bf16_t* Abuf, const bf16_t* Wup_l, bf16_t* Gbuf, bf16_t* Ebuf, const float* cw, const float* cb, int G, int blk) {
    pg8::Gemm g{Abuf, Wup_l, MT, FF2, DM}; pg8::StaticOrder S; S.init(MT, FF2, DM, G, blk); S.wgm = UP_WGM;
    pg8::EpiUp E{Gbuf, Ebuf, cw, cb};
    pg8::gemm_phase<pg8::EpiUp, true, true>(lds, g, S, E);
}
__device__ __forceinline__ void phase_down(LAS unsigned char* lds, const bf16_t* Gbuf, const bf16_t* Wdn_l, bf16_t* Mbuf, float* ss, float* sacc, int G, int blk) {
    pg8::Gemm g{Gbuf, Wdn_l, MT, DM, FF}; pg8::StaticOrder S; S.init(MT, DM, FF, G, blk, MP / 256, 11);
    pg8::EpiPlainSS E{Mbuf, nullptr, ss, sacc, FF / 64};
    pg8::gemm_phase<pg8::EpiPlainSS, true, true>(lds, g, S, E);
}
__device__ __forceinline__ f32x4 ld_bf4(const bf16_t* p) { const u32x2 w = *(const u32x2*)p; return (f32x4){__uint_as_float(w.x << 16), __uint_as_float(w.x & 0xffff0000u), __uint_as_float(w.y << 16), __uint_as_float(w.y & 0xffff0000u)}; }
__device__ __forceinline__ void phase_fix(const bf16_t* Ebuf, bf16_t* Gbuf, const float* cw, const float* cb, const float* cc, float* out, int l, int G, int blk, int tid) {
    for (int i = blk * 512 + tid; i < NSEG * (FF / 4); i += G * 512) {
        const int seg = i / (FF / 4), c4 = (i % (FF / 4)) * 4;
        f32x4 c0r[2], c1r[2];
#pragma unroll
        for (int hf = 0; hf < 2; ++hf) {
            const int col = hf * FF + c4;
            const f32x4 cur0 = ld_bf4(Ebuf + ((size_t)seg * 4 + 0) * FF2 + col), cur1 = ld_bf4(Ebuf + ((size_t)seg * 4 + 1) * FF2 + col);
            f32x4 p0 = {0.f, 0.f, 0.f, 0.f}, p1 = {0.f, 0.f, 0.f, 0.f};
            if (seg >= MP / 64) { const int b = seg - MP / 64; p0 = *(const f32x4*)(cc + ((size_t)b * 2 + 0) * FF2 + col); p1 = *(const f32x4*)(cc + ((size_t)b * 2 + 1) * FF2 + col); }
            else if ((seg & 31) != 0) { p0 = ld_bf4(Ebuf + ((size_t)(seg - 1) * 4 + 2) * FF2 + col); p1 = ld_bf4(Ebuf + ((size_t)(seg - 1) * 4 + 3) * FF2 + col); }
            const f32x4 w0 = *(const f32x4*)(cw + col), w1 = *(const f32x4*)(cw + FF2 + col), w2 = *(const f32x4*)(cw + 2 * FF2 + col), bb = *(const f32x4*)(cb + col);
            c0r[hf] = bb + w0 * p0 + w1 * p1 + w2 * cur0;
            c1r[hf] = bb + w0 * p1 + w1 * cur0 + w2 * cur1;
        }
        f32x4 o0, o1;
#pragma unroll
        for (int q = 0; q < 4; ++q) { o0[q] = gelu_tanh(c0r[0][q]) * c0r[1][q]; o1[q] = gelu_tanh(c1r[0][q]) * c1r[1][q]; }
        u32x2 wv; wv.x = cvt_pk_bf16(o0[0], o0[1]); wv.y = cvt_pk_bf16(o0[2], o0[3]);
        *(u32x2*)(Gbuf + ((size_t)seg * 64 + 0) * FF + c4) = wv;
        wv.x = cvt_pk_bf16(o1[0], o1[1]); wv.y = cvt_pk_bf16(o1[2], o1[3]);
        *(u32x2*)(Gbuf + ((size_t)seg * 64 + 1) * FF + c4) = wv;
    }
    for (int i = blk * 512 + tid; i < (NB + DB) * 2 * (FF2 / 4); i += G * 512) {
        const int ri = i / (FF2 / 4), c4 = (i % (FF2 / 4)) * 4, bb = ri >> 1, e = ri & 1;
        const int seg = (bb < NB) ? bb * 32 + 31 : MP / 64 + (bb - NB);
        const f32x4 v = ld_bf4(Ebuf + ((size_t)seg * 4 + 2 + e) * FF2 + c4);
        float* o = (bb < NB) ? out + O_CP + (((size_t)l * NB + bb) * 2 + e) * FF2 + c4 : out + O_CS + (((size_t)l * DB + (bb - NB)) * 2 + e) * FF2 + c4;
        *(f32x4*)o = v;
    }
}

__global__ void __launch_bounds__(512, 2) fwd_kernel(Args args) {
    extern __shared__ __attribute__((aligned(16))) unsigned char lds_raw[];
    LAS unsigned char* lds = (LAS unsigned char*)lds_raw;
    const int G = gridDim.x, blk = blockIdx.x, NGW = G * 8;
#define IDS int tid = threadIdx.x; asm volatile("" : "+v"(tid)); const int lane = tid & 63, wave = __builtin_amdgcn_readfirstlane(tid >> 6), gw = blk * 8 + wave; (void)lane; (void)gw
    unsigned char* ws = args.ws; float* out = args.out;
    const float* x_prompt = args.in[0]; const float* x_sample = args.in[1];
    bf16_t* Wqkv = (bf16_t*)(ws + WS_WQKV); bf16_t* Wo = (bf16_t*)(ws + WS_WO); bf16_t* Wglu = (bf16_t*)(ws + WS_WGLU); bf16_t* Wup = (bf16_t*)(ws + WS_WUP); bf16_t* Wdn = (bf16_t*)(ws + WS_WDN);
    float* rope = (float*)(ws + WS_ROPE); float* ss = (float*)(ws + WS_SS);
    bf16_t* Abuf = (bf16_t*)(ws + WS_A); bf16_t* Mbuf = (bf16_t*)(ws + WS_MB); bf16_t* Ebuf = (bf16_t*)(ws + WS_E); bf16_t* Gbuf = (bf16_t*)(ws + WS_G);
    bf16_t* X16 = (bf16_t*)(ws + WS_X16); float* sacc = (float*)(ws + WS_SACC);
    bf16_t* Qbuf = (bf16_t*)(ws + WS_Q); bf16_t* Kbuf = (bf16_t*)(ws + WS_K); bf16_t* Vbuf = (bf16_t*)(ws + WS_V);


    const int lo = args.ph_lo, hi_ = args.ph_hi;
    volatile LAS unsigned* misc = (volatile LAS unsigned*)(lds + XL_MISC);
    if (threadIdx.x < 2) misc[threadIdx.x] = 0u;
    __syncthreads();
    XcdBarrier xbar; xbar.bar = (unsigned*)ws; xbar.x = 0; xbar.st = nullptr;
    if (args.coop) xbar = xcd_barrier_post((unsigned*)ws, misc);
    if (args.coop == 2) cg::this_grid().sync();
#define IN(k) (lo <= (k) && (k) < hi_)
#define SEAM(k) do { if (args.coop && (k) + 1 < hi_) xcd_barrier(xbar); } while (0)
#define REP(k) _Pragma("unroll") for (int rep_ = 0; rep_ <= ((PROBE_REPMASK >> (k)) & 1); ++rep_)
    if (IN(0)) { IDS; REP(0) { phase_prologue(lds, args, ws, out, G, blk, wave, lane, tid); } SEAM(0); }
    if (IN(1)) { REP(1) {
        pg8::Gemm g{Abuf, Wqkv, MT, QKVD, DM}; pg8::StaticOrder S; S.init(MT, QKVD, DM, G, blk);
        pg8::EpiQKV E{Qbuf, Kbuf, Vbuf, args.in[12], rope, out + O_KP, out + O_VP, out + O_KS, out + O_VS};
        pg8::gemm_phase<pg8::EpiQKV, true, true>(lds, g, S, E); } SEAM(1); }
    if (IN(2)) { REP(2) { attn_phase(lds, Qbuf, Kbuf, Vbuf, Abuf, args.in[13], G, blk); } SEAM(2); }
    const bool fusedp = (G == 256);
    unsigned long long* xch = (unsigned long long*)(ws + WS_XCH); unsigned* pcnt = (unsigned*)(ws + WS_CNT); LAS unsigned char* xl = lds + XL_OFF;
    if (IN(3)) { REP(3) {
        pg8::Gemm g{Abuf, Wo, MT, DM, DM}; pg8::StaticOrder S; S.init(MT, DM, DM, G, blk, MP / 256, 4);
        { pg8::EpiPlainSS E{Mbuf, args.in[15], ss, sacc, DM / 64}; pg8::gemm_phase<pg8::EpiPlainSS, true, true>(lds, g, S, E); } } SEAM(3); }
    bf16_t* Aup0 = Abuf;
    if (IN(4)) { IDS; REP(4) { phase_rows<0>(x_prompt, x_sample, X16, out, Mbuf, ss, 16, args.in[8], args.in[9], Aup0, gw, NGW, lane, sacc, args.in[15], 4, false); } SEAM(4); }
    if (IN(5)) { REP(5) { phase_up(lds, Aup0, Wup, Gbuf, Ebuf, args.in[27], args.in[28], G, blk); } SEAM(5); }
    if (IN(6)) { IDS; REP(6) { phase_fix(Ebuf, Gbuf, args.in[27], args.in[28], args.in[6], out, 0, G, blk, tid); } SEAM(6); }
    if (IN(7)) { REP(7) {
        if (fusedp) { pg8::Gemm g{Gbuf, Wdn, MT, DM, FF}; pg8::StaticOrder S; S.init(MT, DM, FF, G, blk, MP / 256, 11); S.panel = true;
            pg8::EpiFused<false, false> E{nullptr, X16, X16, nullptr, Abuf, args.in[10], args.in[7] + DM, xch + (size_t)MP * 8, pcnt + 256 * 64, xl, sacc, FF / 64};
            pg8::gemm_phase<pg8::EpiFused<false, false>, true, true>(lds, g, S, E); }
        else phase_down(lds, Gbuf, Wdn, Mbuf, ss, sacc, G, blk); } SEAM(7); }
    if (IN(8)) { IDS; REP(8) { phase_rows<1>(x_prompt, x_sample, X16, out, Mbuf, ss, 16, args.in[10], args.in[7] + DM, Abuf, gw, NGW, lane, sacc, nullptr, 11, fusedp); } SEAM(8); }
    if (IN(9)) { REP(9) {
        SsmP P{args.in[16], args.in[17], args.in[18], args.in[19], args.in[20], args.in[21], args.in[22], args.in[23], args.in[4], args.in[5], out + O_REP, out + O_IMP, out + O_RES, out + O_IMS};
        ssm_phase(lds, Abuf, Qbuf, P, G, blk); } SEAM(9); }
    if (IN(10)) { REP(10) {
        pg8::Gemm g{Qbuf, Wglu, MT, 2 * DM, DM}; pg8::StaticOrder S; S.init(MT, 2 * DM, DM, G, blk, MP / 256, 4);
        pg8::EpiGlu E{Mbuf, args.in[25], ss, sacc, DM / 64};
        pg8::gemm_phase<pg8::EpiGlu, true, true>(lds, g, S, E); } SEAM(10); }
    if (IN(11)) { IDS; REP(11) { phase_rows<1>(x_prompt, x_sample, X16, out, Mbuf, ss, 32, args.in[8] + DM, args.in[9] + DM, Abuf, gw, NGW, lane, sacc, args.in[25], 4, false, true); } SEAM(11); }
    if (IN(12)) { REP(12) { phase_up(lds, Abuf, Wup + (size_t)FF2 * DM, Gbuf, Ebuf, args.in[27] + (size_t)3 * FF2, args.in[28] + FF2, G, blk); } SEAM(12); }
    if (IN(13)) { IDS; REP(13) { phase_fix(Ebuf, Gbuf, args.in[27] + (size_t)3 * FF2, args.in[28] + FF2, args.in[6] + (size_t)DB * 2 * FF2, out, 1, G, blk, tid); } SEAM(13); }
    if (IN(14)) { REP(14) {
        if (fusedp) { pg8::Gemm g{Gbuf, Wdn + (size_t)DM * FF, MT, DM, FF}; pg8::StaticOrder S; S.init(MT, DM, FF, G, blk, MP / 256, 11); S.panel = true;
            pg8::EpiFused<false, true> E{nullptr, X16, nullptr, out, nullptr, args.in[10] + DM, nullptr, xch + (size_t)2 * MP * 8, pcnt + 2 * 256 * 64, xl, sacc, FF / 64};
            pg8::gemm_phase<pg8::EpiFused<false, true>, true, true>(lds, g, S, E); }
        else phase_down(lds, Gbuf, Wdn + (size_t)DM * FF, Mbuf, ss, sacc, G, blk); } SEAM(14); }
    if (IN(15)) { IDS; REP(15) { phase_rows<2>(x_prompt, x_sample, X16, out, Mbuf, ss, 16, args.in[10] + DM, nullptr, nullptr, gw, NGW, lane, sacc, nullptr, 11, fusedp); } }
#undef IN
#undef SEAM
#undef REP
}

extern "C" void kernel_launch(void* const* d_in, const int* in_sizes, int n_in, void* d_out, int out_size, void* d_ws, size_t ws_size, hipStream_t stream) {
    static int grid = 0;
    if (grid == 0) {
        if (n_in != 30 || (size_t)out_size != O_END || ws_size < WS_END) { fprintf(stderr, "kernel_launch: unexpected shapes: n_in %d out %d ws %zu (need out %zu ws %zu)\n", n_in, out_size, ws_size, (size_t)O_END, (size_t)WS_END); grid = -1; return; }
        int dev = 0, cus = 0, per_cu = 0;
        hipGetDevice(&dev); hipDeviceGetAttribute(&cus, hipDeviceAttributeMultiprocessorCount, dev);
        if (hipFuncSetAttribute((const void*)fwd_kernel, hipFuncAttributeMaxDynamicSharedMemorySize, LDS_BYTES) != hipSuccess) { fprintf(stderr, "kernel_launch: hipFuncSetAttribute failed\n"); grid = -1; return; }
        if (hipOccupancyMaxActiveBlocksPerMultiprocessor(&per_cu, (const void*)fwd_kernel, 512, LDS_BYTES) != hipSuccess || per_cu < 1) { fprintf(stderr, "kernel_launch: occupancy query says %d\n", per_cu); per_cu = 1; }
        (void)hipGetLastError();
        grid = cus * 1;
    }
    if (grid < 0) return;
    Args a{};
    for (int i = 0; i < 30; ++i) a.in[i] = (const float*)d_in[i];
    a.out = (float*)d_out; a.ws = (unsigned char*)d_ws;
#ifndef MK_MULTI
    if (hipMemsetAsync(d_ws, 0, CTL_ZERO_BYTES, stream) != hipSuccess) { fprintf(stderr, "kernel_launch: memset failed\n"); return; }
    a.ph_lo = 0; a.ph_hi = NPHASE; a.coop = 1;
    void* kargs[] = {&a};
    hipError_t e = hipLaunchCooperativeKernel((const void*)fwd_kernel, dim3(grid), dim3(512), kargs, LDS_BYTES, stream);
    if (e != hipSuccess) fprintf(stderr, "cooperative launch failed: %s (grid %d)\n", hipGetErrorString(e), grid);
#else
    for (int ph = 0; ph < NPHASE; ++ph) { a.ph_lo = ph; a.ph_hi = ph + 1; a.coop = 0; hipLaunchKernelGGL(fwd_kernel, dim3(grid), dim3(512), LDS_BYTES, stream, a); }
#endif
}
```
